# Optimizing an MI355X kernel written in HIP

```python
import jax, jax.numpy as jnp
from jax import lax
import numpy as np

D_MODEL = 1024
BATCH = 2
SEQ = 8192
DEPTH = 2

CHUNK = 64
N_MIXERS = 2
FOX_HEADS = 8
FOX_HEAD_DIM = D_MODEL // FOX_HEADS
Q_BLOCK = 128
RET_HEADS = 4
RET_QK_DIM = D_MODEL // RET_HEADS
RET_V_DIM = 2 * D_MODEL // RET_HEADS
D_FF = -(-8 * D_MODEL // (3 * 256)) * 256
ROPE_BASE = 10000.0
EPS = 1e-6
N_FOX_LAYERS = (DEPTH + 1) // 2
N_RET_LAYERS = DEPTH // 2

kernel_name = "fox_retnet_interleaved_trunk"


def rmsnorm(x, g):
    xf = x.astype(jnp.float32)
    y = xf * lax.rsqrt(jnp.mean(xf * xf, axis=-1, keepdims=True) + EPS)
    return (y * g.astype(jnp.float32)).astype(x.dtype)


def forgetting_attention(h, w_in, b_f, w_out):
    B, S, _ = h.shape
    H, dh = FOX_HEADS, FOX_HEAD_DIM
    proj = h @ w_in
    q = proj[..., :D_MODEL].reshape(B, S, H, dh).transpose(0, 2, 1, 3)
    k = proj[..., D_MODEL:2 * D_MODEL].reshape(B, S, H, dh).transpose(0, 2, 1, 3)
    v = proj[..., 2 * D_MODEL:3 * D_MODEL].reshape(B, S, H, dh).transpose(0, 2, 1, 3)
    log_f = jax.nn.log_sigmoid((proj[..., 3 * D_MODEL:] + b_f).astype(jnp.float32))
    c = jnp.cumsum(log_f, axis=1).transpose(0, 2, 1)
    nb = S // Q_BLOCK
    qb = q.reshape(B, H, nb, Q_BLOCK, dh).transpose(2, 0, 1, 3, 4)
    cb = c.reshape(B, H, nb, Q_BLOCK).transpose(2, 0, 1, 3)
    pos = jnp.arange(S)
    qpos = pos.reshape(nb, Q_BLOCK)
    scale = dh ** -0.5

    def block(args):
        qi, ci, pi = args
        s = jnp.einsum('bhqd,bhkd->bhqk', qi, k).astype(jnp.float32) * scale
        s = s + (ci[..., :, None] - c[:, :, None, :])
        s = jnp.where(pi[:, None] >= pos[None, :], s, -jnp.inf)
        p = jax.nn.softmax(s, axis=-1).astype(v.dtype)
        return jnp.einsum('bhqk,bhkd->bhqd', p, v)

    o = lax.map(block, (qb, cb, qpos))
    o = o.transpose(1, 0, 3, 2, 4).reshape(B, S, H * dh)
    return o @ w_out


def rotate(t, cos, sin):
    half = t.shape[-1] // 2
    t1, t2 = t[..., :half], t[..., half:]
    return jnp.concatenate([t1 * cos - t2 * sin, t1 * sin + t2 * cos], axis=-1)


def retention(h, w_in, w_out):
    B, S, _ = h.shape
    H, dk, dv, C = RET_HEADS, RET_QK_DIM, RET_V_DIM, CHUNK
    N = S // C
    proj = h @ w_in
    q = proj[..., :D_MODEL].reshape(B, S, H, dk)
    k = proj[..., D_MODEL:2 * D_MODEL].reshape(B, S, H, dk)
    v = proj[..., 2 * D_MODEL:4 * D_MODEL].reshape(B, S, H, dv)
    g = proj[..., 4 * D_MODEL:]
    half = dk // 2
    inv = ROPE_BASE ** (-jnp.arange(half, dtype=jnp.float32) / half)
    ang = jnp.arange(S, dtype=jnp.float32)[:, None] * inv[None, :]
    cos, sin = jnp.cos(ang)[:, None, :], jnp.sin(ang)[:, None, :]
    q = rotate(q.astype(jnp.float32), cos, sin)
    k = rotate(k.astype(jnp.float32), cos, sin) * (dk ** -0.5)
    v = v.astype(jnp.float32)
    log_gamma = jnp.log(jnp.asarray(1.0 - 2.0 ** (-5.0 - np.arange(H)), dtype=jnp.float32))
    idx = jnp.arange(C, dtype=jnp.float32)
    d_intra = jnp.exp(log_gamma[:, None, None] * jnp.abs(idx[:, None] - idx[None, :]))
    q_decay = jnp.exp(log_gamma[:, None] * (idx[None, :] + 1.0))
    k_decay = jnp.exp(log_gamma[:, None] * (C - 1.0 - idx[None, :]))
    chunk_decay = jnp.exp(log_gamma * C)
    to_chunks = lambda t: t.reshape(B, N, C, H, t.shape[-1]).transpose(1, 0, 3, 2, 4)
    qc, kc, vc = to_chunks(q), to_chunks(k), to_chunks(v)

    def step(state, inp):
        qi, ki, vi = inp
        a = jnp.einsum('bhid,bhjd->bhij', qi, ki) * d_intra
        inner = jnp.einsum('bhij,bhjv->bhiv', a, vi)
        cross = jnp.einsum('bhid,bhdv->bhiv', qi, state) * q_decay[None, :, :, None]
        new_state = state * chunk_decay[None, :, None, None] + jnp.einsum(
            'bhjd,bhjv->bhdv', ki * k_decay[None, :, :, None], vi)
        return new_state, inner + cross

    state0 = jnp.zeros((B, H, dk, dv), jnp.float32)
    _, y = lax.scan(step, state0, (qc, kc, vc))
    y = y.transpose(1, 0, 3, 2, 4).reshape(B, S, H, dv)
    mu = jnp.mean(y, axis=-1, keepdims=True)
    var = jnp.mean(jnp.square(y - mu), axis=-1, keepdims=True)
    y = ((y - mu) * lax.rsqrt(var + EPS)).reshape(B, S, H * dv).astype(h.dtype)
    return (jax.nn.silu(g) * y) @ w_out


def swiglu(h, w_in, w_out):
    gu = h @ w_in
    return (jax.nn.silu(gu[..., :D_FF]) * gu[..., D_FF:]) @ w_out


def setup_inputs(seed: int = 0) -> dict:
    key = jax.random.key(seed)
    ks = jax.random.split(key, 12)
    f32 = jnp.float32
    x = jax.random.normal(ks[0], (BATCH, SEQ, D_MODEL), f32)
    norm_mix = 1.0 + 0.02 * jax.random.normal(ks[1], (DEPTH, D_MODEL), f32)
    norm_ffn = 1.0 + 0.02 * jax.random.normal(ks[2], (DEPTH, D_MODEL), f32)
    fox_w_in = jax.random.normal(ks[3], (N_FOX_LAYERS, D_MODEL, 3 * D_MODEL + FOX_HEADS), f32) * D_MODEL ** -0.5
    fox_b_f = 3.0 + 0.5 * jax.random.normal(ks[4], (N_FOX_LAYERS, FOX_HEADS), f32)
    fox_w_out = jax.random.normal(ks[5], (N_FOX_LAYERS, D_MODEL, D_MODEL), f32) * D_MODEL ** -0.5
    ret_w_in = jax.random.normal(ks[6], (N_RET_LAYERS, D_MODEL, 6 * D_MODEL), f32) * D_MODEL ** -0.5
    ret_w_out = jax.random.normal(ks[7], (N_RET_LAYERS, 2 * D_MODEL, D_MODEL), f32) * (2 * D_MODEL) ** -0.5
    ffn_w_in = jax.random.normal(ks[8], (DEPTH, D_MODEL, 2 * D_FF), f32) * D_MODEL ** -0.5
    ffn_w_out = jax.random.normal(ks[9], (DEPTH, D_FF, D_MODEL), f32) * D_FF ** -0.5
    final_norm = 1.0 + 0.02 * jax.random.normal(ks[10], (D_MODEL,), f32)
    return {"x": x, "norm_mix": norm_mix, "norm_ffn": norm_ffn,
            "fox_w_in": fox_w_in, "fox_b_f": fox_b_f, "fox_w_out": fox_w_out,
            "ret_w_in": ret_w_in, "ret_w_out": ret_w_out,
            "ffn_w_in": ffn_w_in, "ffn_w_out": ffn_w_out, "final_norm": final_norm}


def reference(x, norm_mix, norm_ffn, fox_w_in, fox_b_f, fox_w_out, ret_w_in, ret_w_out,
              ffn_w_in, ffn_w_out, final_norm):
    for i in range(DEPTH):
        h = rmsnorm(x, norm_mix[i])
        j = i // N_MIXERS
        if i % N_MIXERS == 0:
            x = x + forgetting_attention(h, fox_w_in[j], fox_b_f[j], fox_w_out[j])
        else:
            x = x + retention(h, ret_w_in[j], ret_w_out[j])
        h = rmsnorm(x, norm_ffn[i])
        x = x + swiglu(h, ffn_w_in[i], ffn_w_out[i])
    return rmsnorm(x, final_norm)
```

```cpp
#define MK_N_LAUNCHES 13
#define FAST_ATTN 0
#define FAST_RET 0
#include <hip/hip_runtime.h>
#include <cstdio>
#include <cstdint>
#include <cmath>
namespace pg8 {
#define PG8_LAS __attribute__((address_space(3)))
typedef unsigned short bf16_t;
typedef short bf16x8 __attribute__((ext_vector_type(8)));
typedef float f32x4 __attribute__((ext_vector_type(4)));
typedef unsigned u32x4 __attribute__((ext_vector_type(4)));
constexpr int BM = 256, BK = 64, HALF = 128, HTB = HALF * BK * 2  , STAGE_BYTES = 8 * HTB, NXCD = 8, WGM = 8;

__host__ __device__ __forceinline__ int lds_byte(int r, int c) { const int st = (r >> 4) * 2 + (c >> 5), rr = r & 15, cc = c & 31, ob = rr * 64 + cc * 2; return st * 1024 + (ob ^ (((ob >> 9) & 1) << 5)); }
__host__ __device__ __forceinline__ void stage_rc(int b, int& R, int& C) { const int st = b / 1024, sb = b % 1024, swz = sb ^ (((sb >> 9) & 1) << 5); R = (st >> 1) * 16 + swz / 64; C = (st & 1) * 32 + (swz % 64) / 2; }
__host__ __device__ __forceinline__ int perm32(int rho) { const int n = rho >> 4, i = rho & 15; return 8 * (i >> 2) + 4 * n + (i & 3); }

struct Unit { int pm, pn; };
struct Gemm { const bf16_t* A; const bf16_t* Bt; int M, N, K; };

struct StaticOrder {
    int nM, nN, nwg, G, c;
    __host__ __device__ void init(int M, int N, int G_, int c_) { nM = M / BM; nN = N / BM; nwg = nM * nN; G = G_; c = c_; }
    __host__ __device__ bool next(int i, Unit& u) const {
        const long L = (long)i * G + c; if (L >= nwg) return false;
        int wgid = (int)L; { const int q = nwg / NXCD, r = nwg % NXCD, xcd = wgid % NXCD, off = wgid / NXCD; wgid = (xcd < r ? xcd * (q + 1) : r * (q + 1) + (xcd - r) * q) + off; }
        const int nig = WGM * nN, gid = wgid / nig, fm = gid * WGM, gsz = (nM - fm) < WGM ? (nM - fm) : WGM;
        u.pm = fm + ((wgid % nig) % gsz); u.pn = (wgid % nig) / gsz; return true;
    }
    __device__ __forceinline__ void a_ready(const Unit&) const {}
    __device__ __forceinline__ void done(const Unit&) const {}
};

__device__ __forceinline__ unsigned cvt_pk_bf16(float lo, float hi) { unsigned r; asm volatile("v_cvt_pk_bf16_f32 %0, %1, %2" : "=v"(r) : "v"(lo), "v"(hi)); return r; }
typedef float f32x2 __attribute__((ext_vector_type(2)));
__device__ __forceinline__ float silu_f(float x) { return x * __builtin_amdgcn_rcpf(1.0f + __builtin_amdgcn_exp2f(-1.4426950408889634f * x)); }
__device__ __forceinline__ u32x4 pack8f(const f32x4 v0, const f32x4 v1) { u32x4 w; w.x = cvt_pk_bf16(v0[0], v0[1]); w.y = cvt_pk_bf16(v0[2], v0[3]); w.z = cvt_pk_bf16(v1[0], v1[1]); w.w = cvt_pk_bf16(v1[2], v1[3]); return w; }
__device__ __forceinline__ float bf_lo(unsigned w) { return __builtin_bit_cast(float, w << 16); }
__device__ __forceinline__ float bf_hi(unsigned w) { return __builtin_bit_cast(float, w & 0xffff0000u); }

struct EpiQKV0 {
    static constexpr bool PERM = true, AFTER_DRAIN = false;
    bf16_t* Q; const PG8_LAS float* tab; float qscale;
    __device__ __forceinline__ void operator()(const f32x4 (&acc)[2][2][4][2], const Unit& u, int ui, int wr, int wc, int fr, int fq) const {
        const int colt = u.pn * BM, t = colt >> 10; bf16_t* base = Q + (size_t)t * ((size_t)16384 * 1024);
        const int cb = (colt & 1023) + wc * 32 + 8 * fq; const float sc = t == 0 ? qscale : 1.f;
#pragma unroll
        for (int ai = 0; ai < 2; ++ai)
#pragma unroll
            for (int m = 0; m < 4; ++m) { const int rl = ai * HALF + wr * 64 + m * 16 + fr; const float rs = tab[ui * 256 + rl] * sc;
                bf16_t* rowp = base + (size_t)(u.pm * BM + rl) * 1024 + cb;
#pragma unroll
                for (int bj = 0; bj < 2; ++bj) *(u32x4*)(rowp + bj * HALF) = pack8f(acc[ai][bj][m][0] * rs, acc[ai][bj][m][1] * rs); }
    }
};
struct EpiRes {
    static constexpr bool PERM = false, AFTER_DRAIN = false;
    const float* base; float* out; bf16_t* xb; float* ssq;
    __device__ __forceinline__ void operator()(const f32x4 (&acc)[2][2][4][2], const Unit& u, int ui, int wr, int wc, int fr, int fq) const {
        typedef unsigned u32x2v __attribute__((ext_vector_type(2)));
        const int col0 = u.pn * BM + wc * 32 + 4 * fq;
#pragma unroll
        for (int ai = 0; ai < 2; ++ai)
#pragma unroll
            for (int m = 0; m < 4; ++m) { const int row = u.pm * BM + ai * HALF + wr * 64 + m * 16 + fr; const size_t off = (size_t)row * 1024 + col0; float s = 0.f;
#pragma unroll
                for (int bj = 0; bj < 2; ++bj)
#pragma unroll
                    for (int n = 0; n < 2; ++n) { const f32x4 b = *(const f32x4*)(base + off + bj * HALF + n * 16); const f32x4 o = b + acc[ai][bj][m][n];
                        *(f32x4*)(out + off + bj * HALF + n * 16) = o; s += (o[0] * o[0] + o[1] * o[1]) + (o[2] * o[2] + o[3] * o[3]);
                        u32x2v w; w.x = cvt_pk_bf16(o[0], o[1]); w.y = cvt_pk_bf16(o[2], o[3]); *(u32x2v*)(xb + off + bj * HALF + n * 16) = w; }
                s += __shfl_xor(s, 16); s += __shfl_xor(s, 32);
                if (fq == 0) ssq[(size_t)row * 16 + u.pn * 4 + wc] = s;
                if (m & 1) asm volatile("" ::: "memory"); }
    }
};
struct EpiSwiGLU {
    static constexpr bool PERM = true, AFTER_DRAIN = false;
    bf16_t* Hd; const PG8_LAS float* tab;
    __device__ __forceinline__ void operator()(const f32x4 (&acc)[2][2][4][2], const Unit& u, int ui, int wr, int wc, int fr, int fq) const {
        const int hc0 = u.pn * HALF + wc * 32 + 8 * fq;
#pragma unroll
        for (int ai = 0; ai < 2; ++ai)
#pragma unroll
            for (int m = 0; m < 4; ++m) { const int rl = ai * HALF + wr * 64 + m * 16 + fr; const float rs = tab[ui * 256 + rl];
                f32x4 h0, h1;
#pragma unroll
                for (int e = 0; e < 4; ++e) { h0[e] = silu_f(acc[ai][0][m][0][e] * rs) * (acc[ai][1][m][0][e] * rs); h1[e] = silu_f(acc[ai][0][m][1][e] * rs) * (acc[ai][1][m][1][e] * rs); }
                *(u32x4*)(Hd + (size_t)(u.pm * BM + rl) * 2816 + hc0) = pack8f(h0, h1); }
    }
};
struct EpiRet {
    static constexpr bool PERM = true, AFTER_DRAIN = false;
    bf16_t* Q; bf16_t* Kp; bf16_t* V; const float* rope; const PG8_LAS float* tab;
    __device__ __forceinline__ void operator()(const f32x4 (&acc)[2][2][4][2], const Unit& u, int ui, int wr, int wc, int fr, int fq) const {
        if (u.pn < 8) {
            const bool isk = u.pn >= 4; const int head = u.pn & 3; bf16_t* dst = isk ? Kp : Q; const float sc = isk ? 0.0625f : 1.f; const int i0 = wc * 32 + 8 * fq;
#pragma unroll
            for (int ai = 0; ai < 2; ++ai)
#pragma unroll
                for (int m = 0; m < 4; ++m) { const int rl = ai * HALF + wr * 64 + m * 16 + fr, row = u.pm * BM + rl; const float rs = tab[ui * 256 + rl] * sc;
                    const f32x4* rp = (const f32x4*)(rope + ((size_t)(row & 8191) * 128 + i0) * 2);
                    f32x4 o1[2], o2[2];
#pragma unroll
                    for (int n = 0; n < 2; ++n) { const f32x4 t1 = acc[ai][0][m][n] * rs, t2 = acc[ai][1][m][n] * rs; const f32x4 ca = rp[2 * n], cb = rp[2 * n + 1];
                        o1[n][0] = t1[0] * ca[0] - t2[0] * ca[1]; o2[n][0] = t1[0] * ca[1] + t2[0] * ca[0];
                        o1[n][1] = t1[1] * ca[2] - t2[1] * ca[3]; o2[n][1] = t1[1] * ca[3] + t2[1] * ca[2];
                        o1[n][2] = t1[2] * cb[0] - t2[2] * cb[1]; o2[n][2] = t1[2] * cb[1] + t2[2] * cb[0];
                        o1[n][3] = t1[3] * cb[2] - t2[3] * cb[3]; o2[n][3] = t1[3] * cb[3] + t2[3] * cb[2]; }
                    bf16_t* rowp = dst + (size_t)row * 1024 + head * 256 + i0;
                    *(u32x4*)(rowp) = pack8f(o1[0], o1[1]); *(u32x4*)(rowp + HALF) = pack8f(o2[0], o2[1]);
                    if (m & 1) asm volatile("" ::: "memory"); }
        } else {
            const int cb = (u.pn - 8) * BM + wc * 32 + 8 * fq;
#pragma unroll
            for (int ai = 0; ai < 2; ++ai)
#pragma unroll
                for (int m = 0; m < 4; ++m) { const int rl = ai * HALF + wr * 64 + m * 16 + fr; const float rs = tab[ui * 256 + rl];
                    bf16_t* rowp = V + (size_t)(u.pm * BM + rl) * 2048 + cb;
#pragma unroll
                    for (int bj = 0; bj < 2; ++bj) *(u32x4*)(rowp + bj * HALF) = pack8f(acc[ai][bj][m][0] * rs, acc[ai][bj][m][1] * rs); }
        }
    }
};
struct EpiGate {
    static constexpr bool PERM = true, AFTER_DRAIN = false;
    bf16_t* Y; const PG8_LAS float* tab; const PG8_LAS f32x2* stab;
    __device__ __forceinline__ void operator()(const f32x4 (&acc)[2][2][4][2], const Unit& u, int ui, int wr, int wc, int fr, int fq) const {
        const int cb = u.pn * BM + wc * 32 + 8 * fq;
#pragma unroll
        for (int ai = 0; ai < 2; ++ai)
#pragma unroll
            for (int m = 0; m < 4; ++m) { const int rl = ai * HALF + wr * 64 + m * 16 + fr; const float rs = tab[ui * 256 + rl]; const f32x2 st = stab[ui * 256 + rl];
                bf16_t* rowp = Y + (size_t)(u.pm * BM + rl) * 2048 + cb;
#pragma unroll
                for (int bj = 0; bj < 2; ++bj) { const u32x4 yv = *(const u32x4*)(rowp + bj * HALF); f32x4 y0, y1;
                    y0[0] = bf_lo(yv.x); y0[1] = bf_hi(yv.x); y0[2] = bf_lo(yv.y); y0[3] = bf_hi(yv.y); y1[0] = bf_lo(yv.z); y1[1] = bf_hi(yv.z); y1[2] = bf_lo(yv.w); y1[3] = bf_hi(yv.w);
                    f32x4 g0 = acc[ai][bj][m][0] * rs, g1 = acc[ai][bj][m][1] * rs;
#pragma unroll
                    for (int e = 0; e < 4; ++e) { g0[e] = silu_f(g0[e]) * ((y0[e] - st.x) * st.y); g1[e] = silu_f(g1[e]) * ((y1[e] - st.x) * st.y); }
                    *(u32x4*)(rowp + bj * HALF) = pack8f(g0, g1); } }
    }
};
template <class Epi, class Sched, bool ALIGN_EPI = false, bool SP2 = false>
__device__ __forceinline__ void gemm_phase(PG8_LAS unsigned char* lds, const Gemm g, const Sched& S, const Epi& E) {
    int tid_ = threadIdx.x; asm volatile("" : "+v"(tid_));
    const int tid = tid_, wid = __builtin_amdgcn_readfirstlane(tid >> 6), lane = tid & 63, wr = wid >> 2, wc = wid & 3, fr = lane & 15, fq = lane >> 4;
    const int K = g.K, nt = K / BK;
    unsigned voffA[2], voffB[2];
#pragma unroll
    for (int i = 0; i < 2; ++i) { int R, C; stage_rc(tid * 16 + i * 8192, R, C); const int Rb = Epi::PERM ? ((R & ~31) + perm32(R & 31)) : R;
        voffA[i] = (unsigned)(R * K + C) * 2u; voffB[i] = (unsigned)(Rb * K + C) * 2u; }
    const size_t kstep = (size_t)(BK * 2);
    const size_t hstep = (size_t)HALF * K * 2;
    const size_t tstep = 2 * hstep;
    const unsigned ldsw = (unsigned)wid * 1024u;
    const int aoff = lds_byte(wr * 64 + fr, fq * 8), boff = lds_byte(wc * 32 + fr, fq * 8);
#define PG8_SA(b, h) (((b) * 2 + (h)) * HTB)
#define PG8_SB(b, h) ((4 + (b) * 2 + (h)) * HTB)
#define PG8_STAGE(bufoff, gbase, voff) do { _Pragma("unroll") for (int _i = 0; _i < 2; ++_i) \
        __builtin_amdgcn_global_load_lds((const unsigned*)((const char*)(gbase) + (voff)[_i]), (PG8_LAS unsigned*)(lds + (bufoff) + ldsw + _i * 8192), 16, 0, 0); } while (0)
#define PG8_LDA(dst, b, h) do { _Pragma("unroll") for (int m = 0; m < 4; ++m) _Pragma("unroll") for (int k = 0; k < 2; ++k) dst[m][k] = *(const PG8_LAS bf16x8*)(lds + PG8_SA(b, h) + aoff + m * 2048 + k * 1024); } while (0)
#define PG8_LDB(dst, b, h) do { _Pragma("unroll") for (int n = 0; n < 2; ++n) _Pragma("unroll") for (int k = 0; k < 2; ++k) dst[n][k] = *(const PG8_LAS bf16x8*)(lds + PG8_SB(b, h) + boff + n * 2048 + k * 1024); } while (0)
#define PG8_MMA(ai, bj, At, Bt) do { __builtin_amdgcn_s_setprio(1); _Pragma("unroll") for (int m = 0; m < 4; ++m) _Pragma("unroll") for (int n = 0; n < 2; ++n) _Pragma("unroll") for (int k = 0; k < 2; ++k) \
        acc[ai][bj][m][n] = __builtin_amdgcn_mfma_f32_16x16x32_bf16(Bt[n][k], At[m][k], acc[ai][bj][m][n], 0, 0, 0); __builtin_amdgcn_s_setprio(0); } while (0)
#define PG8_WAIT_V(n) asm volatile("s_waitcnt vmcnt(" #n ")" ::: "memory")
#define PG8_WAIT_L(n) asm volatile("s_waitcnt lgkmcnt(" #n ")" ::: "memory")
#define PG8_BAR __builtin_amdgcn_s_barrier()
#define PG8_SCHED __builtin_amdgcn_sched_barrier(0)
    Unit cur, nxt; int ui = 0;
    if (!S.next(0, cur)) return;
    f32x4 acc[2][2][4][2];
#pragma unroll
    for (int a = 0; a < 2; ++a)
#pragma unroll
        for (int b = 0; b < 2; ++b)
#pragma unroll
            for (int m = 0; m < 4; ++m)
#pragma unroll
                for (int n = 0; n < 2; ++n) acc[a][b][m][n] = (f32x4){0.f, 0.f, 0.f, 0.f};
    bf16x8 At[4][2], B0[2][2], B1[2][2];
    const char* cA = (const char*)g.A + (size_t)cur.pm * tstep; const char* cB = (const char*)g.Bt + (size_t)cur.pn * tstep;
    S.a_ready(cur);
    if constexpr (SP2) {
        PG8_STAGE(PG8_SB(0, 0), cB, voffB); PG8_STAGE(PG8_SB(0, 1), cB + hstep, voffB); PG8_STAGE(PG8_SA(0, 0), cA, voffA); PG8_STAGE(PG8_SA(0, 1), cA + hstep, voffA);
        if (wr == 1) PG8_BAR;
        PG8_WAIT_V(2); PG8_BAR;
        PG8_STAGE(PG8_SB(1, 0), cB + kstep, voffB); PG8_STAGE(PG8_SA(1, 0), cA + kstep, voffA); PG8_STAGE(PG8_SB(1, 1), cB + hstep + kstep, voffB);
        PG8_WAIT_V(6); PG8_BAR;
    } else {
        PG8_STAGE(PG8_SB(0, 0), cB, voffB); PG8_STAGE(PG8_SA(0, 0), cA, voffA); PG8_STAGE(PG8_SB(0, 1), cB + hstep, voffB); PG8_STAGE(PG8_SA(0, 1), cA + hstep, voffA);
        if (wr == 1) PG8_BAR;
        PG8_WAIT_V(4); PG8_BAR;
        PG8_STAGE(PG8_SB(1, 0), cB + kstep, voffB); PG8_STAGE(PG8_SA(1, 0), cA + kstep, voffA); PG8_STAGE(PG8_SB(1, 1), cB + hstep + kstep, voffB);
        PG8_WAIT_V(6); PG8_BAR;
    }
    for (;;) {
        const bool has_next = S.next(ui + 1, nxt);
        const char* nA = has_next ? (const char*)g.A + (size_t)nxt.pm * tstep : cA; const char* nB = has_next ? (const char*)g.Bt + (size_t)nxt.pn * tstep : cB;
        for (int t = 0; t < nt; t += 2) {
            const bool last = (t == nt - 2);
            const char* a1 = cA + (size_t)(t + 1) * kstep;
            const char* a2 = last ? nA : cA + (size_t)(t + 2) * kstep; const char* b2 = last ? nB : cB + (size_t)(t + 2) * kstep;
            const char* a3 = a2 + kstep; const char* b3 = b2 + kstep;
            if (last && has_next) S.a_ready(nxt);
            if constexpr (SP2) {
            PG8_LDB(B0, 0, 0); PG8_LDB(B1, 0, 1); PG8_SCHED; PG8_LDA(At, 0, 0); PG8_STAGE(PG8_SA(1, 1), a1 + hstep, voffA);
            PG8_WAIT_V(8); PG8_WAIT_L(0); PG8_BAR; PG8_MMA(0, 0, At, B0); PG8_MMA(0, 1, At, B1); PG8_BAR; PG8_SCHED;
            PG8_LDA(At, 0, 1); PG8_STAGE(PG8_SB(0, 0), b2, voffB); PG8_STAGE(PG8_SB(0, 1), b2 + hstep, voffB); PG8_STAGE(PG8_SA(0, 0), a2, voffA);
            PG8_WAIT_V(8); PG8_WAIT_L(0); PG8_BAR; PG8_MMA(1, 0, At, B0); PG8_MMA(1, 1, At, B1); PG8_BAR; PG8_SCHED;
            PG8_LDB(B0, 1, 0); PG8_LDB(B1, 1, 1); PG8_SCHED; PG8_LDA(At, 1, 0); PG8_STAGE(PG8_SA(0, 1), a2 + hstep, voffA);
            PG8_WAIT_V(8); PG8_WAIT_L(0); PG8_BAR; PG8_MMA(0, 0, At, B0); PG8_MMA(0, 1, At, B1); PG8_BAR; PG8_SCHED;
            PG8_LDA(At, 1, 1); PG8_STAGE(PG8_SB(1, 0), b3, voffB); PG8_STAGE(PG8_SB(1, 1), b3 + hstep, voffB); PG8_STAGE(PG8_SA(1, 0), a3, voffA);
            PG8_WAIT_V(8); PG8_WAIT_L(0); PG8_BAR; PG8_MMA(1, 0, At, B0); PG8_MMA(1, 1, At, B1); PG8_BAR; PG8_SCHED;
            } else {
            PG8_LDB(B0, 0, 0); PG8_SCHED; PG8_LDA(At, 0, 0); PG8_STAGE(PG8_SA(1, 1), a1 + hstep, voffA);
            PG8_WAIT_L(8); PG8_BAR; PG8_WAIT_L(0); PG8_MMA(0, 0, At, B0); PG8_BAR; PG8_SCHED;
            PG8_LDB(B1, 0, 1); PG8_STAGE(PG8_SB(0, 0), b2, voffB);
            PG8_BAR; PG8_WAIT_L(0); PG8_MMA(0, 1, At, B1); PG8_BAR;
            PG8_LDA(At, 0, 1); PG8_STAGE(PG8_SA(0, 0), a2, voffA);
            PG8_BAR; PG8_WAIT_L(0); PG8_MMA(1, 0, At, B0); PG8_BAR; PG8_SCHED;
            PG8_STAGE(PG8_SB(0, 1), b2 + hstep, voffB);
            PG8_WAIT_V(6); PG8_BAR; PG8_MMA(1, 1, At, B1); PG8_BAR;
            PG8_LDB(B0, 1, 0); PG8_SCHED; PG8_LDA(At, 1, 0); PG8_STAGE(PG8_SA(0, 1), a2 + hstep, voffA);
            PG8_WAIT_L(8); PG8_BAR; PG8_WAIT_L(0); PG8_MMA(0, 0, At, B0); PG8_BAR; PG8_SCHED;
            PG8_LDB(B1, 1, 1); PG8_STAGE(PG8_SB(1, 0), b3, voffB);
            PG8_BAR; PG8_WAIT_L(0); PG8_MMA(0, 1, At, B1); PG8_BAR;
            PG8_LDA(At, 1, 1); PG8_STAGE(PG8_SA(1, 0), a3, voffA);
            PG8_BAR; PG8_WAIT_L(0); PG8_MMA(1, 0, At, B0); PG8_BAR; PG8_SCHED;
            PG8_STAGE(PG8_SB(1, 1), b3 + hstep, voffB);
            PG8_WAIT_V(6); PG8_BAR; PG8_MMA(1, 1, At, B1); PG8_BAR;
            }
        }
        if constexpr (ALIGN_EPI) { if (wr == 0) PG8_BAR; }
        if constexpr (!Epi::AFTER_DRAIN) { E(acc, cur, ui, wr, wc, fr, fq); S.done(cur); }
        if (!has_next) break;
#pragma unroll
        for (int a = 0; a < 2; ++a)
#pragma unroll
            for (int b = 0; b < 2; ++b)
#pragma unroll
                for (int m = 0; m < 4; ++m)
#pragma unroll
                    for (int n = 0; n < 2; ++n) acc[a][b][m][n] = (f32x4){0.f, 0.f, 0.f, 0.f};
        cur = nxt; cA = nA; cB = nB; ++ui;
        if constexpr (ALIGN_EPI) { if (wr == 1) PG8_BAR; }
    }
    PG8_WAIT_V(0);
    if constexpr (!ALIGN_EPI) { if (wr == 0) PG8_BAR; }
    PG8_BAR;
    if constexpr (Epi::AFTER_DRAIN) { E.fused(acc, cur, wr, wc, fr, fq, lds, wid, lane); S.done(cur); }
#undef PG8_SA
#undef PG8_SB
#undef PG8_STAGE
#undef PG8_LDA
#undef PG8_LDB
#undef PG8_MMA
#undef PG8_WAIT_V
#undef PG8_WAIT_L
#undef PG8_BAR
#undef PG8_SCHED
}
}
constexpr int NWAVES = 8;
constexpr int BATCH = 2, SEQ = 8192, D = 1024, M = BATCH * SEQ;
constexpr int FH = 8, FDH = 128;
constexpr int RH = 4, RDK = 256, RDV = 512, CH = 64, NCH = SEQ / CH;
constexpr int DFF = 2816;
constexpr float EPS = 1e-6f;
constexpr float LOG2E = 1.4426950408889634f;
constexpr float QSCALE = 0.08838834764831845f * LOG2E;
constexpr int NPHASE = 13;

constexpr size_t MiB = 1u << 20;
constexpr size_t WS_CTL = 0, CTL_ZERO_BYTES = 1 * MiB;
constexpr size_t WS_SSQ = 1 * MiB;
constexpr size_t WS_LC = 2 * MiB;
constexpr size_t WS_TT = 2 * MiB + 512 * 1024;
constexpr size_t WS_ROPE = 3 * MiB;
constexpr size_t WS_WQKV0 = 11 * MiB;
constexpr size_t WS_WO0 = 17 * MiB;
constexpr size_t WS_WFI0 = 19 * MiB;
constexpr size_t WS_WFO0 = 30 * MiB;
constexpr size_t WS_WRI = 36 * MiB;
constexpr size_t WS_WRO = 48 * MiB;
constexpr size_t WS_WFI1 = 52 * MiB;
constexpr size_t WS_WFO1 = 63 * MiB;
constexpr size_t WS_XB = 69 * MiB;
constexpr size_t WS_ACT = 101 * MiB;
constexpr size_t WS_Q0 = WS_ACT, WS_K0 = WS_ACT + 32 * MiB, WS_V0 = WS_ACT + 64 * MiB;
constexpr size_t WS_HID = WS_ACT;
constexpr size_t WS_Q1 = WS_ACT, WS_K1 = WS_ACT + 32 * MiB, WS_V1 = WS_ACT + 64 * MiB;
constexpr size_t WS_PST = WS_ACT + 128 * MiB;
constexpr size_t WS_END = WS_PST + 8 * MiB;
static_assert(WS_WFO1 + (size_t)1024 * 2816 * 2 <= WS_XB && WS_HID + (size_t)M * DFF * 2 <= WS_PST && WS_END <= 256 * MiB, "d_ws map");
constexpr int CW_TMO = 0, CW_CODE = 1;
constexpr int CW_BAR = 4096;

constexpr int RING_OFF = 0, RING_BYTES = 131072;
constexpr int LDSCTL_OFF = RING_BYTES, MISC_OFF = LDSCTL_OFF + 320;
constexpr int TAB_OFF = RING_BYTES + 512;
constexpr int STAB_OFF = TAB_OFF + 8192;
constexpr int LDS_BYTES = 147456;
static_assert(STAB_OFF + 4096 <= LDS_BYTES, "LDS map");
#define GAS __attribute__((address_space(1)))
#define LAS __attribute__((address_space(3)))
typedef unsigned short bf16;
typedef unsigned v4u __attribute__((ext_vector_type(4)));
typedef float f32x4 __attribute__((ext_vector_type(4)));
typedef short bf16x8 __attribute__((ext_vector_type(8)));
typedef GAS unsigned gu32;
typedef GAS unsigned long long gu64;
#define RLX_AGENT __ATOMIC_RELAXED, __HIP_MEMORY_SCOPE_AGENT
#define LDS_WAIT() asm volatile("s_waitcnt lgkmcnt(0)" ::: "memory")
#define VM_WAIT() asm volatile("s_waitcnt vmcnt(0)" ::: "memory")
__device__ __forceinline__ unsigned long long rt() { return __builtin_amdgcn_s_memrealtime(); }
__device__ __forceinline__ unsigned f2bf(float f) { unsigned u = __builtin_bit_cast(unsigned, f); return (u + 0x7fffu + ((u >> 16) & 1u)) >> 16; }
__device__ __forceinline__ unsigned pk2(float lo, float hi) { return f2bf(lo) | (f2bf(hi) << 16); }
typedef float f32x2 __attribute__((ext_vector_type(2)));
#define XB_TMO      128
#define XB_XCNT(j)  (256  + 64 * (j))
#define XB_XSUB(j)  (1280 + 64 * (j))
#define XB_XGEN(j)  (2304 + 64 * (j))
#define XB_TOP      3328
#define XB_TOPGEN   3392
#define XCD_BAR_WORDS 3456
#define XB_SPIN_CAP (1u << 18)

__device__ __forceinline__ unsigned xb_ld(unsigned* p)              { return __hip_atomic_load(p, __ATOMIC_RELAXED, __HIP_MEMORY_SCOPE_AGENT); }
__device__ __forceinline__ unsigned xb_add(unsigned* p, unsigned v) { return __hip_atomic_fetch_add(p, v, __ATOMIC_RELAXED, __HIP_MEMORY_SCOPE_AGENT); }
__device__ __forceinline__ unsigned xb_xcc_id() { return (unsigned)__builtin_amdgcn_s_getreg((3 << 11) | 20) & 0xFu; }
#define XB_SPIN(cond, bar) do { unsigned _sp = 0; while (cond) { __builtin_amdgcn_s_sleep(1); \
    if ((++_sp & 255u) == 0u) { if (xb_ld(&(bar)[XB_TMO])) break; if (_sp > XB_SPIN_CAP) { atomicAdd(&(bar)[XB_TMO], 1u); break; } } } } while (0)

struct XcdBarrier {
    unsigned* bar; unsigned x;
    volatile LAS unsigned* st;
};

__device__ __forceinline__ XcdBarrier xcd_barrier_post(unsigned* bar, volatile LAS unsigned* st) {
    XcdBarrier b; b.bar = bar; b.x = xb_xcc_id(); b.st = st;
    if (threadIdx.x == 0) (void)xb_add(&bar[XB_XCNT(b.x)], 1u);
    return b;
}
__device__ __forceinline__ void xcd_barrier_complete(unsigned* bar, unsigned x, unsigned& nloc, unsigned& nx) {
    const unsigned G = gridDim.x * gridDim.y * gridDim.z;
    unsigned sum, cnt, mine, sp = 0u;
    for (;;) {
        sum = 0u; cnt = 0u; mine = 0u;
#pragma unroll
        for (unsigned j = 0; j < 16; ++j) { const unsigned c = xb_ld(&bar[XB_XCNT(j)]); sum += c; cnt += (c > 0u) ? 1u : 0u; mine = (j == x) ? c : mine; }
        if (sum == G) break;
        __builtin_amdgcn_s_sleep(1);
        if ((++sp & 255u) == 0u) { if (xb_ld(&bar[XB_TMO])) break; if (sp > XB_SPIN_CAP) { atomicAdd(&bar[XB_TMO], 1u); break; } }
    }
    nloc = mine > 0u ? mine : 1u; nx = cnt > 0u ? cnt : 1u;
}

__device__ __forceinline__ void xcd_barrier(const XcdBarrier& b) {
    asm volatile("s_waitcnt vmcnt(0)" ::: "memory");
    __syncthreads();
    if (threadIdx.x == 0) {
        unsigned* bar = b.bar;
        __builtin_amdgcn_s_waitcnt(0);
        unsigned nloc = b.st[0], nx = b.st[1];
        if (nloc == 0u) { xcd_barrier_complete(bar, b.x, nloc, nx); b.st[0] = nloc; b.st[1] = nx; }
        const unsigned old = xb_add(&bar[XB_XSUB(b.x)], 1u);
        const unsigned gen = old / nloc;
        if (old + 1u == (gen + 1u) * nloc) {
            __builtin_amdgcn_fence(__ATOMIC_RELEASE, "agent");
            asm volatile("s_waitcnt vmcnt(0)" ::: "memory");
            const unsigned og = xb_add(&bar[XB_TOP], 1u);
            const unsigned tg = og / nx;
            if (og + 1u == (tg + 1u) * nx) xb_add(&bar[XB_TOPGEN], 1u);
            else XB_SPIN(xb_ld(&bar[XB_TOPGEN]) == tg, bar);
            __builtin_amdgcn_fence(__ATOMIC_ACQUIRE, "agent");
            xb_add(&bar[XB_XGEN(b.x)], 1u);
            asm volatile("s_waitcnt vmcnt(0)" ::: "memory");
        } else {
            XB_SPIN(xb_ld(&bar[XB_XGEN(b.x)]) == gen, bar);
            __builtin_amdgcn_fence(__ATOMIC_ACQUIRE, "agent");
            asm volatile("s_waitcnt vmcnt(0)" ::: "memory");
        }
    }
    __syncthreads();
}
struct Frame {
    LAS unsigned char* lds;
    volatile LAS unsigned* MISC;
    gu32* ctl;
    int tid, lane, wave;
    int vcu, G;
    const float *x, *norm_mix, *norm_ffn, *fox_w_in, *fox_b_f, *fox_w_out, *ret_w_in, *ret_w_out, *ffn_w_in, *ffn_w_out, *final_norm;
    float* out; unsigned char* ws;
};
__device__ __forceinline__ float wave_sum(float v) {
#pragma unroll
    for (int o = 1; o < 64; o <<= 1) v += __shfl_xor(v, o);
    return v;
}

__device__ __forceinline__ void p0_item(const float* W, int K, int Nsrc, int scol0, bf16* WT, int drow0, int k0, const float* g, LAS float* scr, int lane) {
#pragma unroll 8
    for (int i = 0; i < 32; ++i) { const int kk = 2 * i + (lane >> 5); const float gv = g ? g[k0 + kk] : 1.f; scr[kk * 33 + (lane & 31)] = W[(size_t)(k0 + kk) * Nsrc + scol0 + (lane & 31)] * gv; }
    LDS_WAIT(); asm volatile("" ::: "memory");
    const int c = lane & 7;
#pragma unroll
    for (int j = 0; j < 4; ++j) { const int n = (lane >> 3) + 8 * j; const LAS float* s = scr + (8 * c) * 33 + n;
        v4u o; o.x = pk2(s[0 * 33], s[1 * 33]); o.y = pk2(s[2 * 33], s[3 * 33]); o.z = pk2(s[4 * 33], s[5 * 33]); o.w = pk2(s[6 * 33], s[7 * 33]);
        *(GAS v4u*)(WT + (size_t)(drow0 + n) * K + k0 + 8 * c) = o; }
    LDS_WAIT(); asm volatile("" ::: "memory");
}
__device__ __forceinline__ void p0_matrix(int r, const float* W, int K, int N, int Nsrc, bool swiglu, bf16* WT, const float* g, LAS float* scr, int lane) {
    const int nblk = N / 32, kb = r / nblk, nb = r % nblk, drow0 = 32 * nb;
    int scol0 = drow0;
    if (swiglu) { const int t = drow0 >> 8, rr = drow0 & 255; scol0 = (rr < 128) ? t * 128 + rr : DFF + t * 128 + (rr - 128); }
    p0_item(W, K, Nsrc, scol0, WT, drow0, 64 * kb, g, scr, lane);
}
__device__ __forceinline__ void p0_xtile(Frame& F, int tile) {
    LAS float* wfs = (LAS float*)(F.lds);
    LAS float* tot = (LAS float*)(F.lds + 32768);
    for (int idx = F.tid; idx < 8192; idx += NWAVES * 64) { const int k = idx >> 3, h = idx & 7; wfs[idx] = F.fox_w_in[(size_t)k * 3080 + 3072 + h] * F.norm_mix[k]; }
    __syncthreads();
    float run[8], mine[8], bfv[8];
#pragma unroll
    for (int h = 0; h < 8; ++h) { run[h] = 0.f; mine[h] = 0.f; bfv[h] = F.fox_b_f[h]; }
    bf16* XB = (bf16*)(F.ws + WS_XB); float* SSQ = (float*)(F.ws + WS_SSQ);
    const int row0 = tile * 256 + F.wave * 32;
    for (int i = 0; i < 32; ++i) {
        const int row = row0 + i;
        const GAS f32x4* xr = (const GAS f32x4*)(F.x + (size_t)row * D) + F.lane;
        f32x4 v[4]; float ss = 0.f;
#pragma unroll
        for (int j = 0; j < 4; ++j) { v[j] = xr[64 * j]; ss += (v[j].x * v[j].x + v[j].y * v[j].y) + (v[j].z * v[j].z + v[j].w * v[j].w); }
        ss = wave_sum(ss);
        const float rstd = 1.0f / sqrtf(ss * (1.f / D) + EPS);
        GAS unsigned long long* o8 = (GAS unsigned long long*)(XB + (size_t)row * D) + F.lane;
#pragma unroll
        for (int j = 0; j < 4; ++j) o8[64 * j] = (unsigned long long)pk2(v[j].x, v[j].y) | ((unsigned long long)pk2(v[j].z, v[j].w) << 32);
        if (F.lane < 16) SSQ[(size_t)row * 16 + F.lane] = (F.lane == 0) ? ss : 0.f;
        float a[8];
#pragma unroll
        for (int h = 0; h < 8; ++h) a[h] = 0.f;
#pragma unroll
        for (int j = 0; j < 4; ++j)
#pragma unroll
            for (int e = 0; e < 4; ++e) { const int k = 4 * (F.lane + 64 * j) + e; const f32x4 w0 = *(const LAS f32x4*)(wfs + k * 8), w1 = *(const LAS f32x4*)(wfs + k * 8 + 4); const float xv = v[j][e];
                a[0] += xv * w0.x; a[1] += xv * w0.y; a[2] += xv * w0.z; a[3] += xv * w0.w; a[4] += xv * w1.x; a[5] += xv * w1.y; a[6] += xv * w1.z; a[7] += xv * w1.w; }
#pragma unroll
        for (int h = 0; h < 8; ++h) { const float z = wave_sum(a[h]) * rstd + bfv[h]; const float lf = fminf(z, 0.f) - log1pf(__expf(-fabsf(z))); run[h] += lf; if (F.lane == i) mine[h] = run[h]; }
    }
    if (F.lane == 0) {
#pragma unroll
        for (int h = 0; h < 8; ++h) tot[F.wave * 8 + h] = run[h];
    }
    __syncthreads();
    float* LC = (float*)(F.ws + WS_LC); float* TT = (float*)(F.ws + WS_TT);
    if (F.lane < 32) {
        f32x4 o0, o1;
#pragma unroll
        for (int h = 0; h < 8; ++h) { float off = 0.f; for (int w = 0; w < F.wave; ++w) off += tot[w * 8 + h]; const float val = mine[h] + off; if (h < 4) o0[h] = val; else o1[h - 4] = val; }
        *(f32x4*)(LC + (size_t)(row0 + F.lane) * 8) = o0; *(f32x4*)(LC + (size_t)(row0 + F.lane) * 8 + 4) = o1;
    }
    if (F.tid < 8) { float s = 0.f; for (int w = 0; w < 8; ++w) s += tot[w * 8 + F.tid]; TT[tile * 8 + F.tid] = s; }
    __syncthreads();
}
__device__ __forceinline__ void p0_prologue(Frame& F) {
    if ((int)blockIdx.x < M / 256) p0_xtile(F, (int)blockIdx.x);
    LAS float* scr = (LAS float*)(F.lds + RING_OFF + F.wave * 16384);
    const int gw = F.vcu * NWAVES + F.wave, NGW = F.G * NWAVES;
    constexpr int I0 = 16 * 96, I1 = 16 * 32, I2 = 16 * 176, I3 = 44 * 32, I4 = 16 * 192, I5 = 32 * 32, I6 = I2, I7 = I3;
    constexpr int NITEMS = I0 + I1 + I2 + I3 + I4 + I5 + I6 + I7;
    unsigned char* ws = F.ws;
    for (int it = gw; it < NITEMS; it += NGW) {
        int r = it;
        if (r < I0) { p0_matrix(r, F.fox_w_in, 1024, 3072, 3080, false, (bf16*)(ws + WS_WQKV0), F.norm_mix, scr, F.lane); continue; } r -= I0;
        if (r < I1) { p0_matrix(r, F.fox_w_out, 1024, 1024, 1024, false, (bf16*)(ws + WS_WO0), nullptr, scr, F.lane); continue; } r -= I1;
        if (r < I2) { p0_matrix(r, F.ffn_w_in, 1024, 2 * DFF, 2 * DFF, true, (bf16*)(ws + WS_WFI0), F.norm_ffn, scr, F.lane); continue; } r -= I2;
        if (r < I3) { p0_matrix(r, F.ffn_w_out, DFF, 1024, 1024, false, (bf16*)(ws + WS_WFO0), nullptr, scr, F.lane); continue; } r -= I3;
        if (r < I4) { p0_matrix(r, F.ret_w_in, 1024, 6144, 6144, false, (bf16*)(ws + WS_WRI), F.norm_mix + D, scr, F.lane); continue; } r -= I4;
        if (r < I5) { p0_matrix(r, F.ret_w_out, 2048, 1024, 1024, false, (bf16*)(ws + WS_WRO), nullptr, scr, F.lane); continue; } r -= I5;
        if (r < I6) { p0_matrix(r, F.ffn_w_in + (size_t)D * 2 * DFF, 1024, 2 * DFF, 2 * DFF, true, (bf16*)(ws + WS_WFI1), F.norm_ffn + D, scr, F.lane); continue; } r -= I6;
        p0_matrix(r, F.ffn_w_out + (size_t)DFF * D, DFF, 1024, 1024, false, (bf16*)(ws + WS_WFO1), nullptr, scr, F.lane);
    }
    float* rope = (float*)(ws + WS_ROPE);
    for (int idx = F.vcu * (NWAVES * 64) + F.tid; idx < SEQ * 128; idx += F.G * NWAVES * 64) {
        const int pos = idx >> 7, i = idx & 127;
        const float inv = (float)exp2(-(double)i * (13.287712379549449 / 128.0));
        const float ang = (float)pos * inv;
        const double t = (double)ang * 0.15915494309189535; const float fr = (float)(t - rint(t));
        f32x2 cs; cs.x = __builtin_amdgcn_cosf(fr); cs.y = __builtin_amdgcn_sinf(fr);
        *(f32x2*)(rope + (size_t)idx * 2) = cs;
    }
}

__device__ __forceinline__ void fill_rstd_tab(Frame& F, const pg8::StaticOrder& S) {
    LAS float* tab = (LAS float*)(F.lds + TAB_OFF); const float* SSQ = (const float*)(F.ws + WS_SSQ);
    pg8::Unit u;
    for (int i = 0; i < 8 && S.next(i, u); ++i) if (F.tid < 256) {
        const f32x4* p = (const f32x4*)(SSQ + (size_t)(u.pm * 256 + F.tid) * 16); const f32x4 a = p[0], b = p[1], c = p[2], d = p[3];
        const float s = ((a.x + a.y) + (a.z + a.w)) + ((b.x + b.y) + (b.z + b.w)) + ((c.x + c.y) + (c.z + c.w)) + ((d.x + d.y) + (d.z + d.w));
        tab[i * 256 + F.tid] = 1.0f / sqrtf(s * (1.f / D) + EPS); }
    __syncthreads();
}
__device__ __forceinline__ void fill_gate_tab(Frame& F, const pg8::StaticOrder& S) {
    LAS f32x2* stab = (LAS f32x2*)(F.lds + STAB_OFF); const float* PST = (const float*)(F.ws + WS_PST);
    pg8::Unit u;
    for (int i = 0; i < 2 && S.next(i, u); ++i) if (F.tid < 256) {
        const f32x4* p = (const f32x4*)(PST + ((size_t)(u.pm * 256 + F.tid) * 4 + (u.pn >> 1)) * 32); float s = 0.f, q = 0.f;
#pragma unroll
        for (int j = 0; j < 8; ++j) { const f32x4 v = p[j]; s += v.x + v.z; q += v.y + v.w; }
        const float mu = s * (1.f / RDV), var = fmaxf(q * (1.f / RDV) - mu * mu, 0.f);
        f32x2 st; st.x = mu; st.y = 1.0f / sqrtf(var + EPS); stab[i * 256 + F.tid] = st; }
    __syncthreads();
}

__device__ __forceinline__ void attn_ref_phase(Frame& F) {
    const bf16* Q = (const bf16*)(F.ws + WS_Q0); const bf16* K = (const bf16*)(F.ws + WS_K0); const bf16* V = (const bf16*)(F.ws + WS_V0); bf16* O = (bf16*)(F.ws + WS_Q0);
    const float* LC = (const float*)(F.ws + WS_LC); const float* TT = (const float*)(F.ws + WS_TT);
    LAS float* Ks = (LAS float*)(F.lds); LAS float* Vs = (LAS float*)(F.lds + 32768); LAS float* cbs = (LAS float*)(F.lds + 65536); LAS float* Pp = (LAS float*)(F.lds + 65536 + 256);
    const int r = F.tid >> 3, part = F.tid & 7;
    const int NU = BATCH * FH * (SEQ / 64);
    for (int unit = (int)blockIdx.x; unit < NU; unit += F.G) {
        const int bh = unit & 15, qb = unit >> 4, b = bh >> 3, h = bh & 7, q0 = qb * 64;
        __syncthreads();
        if (F.tid == 0) { float s = 0.f; for (int t = 0; t < 32; ++t) { Pp[t] = s; s += TT[(b * 32 + t) * 8 + h]; } }
        float q[16], o[16]; float m = -1e30f, l = 0.f;
        { const bf16* qp = Q + (size_t)(b * SEQ + q0 + r) * D + h * FDH + part * 16; const v4u a = *(const v4u*)qp, c = *(const v4u*)(qp + 8);
          q[0] = pg8::bf_lo(a.x); q[1] = pg8::bf_hi(a.x); q[2] = pg8::bf_lo(a.y); q[3] = pg8::bf_hi(a.y); q[4] = pg8::bf_lo(a.z); q[5] = pg8::bf_hi(a.z); q[6] = pg8::bf_lo(a.w); q[7] = pg8::bf_hi(a.w);
          q[8] = pg8::bf_lo(c.x); q[9] = pg8::bf_hi(c.x); q[10] = pg8::bf_lo(c.y); q[11] = pg8::bf_hi(c.y); q[12] = pg8::bf_lo(c.z); q[13] = pg8::bf_hi(c.z); q[14] = pg8::bf_lo(c.w); q[15] = pg8::bf_hi(c.w); }
#pragma unroll
        for (int d = 0; d < 16; ++d) o[d] = 0.f;
        for (int kt = 0; kt <= qb; ++kt) {
            __syncthreads();
            { const size_t go = (size_t)(b * SEQ + kt * 64 + r) * D + h * FDH + part * 16;
              const v4u a = *(const v4u*)(K + go), c = *(const v4u*)(K + go + 8), e = *(const v4u*)(V + go), f = *(const v4u*)(V + go + 8);
              LAS float* kd = Ks + r * 128 + part * 16; LAS float* vd = Vs + r * 128 + part * 16;
              kd[0] = pg8::bf_lo(a.x); kd[1] = pg8::bf_hi(a.x); kd[2] = pg8::bf_lo(a.y); kd[3] = pg8::bf_hi(a.y); kd[4] = pg8::bf_lo(a.z); kd[5] = pg8::bf_hi(a.z); kd[6] = pg8::bf_lo(a.w); kd[7] = pg8::bf_hi(a.w);
              kd[8] = pg8::bf_lo(c.x); kd[9] = pg8::bf_hi(c.x); kd[10] = pg8::bf_lo(c.y); kd[11] = pg8::bf_hi(c.y); kd[12] = pg8::bf_lo(c.z); kd[13] = pg8::bf_hi(c.z); kd[14] = pg8::bf_lo(c.w); kd[15] = pg8::bf_hi(c.w);
              vd[0] = pg8::bf_lo(e.x); vd[1] = pg8::bf_hi(e.x); vd[2] = pg8::bf_lo(e.y); vd[3] = pg8::bf_hi(e.y); vd[4] = pg8::bf_lo(e.z); vd[5] = pg8::bf_hi(e.z); vd[6] = pg8::bf_lo(e.w); vd[7] = pg8::bf_hi(e.w);
              vd[8] = pg8::bf_lo(f.x); vd[9] = pg8::bf_hi(f.x); vd[10] = pg8::bf_lo(f.y); vd[11] = pg8::bf_hi(f.y); vd[12] = pg8::bf_lo(f.z); vd[13] = pg8::bf_hi(f.z); vd[14] = pg8::bf_lo(f.w); vd[15] = pg8::bf_hi(f.w); }
            if (F.tid < 64) { const int key = kt * 64 + F.tid; cbs[F.tid] = -(Pp[key >> 8] + LC[(size_t)(b * SEQ + key) * 8 + h]) * LOG2E; }
            __syncthreads();
            const int jmax = (kt == qb) ? r : 63;
            for (int j = 0; j <= jmax; ++j) {
                const LAS float* kr = Ks + j * 128 + part * 16; float dot = 0.f;
#pragma unroll
                for (int d = 0; d < 16; ++d) dot += q[d] * kr[d];
                dot += __shfl_xor(dot, 1); dot += __shfl_xor(dot, 2); dot += __shfl_xor(dot, 4);
                const float s = dot + cbs[j], mn = fmaxf(m, s), al = __builtin_amdgcn_exp2f(m - mn), p = __builtin_amdgcn_exp2f(s - mn);
                l = l * al + p; m = mn;
                const LAS float* vr = Vs + j * 128 + part * 16;
#pragma unroll
                for (int d = 0; d < 16; ++d) o[d] = o[d] * al + p * vr[d];
            }
        }
        const float il = 1.0f / l;
        v4u w0, w1; w0.x = pk2(o[0] * il, o[1] * il); w0.y = pk2(o[2] * il, o[3] * il); w0.z = pk2(o[4] * il, o[5] * il); w0.w = pk2(o[6] * il, o[7] * il);
        w1.x = pk2(o[8] * il, o[9] * il); w1.y = pk2(o[10] * il, o[11] * il); w1.z = pk2(o[12] * il, o[13] * il); w1.w = pk2(o[14] * il, o[15] * il);
        bf16* op = O + (size_t)(b * SEQ + q0 + r) * D + h * FDH + part * 16; *(v4u*)op = w0; *(v4u*)(op + 8) = w1;
    }
    __syncthreads();
}

__device__ __forceinline__ void ret_ref_phase(Frame& F) {
    const bf16* Q1 = (const bf16*)(F.ws + WS_Q1); const bf16* K1 = (const bf16*)(F.ws + WS_K1); bf16* V1 = (bf16*)(F.ws + WS_V1); float* PST = (float*)(F.ws + WS_PST);
    LAS bf16* Qs = (LAS bf16*)(F.lds); LAS bf16* Ks = (LAS bf16*)(F.lds + 32768); LAS float* Sm = (LAS float*)(F.lds + 65536); LAS float* St = (LAS float*)(F.lds + 81920);
    LAS float* Vs = (LAS float*)(F.lds + 114688); LAS float* pw = (LAS float*)(F.lds + 122880);
    for (int unit = (int)blockIdx.x; unit < BATCH * RH * 16; unit += F.G) {
        const int b = unit >> 6, h = (unit >> 4) & 3, vs = unit & 15, v0 = vs * 32;
        const float lg = logf(1.0f - exp2f(-5.0f - (float)h));
        __syncthreads();
        for (int i = F.tid; i < 256 * 32; i += NWAVES * 64) St[i] = 0.f;
        if (F.tid <= 64) pw[F.tid] = expf(lg * (float)F.tid);
        for (int n = 0; n < NCH; ++n) {
            const size_t t0 = (size_t)b * SEQ + (size_t)n * CH;
            __syncthreads();
#pragma unroll
            for (int i = 0; i < 4; ++i) { const int p = F.tid + 512 * i, row = p >> 5, c = p & 31;
                *(LAS v4u*)(Qs + row * 256 + c * 8) = *(const v4u*)(Q1 + (t0 + row) * 1024 + h * 256 + c * 8);
                *(LAS v4u*)(Ks + row * 256 + c * 8) = *(const v4u*)(K1 + (t0 + row) * 1024 + h * 256 + c * 8); }
            { const int idx = F.tid * 4, row = idx >> 5, c = idx & 31; const unsigned long long vv = *(const unsigned long long*)(V1 + (t0 + row) * 2048 + h * 512 + v0 + c);
              const unsigned lo = (unsigned)vv, hi = (unsigned)(vv >> 32); LAS float* d = Vs + row * 32 + c; d[0] = pg8::bf_lo(lo); d[1] = pg8::bf_hi(lo); d[2] = pg8::bf_lo(hi); d[3] = pg8::bf_hi(hi); }
            __syncthreads();
            {
                const int i = F.tid >> 3, j0 = (F.tid & 7) * 8; float a[8];
#pragma unroll
                for (int jj = 0; jj < 8; ++jj) a[jj] = 0.f;
                for (int d = 0; d < 256; d += 2) { const unsigned qw = *(const LAS unsigned*)(Qs + i * 256 + d); const float qa = pg8::bf_lo(qw), qb = pg8::bf_hi(qw);
#pragma unroll
                    for (int jj = 0; jj < 8; ++jj) { const unsigned kw = *(const LAS unsigned*)(Ks + (j0 + jj) * 256 + d); a[jj] += qa * pg8::bf_lo(kw) + qb * pg8::bf_hi(kw); } }
#pragma unroll
                for (int jj = 0; jj < 8; ++jj) { const int dj = i - (j0 + jj); Sm[i * 64 + j0 + jj] = a[jj] * pw[dj < 0 ? -dj : dj]; }
            }
            __syncthreads();
            {
                const int i = F.tid >> 3, vv0 = (F.tid & 7) * 4; float y[4] = {0.f, 0.f, 0.f, 0.f};
                for (int d = 0; d < 256; d += 2) { const unsigned qw = *(const LAS unsigned*)(Qs + i * 256 + d); const float qa = pg8::bf_lo(qw), qb = pg8::bf_hi(qw);
                    const f32x4 s0 = *(const LAS f32x4*)(St + d * 32 + vv0), s1 = *(const LAS f32x4*)(St + (d + 1) * 32 + vv0);
                    y[0] += qa * s0.x + qb * s1.x; y[1] += qa * s0.y + qb * s1.y; y[2] += qa * s0.z + qb * s1.z; y[3] += qa * s0.w + qb * s1.w; }
                const float qd = pw[i + 1];
#pragma unroll
                for (int e = 0; e < 4; ++e) y[e] *= qd;
                for (int j = 0; j < 64; ++j) { const float s = Sm[i * 64 + j]; const f32x4 vv = *(const LAS f32x4*)(Vs + j * 32 + vv0); y[0] += s * vv.x; y[1] += s * vv.y; y[2] += s * vv.z; y[3] += s * vv.w; }
                float ps = (y[0] + y[1]) + (y[2] + y[3]), pq = (y[0] * y[0] + y[1] * y[1]) + (y[2] * y[2] + y[3] * y[3]);
                ps += __shfl_xor(ps, 1); pq += __shfl_xor(pq, 1); ps += __shfl_xor(ps, 2); pq += __shfl_xor(pq, 2); ps += __shfl_xor(ps, 4); pq += __shfl_xor(pq, 4);
                if ((F.tid & 7) == 0) { f32x2 st; st.x = ps; st.y = pq; *(f32x2*)(PST + (((t0 + i) * 4 + h) * 16 + vs) * 2) = st; }
                *(unsigned long long*)(V1 + (t0 + i) * 2048 + h * 512 + v0 + vv0) = (unsigned long long)pk2(y[0], y[1]) | ((unsigned long long)pk2(y[2], y[3]) << 32);
            }
            __syncthreads();
            {
                const int d = F.tid >> 1, vv0 = (F.tid & 1) * 16; float a[16]; const float cd = pw[64];
#pragma unroll
                for (int e = 0; e < 16; ++e) a[e] = St[d * 32 + vv0 + e] * cd;
                for (int j = 0; j < 64; ++j) { const float kd = pg8::bf_lo((unsigned)Ks[j * 256 + d]) * pw[63 - j];
#pragma unroll
                    for (int e = 0; e < 16; e += 4) { const f32x4 vv = *(const LAS f32x4*)(Vs + j * 32 + vv0 + e); a[e] += kd * vv.x; a[e + 1] += kd * vv.y; a[e + 2] += kd * vv.z; a[e + 3] += kd * vv.w; } }
#pragma unroll
                for (int e = 0; e < 16; ++e) St[d * 32 + vv0 + e] = a[e];
            }
        }
    }
    __syncthreads();
}

__device__ __forceinline__ void final_norm_phase(Frame& F) {
    const float* SSQ = (const float*)(F.ws + WS_SSQ);
    const int gw = F.vcu * NWAVES + F.wave, NGW = F.G * NWAVES;
    f32x4 gv[4];
#pragma unroll
    for (int j = 0; j < 4; ++j) gv[j] = ((const f32x4*)F.final_norm)[F.lane + 64 * j];
    for (int row = gw; row < M; row += NGW) {
        float s = (F.lane < 16) ? SSQ[(size_t)row * 16 + F.lane] : 0.f; s = wave_sum(s);
        const float rstd = 1.0f / sqrtf(s * (1.f / D) + EPS);
        GAS f32x4* xr = (GAS f32x4*)(F.out + (size_t)row * D) + F.lane;
#pragma unroll
        for (int j = 0; j < 4; ++j) { f32x4 v = xr[64 * j]; v = v * rstd * gv[j]; xr[64 * j] = v; }
    }
}
#ifndef MK_N_LAUNCHES
#define MK_N_LAUNCHES 1
#endif
constexpr int N_LAUNCHES = MK_N_LAUNCHES;
#ifndef FAST_ATTN
#define FAST_ATTN 0
#endif
#ifndef FAST_RET
#define FAST_RET 0
#endif
__device__ __forceinline__ bool relaunder(Frame& F) { int t = threadIdx.x; asm volatile("" : "+v"(t)); F.tid = t; F.lane = t & 63; F.wave = __builtin_amdgcn_readfirstlane(t >> 6); return true; }
struct Args { const float* in[11]; float* out; unsigned char* ws; int ph_lo, ph_hi, li, pad; };
__global__ void __launch_bounds__(NWAVES * 64, 2) fox_ret_fwd(Args args) {
    extern __shared__ __attribute__((aligned(16))) unsigned char lds[];
    Frame F;
    F.lds = (LAS unsigned char*)lds;
    F.MISC = (volatile LAS unsigned*)(F.lds + MISC_OFF);
    F.tid = threadIdx.x; F.lane = F.tid & 63; F.wave = __builtin_amdgcn_readfirstlane(F.tid >> 6);
    F.G = gridDim.x; { const int bx = blockIdx.x; F.vcu = (F.G % 8 == 0) ? (bx % 8) * (F.G / 8) + bx / 8 : bx; }
    unsigned char* ws = args.ws; F.ws = ws;
    F.ctl = (gu32*)(ws + WS_CTL);
    F.x = args.in[0]; F.norm_mix = args.in[1]; F.norm_ffn = args.in[2]; F.fox_w_in = args.in[3]; F.fox_b_f = args.in[4]; F.fox_w_out = args.in[5];
    F.ret_w_in = args.in[6]; F.ret_w_out = args.in[7]; F.ffn_w_in = args.in[8]; F.ffn_w_out = args.in[9]; F.final_norm = args.in[10]; F.out = args.out;
    for (int u = F.tid; u < (LDS_BYTES - LDSCTL_OFF) / 4; u += NWAVES * 64) ((LAS unsigned*)(F.lds + LDSCTL_OFF))[u] = 0u;
    __syncthreads();
    XcdBarrier bar; bar.bar = (unsigned*)(F.ctl + CW_BAR); bar.x = 0; bar.st = nullptr;
    if (N_LAUNCHES == 1) bar = xcd_barrier_post((unsigned*)(F.ctl + CW_BAR), F.MISC + 8);
#define GRID_BAR() do { if (N_LAUNCHES == 1) xcd_barrier(bar); } while (0)
    const int lo = args.ph_lo, hi = args.ph_hi;
#define IN(k) (lo <= (k) && (k) < hi && relaunder(F))
#define BOTH(k) (IN(k) && IN((k) + 1))
    pg8::bf16_t* const XB = (pg8::bf16_t*)(ws + WS_XB); float* const SSQ = (float*)(ws + WS_SSQ);
    const LAS float* const tab = (const LAS float*)(F.lds + TAB_OFF);

    if (IN(0)) { p0_prologue(F); if (BOTH(0)) GRID_BAR(); }

    if (IN(1)) {
        pg8::Gemm g{XB, (const pg8::bf16_t*)(ws + WS_WQKV0), M, 3072, 1024}; pg8::StaticOrder S; S.init(M, 3072, F.G, (int)blockIdx.x);
        fill_rstd_tab(F, S);
        pg8::EpiQKV0 E{(pg8::bf16_t*)(ws + WS_Q0), tab, QSCALE};
        pg8::gemm_phase<pg8::EpiQKV0, pg8::StaticOrder, true, true>(F.lds + RING_OFF, g, S, E);
        if (BOTH(1)) GRID_BAR();
    }
    if (IN(2)) {
#if FAST_ATTN
        attn_fast_phase(F);
#else
        attn_ref_phase(F);
#endif
        if (BOTH(2)) GRID_BAR();
    }
    if (IN(3)) {
        pg8::Gemm g{(const pg8::bf16_t*)(ws + WS_Q0), (const pg8::bf16_t*)(ws + WS_WO0), M, 1024, 1024}; pg8::StaticOrder S; S.init(M, 1024, F.G, (int)blockIdx.x);
        pg8::EpiRes E{F.x, F.out, XB, SSQ};
        pg8::gemm_phase<pg8::EpiRes, pg8::StaticOrder, true, true>(F.lds + RING_OFF, g, S, E);
        if (BOTH(3)) GRID_BAR();
    }
    for (int L = 0; L < 2; ++L) {
        const int pa = L == 0 ? 4 : 10, pb = pa + 1;
        if (IN(pa)) {
            pg8::Gemm g{XB, (const pg8::bf16_t*)(ws + (L == 0 ? WS_WFI0 : WS_WFI1)), M, 2 * DFF, 1024}; pg8::StaticOrder S; S.init(M, 2 * DFF, F.G, (int)blockIdx.x);
            fill_rstd_tab(F, S);
            pg8::EpiSwiGLU E{(pg8::bf16_t*)(ws + WS_HID), tab};
            pg8::gemm_phase<pg8::EpiSwiGLU, pg8::StaticOrder, true, true>(F.lds + RING_OFF, g, S, E);
            if (BOTH(pa)) GRID_BAR();
        }
        if (IN(pb)) {
            pg8::Gemm g{(const pg8::bf16_t*)(ws + WS_HID), (const pg8::bf16_t*)(ws + (L == 0 ? WS_WFO0 : WS_WFO1)), M, 1024, DFF}; pg8::StaticOrder S; S.init(M, 1024, F.G, (int)blockIdx.x);
            pg8::EpiRes E{F.out, F.out, XB, SSQ};
            pg8::gemm_phase<pg8::EpiRes, pg8::StaticOrder, true, true>(F.lds + RING_OFF, g, S, E);
            if (BOTH(pb)) GRID_BAR();
        }
        if (L == 1) break;
        if (IN(6)) {
            pg8::Gemm g{XB, (const pg8::bf16_t*)(ws + WS_WRI), M, 4096, 1024}; pg8::StaticOrder S; S.init(M, 4096, F.G, (int)blockIdx.x);
            fill_rstd_tab(F, S);
            pg8::EpiRet E{(pg8::bf16_t*)(ws + WS_Q1), (pg8::bf16_t*)(ws + WS_K1), (pg8::bf16_t*)(ws + WS_V1), (const float*)(ws + WS_ROPE), tab};
            pg8::gemm_phase<pg8::EpiRet, pg8::StaticOrder, true, true>(F.lds + RING_OFF, g, S, E);
            if (BOTH(6)) GRID_BAR();
        }
        if (IN(7)) {
#if FAST_RET
            ret_fast_phase(F);
#else
            ret_ref_phase(F);
#endif
            if (BOTH(7)) GRID_BAR();
        }
        if (IN(8)) {
            pg8::Gemm g{XB, (const pg8::bf16_t*)(ws + WS_WRI) + (size_t)4096 * 1024, M, 2048, 1024}; pg8::StaticOrder S; S.init(M, 2048, F.G, (int)blockIdx.x);
            fill_rstd_tab(F, S); fill_gate_tab(F, S);
            pg8::EpiGate E{(pg8::bf16_t*)(ws + WS_V1), tab, (const LAS pg8::f32x2*)(F.lds + STAB_OFF)};
            pg8::gemm_phase<pg8::EpiGate, pg8::StaticOrder, true, true>(F.lds + RING_OFF, g, S, E);
            if (BOTH(8)) GRID_BAR();
        }
        if (IN(9)) {
            pg8::Gemm g{(const pg8::bf16_t*)(ws + WS_V1), (const pg8::bf16_t*)(ws + WS_WRO), M, 1024, 2048}; pg8::StaticOrder S; S.init(M, 1024, F.G, (int)blockIdx.x);
            pg8::EpiRes E{F.out, F.out, XB, SSQ};
            pg8::gemm_phase<pg8::EpiRes, pg8::StaticOrder, true, true>(F.lds + RING_OFF, g, S, E);
            if (BOTH(9)) GRID_BAR();
        }
    }
    if (IN(12)) final_norm_phase(F);
#undef IN
#undef BOTH
#undef GRID_BAR
}

extern "C" void kernel_launch(void* const* d_in, const int* in_sizes, int n_in, void* d_out, int out_size, void* d_ws, size_t ws_size, hipStream_t stream) {
    static int grid = 0;
    if (grid == 0) {
        if (n_in != 11 || in_sizes[0] != M * D || out_size != M * D || ws_size < WS_END) { fprintf(stderr, "kernel_launch: shape/workspace mismatch (n_in %d, in0 %d, out %d, ws %zu, need %zu)\n", n_in, n_in > 0 ? in_sizes[0] : -1, out_size, ws_size, (size_t)WS_END); grid = -1; return; }
        int dev = 0, cus = 0, per_cu = 0;
        if (hipGetDevice(&dev) != hipSuccess || hipDeviceGetAttribute(&cus, hipDeviceAttributeMultiprocessorCount, dev) != hipSuccess) { fprintf(stderr, "kernel_launch: device query failed\n"); grid = -1; return; }
        if (hipFuncSetAttribute((const void*)fox_ret_fwd, hipFuncAttributeMaxDynamicSharedMemorySize, LDS_BYTES) != hipSuccess) { fprintf(stderr, "kernel_launch: hipFuncSetAttribute failed\n"); grid = -1; return; }
        if (hipOccupancyMaxActiveBlocksPerMultiprocessor(&per_cu, (const void*)fox_ret_fwd, NWAVES * 64, LDS_BYTES) != hipSuccess || per_cu < 1) { fprintf(stderr, "kernel_launch: occupancy query reports %d workgroups per CU\n", per_cu); per_cu = 1; }
        (void)hipGetLastError();
        grid = cus;
        if (grid > 256) grid = 256;
    }
    if (grid < 0) return;
    if (hipMemsetAsync((char*)d_ws + WS_CTL, 0, CTL_ZERO_BYTES, stream) != hipSuccess) { fprintf(stderr, "kernel_launch: hipMemsetAsync failed\n"); return; }
    Args a{};
    for (int i = 0; i < 11; ++i) a.in[i] = (const float*)d_in[i];
    a.out = (float*)d_out; a.ws = (unsigned char*)d_ws;
    for (int li = 0; li < N_LAUNCHES; ++li) {
        a.ph_lo = (N_LAUNCHES == 1) ? 0 : li; a.ph_hi = (N_LAUNCHES == 1) ? NPHASE : li + 1; a.li = li;
        hipLaunchKernelGGL(fox_ret_fwd, dim3(grid), dim3(NWAVES * 64), LDS_BYTES, stream, a);
        const hipError_t le = hipPeekAtLastError();
        if (le != hipSuccess) { fprintf(stderr, "kernel_launch: launch %d failed: %s\n", li, hipGetErrorName(le)); break; }
    }
}
```

```cpp
#define MK_N_LAUNCHES 1
#define FAST_ATTN 1
#define FAST_RET 1
#include <hip/hip_runtime.h>
#include <cstdio>
#include <cstdint>
#include <cmath>
__device__ __forceinline__ int hw_lane_id() { int l; asm volatile("v_mbcnt_lo_u32_b32 %0, -1, 0\n\tv_mbcnt_hi_u32_b32 %0, -1, %0" : "=v"(l)); return l; }
namespace pg8 {
#define PG8_LAS __attribute__((address_space(3)))
typedef unsigned short bf16_t;
typedef short bf16x8 __attribute__((ext_vector_type(8)));
typedef float f32x4 __attribute__((ext_vector_type(4)));
typedef unsigned u32x4 __attribute__((ext_vector_type(4)));
constexpr int BM = 256, BK = 64, HALF = 128, HTB = HALF * BK * 2  , STAGE_BYTES = 8 * HTB, NXCD = 8, WGM = 8;

__host__ __device__ __forceinline__ int lds_byte(int r, int c) { const int st = (r >> 4) * 2 + (c >> 5), rr = r & 15, cc = c & 31, ob = rr * 64 + cc * 2; return st * 1024 + (ob ^ (((ob >> 9) & 1) << 5)); }
__host__ __device__ __forceinline__ void stage_rc(int b, int& R, int& C) { const int st = b / 1024, sb = b % 1024, swz = sb ^ (((sb >> 9) & 1) << 5); R = (st >> 1) * 16 + swz / 64; C = (st & 1) * 32 + (swz % 64) / 2; }
__host__ __device__ __forceinline__ int perm32(int rho) { const int n = rho >> 4, i = rho & 15; return 8 * (i >> 2) + 4 * n + (i & 3); }

struct Unit { int pm, pn; };
struct Gemm { const bf16_t* A; const bf16_t* Bt; int M, N, K; };

struct StaticOrder {
    int nM, nN, nwg, G, c;
    __host__ __device__ void init(int M, int N, int G_, int c_) { nM = M / BM; nN = N / BM; nwg = nM * nN; G = G_; c = c_; }
    __host__ __device__ bool next(int i, Unit& u) const {
        const long L = (long)i * G + c; if (L >= nwg) return false;
        int wgid = (int)L; { const int q = nwg / NXCD, r = nwg % NXCD, xcd = wgid % NXCD, off = wgid / NXCD; wgid = (xcd < r ? xcd * (q + 1) : r * (q + 1) + (xcd - r) * q) + off; }
        const int nig = WGM * nN, gid = wgid / nig, fm = gid * WGM, gsz = (nM - fm) < WGM ? (nM - fm) : WGM;
        u.pm = fm + ((wgid % nig) % gsz); u.pn = (wgid % nig) / gsz; return true;
    }
    __device__ __forceinline__ void a_ready(const Unit&) const {}
    __device__ __forceinline__ void done(const Unit&) const {}
};

__device__ __forceinline__ unsigned cvt_pk_bf16(float lo, float hi) { unsigned r; asm volatile("v_cvt_pk_bf16_f32 %0, %1, %2" : "=v"(r) : "v"(lo), "v"(hi)); return r; }
typedef float f32x2 __attribute__((ext_vector_type(2)));
__device__ __forceinline__ float silu_f(float x) { return x * __builtin_amdgcn_rcpf(1.0f + __builtin_amdgcn_exp2f(-1.4426950408889634f * x)); }
__device__ __forceinline__ u32x4 pack8f(const f32x4 v0, const f32x4 v1) { u32x4 w; w.x = cvt_pk_bf16(v0[0], v0[1]); w.y = cvt_pk_bf16(v0[2], v0[3]); w.z = cvt_pk_bf16(v1[0], v1[1]); w.w = cvt_pk_bf16(v1[2], v1[3]); return w; }
__device__ __forceinline__ float bf_lo(unsigned w) { return __builtin_bit_cast(float, w << 16); }
__device__ __forceinline__ float bf_hi(unsigned w) { return __builtin_bit_cast(float, w & 0xffff0000u); }

struct EpiQKV0 {
    static constexpr bool PERM = true, AFTER_DRAIN = false;
    bf16_t* Q; const PG8_LAS float* tab; float qscale; float* nrm;
    __device__ __forceinline__ void operator()(const f32x4 (&acc)[2][2][4][2], const Unit& u, int ui, int wr, int wc, int fr, int fq) const {
        const int colt = u.pn * BM, t = colt >> 10; bf16_t* base = Q + (size_t)t * ((size_t)16384 * 1024);
        const int cb = (colt & 1023) + wc * 32 + 8 * fq; const float sc = t == 0 ? qscale : 1.f;
        float mx0 = 0.f, mx1 = 0.f;
#pragma unroll
        for (int ai = 0; ai < 2; ++ai)
#pragma unroll
            for (int m = 0; m < 4; ++m) { const int rl = ai * HALF + wr * 64 + m * 16 + fr; const float rs = tab[ui * 256 + rl] * sc;
                bf16_t* rowp = base + (size_t)(u.pm * BM + rl) * 1024 + cb;
#pragma unroll
                for (int bj = 0; bj < 2; ++bj) { const u32x4 w = pack8f(acc[ai][bj][m][0] * rs, acc[ai][bj][m][1] * rs); *(u32x4*)(rowp + bj * HALF) = w;
                    if (t < 2) { float q = (bf_lo(w.x) * bf_lo(w.x) + bf_hi(w.x) * bf_hi(w.x)) + (bf_lo(w.y) * bf_lo(w.y) + bf_hi(w.y) * bf_hi(w.y));
                        q += (bf_lo(w.z) * bf_lo(w.z) + bf_hi(w.z) * bf_hi(w.z)) + (bf_lo(w.w) * bf_lo(w.w) + bf_hi(w.w) * bf_hi(w.w));
                        q += __shfl_xor(q, 16); q += __shfl_xor(q, 32);
                        if (bj == 0) mx0 = fmaxf(mx0, q); else mx1 = fmaxf(mx1, q); } } }
        if (t < 2) {
#pragma unroll
            for (int o = 1; o < 16; o <<= 1) { mx0 = fmaxf(mx0, __shfl_xor(mx0, o)); mx1 = fmaxf(mx1, __shfl_xor(mx1, o)); }
            if (fr == 0 && fq == 0) { const int head = ((colt & 1023) >> 7); float* d = nrm + ((((size_t)t * 64 + u.pm) * 8 + head) * 4 + wc) * 2 + wr; d[0] = mx0; d[8] = mx1; }
        }
    }
};
struct EpiRes {
    static constexpr bool PERM = true, AFTER_DRAIN = false;
    bf16_t* xb; float* ssq;
    __device__ __forceinline__ void operator()(const f32x4 (&acc)[2][2][4][2], const Unit& u, int ui, int wr, int wc, int fr, int fq) const {
        const int col0 = u.pn * BM + wc * 32 + 8 * fq;
#pragma unroll
        for (int ai = 0; ai < 2; ++ai)
#pragma unroll
            for (int m = 0; m < 4; ++m) { const int row = u.pm * BM + ai * HALF + wr * 64 + m * 16 + fr; bf16_t* rowp = xb + (size_t)row * 1024 + col0; float s = 0.f;
#pragma unroll
                for (int bj = 0; bj < 2; ++bj) { const u32x4 b = *(const u32x4*)(rowp + bj * HALF); f32x4 o0, o1;
                    o0[0] = bf_lo(b.x); o0[1] = bf_hi(b.x); o0[2] = bf_lo(b.y); o0[3] = bf_hi(b.y); o1[0] = bf_lo(b.z); o1[1] = bf_hi(b.z); o1[2] = bf_lo(b.w); o1[3] = bf_hi(b.w);
                    o0 = o0 + acc[ai][bj][m][0]; o1 = o1 + acc[ai][bj][m][1];
                    s += ((o0[0] * o0[0] + o0[1] * o0[1]) + (o0[2] * o0[2] + o0[3] * o0[3])) + ((o1[0] * o1[0] + o1[1] * o1[1]) + (o1[2] * o1[2] + o1[3] * o1[3]));
                    *(u32x4*)(rowp + bj * HALF) = pack8f(o0, o1); }
                s += __shfl_xor(s, 16); s += __shfl_xor(s, 32);
                if (fq == 0) ssq[(size_t)row * 16 + u.pn * 4 + wc] = s; }
    }
};
struct EpiSwiGLU {
    static constexpr bool PERM = true, AFTER_DRAIN = false;
    bf16_t* Hd; const PG8_LAS float* tab;
    __device__ __forceinline__ void operator()(const f32x4 (&acc)[2][2][4][2], const Unit& u, int ui, int wr, int wc, int fr, int fq) const {
        const int hc0 = u.pn * HALF + wc * 32 + 8 * fq;
#pragma unroll
        for (int ai = 0; ai < 2; ++ai)
#pragma unroll
            for (int m = 0; m < 4; ++m) { const int rl = ai * HALF + wr * 64 + m * 16 + fr; const float rs = tab[ui * 256 + rl];
                f32x4 h0, h1;
#pragma unroll
                for (int e = 0; e < 4; ++e) { h0[e] = silu_f(acc[ai][0][m][0][e] * rs) * (acc[ai][1][m][0][e] * rs); h1[e] = silu_f(acc[ai][0][m][1][e] * rs) * (acc[ai][1][m][1][e] * rs); }
                *(u32x4*)(Hd + (size_t)(u.pm * BM + rl) * 2816 + hc0) = pack8f(h0, h1); }
    }
};
struct EpiRet {
    static constexpr bool PERM = true, AFTER_DRAIN = false;
    bf16_t* Q; bf16_t* Kp; bf16_t* V; const float* rope; const PG8_LAS float* tab;
    __device__ __forceinline__ void operator()(const f32x4 (&acc)[2][2][4][2], const Unit& u, int ui, int wr, int wc, int fr, int fq) const {
        if (u.pn < 8) {
            const bool isk = u.pn >= 4; const int head = u.pn & 3; bf16_t* dst = isk ? Kp : Q; const float sc = isk ? 0.0625f : 1.f; const int i0 = wc * 32 + 8 * fq;
#pragma unroll
            for (int ai = 0; ai < 2; ++ai)
#pragma unroll
                for (int m = 0; m < 4; ++m) { const int rl = ai * HALF + wr * 64 + m * 16 + fr, row = u.pm * BM + rl; const float rs = tab[ui * 256 + rl] * sc;
                    const f32x4* rp = (const f32x4*)(rope + ((size_t)(row & 8191) * 128 + i0) * 2);
                    f32x4 o1[2], o2[2];
#pragma unroll
                    for (int n = 0; n < 2; ++n) { const f32x4 t1 = acc[ai][0][m][n] * rs, t2 = acc[ai][1][m][n] * rs; const f32x4 ca = rp[2 * n], cb = rp[2 * n + 1];
                        o1[n][0] = t1[0] * ca[0] - t2[0] * ca[1]; o2[n][0] = t1[0] * ca[1] + t2[0] * ca[0];
                        o1[n][1] = t1[1] * ca[2] - t2[1] * ca[3]; o2[n][1] = t1[1] * ca[3] + t2[1] * ca[2];
                        o1[n][2] = t1[2] * cb[0] - t2[2] * cb[1]; o2[n][2] = t1[2] * cb[1] + t2[2] * cb[0];
                        o1[n][3] = t1[3] * cb[2] - t2[3] * cb[3]; o2[n][3] = t1[3] * cb[3] + t2[3] * cb[2]; }
                    bf16_t* rowp = dst + (size_t)row * 1024 + head * 256 + i0;
                    *(u32x4*)(rowp) = pack8f(o1[0], o1[1]); *(u32x4*)(rowp + HALF) = pack8f(o2[0], o2[1]);
                    if (m & 1) asm volatile("" ::: "memory"); }
        } else {
            const int cb = (u.pn - 8) * BM + wc * 32 + 8 * fq;
#pragma unroll
            for (int ai = 0; ai < 2; ++ai)
#pragma unroll
                for (int m = 0; m < 4; ++m) { const int rl = ai * HALF + wr * 64 + m * 16 + fr; const float rs = tab[ui * 256 + rl];
                    bf16_t* rowp = V + (size_t)(u.pm * BM + rl) * 2048 + cb;
#pragma unroll
                    for (int bj = 0; bj < 2; ++bj) *(u32x4*)(rowp + bj * HALF) = pack8f(acc[ai][bj][m][0] * rs, acc[ai][bj][m][1] * rs); }
        }
    }
};
struct EpiGate {
    static constexpr bool PERM = true, AFTER_DRAIN = false;
    bf16_t* Y; const PG8_LAS float* tab; const PG8_LAS f32x2* stab;
    __device__ __forceinline__ void operator()(const f32x4 (&acc)[2][2][4][2], const Unit& u, int ui, int wr, int wc, int fr, int fq) const {
        const int cb = u.pn * BM + wc * 32 + 8 * fq;
#pragma unroll
        for (int ai = 0; ai < 2; ++ai)
#pragma unroll
            for (int m = 0; m < 4; ++m) { const int rl = ai * HALF + wr * 64 + m * 16 + fr; const float rs = tab[ui * 256 + rl]; const f32x2 st = stab[ui * 256 + rl];
                bf16_t* rowp = Y + (size_t)(u.pm * BM + rl) * 2048 + cb;
#pragma unroll
                for (int bj = 0; bj < 2; ++bj) { const u32x4 yv = *(const u32x4*)(rowp + bj * HALF); f32x4 y0, y1;
                    y0[0] = bf_lo(yv.x); y0[1] = bf_hi(yv.x); y0[2] = bf_lo(yv.y); y0[3] = bf_hi(yv.y); y1[0] = bf_lo(yv.z); y1[1] = bf_hi(yv.z); y1[2] = bf_lo(yv.w); y1[3] = bf_hi(yv.w);
                    f32x4 g0 = acc[ai][bj][m][0] * rs, g1 = acc[ai][bj][m][1] * rs;
#pragma unroll
                    for (int e = 0; e < 4; ++e) { g0[e] = silu_f(g0[e]) * ((y0[e] - st.x) * st.y); g1[e] = silu_f(g1[e]) * ((y1[e] - st.x) * st.y); }
                    *(u32x4*)(rowp + bj * HALF) = pack8f(g0, g1); } }
    }
};
struct EpiNull {
    static constexpr bool PERM = true, AFTER_DRAIN = false;
    int dummy;
    __device__ __forceinline__ void operator()(const f32x4 (&acc)[2][2][4][2], const Unit& u, int ui, int wr, int wc, int fr, int fq) const {
#pragma unroll
        for (int ai = 0; ai < 2; ++ai)
#pragma unroll
            for (int bj = 0; bj < 2; ++bj)
#pragma unroll
                for (int m = 0; m < 4; ++m) { asm volatile("" :: "v"(acc[ai][bj][m][0]), "v"(acc[ai][bj][m][1])); }
    }
};
template <class Epi, class Sched, bool ALIGN_EPI = false, bool SP2 = false>
__device__ __forceinline__ void gemm_phase(PG8_LAS unsigned char* lds, const Gemm g, const Sched& S, const Epi& E, int wave_in) {
    int tid_ = wave_in * 64 + hw_lane_id(); asm volatile("" : "+v"(tid_));
    const int tid = tid_, wid = __builtin_amdgcn_readfirstlane(tid >> 6), lane = tid & 63, wr = wid >> 2, wc = wid & 3, fr = lane & 15, fq = lane >> 4;
    const int K = g.K, nt = K / BK;
    unsigned voffA[2], voffB[2];
#pragma unroll
    for (int i = 0; i < 2; ++i) { int R, C; stage_rc(tid * 16 + i * 8192, R, C); const int Rb = Epi::PERM ? ((R & ~31) + perm32(R & 31)) : R;
        voffA[i] = (unsigned)(R * K + C) * 2u; voffB[i] = (unsigned)(Rb * K + C) * 2u; }
    const size_t kstep = (size_t)(BK * 2);
    const size_t hstep = (size_t)HALF * K * 2;
    const size_t tstep = 2 * hstep;
    const unsigned ldsw = (unsigned)wid * 1024u;
    const int aoff = lds_byte(wr * 64 + fr, fq * 8), boff = lds_byte(wc * 32 + fr, fq * 8);
#define PG8_SA(b, h) (((b) * 2 + (h)) * HTB)
#define PG8_SB(b, h) ((4 + (b) * 2 + (h)) * HTB)
#define PG8_STAGE(bufoff, gbase, voff) do { _Pragma("unroll") for (int _i = 0; _i < 2; ++_i) \
        __builtin_amdgcn_global_load_lds((const unsigned*)((const char*)(gbase) + (voff)[_i]), (PG8_LAS unsigned*)(lds + (bufoff) + ldsw + _i * 8192), 16, 0, 0); } while (0)
#define PG8_LDA(dst, b, h) do { _Pragma("unroll") for (int m = 0; m < 4; ++m) _Pragma("unroll") for (int k = 0; k < 2; ++k) dst[m][k] = *(const PG8_LAS bf16x8*)(lds + PG8_SA(b, h) + aoff + m * 2048 + k * 1024); } while (0)
#define PG8_LDB(dst, b, h) do { _Pragma("unroll") for (int n = 0; n < 2; ++n) _Pragma("unroll") for (int k = 0; k < 2; ++k) dst[n][k] = *(const PG8_LAS bf16x8*)(lds + PG8_SB(b, h) + boff + n * 2048 + k * 1024); } while (0)
#define PG8_MMA(ai, bj, At, Bt) do { __builtin_amdgcn_s_setprio(1); _Pragma("unroll") for (int m = 0; m < 4; ++m) _Pragma("unroll") for (int n = 0; n < 2; ++n) _Pragma("unroll") for (int k = 0; k < 2; ++k) \
        acc[ai][bj][m][n] = __builtin_amdgcn_mfma_f32_16x16x32_bf16(Bt[n][k], At[m][k], acc[ai][bj][m][n], 0, 0, 0); __builtin_amdgcn_s_setprio(0); } while (0)
#define PG8_WAIT_V(n) asm volatile("s_waitcnt vmcnt(" #n ")" ::: "memory")
#define PG8_WAIT_L(n) asm volatile("s_waitcnt lgkmcnt(" #n ")" ::: "memory")
#define PG8_BAR __builtin_amdgcn_s_barrier()
#define PG8_SCHED __builtin_amdgcn_sched_barrier(0)
    Unit cur, nxt; int ui = 0;
    if (!S.next(0, cur)) return;
    f32x4 acc[2][2][4][2];
#pragma unroll
    for (int a = 0; a < 2; ++a)
#pragma unroll
        for (int b = 0; b < 2; ++b)
#pragma unroll
            for (int m = 0; m < 4; ++m)
#pragma unroll
                for (int n = 0; n < 2; ++n) acc[a][b][m][n] = (f32x4){0.f, 0.f, 0.f, 0.f};
    bf16x8 At[4][2], B0[2][2], B1[2][2];
    const char* cA = (const char*)g.A + (size_t)cur.pm * tstep; const char* cB = (const char*)g.Bt + (size_t)cur.pn * tstep;
    S.a_ready(cur);
    if constexpr (SP2) {
        PG8_STAGE(PG8_SB(0, 0), cB, voffB); PG8_STAGE(PG8_SB(0, 1), cB + hstep, voffB); PG8_STAGE(PG8_SA(0, 0), cA, voffA); PG8_STAGE(PG8_SA(0, 1), cA + hstep, voffA);
        if (wr == 1) PG8_BAR;
        PG8_WAIT_V(2); PG8_BAR;
        PG8_STAGE(PG8_SB(1, 0), cB + kstep, voffB); PG8_STAGE(PG8_SA(1, 0), cA + kstep, voffA); PG8_STAGE(PG8_SB(1, 1), cB + hstep + kstep, voffB);
        PG8_WAIT_V(6); PG8_BAR;
    } else {
        PG8_STAGE(PG8_SB(0, 0), cB, voffB); PG8_STAGE(PG8_SA(0, 0), cA, voffA); PG8_STAGE(PG8_SB(0, 1), cB + hstep, voffB); PG8_STAGE(PG8_SA(0, 1), cA + hstep, voffA);
        if (wr == 1) PG8_BAR;
        PG8_WAIT_V(4); PG8_BAR;
        PG8_STAGE(PG8_SB(1, 0), cB + kstep, voffB); PG8_STAGE(PG8_SA(1, 0), cA + kstep, voffA); PG8_STAGE(PG8_SB(1, 1), cB + hstep + kstep, voffB);
        PG8_WAIT_V(6); PG8_BAR;
    }
    for (;;) {
        const bool has_next = S.next(ui + 1, nxt);
        const char* nA = has_next ? (const char*)g.A + (size_t)nxt.pm * tstep : cA; const char* nB = has_next ? (const char*)g.Bt + (size_t)nxt.pn * tstep : cB;
        for (int t = 0; t < nt; t += 2) {
            const bool last = (t == nt - 2);
            const char* a1 = cA + (size_t)(t + 1) * kstep;
            const char* a2 = last ? nA : cA + (size_t)(t + 2) * kstep; const char* b2 = last ? nB : cB + (size_t)(t + 2) * kstep;
            const char* a3 = a2 + kstep; const char* b3 = b2 + kstep;
            if (last && has_next) S.a_ready(nxt);
            if constexpr (SP2) {
            PG8_LDB(B0, 0, 0); PG8_LDB(B1, 0, 1); PG8_SCHED; PG8_LDA(At, 0, 0); PG8_STAGE(PG8_SA(1, 1), a1 + hstep, voffA);
            PG8_WAIT_V(8); PG8_WAIT_L(0); PG8_BAR; PG8_MMA(0, 0, At, B0); PG8_MMA(0, 1, At, B1); PG8_BAR; PG8_SCHED;
            PG8_LDA(At, 0, 1); PG8_STAGE(PG8_SB(0, 0), b2, voffB); PG8_STAGE(PG8_SB(0, 1), b2 + hstep, voffB); PG8_STAGE(PG8_SA(0, 0), a2, voffA);
            PG8_WAIT_V(8); PG8_WAIT_L(0); PG8_BAR; PG8_MMA(1, 0, At, B0); PG8_MMA(1, 1, At, B1); PG8_BAR; PG8_SCHED;
            PG8_LDB(B0, 1, 0); PG8_LDB(B1, 1, 1); PG8_SCHED; PG8_LDA(At, 1, 0); PG8_STAGE(PG8_SA(0, 1), a2 + hstep, voffA);
            PG8_WAIT_V(8); PG8_WAIT_L(0); PG8_BAR; PG8_MMA(0, 0, At, B0); PG8_MMA(0, 1, At, B1); PG8_BAR; PG8_SCHED;
            PG8_LDA(At, 1, 1); PG8_STAGE(PG8_SB(1, 0), b3, voffB); PG8_STAGE(PG8_SB(1, 1), b3 + hstep, voffB); PG8_STAGE(PG8_SA(1, 0), a3, voffA);
            PG8_WAIT_V(8); PG8_WAIT_L(0); PG8_BAR; PG8_MMA(1, 0, At, B0); PG8_MMA(1, 1, At, B1); PG8_BAR; PG8_SCHED;
            } else {
            PG8_LDB(B0, 0, 0); PG8_SCHED; PG8_LDA(At, 0, 0); PG8_STAGE(PG8_SA(1, 1), a1 + hstep, voffA);
            PG8_WAIT_L(8); PG8_BAR; PG8_WAIT_L(0); PG8_MMA(0, 0, At, B0); PG8_BAR; PG8_SCHED;
            PG8_LDB(B1, 0, 1); PG8_STAGE(PG8_SB(0, 0), b2, voffB);
            PG8_BAR; PG8_WAIT_L(0); PG8_MMA(0, 1, At, B1); PG8_BAR;
            PG8_LDA(At, 0, 1); PG8_STAGE(PG8_SA(0, 0), a2, voffA);
            PG8_BAR; PG8_WAIT_L(0); PG8_MMA(1, 0, At, B0); PG8_BAR; PG8_SCHED;
            PG8_STAGE(PG8_SB(0, 1), b2 + hstep, voffB);
            PG8_WAIT_V(6); PG8_BAR; PG8_MMA(1, 1, At, B1); PG8_BAR;
            PG8_LDB(B0, 1, 0); PG8_SCHED; PG8_LDA(At, 1, 0); PG8_STAGE(PG8_SA(0, 1), a2 + hstep, voffA);
            PG8_WAIT_L(8); PG8_BAR; PG8_WAIT_L(0); PG8_MMA(0, 0, At, B0); PG8_BAR; PG8_SCHED;
            PG8_LDB(B1, 1, 1); PG8_STAGE(PG8_SB(1, 0), b3, voffB);
            PG8_BAR; PG8_WAIT_L(0); PG8_MMA(0, 1, At, B1); PG8_BAR;
            PG8_LDA(At, 1, 1); PG8_STAGE(PG8_SA(1, 0), a3, voffA);
            PG8_BAR; PG8_WAIT_L(0); PG8_MMA(1, 0, At, B0); PG8_BAR; PG8_SCHED;
            PG8_STAGE(PG8_SB(1, 1), b3 + hstep, voffB);
            PG8_WAIT_V(6); PG8_BAR; PG8_MMA(1, 1, At, B1); PG8_BAR;
            }
        }
        if constexpr (ALIGN_EPI) { if (wr == 0) PG8_BAR; }
        if constexpr (!Epi::AFTER_DRAIN) { E(acc, cur, ui, wr, wc, fr, fq); S.done(cur); }
        if (!has_next) break;
#pragma unroll
        for (int a = 0; a < 2; ++a)
#pragma unroll
            for (int b = 0; b < 2; ++b)
#pragma unroll
                for (int m = 0; m < 4; ++m)
#pragma unroll
                    for (int n = 0; n < 2; ++n) acc[a][b][m][n] = (f32x4){0.f, 0.f, 0.f, 0.f};
        cur = nxt; cA = nA; cB = nB; ++ui;
        if constexpr (ALIGN_EPI) { if (wr == 1) PG8_BAR; }
    }
    PG8_WAIT_V(0);
    if constexpr (!ALIGN_EPI) { if (wr == 0) PG8_BAR; }
    PG8_BAR;
    if constexpr (Epi::AFTER_DRAIN) { E.fused(acc, cur, wr, wc, fr, fq, lds, wid, lane); S.done(cur); }
#undef PG8_SA
#undef PG8_SB
#undef PG8_STAGE
#undef PG8_LDA
#undef PG8_LDB
#undef PG8_MMA
#undef PG8_WAIT_V
#undef PG8_WAIT_L
#undef PG8_BAR
#undef PG8_SCHED
}
}
constexpr int NWAVES = 8;
constexpr int BATCH = 2, SEQ = 8192, D = 1024, M = BATCH * SEQ;
constexpr int FH = 8, FDH = 128;
constexpr int RH = 4, RDK = 256, RDV = 512, CH = 64, NCH = SEQ / CH;
constexpr int DFF = 2816;
constexpr float EPS = 1e-6f;
constexpr float LOG2E = 1.4426950408889634f;
constexpr float QSCALE = 0.08838834764831845f * LOG2E;
constexpr int NPHASE = 14;

constexpr size_t MiB = 1u << 20;
constexpr size_t WS_CTL = 0, CTL_ZERO_BYTES = 1 * MiB;
constexpr size_t WS_SSQ = 1 * MiB;
constexpr size_t WS_LC = 2 * MiB;
constexpr size_t WS_TT = 2 * MiB + 512 * 1024;
constexpr size_t WS_NRM = 2 * MiB + 512 * 1024 + 16384;
constexpr size_t WS_ROPE = 3 * MiB;
constexpr size_t WS_WQKV0 = 11 * MiB;
constexpr size_t WS_WO0 = 17 * MiB;
constexpr size_t WS_WFI0 = 19 * MiB;
constexpr size_t WS_WFO0 = 30 * MiB;
constexpr size_t WS_WRI = 36 * MiB;
constexpr size_t WS_WRO = 48 * MiB;
constexpr size_t WS_WFI1 = 52 * MiB;
constexpr size_t WS_WFO1 = 63 * MiB;
constexpr size_t WS_XB = 69 * MiB;
constexpr size_t WS_ACT = 101 * MiB;
constexpr size_t WS_Q0 = WS_ACT, WS_K0 = WS_ACT + 32 * MiB, WS_V0 = WS_ACT + 64 * MiB;
constexpr size_t WS_O0 = WS_ACT + 96 * MiB;
constexpr size_t WS_HID = WS_ACT;
constexpr size_t WS_Q1 = WS_ACT, WS_K1 = WS_ACT + 32 * MiB, WS_V1 = WS_ACT + 64 * MiB;
constexpr size_t WS_PST = WS_ACT + 128 * MiB;
constexpr size_t WS_CBG = WS_PST;
constexpr size_t WS_LBUF = WS_WQKV0;
constexpr size_t WS_END = WS_PST + 8 * MiB;
static_assert(WS_WFO1 + (size_t)1024 * 2816 * 2 <= WS_XB && WS_HID + (size_t)M * DFF * 2 <= WS_PST && WS_END <= 256 * MiB, "d_ws map");
constexpr int CW_TMO = 0, CW_CODE = 1;
constexpr int CW_BAR = 4096;
constexpr int CW_ATT = 2048;

constexpr int RING_OFF = 0, RING_BYTES = 131072;
constexpr int LDSCTL_OFF = RING_BYTES, MISC_OFF = LDSCTL_OFF + 320;
constexpr int TAB_OFF = RING_BYTES + 512;
constexpr int STAB_OFF = TAB_OFF + 8192;
constexpr int LDS_BYTES = 147456;
static_assert(STAB_OFF + 4096 <= LDS_BYTES, "LDS map");
#define GAS __attribute__((address_space(1)))
#define LAS __attribute__((address_space(3)))
typedef unsigned short bf16;
typedef unsigned v4u __attribute__((ext_vector_type(4)));
typedef float f32x4 __attribute__((ext_vector_type(4)));
typedef short bf16x8 __attribute__((ext_vector_type(8)));
typedef GAS unsigned gu32;
typedef GAS unsigned long long gu64;
#define RLX_AGENT __ATOMIC_RELAXED, __HIP_MEMORY_SCOPE_AGENT
#define LDS_WAIT() asm volatile("s_waitcnt lgkmcnt(0)" ::: "memory")
#define VM_WAIT() asm volatile("s_waitcnt vmcnt(0)" ::: "memory")
__device__ __forceinline__ unsigned long long rt() { return __builtin_amdgcn_s_memrealtime(); }
__device__ __forceinline__ unsigned f2bf(float f) { unsigned u = __builtin_bit_cast(unsigned, f); return (u + 0x7fffu + ((u >> 16) & 1u)) >> 16; }
__device__ __forceinline__ unsigned pk2(float lo, float hi) { return f2bf(lo) | (f2bf(hi) << 16); }
typedef float f32x2 __attribute__((ext_vector_type(2)));
#define XB_TMO      128
#define XB_XCNT(j)  (256  + 64 * (j))
#define XB_XSUB(j)  (1280 + 64 * (j))
#define XB_XGEN(j)  (2304 + 64 * (j))
#define XB_TOP      3328
#define XB_TOPGEN   3392
#define XCD_BAR_WORDS 3456
#define XB_SPIN_CAP (1u << 18)

__device__ __forceinline__ unsigned xb_ld(unsigned* p)              { return __hip_atomic_load(p, __ATOMIC_RELAXED, __HIP_MEMORY_SCOPE_AGENT); }
__device__ __forceinline__ unsigned xb_add(unsigned* p, unsigned v) { return __hip_atomic_fetch_add(p, v, __ATOMIC_RELAXED, __HIP_MEMORY_SCOPE_AGENT); }
__device__ __forceinline__ unsigned xb_xcc_id() { return (unsigned)__builtin_amdgcn_s_getreg((3 << 11) | 20) & 0xFu; }
#define XB_SPIN(cond, bar) do { unsigned _sp = 0; while (cond) { __builtin_amdgcn_s_sleep(1); \
    if ((++_sp & 255u) == 0u) { if (xb_ld(&(bar)[XB_TMO])) break; if (_sp > XB_SPIN_CAP) { atomicAdd(&(bar)[XB_TMO], 1u); break; } } } } while (0)

struct XcdBarrier {
    unsigned* bar; unsigned x;
    volatile LAS unsigned* st;
};

__device__ __forceinline__ XcdBarrier xcd_barrier_post(unsigned* bar, volatile LAS unsigned* st) {
    XcdBarrier b; b.bar = bar; b.x = xb_xcc_id(); b.st = st;
    if (threadIdx.x == 0) (void)xb_add(&bar[XB_XCNT(b.x)], 1u);
    return b;
}
__device__ __forceinline__ void xcd_barrier_complete(unsigned* bar, unsigned x, unsigned& nloc, unsigned& nx) {
    const unsigned G = gridDim.x * gridDim.y * gridDim.z;
    unsigned sum, cnt, mine, sp = 0u;
    for (;;) {
        sum = 0u; cnt = 0u; mine = 0u;
#pragma unroll
        for (unsigned j = 0; j < 16; ++j) { const unsigned c = xb_ld(&bar[XB_XCNT(j)]); sum += c; cnt += (c > 0u) ? 1u : 0u; mine = (j == x) ? c : mine; }
        if (sum == G) break;
        __builtin_amdgcn_s_sleep(1);
        if ((++sp & 255u) == 0u) { if (xb_ld(&bar[XB_TMO])) break; if (sp > XB_SPIN_CAP) { atomicAdd(&bar[XB_TMO], 1u); break; } }
    }
    nloc = mine > 0u ? mine : 1u; nx = cnt > 0u ? cnt : 1u;
}

__device__ __forceinline__ void xcd_barrier(const XcdBarrier& b) {
    asm volatile("s_waitcnt vmcnt(0)" ::: "memory");
    __syncthreads();
    if (threadIdx.x == 0) {
        unsigned* bar = b.bar;
        __builtin_amdgcn_s_waitcnt(0);
        unsigned nloc = b.st[0], nx = b.st[1];
        if (nloc == 0u) { xcd_barrier_complete(bar, b.x, nloc, nx); b.st[0] = nloc; b.st[1] = nx; }
        const unsigned old = xb_add(&bar[XB_XSUB(b.x)], 1u);
        const unsigned gen = old / nloc;
        if (old + 1u == (gen + 1u) * nloc) {
            __builtin_amdgcn_fence(__ATOMIC_RELEASE, "agent");
            asm volatile("s_waitcnt vmcnt(0)" ::: "memory");
            const unsigned og = xb_add(&bar[XB_TOP], 1u);
            const unsigned tg = og / nx;
            if (og + 1u == (tg + 1u) * nx) xb_add(&bar[XB_TOPGEN], 1u);
            else XB_SPIN(xb_ld(&bar[XB_TOPGEN]) == tg, bar);
            __builtin_amdgcn_fence(__ATOMIC_ACQUIRE, "agent");
            xb_add(&bar[XB_XGEN(b.x)], 1u);
            asm volatile("s_waitcnt vmcnt(0)" ::: "memory");
        } else {
            XB_SPIN(xb_ld(&bar[XB_XGEN(b.x)]) == gen, bar);
            __builtin_amdgcn_fence(__ATOMIC_ACQUIRE, "agent");
            asm volatile("s_waitcnt vmcnt(0)" ::: "memory");
        }
    }
    __syncthreads();
}
namespace fa {
constexpr int D = 128, LDQ = 1024;
constexpr float THR = 8.f;
constexpr bool WSKIP = false;
constexpr int NW = 8, QBLK = 32, KVBLK = 64, QB = NW * QBLK;
constexpr int SHM_V = KVBLK * D * 2, SHM_K = KVBLK * D * 2;
constexpr int LDS_BYTES = 131072;
using bf16 = unsigned short;
typedef short bf16x8 __attribute__((ext_vector_type(8)));
typedef short s16x4 __attribute__((ext_vector_type(4)));
typedef float f32x16 __attribute__((ext_vector_type(16)));
typedef float f32x4 __attribute__((ext_vector_type(4)));
typedef unsigned u32x4 __attribute__((ext_vector_type(4)));
#define KSWZ(row, colB) ((row) * 256 + ((colB) ^ (((row) & 7) << 4)))
#define SBAR() __builtin_amdgcn_sched_barrier(0)
__device__ __forceinline__ int v_st(int k, int c) { const int kk = (k & ~0xC) | ((k & 4) << 1) | ((k & 8) >> 1); return ((kk >> 3) * 4 + (c >> 5)) * 512 + ((kk & 7) * 32 + (c & 31)) * 2; }
__device__ __forceinline__ int v_rd_base(int lane) { return ((lane & 3) << 3) | (((lane >> 2) & 3) << 6) | (((lane >> 4) & 1) << 5) | (((lane >> 5) & 1) << 8); }
constexpr int v_rd_off(int d0, int ks, int half) { return d0 * 512 + ks * 4096 + half * 2048; }
__device__ __forceinline__ int crow(int r, int hi) { return (r & 3) + 8 * (r >> 2) + 4 * hi; }
__device__ __forceinline__ unsigned cvtpk(float lo, float hi) {
    unsigned r; asm volatile("v_cvt_pk_bf16_f32 %0, %1, %2" : "=v"(r) : "v"(lo), "v"(hi)); return r;
}
__device__ __forceinline__ bf16x8 pack8(f32x4 a, f32x4 b) {
    u32x4 w = {cvtpk(a[0], a[1]), cvtpk(a[2], a[3]), cvtpk(b[0], b[1]), cvtpk(b[2], b[3])};
    return *reinterpret_cast<bf16x8*>(&w);
}
__device__ __forceinline__ bf16x8 load8(const bf16* p) { return *reinterpret_cast<const bf16x8*>(p); }
__device__ __forceinline__ void mask_tile(f32x16& p0, f32x16& p1, int dq, unsigned W) {
    const float NEG = -__builtin_inff();
#pragma unroll
    for (int r = 0; r < 16; ++r) {
        const int c = (r & 3) + 8 * (r >> 2);
        if ((unsigned)(dq - c) >= W) p0[r] = NEG;
        if ((unsigned)(dq - c - 32) >= W) p1[r] = NEG;
    }
}
__device__ __forceinline__ void partialSM(f32x16& p0, f32x16& p1, float& m_reg, float& mn, float& alpha) {
    float pmax = p0[0]; for (int r = 1; r < 16; ++r) pmax = fmaxf(pmax, p0[r]); for (int r = 0; r < 16; ++r) pmax = fmaxf(pmax, p1[r]);
    { auto rr = __builtin_amdgcn_permlane32_swap(__float_as_uint(pmax), __float_as_uint(pmax), false, false);
      pmax = fmaxf(__uint_as_float(rr[0]), __uint_as_float(rr[1])); }
    if (__builtin_expect(__all((pmax - m_reg) <= THR), 1)) { mn = m_reg; alpha = 1.f; }
    else { mn = fmaxf(m_reg, pmax); alpha = __builtin_amdgcn_exp2f(m_reg - mn); m_reg = mn; }
    for (int r = 0; r < 16; ++r) p0[r] = p0[r] - mn; for (int r = 0; r < 16; ++r) p1[r] = p1[r] - mn;
    for (int r = 0; r < 16; ++r) p0[r] = __builtin_amdgcn_exp2f(p0[r]);
}
__device__ __forceinline__ void finishSM(f32x16& p0, f32x16& p1, float alpha, float& l_reg, bf16x8& pa0, bf16x8& pa1, bf16x8& pa2, bf16x8& pa3) {
    for (int r = 0; r < 16; ++r) p1[r] = __builtin_amdgcn_exp2f(p1[r]);
    float ps = 0; for (int r = 0; r < 16; ++r) ps += p0[r]; for (int r = 0; r < 16; ++r) ps += p1[r];
    { auto rr = __builtin_amdgcn_permlane32_swap(__float_as_uint(ps), __float_as_uint(ps), false, false);
      ps = __uint_as_float(rr[0]) + __uint_as_float(rr[1]); }
    l_reg = l_reg * alpha + ps;
#define PK4(P, B_, OUT) do { unsigned a0 = cvtpk(P[B_+0], P[B_+1]), a1 = cvtpk(P[B_+2], P[B_+3]);                          \
        unsigned b0 = cvtpk(P[B_+4], P[B_+5]), b1 = cvtpk(P[B_+6], P[B_+7]);                                             \
        auto r0 = __builtin_amdgcn_permlane32_swap(a0, b0, false, false); auto r1 = __builtin_amdgcn_permlane32_swap(a1, b1, false, false); \
        u32x4 w = {r0[0], r1[0], r0[1], r1[1]}; OUT = *reinterpret_cast<bf16x8*>(&w); } while (0)
    PK4(p0, 0, pa0); PK4(p0, 8, pa1); PK4(p1, 0, pa2); PK4(p1, 8, pa3);
#undef PK4
}
__device__ __forceinline__ void qkt(f32x16& p0, f32x16& p1, const char* K_slot, int r32, int hi, const bf16x8* qr, const float* cbt) {
#pragma unroll
    for (int g = 0; g < 4; ++g) { const f32x4 a = *(const f32x4*)(cbt + 8 * g + 4 * hi), b = *(const f32x4*)(cbt + 32 + 8 * g + 4 * hi);
        p0[4 * g] = a[0]; p0[4 * g + 1] = a[1]; p0[4 * g + 2] = a[2]; p0[4 * g + 3] = a[3]; p1[4 * g] = b[0]; p1[4 * g + 1] = b[1]; p1[4 * g + 2] = b[2]; p1[4 * g + 3] = b[3]; }
    const char* kb[4];
#pragma unroll
    for (int dd = 0; dd < 4; ++dd) kb[dd] = K_slot + KSWZ(r32, (dd * 16 + hi * 8) * 2);
#pragma unroll
    for (int d0 = 0; d0 < 8; ++d0) { const char* a = kb[d0 & 3] + (d0 >> 2) * 128;
        bf16x8 b0 = *reinterpret_cast<const bf16x8*>(a);
        bf16x8 b1 = *reinterpret_cast<const bf16x8*>(a + 32 * 256);
        p0 = __builtin_amdgcn_mfma_f32_32x32x16_bf16(b0, qr[d0], p0, 0, 0, 0);
        p1 = __builtin_amdgcn_mfma_f32_32x32x16_bf16(b1, qr[d0], p1, 0, 0, 0); }
}
__device__ __forceinline__ void pv_tile(f32x16* o, int vbs, bf16x8 pa0, bf16x8 pa1, bf16x8 pa2, bf16x8 pa3) {
#define TRRD(dst, off) asm volatile("ds_read_b64_tr_b16 %0, %1 offset:%2" : "=&v"(dst) : "v"(vbs), "i"(off) : "memory")
#define PV_D0(d0) do { s16x4 l0, l1, l2, l3, h0, h1, h2, h3; constexpr int b_ = v_rd_off(d0, 0, 0);     \
        TRRD(l0, b_); TRRD(h0, b_ + 2048); TRRD(l1, b_ + 4096); TRRD(h1, b_ + 6144); TRRD(l2, b_ + 8192); TRRD(h2, b_ + 10240); TRRD(l3, b_ + 12288); TRRD(h3, b_ + 14336); \
        asm volatile("s_waitcnt lgkmcnt(0)" ::: "memory"); SBAR();                 \
        o[d0] = __builtin_amdgcn_mfma_f32_32x32x16_bf16(pa0, (bf16x8){l0[0], l0[1], l0[2], l0[3], h0[0], h0[1], h0[2], h0[3]}, o[d0], 0, 0, 0);   \
        o[d0] = __builtin_amdgcn_mfma_f32_32x32x16_bf16(pa1, (bf16x8){l1[0], l1[1], l1[2], l1[3], h1[0], h1[1], h1[2], h1[3]}, o[d0], 0, 0, 0);   \
        o[d0] = __builtin_amdgcn_mfma_f32_32x32x16_bf16(pa2, (bf16x8){l2[0], l2[1], l2[2], l2[3], h2[0], h2[1], h2[2], h2[3]}, o[d0], 0, 0, 0);   \
        o[d0] = __builtin_amdgcn_mfma_f32_32x32x16_bf16(pa3, (bf16x8){l3[0], l3[1], l3[2], l3[3], h3[0], h3[1], h3[2], h3[3]}, o[d0], 0, 0, 0); } while (0)
    PV_D0(0); PV_D0(1); PV_D0(2); PV_D0(3);
#undef PV_D0
#undef TRRD
}

#define FGAS __attribute__((address_space(1)))
struct BlockRef { FGAS char* base; unsigned qo, ko, vo, oo, cbo; int P0, kb0; float Bq; };
constexpr int LDS_VR = 0, LDS_KR = 3 * SHM_V, LDS_CBR = 3 * SHM_V + 3 * SHM_K, LDS_WSR = 131584;
__device__ __forceinline__ void glds16(const FGAS char* gsrc, unsigned lds_dst) {
    unsigned keep; asm volatile("s_mov_b32 %0, m0\n\ts_mov_b32 m0, %2\n\ts_nop 0\n\tglobal_load_lds_dwordx4 %1, off\n\ts_mov_b32 m0, %0" : "=&s"(keep) : "v"(gsrc), "s"(lds_dst) : "memory");
}
#define WAIT_BAR(N) asm volatile("s_waitcnt vmcnt(" #N ") lgkmcnt(0)\n\ts_barrier" ::: "memory")
__device__ __forceinline__ void fa_block(const BlockRef& cur, char* lds, int tid_in) {
    int tid = tid_in; asm volatile("" : "+v"(tid));
    const int wid = __builtin_amdgcn_readfirstlane(tid >> 6), lane = tid & 63, r32 = lane & 31, hi = lane >> 5;
    const int kb0 = cur.kb0, NT0 = (cur.P0 + QB - kb0) / KVBLK;
    const int NT = NT0;
    const int qlo = cur.P0 + wid * QBLK, qm = qlo + r32 - 4 * hi;
    float* CBA = (float*)(lds + LDS_CBR);
    float* ws = (float*)(lds + LDS_WSR) + wid * 64; float* li_l = ws, * al_l = ws + 32; float* mm_l = (float*)(lds + LDS_WSR + 2048);
    const unsigned lds0 = (unsigned)(uintptr_t)lds;
    for (int i = tid; i < (cur.P0 + QB - kb0) / 4; i += NW * 64) ((f32x4*)CBA)[i] = *(const FGAS f32x4*)(cur.base + cur.cbo + (unsigned)(kb0 * 4) + (unsigned)i * 16u);
    bf16x8 qr[8];
    { const unsigned qoff = (unsigned)(((wid * QBLK + r32) * LDQ + hi * 8) * 2);
#pragma unroll
      for (int d0 = 0; d0 < 8; ++d0) qr[d0] = *(const FGAS bf16x8*)(cur.base + cur.qo + qoff + d0 * 32); }
    asm volatile("s_waitcnt vmcnt(0)" ::: "memory");
    unsigned kso[2], vso[2];
#pragma unroll
    for (int i = 0; i < 2; ++i) { const int p = 2 * wid + i, row = 4 * p + (lane >> 4), c = (lane & 15) ^ (row & 7); kso[i] = (unsigned)(row * (LDQ * 2) + c * 16);
        const int sub = 2 * p + (lane >> 5), kk = 8 * (sub >> 2) + ((lane & 31) >> 2), k = (kk & ~0xC) | ((kk & 4) << 1) | ((kk & 8) >> 1), cc = 32 * (sub & 3) + 8 * (lane & 3); vso[i] = (unsigned)(k * (LDQ * 2) + cc * 2); }
    const FGAS char* Kt = cur.base + cur.ko + (size_t)kb0 * (LDQ * 2); const FGAS char* Vt = cur.base + cur.vo + (size_t)kb0 * (LDQ * 2);
#define DMA_K(t, slot) do { const FGAS char* g_ = Kt + (size_t)(NT0 - 1 - (t)) * (KVBLK * LDQ * 2); const unsigned d_ = (unsigned)__builtin_amdgcn_readfirstlane(lds0 + LDS_KR + (slot) + 2048 * wid); glds16(g_ + kso[0], d_); glds16(g_ + kso[1], d_ + 1024); } while (0)
#define DMA_V(t, slot) do { const FGAS char* g_ = Vt + (size_t)(NT0 - 1 - (t)) * (KVBLK * LDQ * 2); const unsigned d_ = (unsigned)__builtin_amdgcn_readfirstlane(lds0 + LDS_VR + (slot) + 2048 * wid); glds16(g_ + vso[0], d_); glds16(g_ + vso[1], d_ + 1024); } while (0)
    DMA_K(0, 0); DMA_V(0, 0); DMA_K(1, SHM_K);
    float m_reg = -1e30f, l_reg = 0; f32x16 o[4] = {};
    const int vb0 = (int)lds0 + LDS_VR + v_rd_base(lane);
#define RESC(a) do { if (__any((a) < 1.f)) { if (hi == 0) al_l[r32] = (a); asm volatile("s_waitcnt lgkmcnt(0)" ::: "memory");              \
                     for (int d_ = 0; d_ < 4; ++d_) for (int r = 0; r < 16; ++r) o[d_][r] *= al_l[crow(r, hi)]; } } while (0)
#define KBASE(t) (kb0 + (NT0 - 1 - (t)) * KVBLK)
#define MASKT(P0_, P1_, t) do { const int kb_ = KBASE(t); if (kb_ + KVBLK - 1 > qlo) mask_tile(P0_, P1_, qm - kb_, 0x40000000u); } while (0)
    f32x16 pA0, pA1, pB0, pB1; float mnA, mnB, alA, alB; bf16x8 pa0, pa1, pa2, pa3;
    int s_prev = 0, s_cur = 0, s_next = SHM_K;
#define ROT() do { s_prev = s_cur; s_cur = s_next; s_next = (s_next == 2 * SHM_K) ? 0 : s_next + SHM_K; } while (0)
    WAIT_BAR(4);
    DMA_K(2, 2 * SHM_K); DMA_V(1, SHM_V);
    SBAR(); qkt(pA0, pA1, lds + LDS_KR, r32, hi, qr, CBA + (NT0 - 1) * KVBLK);
    MASKT(pA0, pA1, 0); partialSM(pA0, pA1, m_reg, mnA, alA);
    WAIT_BAR(4);
    ROT();
#define STEP(PX0, PX1, mnX, alX, PY0, PY1, alY, t) do {                                                                       \
        { const int s_nn = (s_next == 2 * SHM_K) ? 0 : s_next + SHM_K;                  \
          if ((t) + 2 < NT) DMA_K((t) + 2, s_nn); if ((t) + 1 < NT) DMA_V((t) + 1, s_next); }                                  \
        SBAR(); qkt(PX0, PX1, lds + LDS_KR + s_cur, r32, hi, qr, CBA + (NT0 - 1 - (t)) * KVBLK);                                           \
        finishSM(PY0, PY1, alY, l_reg, pa0, pa1, pa2, pa3); SBAR();                                                           \
        pv_tile(o, vb0 + s_prev, pa0, pa1, pa2, pa3); MASKT(PX0, PX1, (t)); partialSM(PX0, PX1, m_reg, mnX, alX);             \
        RESC(alX);                                                                                                            \
        if ((t) + 2 < NT) WAIT_BAR(4); else if ((t) + 1 < NT) WAIT_BAR(2); else WAIT_BAR(0);                                   \
        ROT(); } while (0)
    int t = 1;
    for (; t + 1 < NT; t += 2) {
        STEP(pB0, pB1, mnB, alB, pA0, pA1, alA, t);
        STEP(pA0, pA1, mnA, alA, pB0, pB1, alB, t + 1);
    }
    if (t < NT) {
        STEP(pB0, pB1, mnB, alB, pA0, pA1, alA, t);
        finishSM(pB0, pB1, alB, l_reg, pa0, pa1, pa2, pa3); SBAR();
    } else {
        finishSM(pA0, pA1, alA, l_reg, pa0, pa1, pa2, pa3); SBAR();
    }
    pv_tile(o, vb0 + s_prev, pa0, pa1, pa2, pa3);
    if (hi == 0) li_l[r32] = l_reg; asm volatile("s_waitcnt lgkmcnt(0)" ::: "memory");
    float rli[16];
#pragma unroll
    for (int r = 0; r < 16; ++r) rli[r] = __builtin_amdgcn_rcpf(li_l[crow(r, hi)]);
    const unsigned ooff = (unsigned)(((wid * QBLK + 4 * hi) * LDQ + r32) * 2);
#pragma unroll
    for (int r = 0; r < 16; ++r) { FGAS char* orow = cur.base + cur.oo + ((r & 3) + 8 * (r >> 2)) * (LDQ * 2);
#pragma unroll
        for (int d0 = 0; d0 < 4; ++d0) { const float v = o[d0][r] * rli[r]; const float vn = __shfl_xor(v, 1);
            if ((r32 & 1) == 0) *(FGAS unsigned*)(orow + ooff + d0 * 64) = cvtpk(v, vn); } }
    asm volatile("s_waitcnt vmcnt(0) lgkmcnt(0)\n\ts_barrier" ::: "memory");
#undef RESC
#undef KBASE
#undef MASKT
#undef STEP
#undef ROT
#undef DMA_K
#undef DMA_V
}
#undef WAIT_BAR
#undef FGAS
#undef SBAR
#undef KSWZ
}
namespace rtn {
#define RLAS __attribute__((address_space(3)))
#define RGAS __attribute__((address_space(1)))
typedef short bf16x8 __attribute__((ext_vector_type(8)));
typedef short v4i16_t __attribute__((ext_vector_type(4)));
typedef float f32x16 __attribute__((ext_vector_type(16)));
typedef float f32x4 __attribute__((ext_vector_type(4)));
typedef unsigned u32x4 __attribute__((ext_vector_type(4)));
typedef unsigned u32x2 __attribute__((ext_vector_type(2)));
constexpr int NG = 16, RG = 8;
constexpr int LQ = 0, LK = 32768, LV = 65536, LK2 = 98304, LS = 132096, LPW = 140288;
constexpr int LDS_BYTES = LPW + 1024;
__device__ __forceinline__ int crow(int r, int hi) { return (r & 3) + 8 * (r >> 2) + 4 * hi; }
__device__ __forceinline__ unsigned cvtpk(float lo, float hi) { unsigned r; asm volatile("v_cvt_pk_bf16_f32 %0, %1, %2" : "=v"(r) : "v"(lo), "v"(hi)); return r; }
__device__ __forceinline__ float bflo(unsigned w) { return __builtin_bit_cast(float, w << 16); }
__device__ __forceinline__ float bfhi(unsigned w) { return __builtin_bit_cast(float, w & 0xffff0000u); }
__device__ __forceinline__ int off512(int row, int ch) { return 512 * row + 16 * (ch ^ (((row & 3) << 2) | ((row >> 2) & 3))); }
__device__ __forceinline__ int offS(int row, int ch8) { return 128 * row + 16 * (ch8 ^ ((row >> 1) & 7)); }
__device__ __forceinline__ bf16x8 lds128(unsigned a) { return *(const RLAS bf16x8*)(uintptr_t)a; }
__device__ __forceinline__ v4i16_t ldstr(unsigned a) { return __builtin_amdgcn_ds_read_tr16_b64_v4i16((RLAS v4i16_t*)(uintptr_t)a); }
__device__ __forceinline__ void glds16(const RGAS char* gsrc, unsigned lds_dst) {
    unsigned keep; asm volatile("s_mov_b32 %0, m0\n\ts_mov_b32 m0, %2\n\ts_nop 0\n\tglobal_load_lds_dwordx4 %1, off\n\ts_mov_b32 m0, %0" : "=&s"(keep) : "v"(gsrc), "s"(lds_dst) : "memory");
}
__device__ __forceinline__ void stage_tile(const RGAS char* g, unsigned ld_bytes, unsigned lbase, int wave, int lane) {
#pragma unroll
    for (int i = 0; i < 4; ++i) { const int pid = wave * 4 + i, row = 2 * pid + (lane >> 5), ch = (lane & 31) ^ (((row & 3) << 2) | ((row >> 2) & 3));
        glds16(g + (unsigned)row * ld_bytes + (unsigned)ch * 16u, (unsigned)__builtin_amdgcn_readfirstlane(lbase + 1024u * (unsigned)pid)); }
}
struct Ptrs { const RGAS char* Q; const RGAS char* K; RGAS char* V; RGAS char* L; RGAS float* PST; };
__device__ __forceinline__ void load_vfrags(bf16x8 (&vf)[4], unsigned vb0, unsigned vb1) {
#pragma unroll
    for (int s = 0; s < 4; ++s) { const v4i16_t lo = ldstr(vb0 + 8192 * s), hi = ldstr(vb1 + 8192 * s + 2048); vf[s] = (bf16x8){lo[0], lo[1], lo[2], lo[3], hi[0], hi[1], hi[2], hi[3]}; }
}
__device__ __forceinline__ void update_state(f32x16 (&X)[8], const bf16x8 (&vf)[4], unsigned kt0, unsigned kt1, unsigned lds0, int hh, float scl) {
    const RLAS float* pwr = (const RLAS float*)(uintptr_t)(lds0 + LPW + 144 * 4);
    v4i16_t fa[3][2][2];
#define RT_LOADB(buf, b) do { _Pragma("unroll") for (int j = 0; j < 2; ++j) { const int dt_ = 2 * ((b) & 3) + j, s_ = (b) >> 2; \
        fa[buf][j][0] = ldstr((kt0 ^ (unsigned)(64 * dt_)) + 8192 * s_); fa[buf][j][1] = ldstr((kt1 ^ (unsigned)(64 * dt_)) + 8192 * s_ + 2048); } } while (0)
    RT_LOADB(0, 0); RT_LOADB(1, 1);
    bf16x8 vs;
#pragma unroll
    for (int b = 0; b < 16; ++b) {
        if (b + 2 < 16) RT_LOADB((b + 2) % 3, b + 2);
        if ((b & 3) == 0) { const int s = b >> 2; const f32x4 f0 = *(const RLAS f32x4*)(pwr + 16 * s + 8 * hh), f1 = *(const RLAS f32x4*)(pwr + 16 * s + 8 * hh + 4);
            const u32x4 w = __builtin_bit_cast(u32x4, vf[s]); u32x4 o;
            o.x = cvtpk(bflo(w.x) * f0[0] * scl, bfhi(w.x) * f0[1] * scl); o.y = cvtpk(bflo(w.y) * f0[2] * scl, bfhi(w.y) * f0[3] * scl);
            o.z = cvtpk(bflo(w.z) * f1[0] * scl, bfhi(w.z) * f1[1] * scl); o.w = cvtpk(bflo(w.w) * f1[2] * scl, bfhi(w.w) * f1[3] * scl);
            vs = __builtin_bit_cast(bf16x8, o); }
        __builtin_amdgcn_sched_barrier(0);
#pragma unroll
        for (int j = 0; j < 2; ++j) { const v4i16_t lo = fa[b % 3][j][0], hi = fa[b % 3][j][1]; const int dt = 2 * (b & 3) + j;
            X[dt] = __builtin_amdgcn_mfma_f32_32x32x16_bf16((bf16x8){lo[0], lo[1], lo[2], lo[3], hi[0], hi[1], hi[2], hi[3]}, vs, X[dt], 0, 0, 0); }
        __builtin_amdgcn_sched_barrier(0);
    }
#undef RT_LOADB
}
__device__ __forceinline__ void dump_state(const f32x16 (&X)[8], RGAS char* L, int wave, int lane, float scl) {
#pragma unroll
    for (int dt = 0; dt < 8; ++dt)
#pragma unroll
        for (int s = 0; s < 2; ++s) { u32x4 o; o.x = cvtpk(X[dt][8 * s] * scl, X[dt][8 * s + 1] * scl); o.y = cvtpk(X[dt][8 * s + 2] * scl, X[dt][8 * s + 3] * scl);
            o.z = cvtpk(X[dt][8 * s + 4] * scl, X[dt][8 * s + 5] * scl); o.w = cvtpk(X[dt][8 * s + 6] * scl, X[dt][8 * s + 7] * scl);
            *(RGAS u32x4*)(L + (unsigned)(wave * 16384 + (2 * dt + s) * 1024 + lane * 16)) = o; }
}
__device__ __forceinline__ void accum_state(f32x16 (&X)[8], const RGAS char* L, int wave, int lane, float dec) {
#pragma unroll
    for (int dt = 0; dt < 8; ++dt)
#pragma unroll
        for (int s = 0; s < 2; ++s) { const u32x4 w = *(const RGAS u32x4*)(L + (unsigned)(wave * 16384 + (2 * dt + s) * 1024 + lane * 16));
            X[dt][8 * s] = X[dt][8 * s] * dec + bflo(w.x); X[dt][8 * s + 1] = X[dt][8 * s + 1] * dec + bfhi(w.x); X[dt][8 * s + 2] = X[dt][8 * s + 2] * dec + bflo(w.y); X[dt][8 * s + 3] = X[dt][8 * s + 3] * dec + bfhi(w.y);
            X[dt][8 * s + 4] = X[dt][8 * s + 4] * dec + bflo(w.z); X[dt][8 * s + 5] = X[dt][8 * s + 5] * dec + bfhi(w.z); X[dt][8 * s + 6] = X[dt][8 * s + 6] * dec + bflo(w.w); X[dt][8 * s + 7] = X[dt][8 * s + 7] * dec + bfhi(w.w); }
}
template <bool FULL>
__device__ __forceinline__ void run_item(const Ptrs& P, int bh, int half, int g, unsigned lds0, int wave_in) {
    int lane0_ = hw_lane_id(); asm volatile("" : "+v"(lane0_));
    const int lane0 = lane0_, wave = wave_in, tid = wave * 64 + lane0;
    const int b = bh >> 2, h = bh & 3;
    const float lg = __logf(1.0f - __builtin_amdgcn_exp2f(-5.0f - (float)h));
    const float cd = __expf(lg * 64.f), cdinv = __expf(-lg * 64.f);
    RLAS float* pw = (RLAS float*)(uintptr_t)(lds0 + LPW);
    __syncthreads();
    if (tid <= 64) pw[tid] = __expf(lg * (float)tid);
    if (tid < 64) { pw[80 + tid] = __expf(lg * (float)(tid + 1)); pw[144 + tid] = __expf(lg * (float)(63 - tid)); }
    const int g16 = lane0 >> 4, blk = g16 & 1, q4 = (lane0 & 15) >> 2, p4 = lane0 & 3, sp = ((p4 & 1) << 1) | (p4 >> 1), hh0 = lane0 >> 5;
    const unsigned trrow = (unsigned)(512 * (8 * hh0 + q4));
    const int fl = (q4 << 2) | (hh0 << 1);
    unsigned vb0_ = lds0 + LV + trrow + 16u * (unsigned)((4 * wave + 2 * blk + (p4 >> 1)) ^ fl) + 8u * (unsigned)(p4 & 1);
    unsigned kt0_ = lds0 + LK + trrow + 16u * (unsigned)((2 * blk + (sp >> 1)) ^ fl) + 8u * (unsigned)(sp & 1);
    unsigned lane_ = (unsigned)lane0;
    const size_t tok0 = (size_t)b * 8192 + (size_t)g * (RG * 64);
    const RGAS char* Qg = P.Q + (tok0 * 1024 + (size_t)h * 256) * 2; const RGAS char* Kg = P.K + (tok0 * 1024 + (size_t)h * 256) * 2;
    RGAS char* Vg = P.V + (tok0 * 2048 + (size_t)h * 512 + (size_t)half * 256) * 2;
    f32x16 X[8];
#pragma unroll
    for (int dt = 0; dt < 8; ++dt) X[dt] = f32x16{};
    if constexpr (FULL) {
        const float cdg = __expf(lg * (float)(RG * 64));
        for (int gp = 0; gp < g; ++gp) accum_state(X, P.L + (size_t)((bh * (NG - 1) + gp) * 2 + half) * 131072, wave, lane0, cdg);
    }
    float cdm = 1.f, cdim = cdinv;
    __syncthreads();
    if constexpr (FULL) { stage_tile(Qg, 2048, lds0 + LQ, wave, lane0); stage_tile(Vg, 4096, lds0 + LV, wave, lane0); } else { stage_tile(Vg, 4096, lds0 + LV, wave, lane0); }
    stage_tile(Kg, 2048, lds0 + LK, wave, lane0);
    for (int m = 0; m < RG; ++m) {
        const unsigned kb = (m & 1) ? (unsigned)(LK2 - LK) : 0u, vbuf = (!FULL && (m & 1)) ? (unsigned)(LQ - LV) : 0u;
        asm volatile("s_waitcnt vmcnt(0)" ::: "memory");
        __syncthreads();
        asm volatile("" : "+v"(vb0_), "+v"(kt0_), "+v"(lane_));
        const unsigned vb0 = vb0_ + vbuf, vb1 = vb0 ^ 16u, kt0 = kt0_ + kb, kt1 = kt0 ^ 16u; const int lane = (int)lane_, hh = lane >> 5, c32 = lane & 31, i16 = lane & 15;
        if (m + 1 < RG) { stage_tile(Kg + (size_t)(m + 1) * (64 * 2048), 2048, lds0 + LK + ((m & 1) ? 0u : (unsigned)(LK2 - LK)), wave, lane);
            if constexpr (!FULL) stage_tile(Vg + (size_t)(m + 1) * (64 * 4096), 4096, lds0 + ((m & 1) ? (unsigned)LV : (unsigned)LQ), wave, lane); }
        bf16x8 vf[4];
        if constexpr (FULL) {
            {
                const int itile = wave >> 1, jt0 = 2 * (wave & 1), qq = lane >> 4;
                const int fS = ((i16 & 3) << 2) | ((i16 >> 2) & 3);
                const unsigned qa = lds0 + LQ + (unsigned)(512 * (16 * itile + i16)) + 16u * (unsigned)(qq ^ fS), ka = lds0 + LK + kb + (unsigned)(512 * (16 * jt0 + i16)) + 16u * (unsigned)(qq ^ fS);
                f32x4 s0 = {0.f, 0.f, 0.f, 0.f}, s1 = {0.f, 0.f, 0.f, 0.f};
#pragma unroll
                for (int s = 0; s < 8; ++s) { const bf16x8 qf = lds128(qa ^ (unsigned)(64 * s)), k0 = lds128(ka ^ (unsigned)(64 * s)), k1 = lds128((ka ^ (unsigned)(64 * s)) + 8192);
                    s0 = __builtin_amdgcn_mfma_f32_16x16x32_bf16(k0, qf, s0, 0, 0, 0); s1 = __builtin_amdgcn_mfma_f32_16x16x32_bf16(k1, qf, s1, 0, 0, 0);
                    if ((s & 3) == 3) asm volatile("" ::: "memory"); }
                const int irow = 16 * itile + i16;
#pragma unroll
                for (int tt = 0; tt < 2; ++tt) { const f32x4 sv = tt ? s1 : s0; const int jb = 16 * (jt0 + tt) + 4 * qq; float e[4];
#pragma unroll
                    for (int r = 0; r < 4; ++r) { const int dj = irow - (jb + r); e[r] = sv[r] * pw[dj < 0 ? -dj : dj]; }
                    u32x2 o; o.x = cvtpk(e[0], e[1]); o.y = cvtpk(e[2], e[3]);
                    *(RLAS u32x2*)(uintptr_t)(lds0 + LS + offS(irow, 2 * (jt0 + tt) + (qq >> 1)) + 8 * (qq & 1)) = o; }
            }
            load_vfrags(vf, vb0, vb1);
            f32x16 Y[2]; Y[0] = f32x16{}; Y[1] = f32x16{};
            const int fQ = ((c32 & 3) << 2) | ((c32 >> 2) & 3);
            const unsigned qr0 = lds0 + LQ + (unsigned)(512 * c32) + 16u * (unsigned)(hh ^ fQ);
#pragma unroll
            for (int dt = 0; dt < 8; ++dt)
#pragma unroll
                for (int s = 0; s < 2; ++s) { u32x4 pb; pb.x = cvtpk(X[dt][8 * s], X[dt][8 * s + 1]); pb.y = cvtpk(X[dt][8 * s + 2], X[dt][8 * s + 3]); pb.z = cvtpk(X[dt][8 * s + 4], X[dt][8 * s + 5]); pb.w = cvtpk(X[dt][8 * s + 6], X[dt][8 * s + 7]);
                    const bf16x8 bq = __builtin_bit_cast(bf16x8, pb); const unsigned a = qr0 ^ (unsigned)(16 * (4 * dt + 2 * s));
                    Y[0] = __builtin_amdgcn_mfma_f32_32x32x16_bf16(lds128(a), bq, Y[0], 0, 0, 0); Y[1] = __builtin_amdgcn_mfma_f32_32x32x16_bf16(lds128(a + 16384), bq, Y[1], 0, 0, 0);
                    if (s == 1 && (dt & 1)) asm volatile("" ::: "memory"); }
#pragma unroll
            for (int it = 0; it < 2; ++it)
#pragma unroll
                for (int rg = 0; rg < 4; ++rg) { const f32x4 f = *(const RLAS f32x4*)(pw + 80 + 32 * it + 8 * rg + 4 * hh);
                    Y[it][4 * rg] *= f[0] * cdm; Y[it][4 * rg + 1] *= f[1] * cdm; Y[it][4 * rg + 2] *= f[2] * cdm; Y[it][4 * rg + 3] *= f[3] * cdm; }
            asm volatile("s_waitcnt lgkmcnt(0)" ::: "memory"); __builtin_amdgcn_s_barrier(); asm volatile("" ::: "memory");
            if (m + 1 < RG) { stage_tile(Qg + (size_t)(m + 1) * (64 * 2048), 2048, lds0 + LQ, wave, lane); stage_tile(Vg + (size_t)(m + 1) * (64 * 4096), 4096, lds0 + LV, wave, lane); }
            const unsigned sr0 = lds0 + LS + (unsigned)(128 * c32) + 16u * (unsigned)(hh ^ ((c32 >> 1) & 7));
            const unsigned sr1 = lds0 + LS + (unsigned)(128 * (32 + c32)) + 16u * (unsigned)(hh ^ (((32 + c32) >> 1) & 7));
#pragma unroll
            for (int s = 0; s < 4; ++s) { Y[0] = __builtin_amdgcn_mfma_f32_32x32x16_bf16(lds128(sr0 ^ (unsigned)(32 * s)), vf[s], Y[0], 0, 0, 0);
                Y[1] = __builtin_amdgcn_mfma_f32_32x32x16_bf16(lds128(sr1 ^ (unsigned)(32 * s)), vf[s], Y[1], 0, 0, 0); }
            const size_t tokm = tok0 + (size_t)m * 64;
            RGAS char* yb = P.V + ((tokm * 2048 + (size_t)h * 512 + (size_t)half * 256 + (size_t)wave * 32) * 2);
#pragma unroll
            for (int it = 0; it < 2; ++it) {
#pragma unroll
                for (int r = 0; r < 16; ++r) { const float v = Y[it][r], vn = __shfl_xor(v, 1);
                    if ((c32 & 1) == 0) *(RGAS unsigned*)(yb + (unsigned)(32 * it + crow(r, hh)) * 4096u + (unsigned)c32 * 2u) = cvtpk(v, vn); }
                const bool b4 = (c32 & 16) != 0, b3 = (c32 & 8) != 0, b2 = (c32 & 4) != 0, b1 = (c32 & 2) != 0;
                float c1[8], c2[8], d1[4], d2[4], e1[2], e2[2];
#pragma unroll
                for (int k = 0; k < 8; ++k) { const float lo = Y[it][k], hi = Y[it][8 + k], lo2 = lo * lo, hi2 = hi * hi;
                    c1[k] = (b4 ? hi : lo) + __shfl_xor(b4 ? lo : hi, 16); c2[k] = (b4 ? hi2 : lo2) + __shfl_xor(b4 ? lo2 : hi2, 16); }
#pragma unroll
                for (int k = 0; k < 4; ++k) { d1[k] = (b3 ? c1[4 + k] : c1[k]) + __shfl_xor(b3 ? c1[k] : c1[4 + k], 8); d2[k] = (b3 ? c2[4 + k] : c2[k]) + __shfl_xor(b3 ? c2[k] : c2[4 + k], 8); }
#pragma unroll
                for (int k = 0; k < 2; ++k) { e1[k] = (b2 ? d1[2 + k] : d1[k]) + __shfl_xor(b2 ? d1[k] : d1[2 + k], 4); e2[k] = (b2 ? d2[2 + k] : d2[k]) + __shfl_xor(b2 ? d2[k] : d2[2 + k], 4); }
                float s1 = (b1 ? e1[1] : e1[0]) + __shfl_xor(b1 ? e1[0] : e1[1], 2), s2 = (b1 ? e2[1] : e2[0]) + __shfl_xor(b1 ? e2[0] : e2[1], 2);
                s1 += __shfl_xor(s1, 1); s2 += __shfl_xor(s2, 1);
                if ((c32 & 1) == 0) { typedef float f32x2 __attribute__((ext_vector_type(2))); f32x2 st; st.x = s1; st.y = s2; const int row = 32 * it + crow((c32 >> 1) & 15, hh);
                    *(RGAS f32x2*)(P.PST + (((tokm + row) * 4 + h) * 16 + half * 8 + wave) * 2) = st; }
            }
        } else {
            load_vfrags(vf, vb0, vb1);
        }
        update_state(X, vf, kt0, kt1, lds0, hh, cdim);
        cdm *= cd; cdim *= cdinv;
    }
    __syncthreads();
    if constexpr (!FULL) dump_state(X, P.L + (size_t)((bh * (NG - 1) + g) * 2 + half) * 131072, wave, lane0, cdm);
}
#undef RLAS
#undef RGAS
}
struct Args { const float* in[11]; float* out; unsigned char* wsp; int ph_lo, ph_hi, li, pad; };
struct Frame {
    LAS unsigned char* lds;
    volatile LAS unsigned* MISC;
    int tid, lane, wave;
    int vcu, G;
    const __attribute__((address_space(4))) Args* ap;
};
#define FP(i) (F.ap->in[i])
#define F_x FP(0)
#define F_norm_mix FP(1)
#define F_norm_ffn FP(2)
#define F_fox_w_in FP(3)
#define F_fox_b_f FP(4)
#define F_fox_w_out FP(5)
#define F_ret_w_in FP(6)
#define F_ret_w_out FP(7)
#define F_ffn_w_in FP(8)
#define F_ffn_w_out FP(9)
#define F_final_norm FP(10)
#define F_out (F.ap->out)
#define F_ws (F.ap->wsp)
__device__ __forceinline__ float wave_sum(float v) {
#pragma unroll
    for (int o = 1; o < 64; o <<= 1) v += __shfl_xor(v, o);
    return v;
}

__device__ __forceinline__ void p0_item(const float* W, int K, int Nsrc, int scol0, bf16* WT, int drow0, int k0, const float* g, LAS float* scr, int lane) {
    const int nq = lane & 7, kr = lane >> 3;
    f32x4 v[8];
#pragma unroll
    for (int i = 0; i < 8; ++i) v[i] = *(const GAS f32x4*)(W + (size_t)(k0 + kr + 8 * i) * Nsrc + scol0 + 4 * nq);
#pragma unroll
    for (int i = 0; i < 8; ++i) { const int kk = kr + 8 * i; const float gv = g ? g[k0 + kk] : 1.f; LAS float* d = scr + kk * 33 + 4 * nq;
        d[0] = v[i].x * gv; d[1] = v[i].y * gv; d[2] = v[i].z * gv; d[3] = v[i].w * gv; }
    LDS_WAIT(); asm volatile("" ::: "memory");
    const int c = lane & 7;
#pragma unroll
    for (int j = 0; j < 4; ++j) { const int n = (lane >> 3) + 8 * j; const LAS float* s = scr + (8 * c) * 33 + n;
        v4u o; o.x = pk2(s[0 * 33], s[1 * 33]); o.y = pk2(s[2 * 33], s[3 * 33]); o.z = pk2(s[4 * 33], s[5 * 33]); o.w = pk2(s[6 * 33], s[7 * 33]);
        *(GAS v4u*)(WT + (size_t)(drow0 + n) * K + k0 + 8 * c) = o; }
    LDS_WAIT(); asm volatile("" ::: "memory");
}
__device__ __forceinline__ void p0_matrix(int r, const float* W, int K, int N, int Nsrc, bool swiglu, bf16* WT, const float* g, LAS float* scr, int lane) {
    const int nblk = N / 32, kb = r / nblk, nb = r % nblk, drow0 = 32 * nb;
    int scol0 = drow0;
    if (swiglu) { const int t = drow0 >> 8, rr = drow0 & 255; scol0 = (rr < 128) ? t * 128 + rr : DFF + t * 128 + (rr - 128); }
    p0_item(W, K, Nsrc, scol0, WT, drow0, 64 * kb, g, scr, lane);
}
__device__ __forceinline__ void p0_xtile(Frame& F, int tile) {
    LAS float* wfs = (LAS float*)(F.lds);
    LAS float* tot = (LAS float*)(F.lds + 32768);
#pragma unroll
    for (int kk = 0; kk < 2; ++kk) { const int k = F.tid + 512 * kk; const float gk = F_norm_mix[k];
        const f32x4 w0 = *(const GAS f32x4*)(F_fox_w_in + (size_t)k * 3080 + 3072), w1 = *(const GAS f32x4*)(F_fox_w_in + (size_t)k * 3080 + 3076);
        wfs[k] = w0.x * gk; wfs[1024 + k] = w0.y * gk; wfs[2048 + k] = w0.z * gk; wfs[3072 + k] = w0.w * gk; wfs[4096 + k] = w1.x * gk; wfs[5120 + k] = w1.y * gk; wfs[6144 + k] = w1.z * gk; wfs[7168 + k] = w1.w * gk; }
    __syncthreads();
    const int myh = (F.lane >> 3) & 7;
    const float bfv = F_fox_b_f[myh];
    bf16* XB = (bf16*)(F_ws + WS_XB); float* SSQ = (float*)(F_ws + WS_SSQ);
    const int row0 = tile * 64 + F.wave * 8;
    const bool b5 = (F.lane & 32) != 0, b4 = (F.lane & 16) != 0, b3 = (F.lane & 8) != 0;
    float run = 0.f, mine[8];
    f32x4 v[4], vn[4];
    { const GAS f32x4* xr = (const GAS f32x4*)(F_x + (size_t)row0 * D) + F.lane;
#pragma unroll
      for (int j = 0; j < 4; ++j) vn[j] = xr[64 * j]; }
#pragma unroll
    for (int i = 0; i < 8; ++i) {
        const int row = row0 + i;
#pragma unroll
        for (int j = 0; j < 4; ++j) v[j] = vn[j];
        if (i < 7) { const GAS f32x4* xr = (const GAS f32x4*)(F_x + (size_t)(row + 1) * D) + F.lane;
#pragma unroll
            for (int j = 0; j < 4; ++j) vn[j] = xr[64 * j]; }
        float ss = 0.f;
#pragma unroll
        for (int j = 0; j < 4; ++j) ss += (v[j].x * v[j].x + v[j].y * v[j].y) + (v[j].z * v[j].z + v[j].w * v[j].w);
        GAS unsigned long long* o8 = (GAS unsigned long long*)(XB + (size_t)row * D) + F.lane;
#pragma unroll
        for (int j = 0; j < 4; ++j) o8[64 * j] = (unsigned long long)pk2(v[j].x, v[j].y) | ((unsigned long long)pk2(v[j].z, v[j].w) << 32);
        float a[8];
#pragma unroll
        for (int h = 0; h < 8; ++h) { float acc = 0.f;
#pragma unroll
            for (int j = 0; j < 4; ++j) { const f32x4 w = *(const LAS f32x4*)(wfs + h * 1024 + 4 * (F.lane + 64 * j)); acc += (v[j].x * w.x + v[j].y * w.y) + (v[j].z * w.z + v[j].w * w.w); }
            a[h] = acc; }
        ss = wave_sum(ss);
        float c[4], d[2];
#pragma unroll
        for (int k = 0; k < 4; ++k) c[k] = (b5 ? a[4 + k] : a[k]) + __shfl_xor(b5 ? a[k] : a[4 + k], 32);
#pragma unroll
        for (int k = 0; k < 2; ++k) d[k] = (b4 ? c[2 + k] : c[k]) + __shfl_xor(b4 ? c[k] : c[2 + k], 16);
        float e = (b3 ? d[1] : d[0]) + __shfl_xor(b3 ? d[0] : d[1], 8);
        e += __shfl_xor(e, 4); e += __shfl_xor(e, 2); e += __shfl_xor(e, 1);
        const float rstd = 1.0f / sqrtf(ss * (1.f / D) + EPS);
        if (F.lane < 16) SSQ[(size_t)row * 16 + F.lane] = (F.lane == 0) ? ss : 0.f;
        const float z = e * rstd + bfv; const float lf = fminf(z, 0.f) - log1pf(__expf(-fabsf(z)));
        run += lf; mine[i] = run;
    }
    if ((F.lane & 7) == 0) tot[F.wave * 8 + myh] = run;
    __syncthreads();
    float* LC = (float*)(F_ws + WS_LC); float* TT = (float*)(F_ws + WS_TT);
    if ((F.lane & 7) == 0) { float off = 0.f; for (int w = 0; w < F.wave; ++w) off += tot[w * 8 + myh];
#pragma unroll
        for (int i = 0; i < 8; ++i) LC[(size_t)(row0 + i) * 8 + myh] = mine[i] + off; }
    if (F.tid < 8) { float s = 0.f; for (int w = 0; w < 8; ++w) s += tot[w * 8 + F.tid]; TT[tile * 8 + F.tid] = s; }
    __syncthreads();
}
__device__ __forceinline__ void p0_prologue(Frame& F) {
    for (int t = (int)blockIdx.x; t < M / 64; t += F.G) p0_xtile(F, t);
    LAS float* scr = (LAS float*)(F.lds + RING_OFF + F.wave * 16384);
    const int gw = F.vcu * NWAVES + F.wave, NGW = F.G * NWAVES;
    constexpr int I0 = 16 * 96, I1 = 16 * 32, I2 = 16 * 176, I3 = 44 * 32, I4 = 16 * 192, I5 = 32 * 32;
    constexpr int NITEMS = I0 + I1 + I2 + I3 + I4 + I5;
    unsigned char* ws = F_ws;
    for (int it = gw; it < NITEMS; it += NGW) {
        int r = it;
        if (r < I0) { p0_matrix(r, F_fox_w_in, 1024, 3072, 3080, false, (bf16*)(ws + WS_WQKV0), F_norm_mix, scr, F.lane); continue; } r -= I0;
        if (r < I1) { p0_matrix(r, F_fox_w_out, 1024, 1024, 1024, false, (bf16*)(ws + WS_WO0), nullptr, scr, F.lane); continue; } r -= I1;
        if (r < I2) { p0_matrix(r, F_ffn_w_in, 1024, 2 * DFF, 2 * DFF, true, (bf16*)(ws + WS_WFI0), F_norm_ffn, scr, F.lane); continue; } r -= I2;
        if (r < I3) { p0_matrix(r, F_ffn_w_out, DFF, 1024, 1024, false, (bf16*)(ws + WS_WFO0), nullptr, scr, F.lane); continue; } r -= I3;
        if (r < I4) { p0_matrix(r, F_ret_w_in, 1024, 6144, 6144, false, (bf16*)(ws + WS_WRI), F_norm_mix + D, scr, F.lane); continue; } r -= I4;
        p0_matrix(r, F_ret_w_out, 2048, 1024, 1024, false, (bf16*)(ws + WS_WRO), nullptr, scr, F.lane);
    }
    float* rope = (float*)(ws + WS_ROPE);
    {
        const int idx0 = F.vcu * (NWAVES * 64) + F.tid;
        const float inv = (float)exp2(-(double)(idx0 & 127) * (13.287712379549449 / 128.0));
        for (int idx = idx0; idx < SEQ * 128; idx += F.G * NWAVES * 64) {
            const float ang = (float)(idx >> 7) * inv;
            const double t = (double)ang * 0.15915494309189535; const float fr = (float)(t - rint(t));
            f32x2 cs; cs.x = __builtin_amdgcn_cosf(fr); cs.y = __builtin_amdgcn_sinf(fr);
            *(f32x2*)(rope + (size_t)idx * 2) = cs;
        }
    }
}

__device__ __forceinline__ void p0_late_weights(Frame& F, int first) {
    const int nwg = F.G - first; if ((int)blockIdx.x < first || nwg <= 0) return;
    LAS float* scr = (LAS float*)(F.lds + RING_OFF + F.wave * 16384);
    const int gw = ((int)blockIdx.x - first) * NWAVES + F.wave, NGW = nwg * NWAVES;
    constexpr int I6 = 16 * 176, I7 = 44 * 32;
    unsigned char* ws = F_ws;
    for (int it = gw; it < I6 + I7; it += NGW) {
        if (it < I6) p0_matrix(it, F_ffn_w_in + (size_t)D * 2 * DFF, 1024, 2 * DFF, 2 * DFF, true, (bf16*)(ws + WS_WFI1), F_norm_ffn + D, scr, F.lane);
        else p0_matrix(it - I6, F_ffn_w_out + (size_t)DFF * D, DFF, 1024, 1024, false, (bf16*)(ws + WS_WFO1), nullptr, scr, F.lane);
    }
}

__device__ __forceinline__ void fill_rstd_tab(Frame& F, const pg8::StaticOrder& S) {
    LAS float* tab = (LAS float*)(F.lds + TAB_OFF); const float* SSQ = (const float*)(F_ws + WS_SSQ);
    pg8::Unit u;
    for (int i = 0; i < 8 && S.next(i, u); ++i) if (F.tid < 256) {
        const f32x4* p = (const f32x4*)(SSQ + (size_t)(u.pm * 256 + F.tid) * 16); const f32x4 a = p[0], b = p[1], c = p[2], d = p[3];
        const float s = ((a.x + a.y) + (a.z + a.w)) + ((b.x + b.y) + (b.z + b.w)) + ((c.x + c.y) + (c.z + c.w)) + ((d.x + d.y) + (d.z + d.w));
        tab[i * 256 + F.tid] = 1.0f / sqrtf(s * (1.f / D) + EPS); }
    __syncthreads();
}
__device__ __forceinline__ void fill_gate_tab(Frame& F, const pg8::StaticOrder& S) {
    LAS f32x2* stab = (LAS f32x2*)(F.lds + STAB_OFF); const float* PST = (const float*)(F_ws + WS_PST);
    pg8::Unit u;
    for (int i = 0; i < 2 && S.next(i, u); ++i) if (F.tid < 256) {
        const f32x4* p = (const f32x4*)(PST + ((size_t)(u.pm * 256 + F.tid) * 4 + (u.pn >> 1)) * 32); float s = 0.f, q = 0.f;
#pragma unroll
        for (int j = 0; j < 8; ++j) { const f32x4 v = p[j]; s += v.x + v.z; q += v.y + v.w; }
        const float mu = s * (1.f / RDV), var = fmaxf(q * (1.f / RDV) - mu * mu, 0.f);
        f32x2 st; st.x = mu; st.y = 1.0f / sqrtf(var + EPS); stab[i * 256 + F.tid] = st; }
    __syncthreads();
}


__device__ __forceinline__ void cbg_phase(Frame& F) {
    const float* LC = (const float*)(F_ws + WS_LC); const float* TT = (const float*)(F_ws + WS_TT); float* CBG = (float*)(F_ws + WS_CBG);
    LAS float* pre = (LAS float*)(F.lds);
    for (int item = (int)blockIdx.x; item < 16 * 16; item += F.G) {
        const int bh = item >> 4, seg = item & 15, b = bh >> 3, h = bh & 7, s = seg * 512 + F.tid;
        __syncthreads();
        if (F.tid < 128) pre[F.tid] = TT[(b * 128 + F.tid) * 8 + h];
        __syncthreads();
        if (F.tid == 0) { float p = 0.f; for (int t = 0; t < 128; ++t) { const float v = pre[t]; pre[t] = p; p += v; } }
        __syncthreads();
        CBG[(size_t)bh * SEQ + s] = -(pre[s >> 6] + LC[(size_t)(b * SEQ + s) * 8 + h]) * LOG2E;
    }
    __syncthreads();
}
__device__ __forceinline__ fa::BlockRef fa_ref(Frame& F, int bh, int qb, int kb0, float Bq) {
    const int b = bh >> 3, h = bh & 7; fa::BlockRef r; r.base = (GAS char*)F_ws;
    const unsigned ro = (unsigned)(((b * SEQ + qb * 256) * 1024 + h * 128) * 2), ho = (unsigned)((b * SEQ * 1024 + h * 128) * 2);
    r.qo = (unsigned)WS_Q0 + ro; r.oo = (unsigned)WS_O0 + ro; r.ko = (unsigned)WS_K0 + ho; r.vo = (unsigned)WS_V0 + ho;
    r.cbo = (unsigned)WS_CBG + (unsigned)(bh * SEQ * 4); r.P0 = qb * 256; r.kb0 = kb0; r.Bq = Bq; return r;
}
constexpr float SKIP_LOG2 = 148.f;
constexpr int ATT_LDS_DESC = 133632 + 64;
__device__ __forceinline__ void fa_describe(Frame& F, int n, int xq, LAS float* kmax2, LAS int* desc) {
    const int bh = (n & 1) ? 8 + ((xq + 4) & 7) : xq, qb = 31 - (n >> 1), b = bh >> 3, h = bh & 7;
    const float* nq = (const float*)(F_ws + WS_NRM) + ((size_t)(b * 32 + qb) * 8 + h) * 8;
    float q2 = 0.f;
#pragma unroll
    for (int wc = 0; wc < 4; ++wc) q2 += fmaxf(nq[2 * wc], nq[2 * wc + 1]);
    const float B = sqrtf(q2 * kmax2[bh]) * 1.01f, th = 2.f * B + SKIP_LOG2;
    const float* cb = (const float*)(F_ws + WS_CBG) + (size_t)bh * SEQ;
    const float cbi = cb[qb * 256];
    const float c0 = cb[64 * F.lane + 63], c1 = cb[64 * (F.lane + 64) + 63];
    const unsigned long long m0 = __ballot(cbi - c0 <= th), m1 = __ballot(cbi - c1 <= th);
    int t = m0 ? (int)__builtin_ctzll(m0) : (m1 ? 64 + (int)__builtin_ctzll(m1) : 4 * qb);
    if (t > 4 * qb) t = 4 * qb;
    if (F.lane == 0) { desc[0] = bh; desc[1] = qb; desc[2] = 64 * t; desc[5] = (int)__float_as_uint(B); }
}
__device__ __forceinline__ void attn_fast_phase(Frame& F, char* shm) {
    LAS float* kmax2 = (LAS float*)(F.lds + ATT_LDS_DESC); LAS int* desc = (LAS int*)(F.lds + ATT_LDS_DESC + 64);
    const int total = 64, xq = (int)blockIdx.x & 7;
    __syncthreads();
    if (F.tid < 64) { const int bh = F.tid >> 2, wc = F.tid & 3, b = bh >> 3, h = bh & 7; const float* nk = (const float*)(F_ws + WS_NRM) + (size_t)64 * 64;
        float m = 0.f; for (int pm = 0; pm < 32; ++pm) { const float* p = nk + (((size_t)(b * 32 + pm) * 8 + h) * 4 + wc) * 2; m = fmaxf(m, fmaxf(p[0], p[1])); }
        m += __shfl_xor(m, 1); m += __shfl_xor(m, 2); if (wc == 0) kmax2[bh] = m; }
    __syncthreads();
    gu32* ctr0 = (gu32*)(F_ws + WS_CTL) + CW_ATT;
    int n = (int)blockIdx.x >> 3, qsel = xq;
    while (n < total) {
        if (F.wave == 0) fa_describe(F, n, qsel, kmax2, desc);
        __syncthreads();
        const fa::BlockRef cur = fa_ref(F, __builtin_amdgcn_readfirstlane(desc[0]), __builtin_amdgcn_readfirstlane(desc[1]), __builtin_amdgcn_readfirstlane(desc[2]), __uint_as_float((unsigned)__builtin_amdgcn_readfirstlane(desc[5])));
        fa::fa_block(cur, shm, F.tid);
        if (F.wave == 0) { int nn = total, qs = xq;
            for (int k = 0; k < 8; ++k) { const int q = (xq + k) & 7; int v = 0;
                if (F.lane == 0) v = (((int)F.G + 7 - q) >> 3) + (int)__hip_atomic_fetch_add(ctr0 + 64 * q, 1u, __ATOMIC_RELAXED, __HIP_MEMORY_SCOPE_AGENT);
                v = __builtin_amdgcn_readfirstlane(v); if (v < total) { nn = v; qs = q; break; } }
            if (F.lane == 0) { desc[3] = nn; desc[4] = qs; } }
        __syncthreads();
        n = __builtin_amdgcn_readfirstlane(desc[3]); qsel = __builtin_amdgcn_readfirstlane(desc[4]);
    }
}

__device__ __forceinline__ void attn_ref_phase(Frame& F) {
    const bf16* Q = (const bf16*)(F_ws + WS_Q0); const bf16* K = (const bf16*)(F_ws + WS_K0); const bf16* V = (const bf16*)(F_ws + WS_V0); bf16* O = (bf16*)(F_ws + WS_O0);
    const float* LC = (const float*)(F_ws + WS_LC); const float* TT = (const float*)(F_ws + WS_TT);
    LAS float* Ks = (LAS float*)(F.lds); LAS float* Vs = (LAS float*)(F.lds + 32768); LAS float* cbs = (LAS float*)(F.lds + 65536); LAS float* Pp = (LAS float*)(F.lds + 65536 + 256);
    const int r = F.tid >> 3, part = F.tid & 7;
    const int NU = BATCH * FH * (SEQ / 64);
    for (int unit = (int)blockIdx.x; unit < NU; unit += F.G) {
        const int bh = unit & 15, qb = unit >> 4, b = bh >> 3, h = bh & 7, q0 = qb * 64;
        __syncthreads();
        if (F.tid == 0) { float s = 0.f; for (int t = 0; t < 32; ++t) { Pp[t] = s; s += TT[(b * 32 + t) * 8 + h]; } }
        float q[16], o[16]; float m = -1e30f, l = 0.f;
        { const bf16* qp = Q + (size_t)(b * SEQ + q0 + r) * D + h * FDH + part * 16; const v4u a = *(const v4u*)qp, c = *(const v4u*)(qp + 8);
          q[0] = pg8::bf_lo(a.x); q[1] = pg8::bf_hi(a.x); q[2] = pg8::bf_lo(a.y); q[3] = pg8::bf_hi(a.y); q[4] = pg8::bf_lo(a.z); q[5] = pg8::bf_hi(a.z); q[6] = pg8::bf_lo(a.w); q[7] = pg8::bf_hi(a.w);
          q[8] = pg8::bf_lo(c.x); q[9] = pg8::bf_hi(c.x); q[10] = pg8::bf_lo(c.y); q[11] = pg8::bf_hi(c.y); q[12] = pg8::bf_lo(c.z); q[13] = pg8::bf_hi(c.z); q[14] = pg8::bf_lo(c.w); q[15] = pg8::bf_hi(c.w); }
#pragma unroll
        for (int d = 0; d < 16; ++d) o[d] = 0.f;
        for (int kt = 0; kt <= qb; ++kt) {
            __syncthreads();
            { const size_t go = (size_t)(b * SEQ + kt * 64 + r) * D + h * FDH + part * 16;
              const v4u a = *(const v4u*)(K + go), c = *(const v4u*)(K + go + 8), e = *(const v4u*)(V + go), f = *(const v4u*)(V + go + 8);
              LAS float* kd = Ks + r * 128 + part * 16; LAS float* vd = Vs + r * 128 + part * 16;
              kd[0] = pg8::bf_lo(a.x); kd[1] = pg8::bf_hi(a.x); kd[2] = pg8::bf_lo(a.y); kd[3] = pg8::bf_hi(a.y); kd[4] = pg8::bf_lo(a.z); kd[5] = pg8::bf_hi(a.z); kd[6] = pg8::bf_lo(a.w); kd[7] = pg8::bf_hi(a.w);
              kd[8] = pg8::bf_lo(c.x); kd[9] = pg8::bf_hi(c.x); kd[10] = pg8::bf_lo(c.y); kd[11] = pg8::bf_hi(c.y); kd[12] = pg8::bf_lo(c.z); kd[13] = pg8::bf_hi(c.z); kd[14] = pg8::bf_lo(c.w); kd[15] = pg8::bf_hi(c.w);
              vd[0] = pg8::bf_lo(e.x); vd[1] = pg8::bf_hi(e.x); vd[2] = pg8::bf_lo(e.y); vd[3] = pg8::bf_hi(e.y); vd[4] = pg8::bf_lo(e.z); vd[5] = pg8::bf_hi(e.z); vd[6] = pg8::bf_lo(e.w); vd[7] = pg8::bf_hi(e.w);
              vd[8] = pg8::bf_lo(f.x); vd[9] = pg8::bf_hi(f.x); vd[10] = pg8::bf_lo(f.y); vd[11] = pg8::bf_hi(f.y); vd[12] = pg8::bf_lo(f.z); vd[13] = pg8::bf_hi(f.z); vd[14] = pg8::bf_lo(f.w); vd[15] = pg8::bf_hi(f.w); }
            if (F.tid < 64) { const int key = kt * 64 + F.tid; cbs[F.tid] = ((const float*)(F_ws + WS_CBG))[(size_t)bh * SEQ + key]; }
            __syncthreads();
            const int jmax = (kt == qb) ? r : 63;
            for (int j = 0; j <= jmax; ++j) {
                const LAS float* kr = Ks + j * 128 + part * 16; float dot = 0.f;
#pragma unroll
                for (int d = 0; d < 16; ++d) dot += q[d] * kr[d];
                dot += __shfl_xor(dot, 1); dot += __shfl_xor(dot, 2); dot += __shfl_xor(dot, 4);
                const float s = dot + cbs[j], mn = fmaxf(m, s), al = __builtin_amdgcn_exp2f(m - mn), p = __builtin_amdgcn_exp2f(s - mn);
                l = l * al + p; m = mn;
                const LAS float* vr = Vs + j * 128 + part * 16;
#pragma unroll
                for (int d = 0; d < 16; ++d) o[d] = o[d] * al + p * vr[d];
            }
        }
        const float il = 1.0f / l;
        v4u w0, w1; w0.x = pk2(o[0] * il, o[1] * il); w0.y = pk2(o[2] * il, o[3] * il); w0.z = pk2(o[4] * il, o[5] * il); w0.w = pk2(o[6] * il, o[7] * il);
        w1.x = pk2(o[8] * il, o[9] * il); w1.y = pk2(o[10] * il, o[11] * il); w1.z = pk2(o[12] * il, o[13] * il); w1.w = pk2(o[14] * il, o[15] * il);
        bf16* op = O + (size_t)(b * SEQ + q0 + r) * D + h * FDH + part * 16; *(v4u*)op = w0; *(v4u*)(op + 8) = w1;
    }
    __syncthreads();
}

__device__ __forceinline__ void ret_ref_phase(Frame& F) {
    const bf16* Q1 = (const bf16*)(F_ws + WS_Q1); const bf16* K1 = (const bf16*)(F_ws + WS_K1); bf16* V1 = (bf16*)(F_ws + WS_V1); float* PST = (float*)(F_ws + WS_PST);
    LAS bf16* Qs = (LAS bf16*)(F.lds); LAS bf16* Ks = (LAS bf16*)(F.lds + 32768); LAS float* Sm = (LAS float*)(F.lds + 65536); LAS float* St = (LAS float*)(F.lds + 81920);
    LAS float* Vs = (LAS float*)(F.lds + 114688); LAS float* pw = (LAS float*)(F.lds + 122880);
    for (int unit = (int)blockIdx.x; unit < BATCH * RH * 16; unit += F.G) {
        const int b = unit >> 6, h = (unit >> 4) & 3, vs = unit & 15, v0 = vs * 32;
        const float lg = logf(1.0f - exp2f(-5.0f - (float)h));
        __syncthreads();
        for (int i = F.tid; i < 256 * 32; i += NWAVES * 64) St[i] = 0.f;
        if (F.tid <= 64) pw[F.tid] = expf(lg * (float)F.tid);
        for (int n = 0; n < NCH; ++n) {
            const size_t t0 = (size_t)b * SEQ + (size_t)n * CH;
            __syncthreads();
#pragma unroll
            for (int i = 0; i < 4; ++i) { const int p = F.tid + 512 * i, row = p >> 5, c = p & 31;
                *(LAS v4u*)(Qs + row * 256 + c * 8) = *(const v4u*)(Q1 + (t0 + row) * 1024 + h * 256 + c * 8);
                *(LAS v4u*)(Ks + row * 256 + c * 8) = *(const v4u*)(K1 + (t0 + row) * 1024 + h * 256 + c * 8); }
            { const int idx = F.tid * 4, row = idx >> 5, c = idx & 31; const unsigned long long vv = *(const unsigned long long*)(V1 + (t0 + row) * 2048 + h * 512 + v0 + c);
              const unsigned lo = (unsigned)vv, hi = (unsigned)(vv >> 32); LAS float* d = Vs + row * 32 + c; d[0] = pg8::bf_lo(lo); d[1] = pg8::bf_hi(lo); d[2] = pg8::bf_lo(hi); d[3] = pg8::bf_hi(hi); }
            __syncthreads();
            {
                const int i = F.tid >> 3, j0 = (F.tid & 7) * 8; float a[8];
#pragma unroll
                for (int jj = 0; jj < 8; ++jj) a[jj] = 0.f;
                for (int d = 0; d < 256; d += 2) { const unsigned qw = *(const LAS unsigned*)(Qs + i * 256 + d); const float qa = pg8::bf_lo(qw), qb = pg8::bf_hi(qw);
#pragma unroll
                    for (int jj = 0; jj < 8; ++jj) { const unsigned kw = *(const LAS unsigned*)(Ks + (j0 + jj) * 256 + d); a[jj] += qa * pg8::bf_lo(kw) + qb * pg8::bf_hi(kw); } }
#pragma unroll
                for (int jj = 0; jj < 8; ++jj) { const int dj = i - (j0 + jj); Sm[i * 64 + j0 + jj] = a[jj] * pw[dj < 0 ? -dj : dj]; }
            }
            __syncthreads();
            {
                const int i = F.tid >> 3, vv0 = (F.tid & 7) * 4; float y[4] = {0.f, 0.f, 0.f, 0.f};
                for (int d = 0; d < 256; d += 2) { const unsigned qw = *(const LAS unsigned*)(Qs + i * 256 + d); const float qa = pg8::bf_lo(qw), qb = pg8::bf_hi(qw);
                    const f32x4 s0 = *(const LAS f32x4*)(St + d * 32 + vv0), s1 = *(const LAS f32x4*)(St + (d + 1) * 32 + vv0);
                    y[0] += qa * s0.x + qb * s1.x; y[1] += qa * s0.y + qb * s1.y; y[2] += qa * s0.z + qb * s1.z; y[3] += qa * s0.w + qb * s1.w; }
                const float qd = pw[i + 1];
#pragma unroll
                for (int e = 0; e < 4; ++e) y[e] *= qd;
                for (int j = 0; j < 64; ++j) { const float s = Sm[i * 64 + j]; const f32x4 vv = *(const LAS f32x4*)(Vs + j * 32 + vv0); y[0] += s * vv.x; y[1] += s * vv.y; y[2] += s * vv.z; y[3] += s * vv.w; }
                float ps = (y[0] + y[1]) + (y[2] + y[3]), pq = (y[0] * y[0] + y[1] * y[1]) + (y[2] * y[2] + y[3] * y[3]);
                ps += __shfl_xor(ps, 1); pq += __shfl_xor(pq, 1); ps += __shfl_xor(ps, 2); pq += __shfl_xor(pq, 2); ps += __shfl_xor(ps, 4); pq += __shfl_xor(pq, 4);
                if ((F.tid & 7) == 0) { f32x2 st; st.x = ps; st.y = pq; *(f32x2*)(PST + (((t0 + i) * 4 + h) * 16 + vs) * 2) = st; }
                *(unsigned long long*)(V1 + (t0 + i) * 2048 + h * 512 + v0 + vv0) = (unsigned long long)pk2(y[0], y[1]) | ((unsigned long long)pk2(y[2], y[3]) << 32);
            }
            __syncthreads();
            {
                const int d = F.tid >> 1, vv0 = (F.tid & 1) * 16; float a[16]; const float cd = pw[64];
#pragma unroll
                for (int e = 0; e < 16; ++e) a[e] = St[d * 32 + vv0 + e] * cd;
                for (int j = 0; j < 64; ++j) { const float kd = pg8::bf_lo((unsigned)Ks[j * 256 + d]) * pw[63 - j];
#pragma unroll
                    for (int e = 0; e < 16; e += 4) { const f32x4 vv = *(const LAS f32x4*)(Vs + j * 32 + vv0 + e); a[e] += kd * vv.x; a[e + 1] += kd * vv.y; a[e + 2] += kd * vv.z; a[e + 3] += kd * vv.w; } }
#pragma unroll
                for (int e = 0; e < 16; ++e) St[d * 32 + vv0 + e] = a[e];
            }
        }
    }
    __syncthreads();
}


__device__ __forceinline__ rtn::Ptrs rt_ptrs(Frame& F) {
    rtn::Ptrs P; GAS char* w = (GAS char*)F_ws;
    P.Q = w + WS_Q1; P.K = w + WS_K1; P.V = w + WS_V1; P.L = (GAS char*)F_out; P.PST = (GAS float*)(w + WS_PST); return P;
}
__device__ __forceinline__ void ret_pass1_phase(Frame& F) {
    const rtn::Ptrs P = rt_ptrs(F);
    { const int nit = 8 * (rtn::NG - 1) * 2; p0_late_weights(F, F.G > nit + 16 ? nit : 0); }
    for (int it = (int)blockIdx.x; it < 8 * (rtn::NG - 1) * 2; it += F.G) { const int half = it & 1, r = it >> 1, g = r % (rtn::NG - 1), bh = r / (rtn::NG - 1); rtn::run_item<false>(P, bh, half, g, 0u, F.wave); }
}
__device__ __forceinline__ void ret_pass2_phase(Frame& F) {
    const rtn::Ptrs P = rt_ptrs(F);
    for (int it = (int)blockIdx.x; it < 8 * rtn::NG * 2; it += F.G) { const int half = it & 1, r = it >> 1, g = r % rtn::NG, bh = r / rtn::NG; rtn::run_item<true>(P, bh, half, g, 0u, F.wave); }
}

__device__ __forceinline__ void final_norm_phase(Frame& F) {
    const float* SSQ = (const float*)(F_ws + WS_SSQ); const bf16* XB = (const bf16*)(F_ws + WS_XB);
    const int gw = F.vcu * NWAVES + F.wave, NGW = F.G * NWAVES;
    f32x4 gv[4];
#pragma unroll
    for (int j = 0; j < 4; ++j) gv[j] = ((const f32x4*)F_final_norm)[F.lane + 64 * j];
    for (int row = gw; row < M; row += NGW) {
        float s = (F.lane < 16) ? SSQ[(size_t)row * 16 + F.lane] : 0.f; s = wave_sum(s);
        const float rstd = 1.0f / sqrtf(s * (1.f / D) + EPS);
        const GAS unsigned long long* xr = (const GAS unsigned long long*)(XB + (size_t)row * D) + F.lane;
        GAS f32x4* orow = (GAS f32x4*)(F_out + (size_t)row * D) + F.lane;
#pragma unroll
        for (int j = 0; j < 4; ++j) { const unsigned long long w = xr[64 * j]; const unsigned lo = (unsigned)w, hi = (unsigned)(w >> 32); f32x4 v;
            v.x = pg8::bf_lo(lo); v.y = pg8::bf_hi(lo); v.z = pg8::bf_lo(hi); v.w = pg8::bf_hi(hi); orow[64 * j] = v * rstd * gv[j]; }
    }
}
#ifndef MK_N_LAUNCHES
#define MK_N_LAUNCHES 1
#endif
constexpr int N_LAUNCHES = MK_N_LAUNCHES;
#ifndef REP_PHASE
#define REP_PHASE -1
#endif
#define REPS(k) ((k) == REP_PHASE ? 2 : 1)
#ifndef FAST_ATTN
#define FAST_ATTN 0
#endif
#ifndef FAST_RET
#define FAST_RET 0
#endif
__device__ __forceinline__ bool relaunder(Frame& F) { int t = F.wave * 64 + hw_lane_id(); asm volatile("" : "+v"(t));     F.tid = t; F.lane = t & 63; F.wave = __builtin_amdgcn_readfirstlane(t >> 6); const __attribute__((address_space(4))) Args* a = F.ap; asm volatile("" : "+s"(a)); F.ap = a; return true; }
__global__ void __launch_bounds__(NWAVES * 64, 2) fox_ret_fwd(Args args) {
    extern __shared__ __attribute__((aligned(16))) unsigned char lds[];
    Frame F;
    F.lds = (LAS unsigned char*)lds;
    F.MISC = (volatile LAS unsigned*)(F.lds + MISC_OFF);
    F.tid = threadIdx.x; F.lane = F.tid & 63; F.wave = __builtin_amdgcn_readfirstlane(F.tid >> 6);
    F.G = gridDim.x; { const int bx = blockIdx.x; F.vcu = (F.G % 8 == 0) ? (bx % 8) * (F.G / 8) + bx / 8 : bx; }
    F.ap = (const __attribute__((address_space(4))) Args*)__builtin_amdgcn_kernarg_segment_ptr();
    for (int u = F.tid; u < (LDS_BYTES - LDSCTL_OFF) / 4; u += NWAVES * 64) ((LAS unsigned*)(F.lds + LDSCTL_OFF))[u] = 0u;
    __syncthreads();
    XcdBarrier bar; bar.bar = (unsigned*)(F_ws + WS_CTL) + CW_BAR; bar.x = 0; bar.st = nullptr;
    if (N_LAUNCHES == 1) bar = xcd_barrier_post((unsigned*)(F_ws + WS_CTL) + CW_BAR, F.MISC + 8);
#define GRID_BAR() do { if (N_LAUNCHES == 1) { xcd_barrier(bar); if (REP_PHASE == -2) xcd_barrier(bar); } } while (0)
    const int lo = F.ap->ph_lo, hi = F.ap->ph_hi;
#define IN(k) (lo <= (k) && (k) < hi && relaunder(F))
#define BOTH(k) (IN(k) && IN((k) + 1))
#define ws F_ws
#define XB ((pg8::bf16_t*)(F_ws + WS_XB))
#define SSQ ((float*)(F_ws + WS_SSQ))
    const LAS float* const tab = (const LAS float*)(F.lds + TAB_OFF);

#define RUN_PHASE(k, BODY) if (IN(k)) { BODY; if (REP_PHASE == (k)) { GRID_BAR(); relaunder(F); BODY; } if (BOTH(k)) GRID_BAR(); }
#define RUN_PHASE2(k, BODY, BODY2) if (IN(k)) { BODY; if (REP_PHASE == (k) || REP_PHASE == 100 + (k)) { GRID_BAR(); relaunder(F); BODY2; } if (BOTH(k)) GRID_BAR(); }
#define GEMM_PHASE(EPI, Aptr, Bptr, N_, K_, PRE, ...) do { \
        pg8::Gemm g{(const pg8::bf16_t*)(Aptr), (const pg8::bf16_t*)(Bptr), M, (N_), (K_)}; pg8::StaticOrder S; S.init(M, (N_), F.G, (int)blockIdx.x); \
        PRE; pg8::EPI E{__VA_ARGS__}; \
        pg8::gemm_phase<pg8::EPI, pg8::StaticOrder, true, true>(F.lds + RING_OFF, g, S, E, F.wave); } while (0)
    RUN_PHASE(0, p0_prologue(F))
    RUN_PHASE(1, GEMM_PHASE(EpiQKV0, XB, ws + WS_WQKV0, 3072, 1024, cbg_phase(F); fill_rstd_tab(F, S), (pg8::bf16_t*)(ws + WS_Q0), tab, QSCALE, (float*)(ws + WS_NRM)))
#if FAST_ATTN
    RUN_PHASE(2, attn_fast_phase(F, (char*)lds))
#else
    RUN_PHASE(2, attn_ref_phase(F))
#endif
    RUN_PHASE2(3, GEMM_PHASE(EpiRes, ws + WS_O0, ws + WS_WO0, 1024, 1024, (void)0, XB, SSQ), GEMM_PHASE(EpiRes, ws + WS_O0, ws + WS_WO0, 1024, 1024, (void)0, (pg8::bf16_t*)F_out, (float*)F_out + 8388608))
#if REP_PHASE == 104
    RUN_PHASE2(4, GEMM_PHASE(EpiSwiGLU, XB, ws + WS_WFI0, 2 * DFF, 1024, fill_rstd_tab(F, S), (pg8::bf16_t*)(ws + WS_HID), tab), GEMM_PHASE(EpiNull, XB, ws + WS_WFI0, 2 * DFF, 1024, (void)0, 0))
#else
    RUN_PHASE(4, GEMM_PHASE(EpiSwiGLU, XB, ws + WS_WFI0, 2 * DFF, 1024, fill_rstd_tab(F, S), (pg8::bf16_t*)(ws + WS_HID), tab))
#endif
#if REP_PHASE == 105
    RUN_PHASE2(5, GEMM_PHASE(EpiRes, ws + WS_HID, ws + WS_WFO0, 1024, DFF, (void)0, XB, SSQ), GEMM_PHASE(EpiNull, ws + WS_HID, ws + WS_WFO0, 1024, DFF, (void)0, 0))
#else
    RUN_PHASE2(5, GEMM_PHASE(EpiRes, ws + WS_HID, ws + WS_WFO0, 1024, DFF, (void)0, XB, SSQ), GEMM_PHASE(EpiRes, ws + WS_HID, ws + WS_WFO0, 1024, DFF, (void)0, (pg8::bf16_t*)F_out, (float*)F_out + 8388608))
#endif
    RUN_PHASE(6, GEMM_PHASE(EpiRet, XB, ws + WS_WRI, 4096, 1024, fill_rstd_tab(F, S), (pg8::bf16_t*)(ws + WS_Q1), (pg8::bf16_t*)(ws + WS_K1), (pg8::bf16_t*)(ws + WS_V1), (const float*)(ws + WS_ROPE), tab))
#if FAST_RET
    RUN_PHASE(7, ret_pass1_phase(F))
    RUN_PHASE(8, ret_pass2_phase(F))
#else
    RUN_PHASE(7, (void)0)
    RUN_PHASE(8, ret_ref_phase(F))
#endif
#if REP_PHASE == 109
    RUN_PHASE2(9, GEMM_PHASE(EpiGate, XB, (const pg8::bf16_t*)(ws + WS_WRI) + (size_t)4096 * 1024, 2048, 1024, fill_rstd_tab(F, S); fill_gate_tab(F, S), (pg8::bf16_t*)(ws + WS_V1), tab, (const LAS pg8::f32x2*)(F.lds + STAB_OFF)), GEMM_PHASE(EpiNull, XB, (const pg8::bf16_t*)(ws + WS_WRI) + (size_t)4096 * 1024, 2048, 1024, (void)0, 0))
#else
    RUN_PHASE(9, GEMM_PHASE(EpiGate, XB, (const pg8::bf16_t*)(ws + WS_WRI) + (size_t)4096 * 1024, 2048, 1024, fill_rstd_tab(F, S); fill_gate_tab(F, S), (pg8::bf16_t*)(ws + WS_V1), tab, (const LAS pg8::f32x2*)(F.lds + STAB_OFF)))
#endif
    RUN_PHASE2(10, GEMM_PHASE(EpiRes, ws + WS_V1, ws + WS_WRO, 1024, 2048, (void)0, XB, SSQ), GEMM_PHASE(EpiRes, ws + WS_V1, ws + WS_WRO, 1024, 2048, (void)0, (pg8::bf16_t*)F_out, (float*)F_out + 8388608))
    RUN_PHASE(11, GEMM_PHASE(EpiSwiGLU, XB, ws + WS_WFI1, 2 * DFF, 1024, fill_rstd_tab(F, S), (pg8::bf16_t*)(ws + WS_HID), tab))
    RUN_PHASE2(12, GEMM_PHASE(EpiRes, ws + WS_HID, ws + WS_WFO1, 1024, DFF, (void)0, XB, SSQ), GEMM_PHASE(EpiRes, ws + WS_HID, ws + WS_WFO1, 1024, DFF, (void)0, (pg8::bf16_t*)F_out, (float*)F_out + 8388608))
    if (IN(13)) final_norm_phase(F);
#undef RUN_PHASE
#undef RUN_PHASE2
#undef GEMM_PHASE
#undef IN
#undef ws
#undef XB
#undef SSQ
#undef BOTH
#undef GRID_BAR
}

extern "C" void kernel_launch(void* const* d_in, const int* in_sizes, int n_in, void* d_out, int out_size, void* d_ws, size_t ws_size, hipStream_t stream) {
    static int grid = 0;
    if (grid == 0) {
        if (n_in != 11 || in_sizes[0] != M * D || out_size != M * D || ws_size < WS_END) { fprintf(stderr, "kernel_launch: shape/workspace mismatch (n_in %d, in0 %d, out %d, ws %zu, need %zu)\n", n_in, n_in > 0 ? in_sizes[0] : -1, out_size, ws_size, (size_t)WS_END); grid = -1; return; }
        int dev = 0, cus = 0, per_cu = 0;
        if (hipGetDevice(&dev) != hipSuccess || hipDeviceGetAttribute(&cus, hipDeviceAttributeMultiprocessorCount, dev) != hipSuccess) { fprintf(stderr, "kernel_launch: device query failed\n"); grid = -1; return; }
        if (hipFuncSetAttribute((const void*)fox_ret_fwd, hipFuncAttributeMaxDynamicSharedMemorySize, LDS_BYTES) != hipSuccess) { fprintf(stderr, "kernel_launch: hipFuncSetAttribute failed\n"); grid = -1; return; }
        if (hipOccupancyMaxActiveBlocksPerMultiprocessor(&per_cu, (const void*)fox_ret_fwd, NWAVES * 64, LDS_BYTES) != hipSuccess || per_cu < 1) { fprintf(stderr, "kernel_launch: occupancy query reports %d workgroups per CU\n", per_cu); per_cu = 1; }
        (void)hipGetLastError();
        grid = cus;
        if (grid > 256) grid = 256;
    }
    if (grid < 0) return;
    if (hipMemsetAsync((char*)d_ws + WS_CTL, 0, CTL_ZERO_BYTES, stream) != hipSuccess) { fprintf(stderr, "kernel_launch: hipMemsetAsync failed\n"); return; }
    Args a{};
    for (int i = 0; i < 11; ++i) a.in[i] = (const float*)d_in[i];
    a.out = (float*)d_out; a.wsp = (unsigned char*)d_ws;
    for (int li = 0; li < N_LAUNCHES; ++li) {
        a.ph_lo = (N_LAUNCHES == 1) ? 0 : li; a.ph_hi = (N_LAUNCHES == 1) ? NPHASE : li + 1; a.li = li;
        hipLaunchKernelGGL(fox_ret_fwd, dim3(grid), dim3(NWAVES * 64), LDS_BYTES, stream, a);
        const hipError_t le = hipPeekAtLastError();
        if (le != hipSuccess) { fprintf(stderr, "kernel_launch: launch %d failed: %s\n", li, hipGetErrorName(le)); break; }
    }
}
```

```cpp
#define MK_N_LAUNCHES 1
#define FAST_ATTN 1
#define FAST_RET 1
#include <hip/hip_runtime.h>
#include <cstdio>
#include <cstdint>
#include <cmath>
__device__ __forceinline__ int hw_lane_id() { int l; asm volatile("v_mbcnt_lo_u32_b32 %0, -1, 0\n\tv_mbcnt_hi_u32_b32 %0, -1, %0" : "=v"(l)); return l; }
namespace pg8 {
#define PG8_LAS __attribute__((address_space(3)))
typedef unsigned short bf16_t;
typedef short bf16x8 __attribute__((ext_vector_type(8)));
typedef float f32x4 __attribute__((ext_vector_type(4)));
typedef unsigned u32x4 __attribute__((ext_vector_type(4)));
constexpr int BM = 256, BK = 64, HALF = 128, HTB = HALF * BK * 2  , STAGE_BYTES = 8 * HTB, NXCD = 8, WGM = 8;

__host__ __device__ __forceinline__ int lds_byte(int r, int c) { const int st = (r >> 4) * 2 + (c >> 5), rr = r & 15, cc = c & 31, ob = rr * 64 + cc * 2; return st * 1024 + (ob ^ (((ob >> 9) & 1) << 5)); }
__host__ __device__ __forceinline__ void stage_rc(int b, int& R, int& C) { const int st = b / 1024, sb = b % 1024, swz = sb ^ (((sb >> 9) & 1) << 5); R = (st >> 1) * 16 + swz / 64; C = (st & 1) * 32 + (swz % 64) / 2; }
__host__ __device__ __forceinline__ int perm32(int rho) { const int n = rho >> 4, i = rho & 15; return 8 * (i >> 2) + 4 * n + (i & 3); }

struct Unit { int pm, pn; };
struct Gemm { const bf16_t* A; const bf16_t* Bt; int M, N, K; };

struct StaticOrder {
    int nM, nN, nwg, G, c;
    __host__ __device__ void init(int M, int N, int G_, int c_) { nM = M / BM; nN = N / BM; nwg = nM * nN; G = G_; c = c_; }
    __host__ __device__ bool next(int i, Unit& u) const {
        const long L = (long)i * G + c; if (L >= nwg) return false;
        int wgid = (int)L; { const int q = nwg / NXCD, r = nwg % NXCD, xcd = wgid % NXCD, off = wgid / NXCD; wgid = (xcd < r ? xcd * (q + 1) : r * (q + 1) + (xcd - r) * q) + off; }
        const int nig = WGM * nN, gid = wgid / nig, fm = gid * WGM, gsz = (nM - fm) < WGM ? (nM - fm) : WGM;
        u.pm = fm + ((wgid % nig) % gsz); u.pn = (wgid % nig) / gsz; return true;
    }
    __device__ __forceinline__ void a_ready(const Unit&) const {}
    __device__ __forceinline__ void done(const Unit&) const {}
};

__device__ __forceinline__ unsigned cvt_pk_bf16(float lo, float hi) { unsigned r; asm volatile("v_cvt_pk_bf16_f32 %0, %1, %2" : "=v"(r) : "v"(lo), "v"(hi)); return r; }
typedef float f32x2 __attribute__((ext_vector_type(2)));
__device__ __forceinline__ float silu_f(float x) { return x * __builtin_amdgcn_rcpf(1.0f + __builtin_amdgcn_exp2f(-1.4426950408889634f * x)); }
__device__ __forceinline__ u32x4 pack8f(const f32x4 v0, const f32x4 v1) { u32x4 w; w.x = cvt_pk_bf16(v0[0], v0[1]); w.y = cvt_pk_bf16(v0[2], v0[3]); w.z = cvt_pk_bf16(v1[0], v1[1]); w.w = cvt_pk_bf16(v1[2], v1[3]); return w; }
__device__ __forceinline__ float bf_lo(unsigned w) { return __builtin_bit_cast(float, w << 16); }
__device__ __forceinline__ float bf_hi(unsigned w) { return __builtin_bit_cast(float, w & 0xffff0000u); }

struct EpiQKV0 {
    static constexpr bool PERM = true, AFTER_DRAIN = false;
    bf16_t* Q; const PG8_LAS float* tab; float qscale; float* nrm;
    __device__ __forceinline__ void operator()(const f32x4 (&acc)[2][2][4][2], const Unit& u, int ui, int wr, int wc, int fr, int fq) const {
        const int colt = u.pn * BM, t = colt >> 10; bf16_t* base = Q + (size_t)t * ((size_t)16384 * 1024);
        const int cb = (colt & 1023) + wc * 32 + 8 * fq; const float sc = t == 0 ? qscale : 1.f;
        float mx0 = 0.f, mx1 = 0.f;
#pragma unroll
        for (int ai = 0; ai < 2; ++ai)
#pragma unroll
            for (int m = 0; m < 4; ++m) { const int rl = ai * HALF + wr * 64 + m * 16 + fr; const float rs = tab[ui * 256 + rl] * sc;
                bf16_t* rowp = base + (size_t)(u.pm * BM + rl) * 1024 + cb;
#pragma unroll
                for (int bj = 0; bj < 2; ++bj) { const u32x4 w = pack8f(acc[ai][bj][m][0] * rs, acc[ai][bj][m][1] * rs); *(u32x4*)(rowp + bj * HALF) = w;
                    if (t < 2) { float q = (bf_lo(w.x) * bf_lo(w.x) + bf_hi(w.x) * bf_hi(w.x)) + (bf_lo(w.y) * bf_lo(w.y) + bf_hi(w.y) * bf_hi(w.y));
                        q += (bf_lo(w.z) * bf_lo(w.z) + bf_hi(w.z) * bf_hi(w.z)) + (bf_lo(w.w) * bf_lo(w.w) + bf_hi(w.w) * bf_hi(w.w));
                        q += __shfl_xor(q, 16); q += __shfl_xor(q, 32);
                        if (bj == 0) mx0 = fmaxf(mx0, q); else mx1 = fmaxf(mx1, q); } } }
        if (t < 2) {
#pragma unroll
            for (int o = 1; o < 16; o <<= 1) { mx0 = fmaxf(mx0, __shfl_xor(mx0, o)); mx1 = fmaxf(mx1, __shfl_xor(mx1, o)); }
            if (fr == 0 && fq == 0) { const int head = ((colt & 1023) >> 7); float* d = nrm + ((((size_t)t * 64 + u.pm) * 8 + head) * 4 + wc) * 2 + wr; d[0] = mx0; d[8] = mx1; }
        }
    }
};
struct EpiRes {
    static constexpr bool PERM = true, AFTER_DRAIN = false;
    bf16_t* xb; float* ssq;
    __device__ __forceinline__ void operator()(const f32x4 (&acc)[2][2][4][2], const Unit& u, int ui, int wr, int wc, int fr, int fq) const {
        const int col0 = u.pn * BM + wc * 32 + 8 * fq;
#pragma unroll
        for (int ai = 0; ai < 2; ++ai)
#pragma unroll
            for (int m = 0; m < 4; ++m) { const int row = u.pm * BM + ai * HALF + wr * 64 + m * 16 + fr; bf16_t* rowp = xb + (size_t)row * 1024 + col0; float s = 0.f;
#pragma unroll
                for (int bj = 0; bj < 2; ++bj) { const u32x4 b = *(const u32x4*)(rowp + bj * HALF); f32x4 o0, o1;
                    o0[0] = bf_lo(b.x); o0[1] = bf_hi(b.x); o0[2] = bf_lo(b.y); o0[3] = bf_hi(b.y); o1[0] = bf_lo(b.z); o1[1] = bf_hi(b.z); o1[2] = bf_lo(b.w); o1[3] = bf_hi(b.w);
                    o0 = o0 + acc[ai][bj][m][0]; o1 = o1 + acc[ai][bj][m][1];
                    s += ((o0[0] * o0[0] + o0[1] * o0[1]) + (o0[2] * o0[2] + o0[3] * o0[3])) + ((o1[0] * o1[0] + o1[1] * o1[1]) + (o1[2] * o1[2] + o1[3] * o1[3]));
                    *(u32x4*)(rowp + bj * HALF) = pack8f(o0, o1); }
                s += __shfl_xor(s, 16); s += __shfl_xor(s, 32);
                if (fq == 0) ssq[(size_t)row * 16 + u.pn * 4 + wc] = s; }
    }
};
struct EpiSwiGLU {
    static constexpr bool PERM = true, AFTER_DRAIN = false;
    bf16_t* Hd; const PG8_LAS float* tab;
    __device__ __forceinline__ void operator()(const f32x4 (&acc)[2][2][4][2], const Unit& u, int ui, int wr, int wc, int fr, int fq) const {
        const int hc0 = u.pn * HALF + wc * 32 + 8 * fq;
#pragma unroll
        for (int ai = 0; ai < 2; ++ai)
#pragma unroll
            for (int m = 0; m < 4; ++m) { const int rl = ai * HALF + wr * 64 + m * 16 + fr; const float rs = tab[ui * 256 + rl];
                f32x4 h0, h1;
#pragma unroll
                for (int e = 0; e < 4; ++e) { h0[e] = silu_f(acc[ai][0][m][0][e] * rs) * (acc[ai][1][m][0][e] * rs); h1[e] = silu_f(acc[ai][0][m][1][e] * rs) * (acc[ai][1][m][1][e] * rs); }
                *(u32x4*)(Hd + (size_t)(u.pm * BM + rl) * 2816 + hc0) = pack8f(h0, h1); }
    }
};
struct EpiRet {
    static constexpr bool PERM = true, AFTER_DRAIN = false;
    bf16_t* Q; bf16_t* Kp; bf16_t* V; const float* rope; const PG8_LAS float* tab;
    __device__ __forceinline__ void operator()(const f32x4 (&acc)[2][2][4][2], const Unit& u, int ui, int wr, int wc, int fr, int fq) const {
        if (u.pn < 8) {
            const bool isk = u.pn >= 4; const int head = u.pn & 3; bf16_t* dst = isk ? Kp : Q; const float sc = isk ? 0.0625f : 1.f; const int i0 = wc * 32 + 8 * fq;
#pragma unroll
            for (int ai = 0; ai < 2; ++ai)
#pragma unroll
                for (int m = 0; m < 4; ++m) { const int rl = ai * HALF + wr * 64 + m * 16 + fr, row = u.pm * BM + rl; const float rs = tab[ui * 256 + rl] * sc;
                    const f32x4* rp = (const f32x4*)(rope + ((size_t)(row & 8191) * 128 + i0) * 2);
                    f32x4 o1[2], o2[2];
#pragma unroll
                    for (int n = 0; n < 2; ++n) { const f32x4 t1 = acc[ai][0][m][n] * rs, t2 = acc[ai][1][m][n] * rs; const f32x4 ca = rp[2 * n], cb = rp[2 * n + 1];
                        o1[n][0] = t1[0] * ca[0] - t2[0] * ca[1]; o2[n][0] = t1[0] * ca[1] + t2[0] * ca[0];
                        o1[n][1] = t1[1] * ca[2] - t2[1] * ca[3]; o2[n][1] = t1[1] * ca[3] + t2[1] * ca[2];
                        o1[n][2] = t1[2] * cb[0] - t2[2] * cb[1]; o2[n][2] = t1[2] * cb[1] + t2[2] * cb[0];
                        o1[n][3] = t1[3] * cb[2] - t2[3] * cb[3]; o2[n][3] = t1[3] * cb[3] + t2[3] * cb[2]; }
                    bf16_t* rowp = dst + (size_t)row * 1024 + head * 256 + i0;
                    *(u32x4*)(rowp) = pack8f(o1[0], o1[1]); *(u32x4*)(rowp + HALF) = pack8f(o2[0], o2[1]);
                    if (m & 1) asm volatile("" ::: "memory"); }
        } else {
            const int cb = (u.pn - 8) * BM + wc * 32 + 8 * fq;
#pragma unroll
            for (int ai = 0; ai < 2; ++ai)
#pragma unroll
                for (int m = 0; m < 4; ++m) { const int rl = ai * HALF + wr * 64 + m * 16 + fr; const float rs = tab[ui * 256 + rl];
                    bf16_t* rowp = V + (size_t)(u.pm * BM + rl) * 2048 + cb;
#pragma unroll
                    for (int bj = 0; bj < 2; ++bj) *(u32x4*)(rowp + bj * HALF) = pack8f(acc[ai][bj][m][0] * rs, acc[ai][bj][m][1] * rs); }
        }
    }
};
struct EpiGate {
    static constexpr bool PERM = true, AFTER_DRAIN = false;
    bf16_t* Y; const PG8_LAS float* tab; const PG8_LAS f32x2* stab;
    __device__ __forceinline__ void operator()(const f32x4 (&acc)[2][2][4][2], const Unit& u, int ui, int wr, int wc, int fr, int fq) const {
        const int cb = u.pn * BM + wc * 32 + 8 * fq;
#pragma unroll
        for (int ai = 0; ai < 2; ++ai)
#pragma unroll
            for (int m = 0; m < 4; ++m) { const int rl = ai * HALF + wr * 64 + m * 16 + fr; const float rs = tab[ui * 256 + rl]; const f32x2 st = stab[ui * 256 + rl];
                bf16_t* rowp = Y + (size_t)(u.pm * BM + rl) * 2048 + cb;
#pragma unroll
                for (int bj = 0; bj < 2; ++bj) { const u32x4 yv = *(const u32x4*)(rowp + bj * HALF); f32x4 y0, y1;
                    y0[0] = bf_lo(yv.x); y0[1] = bf_hi(yv.x); y0[2] = bf_lo(yv.y); y0[3] = bf_hi(yv.y); y1[0] = bf_lo(yv.z); y1[1] = bf_hi(yv.z); y1[2] = bf_lo(yv.w); y1[3] = bf_hi(yv.w);
                    f32x4 g0 = acc[ai][bj][m][0] * rs, g1 = acc[ai][bj][m][1] * rs;
#pragma unroll
                    for (int e = 0; e < 4; ++e) { g0[e] = silu_f(g0[e]) * ((y0[e] - st.x) * st.y); g1[e] = silu_f(g1[e]) * ((y1[e] - st.x) * st.y); }
                    *(u32x4*)(rowp + bj * HALF) = pack8f(g0, g1); } }
    }
};
struct EpiNull {
    static constexpr bool PERM = true, AFTER_DRAIN = false;
    int dummy;
    __device__ __forceinline__ void operator()(const f32x4 (&acc)[2][2][4][2], const Unit& u, int ui, int wr, int wc, int fr, int fq) const {
#pragma unroll
        for (int ai = 0; ai < 2; ++ai)
#pragma unroll
            for (int bj = 0; bj < 2; ++bj)
#pragma unroll
                for (int m = 0; m < 4; ++m) { asm volatile("" :: "v"(acc[ai][bj][m][0]), "v"(acc[ai][bj][m][1])); }
    }
};
template <class Epi, class Sched, bool ALIGN_EPI = false, bool SP2 = false>
__device__ __forceinline__ void gemm_phase(PG8_LAS unsigned char* lds, const Gemm g, const Sched& S, const Epi& E, int wave_in) {
    int tid_ = wave_in * 64 + hw_lane_id(); asm volatile("" : "+v"(tid_));
    const int tid = tid_, wid = __builtin_amdgcn_readfirstlane(tid >> 6), lane = tid & 63, wr = wid >> 2, wc = wid & 3, fr = lane & 15, fq = lane >> 4;
    const int K = g.K, nt = K / BK;
    unsigned voffA[2], voffB[2];
#pragma unroll
    for (int i = 0; i < 2; ++i) { int R, C; stage_rc(tid * 16 + i * 8192, R, C); const int Rb = Epi::PERM ? ((R & ~31) + perm32(R & 31)) : R;
        voffA[i] = (unsigned)(R * K + C) * 2u; voffB[i] = (unsigned)(Rb * K + C) * 2u; }
    const size_t kstep = (size_t)(BK * 2);
    const size_t hstep = (size_t)HALF * K * 2;
    const size_t tstep = 2 * hstep;
    const unsigned ldsw = (unsigned)wid * 1024u;
    const int aoff = lds_byte(wr * 64 + fr, fq * 8), boff = lds_byte(wc * 32 + fr, fq * 8);
#define PG8_SA(b, h) (((b) * 2 + (h)) * HTB)
#define PG8_SB(b, h) ((4 + (b) * 2 + (h)) * HTB)
#define PG8_STAGE(bufoff, gbase, voff) do { _Pragma("unroll") for (int _i = 0; _i < 2; ++_i) \
        __builtin_amdgcn_global_load_lds((const unsigned*)((const char*)(gbase) + (voff)[_i]), (PG8_LAS unsigned*)(lds + (bufoff) + ldsw + _i * 8192), 16, 0, 0); } while (0)
#define PG8_LDA(dst, b, h) do { _Pragma("unroll") for (int m = 0; m < 4; ++m) _Pragma("unroll") for (int k = 0; k < 2; ++k) dst[m][k] = *(const PG8_LAS bf16x8*)(lds + PG8_SA(b, h) + aoff + m * 2048 + k * 1024); } while (0)
#define PG8_LDB(dst, b, h) do { _Pragma("unroll") for (int n = 0; n < 2; ++n) _Pragma("unroll") for (int k = 0; k < 2; ++k) dst[n][k] = *(const PG8_LAS bf16x8*)(lds + PG8_SB(b, h) + boff + n * 2048 + k * 1024); } while (0)
#define PG8_MMA(ai, bj, At, Bt) do { __builtin_amdgcn_s_setprio(1); _Pragma("unroll") for (int m = 0; m < 4; ++m) _Pragma("unroll") for (int n = 0; n < 2; ++n) _Pragma("unroll") for (int k = 0; k < 2; ++k) \
        acc[ai][bj][m][n] = __builtin_amdgcn_mfma_f32_16x16x32_bf16(Bt[n][k], At[m][k], acc[ai][bj][m][n], 0, 0, 0); __builtin_amdgcn_s_setprio(0); } while (0)
#define PG8_WAIT_V(n) asm volatile("s_waitcnt vmcnt(" #n ")" ::: "memory")
#define PG8_WAIT_L(n) asm volatile("s_waitcnt lgkmcnt(" #n ")" ::: "memory")
#define PG8_BAR __builtin_amdgcn_s_barrier()
#define PG8_SCHED __builtin_amdgcn_sched_barrier(0)
    Unit cur, nxt; int ui = 0;
    if (!S.next(0, cur)) return;
    f32x4 acc[2][2][4][2];
#pragma unroll
    for (int a = 0; a < 2; ++a)
#pragma unroll
        for (int b = 0; b < 2; ++b)
#pragma unroll
            for (int m = 0; m < 4; ++m)
#pragma unroll
                for (int n = 0; n < 2; ++n) acc[a][b][m][n] = (f32x4){0.f, 0.f, 0.f, 0.f};
    bf16x8 At[4][2], B0[2][2], B1[2][2];
    const char* cA = (const char*)g.A + (size_t)cur.pm * tstep; const char* cB = (const char*)g.Bt + (size_t)cur.pn * tstep;
    S.a_ready(cur);
    if constexpr (SP2) {
        PG8_STAGE(PG8_SB(0, 0), cB, voffB); PG8_STAGE(PG8_SB(0, 1), cB + hstep, voffB); PG8_STAGE(PG8_SA(0, 0), cA, voffA); PG8_STAGE(PG8_SA(0, 1), cA + hstep, voffA);
        if (wr == 1) PG8_BAR;
        PG8_WAIT_V(2); PG8_BAR;
        PG8_STAGE(PG8_SB(1, 0), cB + kstep, voffB); PG8_STAGE(PG8_SA(1, 0), cA + kstep, voffA); PG8_STAGE(PG8_SB(1, 1), cB + hstep + kstep, voffB);
        PG8_WAIT_V(6); PG8_BAR;
    } else {
        PG8_STAGE(PG8_SB(0, 0), cB, voffB); PG8_STAGE(PG8_SA(0, 0), cA, voffA); PG8_STAGE(PG8_SB(0, 1), cB + hstep, voffB); PG8_STAGE(PG8_SA(0, 1), cA + hstep, voffA);
        if (wr == 1) PG8_BAR;
        PG8_WAIT_V(4); PG8_BAR;
        PG8_STAGE(PG8_SB(1, 0), cB + kstep, voffB); PG8_STAGE(PG8_SA(1, 0), cA + kstep, voffA); PG8_STAGE(PG8_SB(1, 1), cB + hstep + kstep, voffB);
        PG8_WAIT_V(6); PG8_BAR;
    }
    for (;;) {
        const bool has_next = S.next(ui + 1, nxt);
        const char* nA = has_next ? (const char*)g.A + (size_t)nxt.pm * tstep : cA; const char* nB = has_next ? (const char*)g.Bt + (size_t)nxt.pn * tstep : cB;
        for (int t = 0; t < nt; t += 2) {
            const bool last = (t == nt - 2);
            const char* a1 = cA + (size_t)(t + 1) * kstep;
            const char* a2 = last ? nA : cA + (size_t)(t + 2) * kstep; const char* b2 = last ? nB : cB + (size_t)(t + 2) * kstep;
            const char* a3 = a2 + kstep; const char* b3 = b2 + kstep;
            if (last && has_next) S.a_ready(nxt);
            if constexpr (SP2) {
            PG8_LDB(B0, 0, 0); PG8_LDB(B1, 0, 1); PG8_SCHED; PG8_LDA(At, 0, 0); PG8_STAGE(PG8_SA(1, 1), a1 + hstep, voffA);
            PG8_WAIT_V(8); PG8_WAIT_L(0); PG8_BAR; PG8_MMA(0, 0, At, B0); PG8_MMA(0, 1, At, B1); PG8_BAR; PG8_SCHED;
            PG8_LDA(At, 0, 1); PG8_STAGE(PG8_SB(0, 0), b2, voffB); PG8_STAGE(PG8_SB(0, 1), b2 + hstep, voffB); PG8_STAGE(PG8_SA(0, 0), a2, voffA);
            PG8_WAIT_V(8); PG8_WAIT_L(0); PG8_BAR; PG8_MMA(1, 0, At, B0); PG8_MMA(1, 1, At, B1); PG8_BAR; PG8_SCHED;
            PG8_LDB(B0, 1, 0); PG8_LDB(B1, 1, 1); PG8_SCHED; PG8_LDA(At, 1, 0); PG8_STAGE(PG8_SA(0, 1), a2 + hstep, voffA);
            PG8_WAIT_V(8); PG8_WAIT_L(0); PG8_BAR; PG8_MMA(0, 0, At, B0); PG8_MMA(0, 1, At, B1); PG8_BAR; PG8_SCHED;
            PG8_LDA(At, 1, 1); PG8_STAGE(PG8_SB(1, 0), b3, voffB); PG8_STAGE(PG8_SB(1, 1), b3 + hstep, voffB); PG8_STAGE(PG8_SA(1, 0), a3, voffA);
            PG8_WAIT_V(8); PG8_WAIT_L(0); PG8_BAR; PG8_MMA(1, 0, At, B0); PG8_MMA(1, 1, At, B1); PG8_BAR; PG8_SCHED;
            } else {
            PG8_LDB(B0, 0, 0); PG8_SCHED; PG8_LDA(At, 0, 0); PG8_STAGE(PG8_SA(1, 1), a1 + hstep, voffA);
            PG8_WAIT_L(8); PG8_BAR; PG8_WAIT_L(0); PG8_MMA(0, 0, At, B0); PG8_BAR; PG8_SCHED;
            PG8_LDB(B1, 0, 1); PG8_STAGE(PG8_SB(0, 0), b2, voffB);
            PG8_BAR; PG8_WAIT_L(0); PG8_MMA(0, 1, At, B1); PG8_BAR;
            PG8_LDA(At, 0, 1); PG8_STAGE(PG8_SA(0, 0), a2, voffA);
            PG8_BAR; PG8_WAIT_L(0); PG8_MMA(1, 0, At, B0); PG8_BAR; PG8_SCHED;
            PG8_STAGE(PG8_SB(0, 1), b2 + hstep, voffB);
            PG8_WAIT_V(6); PG8_BAR; PG8_MMA(1, 1, At, B1); PG8_BAR;
            PG8_LDB(B0, 1, 0); PG8_SCHED; PG8_LDA(At, 1, 0); PG8_STAGE(PG8_SA(0, 1), a2 + hstep, voffA);
            PG8_WAIT_L(8); PG8_BAR; PG8_WAIT_L(0); PG8_MMA(0, 0, At, B0); PG8_BAR; PG8_SCHED;
            PG8_LDB(B1, 1, 1); PG8_STAGE(PG8_SB(1, 0), b3, voffB);
            PG8_BAR; PG8_WAIT_L(0); PG8_MMA(0, 1, At, B1); PG8_BAR;
            PG8_LDA(At, 1, 1); PG8_STAGE(PG8_SA(1, 0), a3, voffA);
            PG8_BAR; PG8_WAIT_L(0); PG8_MMA(1, 0, At, B0); PG8_BAR; PG8_SCHED;
            PG8_STAGE(PG8_SB(1, 1), b3 + hstep, voffB);
            PG8_WAIT_V(6); PG8_BAR; PG8_MMA(1, 1, At, B1); PG8_BAR;
            }
        }
        if constexpr (ALIGN_EPI) { if (wr == 0) PG8_BAR; }
        if constexpr (!Epi::AFTER_DRAIN) { E(acc, cur, ui, wr, wc, fr, fq); S.done(cur); }
        if (!has_next) break;
#pragma unroll
        for (int a = 0; a < 2; ++a)
#pragma unroll
            for (int b = 0; b < 2; ++b)
#pragma unroll
                for (int m = 0; m < 4; ++m)
#pragma unroll
                    for (int n = 0; n < 2; ++n) acc[a][b][m][n] = (f32x4){0.f, 0.f, 0.f, 0.f};
        cur = nxt; cA = nA; cB = nB; ++ui;
        if constexpr (ALIGN_EPI) { if (wr == 1) PG8_BAR; }
    }
    PG8_WAIT_V(0);
    if constexpr (!ALIGN_EPI) { if (wr == 0) PG8_BAR; }
    PG8_BAR;
    if constexpr (Epi::AFTER_DRAIN) { E.fused(acc, cur, wr, wc, fr, fq, lds, wid, lane); S.done(cur); }
#undef PG8_SA
#undef PG8_SB
#undef PG8_STAGE
#undef PG8_LDA
#undef PG8_LDB
#undef PG8_MMA
#undef PG8_WAIT_V
#undef PG8_WAIT_L
#undef PG8_BAR
#undef PG8_SCHED
}
}
constexpr int NWAVES = 8;
constexpr int BATCH = 2, SEQ = 8192, D = 1024, M = BATCH * SEQ;
constexpr int FH = 8, FDH = 128;
constexpr int RH = 4, RDK = 256, RDV = 512, CH = 64, NCH = SEQ / CH;
constexpr int DFF = 2816;
constexpr float EPS = 1e-6f;
constexpr float LOG2E = 1.4426950408889634f;
constexpr float QSCALE = 0.08838834764831845f * LOG2E;
constexpr int NPHASE = 14;

constexpr size_t MiB = 1u << 20;
constexpr size_t WS_CTL = 0, CTL_ZERO_BYTES = 32768;
constexpr size_t WS_SSQ = 1 * MiB;
constexpr size_t WS_LC = 2 * MiB;
constexpr size_t WS_TT = 2 * MiB + 512 * 1024;
constexpr size_t WS_NRM = 2 * MiB + 512 * 1024 + 16384;
constexpr size_t WS_ROPE = 3 * MiB;
constexpr size_t WS_WQKV0 = 11 * MiB;
constexpr size_t WS_WO0 = 17 * MiB;
constexpr size_t WS_WFI0 = 19 * MiB;
constexpr size_t WS_WFO0 = 30 * MiB;
constexpr size_t WS_WRI = 36 * MiB;
constexpr size_t WS_WRO = 48 * MiB;
constexpr size_t WS_WFI1 = 52 * MiB;
constexpr size_t WS_WFO1 = 63 * MiB;
constexpr size_t WS_XB = 69 * MiB;
constexpr size_t WS_ACT = 101 * MiB;
constexpr size_t WS_Q0 = WS_ACT, WS_K0 = WS_ACT + 32 * MiB, WS_V0 = WS_ACT + 64 * MiB;
constexpr size_t WS_O0 = WS_ACT + 96 * MiB;
constexpr size_t WS_HID = WS_ACT;
constexpr size_t WS_Q1 = WS_ACT, WS_K1 = WS_ACT + 32 * MiB, WS_V1 = WS_ACT + 64 * MiB;
constexpr size_t WS_PST = WS_ACT + 128 * MiB;
constexpr size_t WS_CBG = WS_PST;
constexpr size_t WS_LBUF = WS_WQKV0;
constexpr size_t WS_END = WS_PST + 8 * MiB;
static_assert(WS_WFO1 + (size_t)1024 * 2816 * 2 <= WS_XB && WS_HID + (size_t)M * DFF * 2 <= WS_PST && WS_END <= 256 * MiB, "d_ws map");
constexpr int CW_TMO = 0, CW_CODE = 1;
constexpr int CW_BAR = 4096;
constexpr int CW_ATT = 2048;

constexpr int RING_OFF = 0, RING_BYTES = 131072;
constexpr int LDSCTL_OFF = RING_BYTES, MISC_OFF = LDSCTL_OFF + 320;
constexpr int TAB_OFF = RING_BYTES + 512;
constexpr int STAB_OFF = TAB_OFF + 8192;
constexpr int LDS_BYTES = 147456;
static_assert(STAB_OFF + 4096 <= LDS_BYTES, "LDS map");
#define GAS __attribute__((address_space(1)))
#define LAS __attribute__((address_space(3)))
typedef unsigned short bf16;
typedef unsigned v4u __attribute__((ext_vector_type(4)));
typedef float f32x4 __attribute__((ext_vector_type(4)));
typedef short bf16x8 __attribute__((ext_vector_type(8)));
typedef GAS unsigned gu32;
typedef GAS unsigned long long gu64;
#define RLX_AGENT __ATOMIC_RELAXED, __HIP_MEMORY_SCOPE_AGENT
#define LDS_WAIT() asm volatile("s_waitcnt lgkmcnt(0)" ::: "memory")
#define VM_WAIT() asm volatile("s_waitcnt vmcnt(0)" ::: "memory")
__device__ __forceinline__ unsigned long long rt() { return __builtin_amdgcn_s_memrealtime(); }
__device__ __forceinline__ unsigned f2bf(float f) { unsigned u = __builtin_bit_cast(unsigned, f); return (u + 0x7fffu + ((u >> 16) & 1u)) >> 16; }
__device__ __forceinline__ unsigned pk2(float lo, float hi) { return f2bf(lo) | (f2bf(hi) << 16); }
typedef float f32x2 __attribute__((ext_vector_type(2)));
#define XB_TMO      128
#define XB_XCNT(j)  (256  + 64 * (j))
#define XB_XSUB(j)  (1280 + 64 * (j))
#define XB_XGEN(j)  (2304 + 64 * (j))
#define XB_TOP      3328
#define XB_TOPGEN   3392
#define XCD_BAR_WORDS 3456
#define XB_SPIN_CAP (1u << 18)

__device__ __forceinline__ unsigned xb_ld(unsigned* p)              { return __hip_atomic_load(p, __ATOMIC_RELAXED, __HIP_MEMORY_SCOPE_AGENT); }
__device__ __forceinline__ unsigned xb_add(unsigned* p, unsigned v) { return __hip_atomic_fetch_add(p, v, __ATOMIC_RELAXED, __HIP_MEMORY_SCOPE_AGENT); }
__device__ __forceinline__ unsigned xb_xcc_id() { return (unsigned)__builtin_amdgcn_s_getreg((3 << 11) | 20) & 0xFu; }
#define XB_SPIN(cond, bar) do { unsigned _sp = 0; while (cond) { __builtin_amdgcn_s_sleep(1); \
    if ((++_sp & 255u) == 0u) { if (xb_ld(&(bar)[XB_TMO])) break; if (_sp > XB_SPIN_CAP) { atomicAdd(&(bar)[XB_TMO], 1u); break; } } } } while (0)

struct XcdBarrier {
    unsigned* bar; unsigned x;
    volatile LAS unsigned* st;
};

__device__ __forceinline__ XcdBarrier xcd_barrier_post(unsigned* bar, volatile LAS unsigned* st) {
    XcdBarrier b; b.bar = bar; b.x = xb_xcc_id(); b.st = st;
    if (threadIdx.x == 0) (void)xb_add(&bar[XB_XCNT(b.x)], 1u);
    return b;
}
__device__ __forceinline__ void xcd_barrier_complete(unsigned* bar, unsigned x, unsigned& nloc, unsigned& nx) {
    const unsigned G = gridDim.x * gridDim.y * gridDim.z;
    unsigned sum, cnt, mine, sp = 0u;
    for (;;) {
        sum = 0u; cnt = 0u; mine = 0u;
#pragma unroll
        for (unsigned j = 0; j < 16; ++j) { const unsigned c = xb_ld(&bar[XB_XCNT(j)]); sum += c; cnt += (c > 0u) ? 1u : 0u; mine = (j == x) ? c : mine; }
        if (sum == G) break;
        __builtin_amdgcn_s_sleep(1);
        if ((++sp & 255u) == 0u) { if (xb_ld(&bar[XB_TMO])) break; if (sp > XB_SPIN_CAP) { atomicAdd(&bar[XB_TMO], 1u); break; } }
    }
    nloc = mine > 0u ? mine : 1u; nx = cnt > 0u ? cnt : 1u;
}

__device__ __forceinline__ void xcd_barrier(const XcdBarrier& b) {
    asm volatile("s_waitcnt vmcnt(0)" ::: "memory");
    __syncthreads();
    if (threadIdx.x == 0) {
        unsigned* bar = b.bar;
        __builtin_amdgcn_s_waitcnt(0);
        unsigned nloc = b.st[0], nx = b.st[1];
        if (nloc == 0u) { xcd_barrier_complete(bar, b.x, nloc, nx); b.st[0] = nloc; b.st[1] = nx; }
        const unsigned old = xb_add(&bar[XB_XSUB(b.x)], 1u);
        const unsigned gen = old / nloc;
        if (old + 1u == (gen + 1u) * nloc) {
            __builtin_amdgcn_fence(__ATOMIC_RELEASE, "agent");
            asm volatile("s_waitcnt vmcnt(0)" ::: "memory");
            const unsigned og = xb_add(&bar[XB_TOP], 1u);
            const unsigned tg = og / nx;
            if (og + 1u == (tg + 1u) * nx) xb_add(&bar[XB_TOPGEN], 1u);
            else XB_SPIN(xb_ld(&bar[XB_TOPGEN]) == tg, bar);
            __builtin_amdgcn_fence(__ATOMIC_ACQUIRE, "agent");
            xb_add(&bar[XB_XGEN(b.x)], 1u);
            asm volatile("s_waitcnt vmcnt(0)" ::: "memory");
        } else {
            XB_SPIN(xb_ld(&bar[XB_XGEN(b.x)]) == gen, bar);
            __builtin_amdgcn_fence(__ATOMIC_ACQUIRE, "agent");
            asm volatile("s_waitcnt vmcnt(0)" ::: "memory");
        }
    }
    __syncthreads();
}
namespace fa {
constexpr int D = 128, LDQ = 1024;
constexpr float THR = 8.f;
constexpr bool WSKIP = false;
constexpr int NW = 8, QBLK = 32, KVBLK = 64, QB = NW * QBLK;
constexpr int SHM_V = KVBLK * D * 2, SHM_K = KVBLK * D * 2;
constexpr int LDS_BYTES = 131072;
using bf16 = unsigned short;
typedef short bf16x8 __attribute__((ext_vector_type(8)));
typedef short s16x4 __attribute__((ext_vector_type(4)));
typedef float f32x16 __attribute__((ext_vector_type(16)));
typedef float f32x4 __attribute__((ext_vector_type(4)));
typedef unsigned u32x4 __attribute__((ext_vector_type(4)));
#define KSWZ(row, colB) ((row) * 256 + ((colB) ^ (((row) & 7) << 4)))
#define SBAR() __builtin_amdgcn_sched_barrier(0)
__device__ __forceinline__ int v_st(int k, int c) { const int kk = (k & ~0xC) | ((k & 4) << 1) | ((k & 8) >> 1); return ((kk >> 3) * 4 + (c >> 5)) * 512 + ((kk & 7) * 32 + (c & 31)) * 2; }
__device__ __forceinline__ int v_rd_base(int lane) { return ((lane & 3) << 3) | (((lane >> 2) & 3) << 6) | (((lane >> 4) & 1) << 5) | (((lane >> 5) & 1) << 8); }
constexpr int v_rd_off(int d0, int ks, int half) { return d0 * 512 + ks * 4096 + half * 2048; }
__device__ __forceinline__ int crow(int r, int hi) { return (r & 3) + 8 * (r >> 2) + 4 * hi; }
__device__ __forceinline__ unsigned cvtpk(float lo, float hi) {
    unsigned r; asm volatile("v_cvt_pk_bf16_f32 %0, %1, %2" : "=v"(r) : "v"(lo), "v"(hi)); return r;
}
__device__ __forceinline__ bf16x8 pack8(f32x4 a, f32x4 b) {
    u32x4 w = {cvtpk(a[0], a[1]), cvtpk(a[2], a[3]), cvtpk(b[0], b[1]), cvtpk(b[2], b[3])};
    return *reinterpret_cast<bf16x8*>(&w);
}
__device__ __forceinline__ bf16x8 load8(const bf16* p) { return *reinterpret_cast<const bf16x8*>(p); }
__device__ __forceinline__ void mask_tile(f32x16& p0, f32x16& p1, int dq, unsigned W) {
    const float NEG = -__builtin_inff();
#pragma unroll
    for (int r = 0; r < 16; ++r) {
        const int c = (r & 3) + 8 * (r >> 2);
        if ((unsigned)(dq - c) >= W) p0[r] = NEG;
        if ((unsigned)(dq - c - 32) >= W) p1[r] = NEG;
    }
}
__device__ __forceinline__ void partialSM(f32x16& p0, f32x16& p1, float& m_reg, float& mn, float& alpha) {
    float pmax = p0[0]; for (int r = 1; r < 16; ++r) pmax = fmaxf(pmax, p0[r]); for (int r = 0; r < 16; ++r) pmax = fmaxf(pmax, p1[r]);
    { auto rr = __builtin_amdgcn_permlane32_swap(__float_as_uint(pmax), __float_as_uint(pmax), false, false);
      pmax = fmaxf(__uint_as_float(rr[0]), __uint_as_float(rr[1])); }
    if (__builtin_expect(__all((pmax - m_reg) <= THR), 1)) { mn = m_reg; alpha = 1.f; }
    else { mn = fmaxf(m_reg, pmax); alpha = __builtin_amdgcn_exp2f(m_reg - mn); m_reg = mn; }
    for (int r = 0; r < 16; ++r) p0[r] = p0[r] - mn; for (int r = 0; r < 16; ++r) p1[r] = p1[r] - mn;
    for (int r = 0; r < 16; ++r) p0[r] = __builtin_amdgcn_exp2f(p0[r]);
}
__device__ __forceinline__ void finishSM(f32x16& p0, f32x16& p1, float alpha, float& l_reg, bf16x8& pa0, bf16x8& pa1, bf16x8& pa2, bf16x8& pa3) {
    for (int r = 0; r < 16; ++r) p1[r] = __builtin_amdgcn_exp2f(p1[r]);
    float ps = 0; for (int r = 0; r < 16; ++r) ps += p0[r]; for (int r = 0; r < 16; ++r) ps += p1[r];
    { auto rr = __builtin_amdgcn_permlane32_swap(__float_as_uint(ps), __float_as_uint(ps), false, false);
      ps = __uint_as_float(rr[0]) + __uint_as_float(rr[1]); }
    l_reg = l_reg * alpha + ps;
#define PK4(P, B_, OUT) do { unsigned a0 = cvtpk(P[B_+0], P[B_+1]), a1 = cvtpk(P[B_+2], P[B_+3]);                          \
        unsigned b0 = cvtpk(P[B_+4], P[B_+5]), b1 = cvtpk(P[B_+6], P[B_+7]);                                             \
        auto r0 = __builtin_amdgcn_permlane32_swap(a0, b0, false, false); auto r1 = __builtin_amdgcn_permlane32_swap(a1, b1, false, false); \
        u32x4 w = {r0[0], r1[0], r0[1], r1[1]}; OUT = *reinterpret_cast<bf16x8*>(&w); } while (0)
    PK4(p0, 0, pa0); PK4(p0, 8, pa1); PK4(p1, 0, pa2); PK4(p1, 8, pa3);
#undef PK4
}
__device__ __forceinline__ void qkt(f32x16& p0, f32x16& p1, const char* K_slot, int r32, int hi, const bf16x8* qr, const float* cbt) {
#pragma unroll
    for (int g = 0; g < 4; ++g) { const f32x4 a = *(const f32x4*)(cbt + 8 * g + 4 * hi), b = *(const f32x4*)(cbt + 32 + 8 * g + 4 * hi);
        p0[4 * g] = a[0]; p0[4 * g + 1] = a[1]; p0[4 * g + 2] = a[2]; p0[4 * g + 3] = a[3]; p1[4 * g] = b[0]; p1[4 * g + 1] = b[1]; p1[4 * g + 2] = b[2]; p1[4 * g + 3] = b[3]; }
    const char* kb[4];
#pragma unroll
    for (int dd = 0; dd < 4; ++dd) kb[dd] = K_slot + KSWZ(r32, (dd * 16 + hi * 8) * 2);
#pragma unroll
    for (int d0 = 0; d0 < 8; ++d0) { const char* a = kb[d0 & 3] + (d0 >> 2) * 128;
        bf16x8 b0 = *reinterpret_cast<const bf16x8*>(a);
        bf16x8 b1 = *reinterpret_cast<const bf16x8*>(a + 32 * 256);
        p0 = __builtin_amdgcn_mfma_f32_32x32x16_bf16(b0, qr[d0], p0, 0, 0, 0);
        p1 = __builtin_amdgcn_mfma_f32_32x32x16_bf16(b1, qr[d0], p1, 0, 0, 0); }
}
__device__ __forceinline__ void pv_tile(f32x16* o, int vbs, bf16x8 pa0, bf16x8 pa1, bf16x8 pa2, bf16x8 pa3) {
#define TRRD(dst, off) asm volatile("ds_read_b64_tr_b16 %0, %1 offset:%2" : "=&v"(dst) : "v"(vbs), "i"(off) : "memory")
#define PV_D0(d0) do { s16x4 l0, l1, l2, l3, h0, h1, h2, h3; constexpr int b_ = v_rd_off(d0, 0, 0);     \
        TRRD(l0, b_); TRRD(h0, b_ + 2048); TRRD(l1, b_ + 4096); TRRD(h1, b_ + 6144); TRRD(l2, b_ + 8192); TRRD(h2, b_ + 10240); TRRD(l3, b_ + 12288); TRRD(h3, b_ + 14336); \
        asm volatile("s_waitcnt lgkmcnt(0)" ::: "memory"); SBAR();                 \
        o[d0] = __builtin_amdgcn_mfma_f32_32x32x16_bf16(pa0, (bf16x8){l0[0], l0[1], l0[2], l0[3], h0[0], h0[1], h0[2], h0[3]}, o[d0], 0, 0, 0);   \
        o[d0] = __builtin_amdgcn_mfma_f32_32x32x16_bf16(pa1, (bf16x8){l1[0], l1[1], l1[2], l1[3], h1[0], h1[1], h1[2], h1[3]}, o[d0], 0, 0, 0);   \
        o[d0] = __builtin_amdgcn_mfma_f32_32x32x16_bf16(pa2, (bf16x8){l2[0], l2[1], l2[2], l2[3], h2[0], h2[1], h2[2], h2[3]}, o[d0], 0, 0, 0);   \
        o[d0] = __builtin_amdgcn_mfma_f32_32x32x16_bf16(pa3, (bf16x8){l3[0], l3[1], l3[2], l3[3], h3[0], h3[1], h3[2], h3[3]}, o[d0], 0, 0, 0); } while (0)
    PV_D0(0); PV_D0(1); PV_D0(2); PV_D0(3);
#undef PV_D0
#undef TRRD
}

#define FGAS __attribute__((address_space(1)))
struct BlockRef { FGAS char* base; unsigned qo, ko, vo, oo, cbo; int P0, kb0; float Bq; };
constexpr int LDS_VR = 0, LDS_KR = 3 * SHM_V, LDS_CBR = 3 * SHM_V + 3 * SHM_K, LDS_WSR = 131584;
__device__ __forceinline__ void glds16(const FGAS char* gsrc, unsigned lds_dst) {
    unsigned keep; asm volatile("s_mov_b32 %0, m0\n\ts_mov_b32 m0, %2\n\ts_nop 0\n\tglobal_load_lds_dwordx4 %1, off\n\ts_mov_b32 m0, %0" : "=&s"(keep) : "v"(gsrc), "s"(lds_dst) : "memory");
}
#define WAIT_BAR(N) asm volatile("s_waitcnt vmcnt(" #N ") lgkmcnt(0)\n\ts_barrier" ::: "memory")
__device__ __forceinline__ void fa_block(const BlockRef& cur, char* lds, int tid_in) {
    int tid = tid_in; asm volatile("" : "+v"(tid));
    const int wid = __builtin_amdgcn_readfirstlane(tid >> 6), lane = tid & 63, r32 = lane & 31, hi = lane >> 5;
    const int kb0 = cur.kb0, NT0 = (cur.P0 + QB - kb0) / KVBLK;
    const int NT = NT0;
    const int qlo = cur.P0 + wid * QBLK, qm = qlo + r32 - 4 * hi;
    float* CBA = (float*)(lds + LDS_CBR);
    float* ws = (float*)(lds + LDS_WSR) + wid * 64; float* li_l = ws, * al_l = ws + 32; float* mm_l = (float*)(lds + LDS_WSR + 2048);
    const unsigned lds0 = (unsigned)(uintptr_t)lds;
    for (int i = tid; i < (cur.P0 + QB - kb0) / 4; i += NW * 64) ((f32x4*)CBA)[i] = *(const FGAS f32x4*)(cur.base + cur.cbo + (unsigned)(kb0 * 4) + (unsigned)i * 16u);
    bf16x8 qr[8];
    { const unsigned qoff = (unsigned)(((wid * QBLK + r32) * LDQ + hi * 8) * 2);
#pragma unroll
      for (int d0 = 0; d0 < 8; ++d0) qr[d0] = *(const FGAS bf16x8*)(cur.base + cur.qo + qoff + d0 * 32); }
    asm volatile("s_waitcnt vmcnt(0)" ::: "memory");
    unsigned kso[2], vso[2];
#pragma unroll
    for (int i = 0; i < 2; ++i) { const int p = 2 * wid + i, row = 4 * p + (lane >> 4), c = (lane & 15) ^ (row & 7); kso[i] = (unsigned)(row * (LDQ * 2) + c * 16);
        const int sub = 2 * p + (lane >> 5), kk = 8 * (sub >> 2) + ((lane & 31) >> 2), k = (kk & ~0xC) | ((kk & 4) << 1) | ((kk & 8) >> 1), cc = 32 * (sub & 3) + 8 * (lane & 3); vso[i] = (unsigned)(k * (LDQ * 2) + cc * 2); }
    const FGAS char* Kt = cur.base + cur.ko + (size_t)kb0 * (LDQ * 2); const FGAS char* Vt = cur.base + cur.vo + (size_t)kb0 * (LDQ * 2);
#define DMA_K(t, slot) do { const FGAS char* g_ = Kt + (size_t)(NT0 - 1 - (t)) * (KVBLK * LDQ * 2); const unsigned d_ = (unsigned)__builtin_amdgcn_readfirstlane(lds0 + LDS_KR + (slot) + 2048 * wid); glds16(g_ + kso[0], d_); glds16(g_ + kso[1], d_ + 1024); } while (0)
#define DMA_V(t, slot) do { const FGAS char* g_ = Vt + (size_t)(NT0 - 1 - (t)) * (KVBLK * LDQ * 2); const unsigned d_ = (unsigned)__builtin_amdgcn_readfirstlane(lds0 + LDS_VR + (slot) + 2048 * wid); glds16(g_ + vso[0], d_); glds16(g_ + vso[1], d_ + 1024); } while (0)
    DMA_K(0, 0); DMA_V(0, 0); DMA_K(1, SHM_K);
    float m_reg = -1e30f, l_reg = 0; f32x16 o[4] = {};
    const int vb0 = (int)lds0 + LDS_VR + v_rd_base(lane);
#define RESC(a) do { if (__any((a) < 1.f)) { if (hi == 0) al_l[r32] = (a); asm volatile("s_waitcnt lgkmcnt(0)" ::: "memory");              \
                     for (int d_ = 0; d_ < 4; ++d_) for (int r = 0; r < 16; ++r) o[d_][r] *= al_l[crow(r, hi)]; } } while (0)
#define KBASE(t) (kb0 + (NT0 - 1 - (t)) * KVBLK)
#define MASKT(P0_, P1_, t) do { const int kb_ = KBASE(t); if (kb_ + KVBLK - 1 > qlo) mask_tile(P0_, P1_, qm - kb_, 0x40000000u); } while (0)
    f32x16 pA0, pA1, pB0, pB1; float mnA, mnB, alA, alB; bf16x8 pa0, pa1, pa2, pa3;
    int s_prev = 0, s_cur = 0, s_next = SHM_K;
#define ROT() do { s_prev = s_cur; s_cur = s_next; s_next = (s_next == 2 * SHM_K) ? 0 : s_next + SHM_K; } while (0)
    WAIT_BAR(4);
    DMA_K(2, 2 * SHM_K); DMA_V(1, SHM_V);
    SBAR(); qkt(pA0, pA1, lds + LDS_KR, r32, hi, qr, CBA + (NT0 - 1) * KVBLK);
    MASKT(pA0, pA1, 0); partialSM(pA0, pA1, m_reg, mnA, alA);
    WAIT_BAR(4);
    ROT();
#define STEP(PX0, PX1, mnX, alX, PY0, PY1, alY, t) do {                                                                       \
        { const int s_nn = (s_next == 2 * SHM_K) ? 0 : s_next + SHM_K;                  \
          if ((t) + 2 < NT) DMA_K((t) + 2, s_nn); if ((t) + 1 < NT) DMA_V((t) + 1, s_next); }                                  \
        SBAR(); qkt(PX0, PX1, lds + LDS_KR + s_cur, r32, hi, qr, CBA + (NT0 - 1 - (t)) * KVBLK);                                           \
        finishSM(PY0, PY1, alY, l_reg, pa0, pa1, pa2, pa3); SBAR();                                                           \
        pv_tile(o, vb0 + s_prev, pa0, pa1, pa2, pa3); MASKT(PX0, PX1, (t)); partialSM(PX0, PX1, m_reg, mnX, alX);             \
        RESC(alX);                                                                                                            \
        if ((t) + 2 < NT) WAIT_BAR(4); else if ((t) + 1 < NT) WAIT_BAR(2); else WAIT_BAR(0);                                   \
        ROT(); } while (0)
    int t = 1;
    for (; t + 1 < NT; t += 2) {
        STEP(pB0, pB1, mnB, alB, pA0, pA1, alA, t);
        STEP(pA0, pA1, mnA, alA, pB0, pB1, alB, t + 1);
    }
    if (t < NT) {
        STEP(pB0, pB1, mnB, alB, pA0, pA1, alA, t);
        finishSM(pB0, pB1, alB, l_reg, pa0, pa1, pa2, pa3); SBAR();
    } else {
        finishSM(pA0, pA1, alA, l_reg, pa0, pa1, pa2, pa3); SBAR();
    }
    pv_tile(o, vb0 + s_prev, pa0, pa1, pa2, pa3);
    if (hi == 0) li_l[r32] = l_reg; asm volatile("s_waitcnt lgkmcnt(0)" ::: "memory");
    float rli[16];
#pragma unroll
    for (int r = 0; r < 16; ++r) rli[r] = __builtin_amdgcn_rcpf(li_l[crow(r, hi)]);
    const unsigned ooff = (unsigned)(((wid * QBLK + 4 * hi) * LDQ + r32) * 2);
#pragma unroll
    for (int r = 0; r < 16; ++r) { FGAS char* orow = cur.base + cur.oo + ((r & 3) + 8 * (r >> 2)) * (LDQ * 2);
#pragma unroll
        for (int d0 = 0; d0 < 4; ++d0) { const float v = o[d0][r] * rli[r]; const float vn = __shfl_xor(v, 1);
            if ((r32 & 1) == 0) *(FGAS unsigned*)(orow + ooff + d0 * 64) = cvtpk(v, vn); } }
    asm volatile("s_waitcnt vmcnt(0) lgkmcnt(0)\n\ts_barrier" ::: "memory");
#undef RESC
#undef KBASE
#undef MASKT
#undef STEP
#undef ROT
#undef DMA_K
#undef DMA_V
}
#undef WAIT_BAR
#undef FGAS
#undef SBAR
#undef KSWZ
}
namespace rtn {
#define RLAS __attribute__((address_space(3)))
#define RGAS __attribute__((address_space(1)))
typedef short bf16x8 __attribute__((ext_vector_type(8)));
typedef short v4i16_t __attribute__((ext_vector_type(4)));
typedef float f32x16 __attribute__((ext_vector_type(16)));
typedef float f32x4 __attribute__((ext_vector_type(4)));
typedef unsigned u32x4 __attribute__((ext_vector_type(4)));
typedef unsigned u32x2 __attribute__((ext_vector_type(2)));
constexpr int NG = 16, RG = 8;
constexpr int LQ = 0, LK = 32768, LV = 65536, LK2 = 98304, LS = 132096, LPW = 140288;
constexpr int LDS_BYTES = LPW + 1024;
__device__ __forceinline__ int crow(int r, int hi) { return (r & 3) + 8 * (r >> 2) + 4 * hi; }
__device__ __forceinline__ unsigned cvtpk(float lo, float hi) { unsigned r; asm volatile("v_cvt_pk_bf16_f32 %0, %1, %2" : "=v"(r) : "v"(lo), "v"(hi)); return r; }
__device__ __forceinline__ float bflo(unsigned w) { return __builtin_bit_cast(float, w << 16); }
__device__ __forceinline__ float bfhi(unsigned w) { return __builtin_bit_cast(float, w & 0xffff0000u); }
__device__ __forceinline__ int off512(int row, int ch) { return 512 * row + 16 * (ch ^ (((row & 3) << 2) | ((row >> 2) & 3))); }
__device__ __forceinline__ int offS(int row, int ch8) { return 128 * row + 16 * (ch8 ^ ((row >> 1) & 7)); }
__device__ __forceinline__ bf16x8 lds128(unsigned a) { return *(const RLAS bf16x8*)(uintptr_t)a; }
__device__ __forceinline__ v4i16_t ldstr(unsigned a) { return __builtin_amdgcn_ds_read_tr16_b64_v4i16((RLAS v4i16_t*)(uintptr_t)a); }
__device__ __forceinline__ void glds16(const RGAS char* gsrc, unsigned lds_dst) {
    unsigned keep; asm volatile("s_mov_b32 %0, m0\n\ts_mov_b32 m0, %2\n\ts_nop 0\n\tglobal_load_lds_dwordx4 %1, off\n\ts_mov_b32 m0, %0" : "=&s"(keep) : "v"(gsrc), "s"(lds_dst) : "memory");
}
__device__ __forceinline__ void stage_tile(const RGAS char* g, unsigned ld_bytes, unsigned lbase, int wave, int lane) {
#pragma unroll
    for (int i = 0; i < 4; ++i) { const int pid = wave * 4 + i, row = 2 * pid + (lane >> 5), ch = (lane & 31) ^ (((row & 3) << 2) | ((row >> 2) & 3));
        glds16(g + (unsigned)row * ld_bytes + (unsigned)ch * 16u, (unsigned)__builtin_amdgcn_readfirstlane(lbase + 1024u * (unsigned)pid)); }
}
struct Ptrs { const RGAS char* Q; const RGAS char* K; RGAS char* V; RGAS char* L; RGAS float* PST; };
__device__ __forceinline__ void load_vfrags(bf16x8 (&vf)[4], unsigned vb0, unsigned vb1) {
#pragma unroll
    for (int s = 0; s < 4; ++s) { const v4i16_t lo = ldstr(vb0 + 8192 * s), hi = ldstr(vb1 + 8192 * s + 2048); vf[s] = (bf16x8){lo[0], lo[1], lo[2], lo[3], hi[0], hi[1], hi[2], hi[3]}; }
}
__device__ __forceinline__ void update_state(f32x16 (&X)[8], const bf16x8 (&vf)[4], unsigned kt0, unsigned kt1, unsigned lds0, int hh, float scl) {
    const RLAS float* pwr = (const RLAS float*)(uintptr_t)(lds0 + LPW + 144 * 4);
    v4i16_t fa[3][2][2];
#define RT_LOADB(buf, b) do { _Pragma("unroll") for (int j = 0; j < 2; ++j) { const int dt_ = 2 * ((b) & 3) + j, s_ = (b) >> 2; \
        fa[buf][j][0] = ldstr((kt0 ^ (unsigned)(64 * dt_)) + 8192 * s_); fa[buf][j][1] = ldstr((kt1 ^ (unsigned)(64 * dt_)) + 8192 * s_ + 2048); } } while (0)
    RT_LOADB(0, 0); RT_LOADB(1, 1);
    bf16x8 vs;
#pragma unroll
    for (int b = 0; b < 16; ++b) {
        if (b + 2 < 16) RT_LOADB((b + 2) % 3, b + 2);
        if ((b & 3) == 0) { const int s = b >> 2; const f32x4 f0 = *(const RLAS f32x4*)(pwr + 16 * s + 8 * hh), f1 = *(const RLAS f32x4*)(pwr + 16 * s + 8 * hh + 4);
            const u32x4 w = __builtin_bit_cast(u32x4, vf[s]); u32x4 o;
            o.x = cvtpk(bflo(w.x) * f0[0] * scl, bfhi(w.x) * f0[1] * scl); o.y = cvtpk(bflo(w.y) * f0[2] * scl, bfhi(w.y) * f0[3] * scl);
            o.z = cvtpk(bflo(w.z) * f1[0] * scl, bfhi(w.z) * f1[1] * scl); o.w = cvtpk(bflo(w.w) * f1[2] * scl, bfhi(w.w) * f1[3] * scl);
            vs = __builtin_bit_cast(bf16x8, o); }
        __builtin_amdgcn_sched_barrier(0);
#pragma unroll
        for (int j = 0; j < 2; ++j) { const v4i16_t lo = fa[b % 3][j][0], hi = fa[b % 3][j][1]; const int dt = 2 * (b & 3) + j;
            X[dt] = __builtin_amdgcn_mfma_f32_32x32x16_bf16((bf16x8){lo[0], lo[1], lo[2], lo[3], hi[0], hi[1], hi[2], hi[3]}, vs, X[dt], 0, 0, 0); }
        __builtin_amdgcn_sched_barrier(0);
    }
#undef RT_LOADB
}
__device__ __forceinline__ void dump_state(const f32x16 (&X)[8], RGAS char* L, int wave, int lane, float scl) {
#pragma unroll
    for (int dt = 0; dt < 8; ++dt)
#pragma unroll
        for (int s = 0; s < 2; ++s) { u32x4 o; o.x = cvtpk(X[dt][8 * s] * scl, X[dt][8 * s + 1] * scl); o.y = cvtpk(X[dt][8 * s + 2] * scl, X[dt][8 * s + 3] * scl);
            o.z = cvtpk(X[dt][8 * s + 4] * scl, X[dt][8 * s + 5] * scl); o.w = cvtpk(X[dt][8 * s + 6] * scl, X[dt][8 * s + 7] * scl);
            *(RGAS u32x4*)(L + (unsigned)(wave * 16384 + (2 * dt + s) * 1024 + lane * 16)) = o; }
}
__device__ __forceinline__ void accum_state(f32x16 (&X)[8], const RGAS char* L, int wave, int lane, float dec) {
#pragma unroll
    for (int dt = 0; dt < 8; ++dt)
#pragma unroll
        for (int s = 0; s < 2; ++s) { const u32x4 w = *(const RGAS u32x4*)(L + (unsigned)(wave * 16384 + (2 * dt + s) * 1024 + lane * 16));
            X[dt][8 * s] = X[dt][8 * s] * dec + bflo(w.x); X[dt][8 * s + 1] = X[dt][8 * s + 1] * dec + bfhi(w.x); X[dt][8 * s + 2] = X[dt][8 * s + 2] * dec + bflo(w.y); X[dt][8 * s + 3] = X[dt][8 * s + 3] * dec + bfhi(w.y);
            X[dt][8 * s + 4] = X[dt][8 * s + 4] * dec + bflo(w.z); X[dt][8 * s + 5] = X[dt][8 * s + 5] * dec + bfhi(w.z); X[dt][8 * s + 6] = X[dt][8 * s + 6] * dec + bflo(w.w); X[dt][8 * s + 7] = X[dt][8 * s + 7] * dec + bfhi(w.w); }
}
template <bool FULL>
__device__ __forceinline__ void run_item(const Ptrs& P, int bh, int half, int g, unsigned lds0, int wave_in) {
    int lane0_ = hw_lane_id(); asm volatile("" : "+v"(lane0_));
    const int lane0 = lane0_, wave = wave_in, tid = wave * 64 + lane0;
    const int b = bh >> 2, h = bh & 3;
    const float lg = __logf(1.0f - __builtin_amdgcn_exp2f(-5.0f - (float)h));
    const float cd = __expf(lg * 64.f), cdinv = __expf(-lg * 64.f);
    RLAS float* pw = (RLAS float*)(uintptr_t)(lds0 + LPW);
    __syncthreads();
    if (tid <= 64) pw[tid] = __expf(lg * (float)tid);
    if (tid < 64) { pw[80 + tid] = __expf(lg * (float)(tid + 1)); pw[144 + tid] = __expf(lg * (float)(63 - tid)); }
    const int g16 = lane0 >> 4, blk = g16 & 1, q4 = (lane0 & 15) >> 2, p4 = lane0 & 3, sp = ((p4 & 1) << 1) | (p4 >> 1), hh0 = lane0 >> 5;
    const unsigned trrow = (unsigned)(512 * (8 * hh0 + q4));
    const int fl = (q4 << 2) | (hh0 << 1);
    unsigned vb0_ = lds0 + LV + trrow + 16u * (unsigned)((4 * wave + 2 * blk + (p4 >> 1)) ^ fl) + 8u * (unsigned)(p4 & 1);
    unsigned kt0_ = lds0 + LK + trrow + 16u * (unsigned)((2 * blk + (sp >> 1)) ^ fl) + 8u * (unsigned)(sp & 1);
    unsigned lane_ = (unsigned)lane0;
    const size_t tok0 = (size_t)b * 8192 + (size_t)g * (RG * 64);
    const RGAS char* Qg = P.Q + (tok0 * 1024 + (size_t)h * 256) * 2; const RGAS char* Kg = P.K + (tok0 * 1024 + (size_t)h * 256) * 2;
    RGAS char* Vg = P.V + (tok0 * 2048 + (size_t)h * 512 + (size_t)half * 256) * 2;
    f32x16 X[8];
#pragma unroll
    for (int dt = 0; dt < 8; ++dt) X[dt] = f32x16{};
    if constexpr (FULL) {
        const float cdg = __expf(lg * (float)(RG * 64));
        for (int gp = 0; gp < g; ++gp) accum_state(X, P.L + (size_t)((bh * (NG - 1) + gp) * 2 + half) * 131072, wave, lane0, cdg);
    }
    float cdm = 1.f, cdim = cdinv;
    __syncthreads();
    if constexpr (FULL) { stage_tile(Qg, 2048, lds0 + LQ, wave, lane0); stage_tile(Vg, 4096, lds0 + LV, wave, lane0); } else { stage_tile(Vg, 4096, lds0 + LV, wave, lane0); }
    stage_tile(Kg, 2048, lds0 + LK, wave, lane0);
    for (int m = 0; m < RG; ++m) {
        const unsigned kb = (m & 1) ? (unsigned)(LK2 - LK) : 0u, vbuf = (!FULL && (m & 1)) ? (unsigned)(LQ - LV) : 0u;
        asm volatile("s_waitcnt vmcnt(0)" ::: "memory");
        __syncthreads();
        asm volatile("" : "+v"(vb0_), "+v"(kt0_), "+v"(lane_));
        const unsigned vb0 = vb0_ + vbuf, vb1 = vb0 ^ 16u, kt0 = kt0_ + kb, kt1 = kt0 ^ 16u; const int lane = (int)lane_, hh = lane >> 5, c32 = lane & 31, i16 = lane & 15;
        if (m + 1 < RG) { stage_tile(Kg + (size_t)(m + 1) * (64 * 2048), 2048, lds0 + LK + ((m & 1) ? 0u : (unsigned)(LK2 - LK)), wave, lane);
            if constexpr (!FULL) stage_tile(Vg + (size_t)(m + 1) * (64 * 4096), 4096, lds0 + ((m & 1) ? (unsigned)LV : (unsigned)LQ), wave, lane); }
        bf16x8 vf[4];
        if constexpr (FULL) {
            {
                const int itile = wave >> 1, jt0 = 2 * (wave & 1), qq = lane >> 4;
                const int fS = ((i16 & 3) << 2) | ((i16 >> 2) & 3);
                const unsigned qa = lds0 + LQ + (unsigned)(512 * (16 * itile + i16)) + 16u * (unsigned)(qq ^ fS), ka = lds0 + LK + kb + (unsigned)(512 * (16 * jt0 + i16)) + 16u * (unsigned)(qq ^ fS);
                f32x4 s0 = {0.f, 0.f, 0.f, 0.f}, s1 = {0.f, 0.f, 0.f, 0.f};
#pragma unroll
                for (int s = 0; s < 8; ++s) { const bf16x8 qf = lds128(qa ^ (unsigned)(64 * s)), k0 = lds128(ka ^ (unsigned)(64 * s)), k1 = lds128((ka ^ (unsigned)(64 * s)) + 8192);
                    s0 = __builtin_amdgcn_mfma_f32_16x16x32_bf16(k0, qf, s0, 0, 0, 0); s1 = __builtin_amdgcn_mfma_f32_16x16x32_bf16(k1, qf, s1, 0, 0, 0);
                    if ((s & 3) == 3) asm volatile("" ::: "memory"); }
                const int irow = 16 * itile + i16;
#pragma unroll
                for (int tt = 0; tt < 2; ++tt) { const f32x4 sv = tt ? s1 : s0; const int jb = 16 * (jt0 + tt) + 4 * qq; float e[4];
#pragma unroll
                    for (int r = 0; r < 4; ++r) { const int dj = irow - (jb + r); e[r] = sv[r] * pw[dj < 0 ? -dj : dj]; }
                    u32x2 o; o.x = cvtpk(e[0], e[1]); o.y = cvtpk(e[2], e[3]);
                    *(RLAS u32x2*)(uintptr_t)(lds0 + LS + offS(irow, 2 * (jt0 + tt) + (qq >> 1)) + 8 * (qq & 1)) = o; }
            }
            load_vfrags(vf, vb0, vb1);
            f32x16 Y[2]; Y[0] = f32x16{}; Y[1] = f32x16{};
            const int fQ = ((c32 & 3) << 2) | ((c32 >> 2) & 3);
            const unsigned qr0 = lds0 + LQ + (unsigned)(512 * c32) + 16u * (unsigned)(hh ^ fQ);
#pragma unroll
            for (int dt = 0; dt < 8; ++dt)
#pragma unroll
                for (int s = 0; s < 2; ++s) { u32x4 pb; pb.x = cvtpk(X[dt][8 * s], X[dt][8 * s + 1]); pb.y = cvtpk(X[dt][8 * s + 2], X[dt][8 * s + 3]); pb.z = cvtpk(X[dt][8 * s + 4], X[dt][8 * s + 5]); pb.w = cvtpk(X[dt][8 * s + 6], X[dt][8 * s + 7]);
                    const bf16x8 bq = __builtin_bit_cast(bf16x8, pb); const unsigned a = qr0 ^ (unsigned)(16 * (4 * dt + 2 * s));
                    Y[0] = __builtin_amdgcn_mfma_f32_32x32x16_bf16(lds128(a), bq, Y[0], 0, 0, 0); Y[1] = __builtin_amdgcn_mfma_f32_32x32x16_bf16(lds128(a + 16384), bq, Y[1], 0, 0, 0);
                    if (s == 1 && (dt & 1)) asm volatile("" ::: "memory"); }
#pragma unroll
            for (int it = 0; it < 2; ++it)
#pragma unroll
                for (int rg = 0; rg < 4; ++rg) { const f32x4 f = *(const RLAS f32x4*)(pw + 80 + 32 * it + 8 * rg + 4 * hh);
                    Y[it][4 * rg] *= f[0] * cdm; Y[it][4 * rg + 1] *= f[1] * cdm; Y[it][4 * rg + 2] *= f[2] * cdm; Y[it][4 * rg + 3] *= f[3] * cdm; }
            asm volatile("s_waitcnt lgkmcnt(0)" ::: "memory"); __builtin_amdgcn_s_barrier(); asm volatile("" ::: "memory");
            if (m + 1 < RG) { stage_tile(Qg + (size_t)(m + 1) * (64 * 2048), 2048, lds0 + LQ, wave, lane); stage_tile(Vg + (size_t)(m + 1) * (64 * 4096), 4096, lds0 + LV, wave, lane); }
            const unsigned sr0 = lds0 + LS + (unsigned)(128 * c32) + 16u * (unsigned)(hh ^ ((c32 >> 1) & 7));
            const unsigned sr1 = lds0 + LS + (unsigned)(128 * (32 + c32)) + 16u * (unsigned)(hh ^ (((32 + c32) >> 1) & 7));
#pragma unroll
            for (int s = 0; s < 4; ++s) { Y[0] = __builtin_amdgcn_mfma_f32_32x32x16_bf16(lds128(sr0 ^ (unsigned)(32 * s)), vf[s], Y[0], 0, 0, 0);
                Y[1] = __builtin_amdgcn_mfma_f32_32x32x16_bf16(lds128(sr1 ^ (unsigned)(32 * s)), vf[s], Y[1], 0, 0, 0); }
            const size_t tokm = tok0 + (size_t)m * 64;
            RGAS char* yb = P.V + ((tokm * 2048 + (size_t)h * 512 + (size_t)half * 256 + (size_t)wave * 32) * 2);
#pragma unroll
            for (int it = 0; it < 2; ++it) {
#pragma unroll
                for (int r = 0; r < 16; ++r) { const float v = Y[it][r], vn = __shfl_xor(v, 1);
                    if ((c32 & 1) == 0) *(RGAS unsigned*)(yb + (unsigned)(32 * it + crow(r, hh)) * 4096u + (unsigned)c32 * 2u) = cvtpk(v, vn); }
                const bool b4 = (c32 & 16) != 0, b3 = (c32 & 8) != 0, b2 = (c32 & 4) != 0, b1 = (c32 & 2) != 0;
                float c1[8], c2[8], d1[4], d2[4], e1[2], e2[2];
#pragma unroll
                for (int k = 0; k < 8; ++k) { const float lo = Y[it][k], hi = Y[it][8 + k], lo2 = lo * lo, hi2 = hi * hi;
                    c1[k] = (b4 ? hi : lo) + __shfl_xor(b4 ? lo : hi, 16); c2[k] = (b4 ? hi2 : lo2) + __shfl_xor(b4 ? lo2 : hi2, 16); }
#pragma unroll
                for (int k = 0; k < 4; ++k) { d1[k] = (b3 ? c1[4 + k] : c1[k]) + __shfl_xor(b3 ? c1[k] : c1[4 + k], 8); d2[k] = (b3 ? c2[4 + k] : c2[k]) + __shfl_xor(b3 ? c2[k] : c2[4 + k], 8); }
#pragma unroll
                for (int k = 0; k < 2; ++k) { e1[k] = (b2 ? d1[2 + k] : d1[k]) + __shfl_xor(b2 ? d1[k] : d1[2 + k], 4); e2[k] = (b2 ? d2[2 + k] : d2[k]) + __shfl_xor(b2 ? d2[k] : d2[2 + k], 4); }
                float s1 = (b1 ? e1[1] : e1[0]) + __shfl_xor(b1 ? e1[0] : e1[1], 2), s2 = (b1 ? e2[1] : e2[0]) + __shfl_xor(b1 ? e2[0] : e2[1], 2);
                s1 += __shfl_xor(s1, 1); s2 += __shfl_xor(s2, 1);
                if ((c32 & 1) == 0) { typedef float f32x2 __attribute__((ext_vector_type(2))); f32x2 st; st.x = s1; st.y = s2; const int row = 32 * it + crow((c32 >> 1) & 15, hh);
                    *(RGAS f32x2*)(P.PST + (((tokm + row) * 4 + h) * 16 + half * 8 + wave) * 2) = st; }
            }
        } else {
            load_vfrags(vf, vb0, vb1);
        }
        update_state(X, vf, kt0, kt1, lds0, hh, cdim);
        cdm *= cd; cdim *= cdinv;
    }
    __syncthreads();
    if constexpr (!FULL) dump_state(X, P.L + (size_t)((bh * (NG - 1) + g) * 2 + half) * 131072, wave, lane0, cdm);
}
#undef RLAS
#undef RGAS
}
struct Args { const float* in[11]; float* out; unsigned char* wsp; int ph_lo, ph_hi, li, pad; };
struct Frame {
    LAS unsigned char* lds;
    volatile LAS unsigned* MISC;
    int tid, lane, wave;
    int vcu, G;
    const __attribute__((address_space(4))) Args* ap;
};
#define FP(i) (F.ap->in[i])
#define F_x FP(0)
#define F_norm_mix FP(1)
#define F_norm_ffn FP(2)
#define F_fox_w_in FP(3)
#define F_fox_b_f FP(4)
#define F_fox_w_out FP(5)
#define F_ret_w_in FP(6)
#define F_ret_w_out FP(7)
#define F_ffn_w_in FP(8)
#define F_ffn_w_out FP(9)
#define F_final_norm FP(10)
#define F_out (F.ap->out)
#define F_ws (F.ap->wsp)
__device__ __forceinline__ float wave_sum(float v) {
#pragma unroll
    for (int o = 1; o < 64; o <<= 1) v += __shfl_xor(v, o);
    return v;
}

__device__ __forceinline__ void p0_item(const float* W, int K, int Nsrc, int scol0, bf16* WT, int drow0, int k0, const float* g, LAS float* scr, int lane) {
    const int nq = lane & 7, kr = lane >> 3;
    f32x4 v[8];
#pragma unroll
    for (int i = 0; i < 8; ++i) v[i] = *(const GAS f32x4*)(W + (size_t)(k0 + kr + 8 * i) * Nsrc + scol0 + 4 * nq);
#pragma unroll
    for (int i = 0; i < 8; ++i) { const int kk = kr + 8 * i; const float gv = g ? g[k0 + kk] : 1.f; LAS float* d = scr + kk * 33 + 4 * nq;
        d[0] = v[i].x * gv; d[1] = v[i].y * gv; d[2] = v[i].z * gv; d[3] = v[i].w * gv; }
    LDS_WAIT(); asm volatile("" ::: "memory");
    const int c = lane & 7;
#pragma unroll
    for (int j = 0; j < 4; ++j) { const int n = (lane >> 3) + 8 * j; const LAS float* s = scr + (8 * c) * 33 + n;
        v4u o; o.x = pk2(s[0 * 33], s[1 * 33]); o.y = pk2(s[2 * 33], s[3 * 33]); o.z = pk2(s[4 * 33], s[5 * 33]); o.w = pk2(s[6 * 33], s[7 * 33]);
        *(GAS v4u*)(WT + (size_t)(drow0 + n) * K + k0 + 8 * c) = o; }
    LDS_WAIT(); asm volatile("" ::: "memory");
}
__device__ __forceinline__ void p0_matrix(int r, const float* W, int K, int N, int Nsrc, bool swiglu, bf16* WT, const float* g, LAS float* scr, int lane) {
    const int nblk = N / 32, kb = r / nblk, nb = r % nblk, drow0 = 32 * nb;
    int scol0 = drow0;
    if (swiglu) { const int t = drow0 >> 8, rr = drow0 & 255; scol0 = (rr < 128) ? t * 128 + rr : DFF + t * 128 + (rr - 128); }
    p0_item(W, K, Nsrc, scol0, WT, drow0, 64 * kb, g, scr, lane);
}
__device__ __forceinline__ void p0_xtile(Frame& F, int tile) {
    LAS float* wfs = (LAS float*)(F.lds);
    LAS float* tot = (LAS float*)(F.lds + 32768);
#pragma unroll
    for (int kk = 0; kk < 2; ++kk) { const int k = F.tid + 512 * kk; const float gk = F_norm_mix[k];
        const f32x4 w0 = *(const GAS f32x4*)(F_fox_w_in + (size_t)k * 3080 + 3072), w1 = *(const GAS f32x4*)(F_fox_w_in + (size_t)k * 3080 + 3076);
        wfs[k] = w0.x * gk; wfs[1024 + k] = w0.y * gk; wfs[2048 + k] = w0.z * gk; wfs[3072 + k] = w0.w * gk; wfs[4096 + k] = w1.x * gk; wfs[5120 + k] = w1.y * gk; wfs[6144 + k] = w1.z * gk; wfs[7168 + k] = w1.w * gk; }
    __syncthreads();
    const int myh = (F.lane >> 3) & 7;
    const float bfv = F_fox_b_f[myh];
    bf16* XB = (bf16*)(F_ws + WS_XB); float* SSQ = (float*)(F_ws + WS_SSQ);
    const int row0 = tile * 64 + F.wave * 8;
    const bool b5 = (F.lane & 32) != 0, b4 = (F.lane & 16) != 0, b3 = (F.lane & 8) != 0;
    float run = 0.f, mine[8];
    f32x4 v[4], vn[4];
    { const GAS f32x4* xr = (const GAS f32x4*)(F_x + (size_t)row0 * D) + F.lane;
#pragma unroll
      for (int j = 0; j < 4; ++j) vn[j] = xr[64 * j]; }
#pragma unroll
    for (int i = 0; i < 8; ++i) {
        const int row = row0 + i;
#pragma unroll
        for (int j = 0; j < 4; ++j) v[j] = vn[j];
        if (i < 7) { const GAS f32x4* xr = (const GAS f32x4*)(F_x + (size_t)(row + 1) * D) + F.lane;
#pragma unroll
            for (int j = 0; j < 4; ++j) vn[j] = xr[64 * j]; }
        float ss = 0.f;
#pragma unroll
        for (int j = 0; j < 4; ++j) ss += (v[j].x * v[j].x + v[j].y * v[j].y) + (v[j].z * v[j].z + v[j].w * v[j].w);
        GAS unsigned long long* o8 = (GAS unsigned long long*)(XB + (size_t)row * D) + F.lane;
#pragma unroll
        for (int j = 0; j < 4; ++j) o8[64 * j] = (unsigned long long)pk2(v[j].x, v[j].y) | ((unsigned long long)pk2(v[j].z, v[j].w) << 32);
        float a[8];
#pragma unroll
        for (int h = 0; h < 8; ++h) { float acc = 0.f;
#pragma unroll
            for (int j = 0; j < 4; ++j) { const f32x4 w = *(const LAS f32x4*)(wfs + h * 1024 + 4 * (F.lane + 64 * j)); acc += (v[j].x * w.x + v[j].y * w.y) + (v[j].z * w.z + v[j].w * w.w); }
            a[h] = acc; }
        ss = wave_sum(ss);
        float c[4], d[2];
#pragma unroll
        for (int k = 0; k < 4; ++k) c[k] = (b5 ? a[4 + k] : a[k]) + __shfl_xor(b5 ? a[k] : a[4 + k], 32);
#pragma unroll
        for (int k = 0; k < 2; ++k) d[k] = (b4 ? c[2 + k] : c[k]) + __shfl_xor(b4 ? c[k] : c[2 + k], 16);
        float e = (b3 ? d[1] : d[0]) + __shfl_xor(b3 ? d[0] : d[1], 8);
        e += __shfl_xor(e, 4); e += __shfl_xor(e, 2); e += __shfl_xor(e, 1);
        const float rstd = 1.0f / sqrtf(ss * (1.f / D) + EPS);
        if (F.lane < 16) SSQ[(size_t)row * 16 + F.lane] = (F.lane == 0) ? ss : 0.f;
        const float z = e * rstd + bfv; const float lf = fminf(z, 0.f) - log1pf(__expf(-fabsf(z)));
        run += lf; mine[i] = run;
    }
    if ((F.lane & 7) == 0) tot[F.wave * 8 + myh] = run;
    __syncthreads();
    float* LC = (float*)(F_ws + WS_LC); float* TT = (float*)(F_ws + WS_TT);
    if ((F.lane & 7) == 0) { float off = 0.f; for (int w = 0; w < F.wave; ++w) off += tot[w * 8 + myh];
#pragma unroll
        for (int i = 0; i < 8; ++i) LC[(size_t)(row0 + i) * 8 + myh] = mine[i] + off; }
    if (F.tid < 8) { float s = 0.f; for (int w = 0; w < 8; ++w) s += tot[w * 8 + F.tid]; TT[tile * 8 + F.tid] = s; }
    __syncthreads();
}
__device__ __forceinline__ void p0_prologue(Frame& F) {
    for (int t = (int)blockIdx.x; t < M / 64; t += F.G) p0_xtile(F, t);
    LAS float* scr = (LAS float*)(F.lds + RING_OFF + F.wave * 16384);
    const int gw = F.vcu * NWAVES + F.wave, NGW = F.G * NWAVES;
    constexpr int I0 = 16 * 96, I1 = 16 * 32, I2 = 16 * 176, I3 = 44 * 32, I4 = 16 * 192, I5 = 32 * 32;
    constexpr int NITEMS = I0 + I1 + I2 + I3 + I4 + I5;
    unsigned char* ws = F_ws;
    for (int it = gw; it < NITEMS; it += NGW) {
        int r = it;
        if (r < I0) { p0_matrix(r, F_fox_w_in, 1024, 3072, 3080, false, (bf16*)(ws + WS_WQKV0), F_norm_mix, scr, F.lane); continue; } r -= I0;
        if (r < I1) { p0_matrix(r, F_fox_w_out, 1024, 1024, 1024, false, (bf16*)(ws + WS_WO0), nullptr, scr, F.lane); continue; } r -= I1;
        if (r < I2) { p0_matrix(r, F_ffn_w_in, 1024, 2 * DFF, 2 * DFF, true, (bf16*)(ws + WS_WFI0), F_norm_ffn, scr, F.lane); continue; } r -= I2;
        if (r < I3) { p0_matrix(r, F_ffn_w_out, DFF, 1024, 1024, false, (bf16*)(ws + WS_WFO0), nullptr, scr, F.lane); continue; } r -= I3;
        if (r < I4) { p0_matrix(r, F_ret_w_in, 1024, 6144, 6144, false, (bf16*)(ws + WS_WRI), F_norm_mix + D, scr, F.lane); continue; } r -= I4;
        p0_matrix(r, F_ret_w_out, 2048, 1024, 1024, false, (bf16*)(ws + WS_WRO), nullptr, scr, F.lane);
    }
    float* rope = (float*)(ws + WS_ROPE);
    {
        const int idx0 = F.vcu * (NWAVES * 64) + F.tid;
        const float inv = (float)exp2(-(double)(idx0 & 127) * (13.287712379549449 / 128.0));
        for (int idx = idx0; idx < SEQ * 128; idx += F.G * NWAVES * 64) {
            const float ang = (float)(idx >> 7) * inv;
            const double t = (double)ang * 0.15915494309189535; const float fr = (float)(t - rint(t));
            f32x2 cs; cs.x = __builtin_amdgcn_cosf(fr); cs.y = __builtin_amdgcn_sinf(fr);
            *(f32x2*)(rope + (size_t)idx * 2) = cs;
        }
    }
}

__device__ __forceinline__ void p0_late_weights(Frame& F, int first) {
    const int nwg = F.G - first; if ((int)blockIdx.x < first || nwg <= 0) return;
    LAS float* scr = (LAS float*)(F.lds + RING_OFF + F.wave * 16384);
    const int gw = ((int)blockIdx.x - first) * NWAVES + F.wave, NGW = nwg * NWAVES;
    constexpr int I6 = 16 * 176, I7 = 44 * 32;
    unsigned char* ws = F_ws;
    for (int it = gw; it < I6 + I7; it += NGW) {
        if (it < I6) p0_matrix(it, F_ffn_w_in + (size_t)D * 2 * DFF, 1024, 2 * DFF, 2 * DFF, true, (bf16*)(ws + WS_WFI1), F_norm_ffn + D, scr, F.lane);
        else p0_matrix(it - I6, F_ffn_w_out + (size_t)DFF * D, DFF, 1024, 1024, false, (bf16*)(ws + WS_WFO1), nullptr, scr, F.lane);
    }
}

__device__ __forceinline__ void fill_rstd_tab(Frame& F, const pg8::StaticOrder& S) {
    LAS float* tab = (LAS float*)(F.lds + TAB_OFF); const float* SSQ = (const float*)(F_ws + WS_SSQ);
    pg8::Unit u;
    for (int i = 0; i < 8 && S.next(i, u); ++i) if (F.tid < 256) {
        const f32x4* p = (const f32x4*)(SSQ + (size_t)(u.pm * 256 + F.tid) * 16); const f32x4 a = p[0], b = p[1], c = p[2], d = p[3];
        const float s = ((a.x + a.y) + (a.z + a.w)) + ((b.x + b.y) + (b.z + b.w)) + ((c.x + c.y) + (c.z + c.w)) + ((d.x + d.y) + (d.z + d.w));
        tab[i * 256 + F.tid] = 1.0f / sqrtf(s * (1.f / D) + EPS); }
    __syncthreads();
}
__device__ __forceinline__ void fill_gate_tab(Frame& F, const pg8::StaticOrder& S) {
    LAS f32x2* stab = (LAS f32x2*)(F.lds + STAB_OFF); const float* PST = (const float*)(F_ws + WS_PST);
    pg8::Unit u;
    for (int i = 0; i < 2 && S.next(i, u); ++i) if (F.tid < 256) {
        const f32x4* p = (const f32x4*)(PST + ((size_t)(u.pm * 256 + F.tid) * 4 + (u.pn >> 1)) * 32); float s = 0.f, q = 0.f;
#pragma unroll
        for (int j = 0; j < 8; ++j) { const f32x4 v = p[j]; s += v.x + v.z; q += v.y + v.w; }
        const float mu = s * (1.f / RDV), var = fmaxf(q * (1.f / RDV) - mu * mu, 0.f);
        f32x2 st; st.x = mu; st.y = 1.0f / sqrtf(var + EPS); stab[i * 256 + F.tid] = st; }
    __syncthreads();
}


__device__ __forceinline__ void cbg_phase(Frame& F) {
    const float* LC = (const float*)(F_ws + WS_LC); const float* TT = (const float*)(F_ws + WS_TT); float* CBG = (float*)(F_ws + WS_CBG);
    LAS float* pre = (LAS float*)(F.lds);
    for (int item = (int)blockIdx.x; item < 16 * 16; item += F.G) {
        const int bh = item >> 4, seg = item & 15, b = bh >> 3, h = bh & 7, s = seg * 512 + F.tid;
        __syncthreads();
        if (F.tid < 128) pre[F.tid] = TT[(b * 128 + F.tid) * 8 + h];
        __syncthreads();
        if (F.tid == 0) { float p = 0.f; for (int t = 0; t < 128; ++t) { const float v = pre[t]; pre[t] = p; p += v; } }
        __syncthreads();
        CBG[(size_t)bh * SEQ + s] = -(pre[s >> 6] + LC[(size_t)(b * SEQ + s) * 8 + h]) * LOG2E;
    }
    __syncthreads();
}
__device__ __forceinline__ fa::BlockRef fa_ref(Frame& F, int bh, int qb, int kb0, float Bq) {
    const int b = bh >> 3, h = bh & 7; fa::BlockRef r; r.base = (GAS char*)F_ws;
    const unsigned ro = (unsigned)(((b * SEQ + qb * 256) * 1024 + h * 128) * 2), ho = (unsigned)((b * SEQ * 1024 + h * 128) * 2);
    r.qo = (unsigned)WS_Q0 + ro; r.oo = (unsigned)WS_O0 + ro; r.ko = (unsigned)WS_K0 + ho; r.vo = (unsigned)WS_V0 + ho;
    r.cbo = (unsigned)WS_CBG + (unsigned)(bh * SEQ * 4); r.P0 = qb * 256; r.kb0 = kb0; r.Bq = Bq; return r;
}
constexpr float SKIP_LOG2 = 148.f;
constexpr int ATT_LDS_DESC = 133632 + 64;
__device__ __forceinline__ void fa_describe(Frame& F, int n, int xq, LAS float* kmax2, LAS int* desc) {
    const int bh = (n & 1) ? 8 + ((xq + 4) & 7) : xq, qb = 31 - (n >> 1), b = bh >> 3, h = bh & 7;
    const float* nq = (const float*)(F_ws + WS_NRM) + ((size_t)(b * 32 + qb) * 8 + h) * 8;
    float q2 = 0.f;
#pragma unroll
    for (int wc = 0; wc < 4; ++wc) q2 += fmaxf(nq[2 * wc], nq[2 * wc + 1]);
    const float B = sqrtf(q2 * kmax2[bh]) * 1.01f, th = 2.f * B + SKIP_LOG2;
    const float* cb = (const float*)(F_ws + WS_CBG) + (size_t)bh * SEQ;
    const float cbi = cb[qb * 256];
    const float c0 = cb[64 * F.lane + 63], c1 = cb[64 * (F.lane + 64) + 63];
    const unsigned long long m0 = __ballot(cbi - c0 <= th), m1 = __ballot(cbi - c1 <= th);
    int t = m0 ? (int)__builtin_ctzll(m0) : (m1 ? 64 + (int)__builtin_ctzll(m1) : 4 * qb);
    if (t > 4 * qb) t = 4 * qb;
    if (F.lane == 0) { desc[0] = bh; desc[1] = qb; desc[2] = 64 * t; desc[5] = (int)__float_as_uint(B); }
}
__device__ __forceinline__ void attn_fast_phase(Frame& F, char* shm) {
    LAS float* kmax2 = (LAS float*)(F.lds + ATT_LDS_DESC); LAS int* desc = (LAS int*)(F.lds + ATT_LDS_DESC + 64);
    const int total = 64, xq = (int)blockIdx.x & 7;
    __syncthreads();
    if (F.tid < 64) { const int bh = F.tid >> 2, wc = F.tid & 3, b = bh >> 3, h = bh & 7; const float* nk = (const float*)(F_ws + WS_NRM) + (size_t)64 * 64;
        float m = 0.f; for (int pm = 0; pm < 32; ++pm) { const float* p = nk + (((size_t)(b * 32 + pm) * 8 + h) * 4 + wc) * 2; m = fmaxf(m, fmaxf(p[0], p[1])); }
        m += __shfl_xor(m, 1); m += __shfl_xor(m, 2); if (wc == 0) kmax2[bh] = m; }
    __syncthreads();
    gu32* ctr0 = (gu32*)(F_ws + WS_CTL) + CW_ATT;
    int n = (int)blockIdx.x >> 3, qsel = xq;
    while (n < total) {
        if (F.wave == 0) fa_describe(F, n, qsel, kmax2, desc);
        __syncthreads();
        const fa::BlockRef cur = fa_ref(F, __builtin_amdgcn_readfirstlane(desc[0]), __builtin_amdgcn_readfirstlane(desc[1]), __builtin_amdgcn_readfirstlane(desc[2]), __uint_as_float((unsigned)__builtin_amdgcn_readfirstlane(desc[5])));
        fa::fa_block(cur, shm, F.tid);
        if (F.wave == 0) { int nn = total, qs = xq;
            for (int k = 0; k < 8; ++k) { const int q = (xq + k) & 7; int v = 0;
                if (F.lane == 0) v = (((int)F.G + 7 - q) >> 3) + (int)__hip_atomic_fetch_add(ctr0 + 64 * q, 1u, __ATOMIC_RELAXED, __HIP_MEMORY_SCOPE_AGENT);
                v = __builtin_amdgcn_readfirstlane(v); if (v < total) { nn = v; qs = q; break; } }
            if (F.lane == 0) { desc[3] = nn; desc[4] = qs; } }
        __syncthreads();
        n = __builtin_amdgcn_readfirstlane(desc[3]); qsel = __builtin_amdgcn_readfirstlane(desc[4]);
    }
}

__device__ __forceinline__ void attn_ref_phase(Frame& F) {
    const bf16* Q = (const bf16*)(F_ws + WS_Q0); const bf16* K = (const bf16*)(F_ws + WS_K0); const bf16* V = (const bf16*)(F_ws + WS_V0); bf16* O = (bf16*)(F_ws + WS_O0);
    const float* LC = (const float*)(F_ws + WS_LC); const float* TT = (const float*)(F_ws + WS_TT);
    LAS float* Ks = (LAS float*)(F.lds); LAS float* Vs = (LAS float*)(F.lds + 32768); LAS float* cbs = (LAS float*)(F.lds + 65536); LAS float* Pp = (LAS float*)(F.lds + 65536 + 256);
    const int r = F.tid >> 3, part = F.tid & 7;
    const int NU = BATCH * FH * (SEQ / 64);
    for (int unit = (int)blockIdx.x; unit < NU; unit += F.G) {
        const int bh = unit & 15, qb = unit >> 4, b = bh >> 3, h = bh & 7, q0 = qb * 64;
        __syncthreads();
        if (F.tid == 0) { float s = 0.f; for (int t = 0; t < 32; ++t) { Pp[t] = s; s += TT[(b * 32 + t) * 8 + h]; } }
        float q[16], o[16]; float m = -1e30f, l = 0.f;
        { const bf16* qp = Q + (size_t)(b * SEQ + q0 + r) * D + h * FDH + part * 16; const v4u a = *(const v4u*)qp, c = *(const v4u*)(qp + 8);
          q[0] = pg8::bf_lo(a.x); q[1] = pg8::bf_hi(a.x); q[2] = pg8::bf_lo(a.y); q[3] = pg8::bf_hi(a.y); q[4] = pg8::bf_lo(a.z); q[5] = pg8::bf_hi(a.z); q[6] = pg8::bf_lo(a.w); q[7] = pg8::bf_hi(a.w);
          q[8] = pg8::bf_lo(c.x); q[9] = pg8::bf_hi(c.x); q[10] = pg8::bf_lo(c.y); q[11] = pg8::bf_hi(c.y); q[12] = pg8::bf_lo(c.z); q[13] = pg8::bf_hi(c.z); q[14] = pg8::bf_lo(c.w); q[15] = pg8::bf_hi(c.w); }
#pragma unroll
        for (int d = 0; d < 16; ++d) o[d] = 0.f;
        for (int kt = 0; kt <= qb; ++kt) {
            __syncthreads();
            { const size_t go = (size_t)(b * SEQ + kt * 64 + r) * D + h * FDH + part * 16;
              const v4u a = *(const v4u*)(K + go), c = *(const v4u*)(K + go + 8), e = *(const v4u*)(V + go), f = *(const v4u*)(V + go + 8);
              LAS float* kd = Ks + r * 128 + part * 16; LAS float* vd = Vs + r * 128 + part * 16;
              kd[0] = pg8::bf_lo(a.x); kd[1] = pg8::bf_hi(a.x); kd[2] = pg8::bf_lo(a.y); kd[3] = pg8::bf_hi(a.y); kd[4] = pg8::bf_lo(a.z); kd[5] = pg8::bf_hi(a.z); kd[6] = pg8::bf_lo(a.w); kd[7] = pg8::bf_hi(a.w);
              kd[8] = pg8::bf_lo(c.x); kd[9] = pg8::bf_hi(c.x); kd[10] = pg8::bf_lo(c.y); kd[11] = pg8::bf_hi(c.y); kd[12] = pg8::bf_lo(c.z); kd[13] = pg8::bf_hi(c.z); kd[14] = pg8::bf_lo(c.w); kd[15] = pg8::bf_hi(c.w);
              vd[0] = pg8::bf_lo(e.x); vd[1] = pg8::bf_hi(e.x); vd[2] = pg8::bf_lo(e.y); vd[3] = pg8::bf_hi(e.y); vd[4] = pg8::bf_lo(e.z); vd[5] = pg8::bf_hi(e.z); vd[6] = pg8::bf_lo(e.w); vd[7] = pg8::bf_hi(e.w);
              vd[8] = pg8::bf_lo(f.x); vd[9] = pg8::bf_hi(f.x); vd[10] = pg8::bf_lo(f.y); vd[11] = pg8::bf_hi(f.y); vd[12] = pg8::bf_lo(f.z); vd[13] = pg8::bf_hi(f.z); vd[14] = pg8::bf_lo(f.w); vd[15] = pg8::bf_hi(f.w); }
            if (F.tid < 64) { const int key = kt * 64 + F.tid; cbs[F.tid] = ((const float*)(F_ws + WS_CBG))[(size_t)bh * SEQ + key]; }
            __syncthreads();
            const int jmax = (kt == qb) ? r : 63;
            for (int j = 0; j <= jmax; ++j) {
                const LAS float* kr = Ks + j * 128 + part * 16; float dot = 0.f;
#pragma unroll
                for (int d = 0; d < 16; ++d) dot += q[d] * kr[d];
                dot += __shfl_xor(dot, 1); dot += __shfl_xor(dot, 2); dot += __shfl_xor(dot, 4);
                const float s = dot + cbs[j], mn = fmaxf(m, s), al = __builtin_amdgcn_exp2f(m - mn), p = __builtin_amdgcn_exp2f(s - mn);
                l = l * al + p; m = mn;
                const LAS float* vr = Vs + j * 128 + part * 16;
#pragma unroll
                for (int d = 0; d < 16; ++d) o[d] = o[d] * al + p * vr[d];
            }
        }
        const float il = 1.0f / l;
        v4u w0, w1; w0.x = pk2(o[0] * il, o[1] * il); w0.y = pk2(o[2] * il, o[3] * il); w0.z = pk2(o[4] * il, o[5] * il); w0.w = pk2(o[6] * il, o[7] * il);
        w1.x = pk2(o[8] * il, o[9] * il); w1.y = pk2(o[10] * il, o[11] * il); w1.z = pk2(o[12] * il, o[13] * il); w1.w = pk2(o[14] * il, o[15] * il);
        bf16* op = O + (size_t)(b * SEQ + q0 + r) * D + h * FDH + part * 16; *(v4u*)op = w0; *(v4u*)(op + 8) = w1;
    }
    __syncthreads();
}

__device__ __forceinline__ void ret_ref_phase(Frame& F) {
    const bf16* Q1 = (const bf16*)(F_ws + WS_Q1); const bf16* K1 = (const bf16*)(F_ws + WS_K1); bf16* V1 = (bf16*)(F_ws + WS_V1); float* PST = (float*)(F_ws + WS_PST);
    LAS bf16* Qs = (LAS bf16*)(F.lds); LAS bf16* Ks = (LAS bf16*)(F.lds + 32768); LAS float* Sm = (LAS float*)(F.lds + 65536); LAS float* St = (LAS float*)(F.lds + 81920);
    LAS float* Vs = (LAS float*)(F.lds + 114688); LAS float* pw = (LAS float*)(F.lds + 122880);
    for (int unit = (int)blockIdx.x; unit < BATCH * RH * 16; unit += F.G) {
        const int b = unit >> 6, h = (unit >> 4) & 3, vs = unit & 15, v0 = vs * 32;
        const float lg = logf(1.0f - exp2f(-5.0f - (float)h));
        __syncthreads();
        for (int i = F.tid; i < 256 * 32; i += NWAVES * 64) St[i] = 0.f;
        if (F.tid <= 64) pw[F.tid] = expf(lg * (float)F.tid);
        for (int n = 0; n < NCH; ++n) {
            const size_t t0 = (size_t)b * SEQ + (size_t)n * CH;
            __syncthreads();
#pragma unroll
            for (int i = 0; i < 4; ++i) { const int p = F.tid + 512 * i, row = p >> 5, c = p & 31;
                *(LAS v4u*)(Qs + row * 256 + c * 8) = *(const v4u*)(Q1 + (t0 + row) * 1024 + h * 256 + c * 8);
                *(LAS v4u*)(Ks + row * 256 + c * 8) = *(const v4u*)(K1 + (t0 + row) * 1024 + h * 256 + c * 8); }
            { const int idx = F.tid * 4, row = idx >> 5, c = idx & 31; const unsigned long long vv = *(const unsigned long long*)(V1 + (t0 + row) * 2048 + h * 512 + v0 + c);
              const unsigned lo = (unsigned)vv, hi = (unsigned)(vv >> 32); LAS float* d = Vs + row * 32 + c; d[0] = pg8::bf_lo(lo); d[1] = pg8::bf_hi(lo); d[2] = pg8::bf_lo(hi); d[3] = pg8::bf_hi(hi); }
            __syncthreads();
            {
                const int i = F.tid >> 3, j0 = (F.tid & 7) * 8; float a[8];
#pragma unroll
                for (int jj = 0; jj < 8; ++jj) a[jj] = 0.f;
                for (int d = 0; d < 256; d += 2) { const unsigned qw = *(const LAS unsigned*)(Qs + i * 256 + d); const float qa = pg8::bf_lo(qw), qb = pg8::bf_hi(qw);
#pragma unroll
                    for (int jj = 0; jj < 8; ++jj) { const unsigned kw = *(const LAS unsigned*)(Ks + (j0 + jj) * 256 + d); a[jj] += qa * pg8::bf_lo(kw) + qb * pg8::bf_hi(kw); } }
#pragma unroll
                for (int jj = 0; jj < 8; ++jj) { const int dj = i - (j0 + jj); Sm[i * 64 + j0 + jj] = a[jj] * pw[dj < 0 ? -dj : dj]; }
            }
            __syncthreads();
            {
                const int i = F.tid >> 3, vv0 = (F.tid & 7) * 4; float y[4] = {0.f, 0.f, 0.f, 0.f};
                for (int d = 0; d < 256; d += 2) { const unsigned qw = *(const LAS unsigned*)(Qs + i * 256 + d); const float qa = pg8::bf_lo(qw), qb = pg8::bf_hi(qw);
                    const f32x4 s0 = *(const LAS f32x4*)(St + d * 32 + vv0), s1 = *(const LAS f32x4*)(St + (d + 1) * 32 + vv0);
                    y[0] += qa * s0.x + qb * s1.x; y[1] += qa * s0.y + qb * s1.y; y[2] += qa * s0.z + qb * s1.z; y[3] += qa * s0.w + qb * s1.w; }
                const float qd = pw[i + 1];
#pragma unroll
                for (int e = 0; e < 4; ++e) y[e] *= qd;
                for (int j = 0; j < 64; ++j) { const float s = Sm[i * 64 + j]; const f32x4 vv = *(const LAS f32x4*)(Vs + j * 32 + vv0); y[0] += s * vv.x; y[1] += s * vv.y; y[2] += s * vv.z; y[3] += s * vv.w; }
                float ps = (y[0] + y[1]) + (y[2] + y[3]), pq = (y[0] * y[0] + y[1] * y[1]) + (y[2] * y[2] + y[3] * y[3]);
                ps += __shfl_xor(ps, 1); pq += __shfl_xor(pq, 1); ps += __shfl_xor(ps, 2); pq += __shfl_xor(pq, 2); ps += __shfl_xor(ps, 4); pq += __shfl_xor(pq, 4);
                if ((F.tid & 7) == 0) { f32x2 st; st.x = ps; st.y = pq; *(f32x2*)(PST + (((t0 + i) * 4 + h) * 16 + vs) * 2) = st; }
                *(unsigned long long*)(V1 + (t0 + i) * 2048 + h * 512 + v0 + vv0) = (unsigned long long)pk2(y[0], y[1]) | ((unsigned long long)pk2(y[2], y[3]) << 32);
            }
            __syncthreads();
            {
                const int d = F.tid >> 1, vv0 = (F.tid & 1) * 16; float a[16]; const float cd = pw[64];
#pragma unroll
                for (int e = 0; e < 16; ++e) a[e] = St[d * 32 + vv0 + e] * cd;
                for (int j = 0; j < 64; ++j) { const float kd = pg8::bf_lo((unsigned)Ks[j * 256 + d]) * pw[63 - j];
#pragma unroll
                    for (int e = 0; e < 16; e += 4) { const f32x4 vv = *(const LAS f32x4*)(Vs + j * 32 + vv0 + e); a[e] += kd * vv.x; a[e + 1] += kd * vv.y; a[e + 2] += kd * vv.z; a[e + 3] += kd * vv.w; } }
#pragma unroll
                for (int e = 0; e < 16; ++e) St[d * 32 + vv0 + e] = a[e];
            }
        }
    }
    __syncthreads();
}


__device__ __forceinline__ rtn::Ptrs rt_ptrs(Frame& F) {
    rtn::Ptrs P; GAS char* w = (GAS char*)F_ws;
    P.Q = w + WS_Q1; P.K = w + WS_K1; P.V = w + WS_V1; P.L = (GAS char*)F_out; P.PST = (GAS float*)(w + WS_PST); return P;
}
__device__ __forceinline__ void ret_pass1_phase(Frame& F) {
    const rtn::Ptrs P = rt_ptrs(F);
    { const int nit = 8 * (rtn::NG - 1) * 2; p0_late_weights(F, F.G > nit + 16 ? nit : 0); }
    for (int it = (int)blockIdx.x; it < 8 * (rtn::NG - 1) * 2; it += F.G) { const int half = it & 1, r = it >> 1, g = r % (rtn::NG - 1), bh = r / (rtn::NG - 1); rtn::run_item<false>(P, bh, half, g, 0u, F.wave); }
}
__device__ __forceinline__ void ret_pass2_phase(Frame& F) {
    const rtn::Ptrs P = rt_ptrs(F);
    for (int it = (int)blockIdx.x; it < 8 * rtn::NG * 2; it += F.G) { const int half = it & 1, r = it >> 1, g = r % rtn::NG, bh = r / rtn::NG; rtn::run_item<true>(P, bh, half, g, 0u, F.wave); }
}

__device__ __forceinline__ void final_norm_phase(Frame& F) {
    const float* SSQ = (const float*)(F_ws + WS_SSQ); const bf16* XB = (const bf16*)(F_ws + WS_XB);
    const int gw = F.vcu * NWAVES + F.wave, NGW = F.G * NWAVES;
    f32x4 gv[4];
#pragma unroll
    for (int j = 0; j < 4; ++j) gv[j] = ((const f32x4*)F_final_norm)[F.lane + 64 * j];
    for (int row = gw; row < M; row += NGW) {
        float s = (F.lane < 16) ? SSQ[(size_t)row * 16 + F.lane] : 0.f; s = wave_sum(s);
        const float rstd = 1.0f / sqrtf(s * (1.f / D) + EPS);
        const GAS unsigned long long* xr = (const GAS unsigned long long*)(XB + (size_t)row * D) + F.lane;
        GAS f32x4* orow = (GAS f32x4*)(F_out + (size_t)row * D) + F.lane;
#pragma unroll
        for (int j = 0; j < 4; ++j) { const unsigned long long w = xr[64 * j]; const unsigned lo = (unsigned)w, hi = (unsigned)(w >> 32); f32x4 v;
            v.x = pg8::bf_lo(lo); v.y = pg8::bf_hi(lo); v.z = pg8::bf_lo(hi); v.w = pg8::bf_hi(hi); orow[64 * j] = v * rstd * gv[j]; }
    }
}
#ifndef MK_N_LAUNCHES
#define MK_N_LAUNCHES 1
#endif
constexpr int N_LAUNCHES = MK_N_LAUNCHES;
#ifndef REP_PHASE
#define REP_PHASE -1
#endif
#define REPS(k) ((k) == REP_PHASE ? 2 : 1)
#ifndef FAST_ATTN
#define FAST_ATTN 0
#endif
#ifndef FAST_RET
#define FAST_RET 0
#endif
__device__ __forceinline__ bool relaunder(Frame& F) { int t = F.wave * 64 + hw_lane_id(); asm volatile("" : "+v"(t));     F.tid = t; F.lane = t & 63; F.wave = __builtin_amdgcn_readfirstlane(t >> 6); const __attribute__((address_space(4))) Args* a = F.ap; asm volatile("" : "+s"(a)); F.ap = a; return true; }
__global__ void __launch_bounds__(NWAVES * 64, 2) fox_ret_fwd(Args args) {
    extern __shared__ __attribute__((aligned(16))) unsigned char lds[];
    Frame F;
    F.lds = (LAS unsigned char*)lds;
    F.MISC = (volatile LAS unsigned*)(F.lds + MISC_OFF);
    F.tid = threadIdx.x; F.lane = F.tid & 63; F.wave = __builtin_amdgcn_readfirstlane(F.tid >> 6);
    F.G = gridDim.x; { const int bx = blockIdx.x; F.vcu = (F.G % 8 == 0) ? (bx % 8) * (F.G / 8) + bx / 8 : bx; }
    F.ap = (const __attribute__((address_space(4))) Args*)__builtin_amdgcn_kernarg_segment_ptr();
    for (int u = F.tid; u < (LDS_BYTES - LDSCTL_OFF) / 4; u += NWAVES * 64) ((LAS unsigned*)(F.lds + LDSCTL_OFF))[u] = 0u;
    __syncthreads();
    XcdBarrier bar; bar.bar = (unsigned*)(F_ws + WS_CTL) + CW_BAR; bar.x = 0; bar.st = nullptr;
    if (N_LAUNCHES == 1) bar = xcd_barrier_post((unsigned*)(F_ws + WS_CTL) + CW_BAR, F.MISC + 8);
#define GRID_BAR() do { if (N_LAUNCHES == 1) { xcd_barrier(bar); if (REP_PHASE == -2) xcd_barrier(bar); } } while (0)
    const int lo = F.ap->ph_lo, hi = F.ap->ph_hi;
#define IN(k) (lo <= (k) && (k) < hi && relaunder(F))
#define BOTH(k) (IN(k) && IN((k) + 1))
#define ws F_ws
#define XB ((pg8::bf16_t*)(F_ws + WS_XB))
#define SSQ ((float*)(F_ws + WS_SSQ))
    const LAS float* const tab = (const LAS float*)(F.lds + TAB_OFF);

#define RUN_PHASE(k, BODY) if (IN(k)) { BODY; if (REP_PHASE == (k)) { GRID_BAR(); relaunder(F); BODY; } if (BOTH(k)) GRID_BAR(); }
#define RUN_PHASE2(k, BODY, BODY2) if (IN(k)) { BODY; if (REP_PHASE == (k) || REP_PHASE == 100 + (k)) { GRID_BAR(); relaunder(F); BODY2; } if (BOTH(k)) GRID_BAR(); }
#define GEMM_PHASE(EPI, Aptr, Bptr, N_, K_, PRE, ...) do { \
        pg8::Gemm g{(const pg8::bf16_t*)(Aptr), (const pg8::bf16_t*)(Bptr), M, (N_), (K_)}; pg8::StaticOrder S; S.init(M, (N_), F.G, (int)blockIdx.x); \
        PRE; pg8::EPI E{__VA_ARGS__}; \
        pg8::gemm_phase<pg8::EPI, pg8::StaticOrder, true, true>(F.lds + RING_OFF, g, S, E, F.wave); } while (0)
    RUN_PHASE(0, p0_prologue(F))
    RUN_PHASE(1, GEMM_PHASE(EpiQKV0, XB, ws + WS_WQKV0, 3072, 1024, cbg_phase(F); fill_rstd_tab(F, S), (pg8::bf16_t*)(ws + WS_Q0), tab, QSCALE, (float*)(ws + WS_NRM)))
#if FAST_ATTN
    RUN_PHASE(2, attn_fast_phase(F, (char*)lds))
#else
    RUN_PHASE(2, attn_ref_phase(F))
#endif
    RUN_PHASE2(3, GEMM_PHASE(EpiRes, ws + WS_O0, ws + WS_WO0, 1024, 1024, (void)0, XB, SSQ), GEMM_PHASE(EpiRes, ws + WS_O0, ws + WS_WO0, 1024, 1024, (void)0, (pg8::bf16_t*)F_out, (float*)F_out + 8388608))
#if REP_PHASE == 104
    RUN_PHASE2(4, GEMM_PHASE(EpiSwiGLU, XB, ws + WS_WFI0, 2 * DFF, 1024, fill_rstd_tab(F, S), (pg8::bf16_t*)(ws + WS_HID), tab), GEMM_PHASE(EpiNull, XB, ws + WS_WFI0, 2 * DFF, 1024, (void)0, 0))
#else
    RUN_PHASE(4, GEMM_PHASE(EpiSwiGLU, XB, ws + WS_WFI0, 2 * DFF, 1024, fill_rstd_tab(F, S), (pg8::bf16_t*)(ws + WS_HID), tab))
#endif
#if REP_PHASE == 105
    RUN_PHASE2(5, GEMM_PHASE(EpiRes, ws + WS_HID, ws + WS_WFO0, 1024, DFF, (void)0, XB, SSQ), GEMM_PHASE(EpiNull, ws + WS_HID, ws + WS_WFO0, 1024, DFF, (void)0, 0))
#else
    RUN_PHASE2(5, GEMM_PHASE(EpiRes, ws + WS_HID, ws + WS_WFO0, 1024, DFF, (void)0, XB, SSQ), GEMM_PHASE(EpiRes, ws + WS_HID, ws + WS_WFO0, 1024, DFF, (void)0, (pg8::bf16_t*)F_out, (float*)F_out + 8388608))
#endif
    RUN_PHASE(6, GEMM_PHASE(EpiRet, XB, ws + WS_WRI, 4096, 1024, fill_rstd_tab(F, S), (pg8::bf16_t*)(ws + WS_Q1), (pg8::bf16_t*)(ws + WS_K1), (pg8::bf16_t*)(ws + WS_V1), (const float*)(ws + WS_ROPE), tab))
#if FAST_RET
    RUN_PHASE(7, ret_pass1_phase(F))
    RUN_PHASE(8, ret_pass2_phase(F))
#else
    RUN_PHASE(7, (void)0)
    RUN_PHASE(8, ret_ref_phase(F))
#endif
#if REP_PHASE == 109
    RUN_PHASE2(9, GEMM_PHASE(EpiGate, XB, (const pg8::bf16_t*)(ws + WS_WRI) + (size_t)4096 * 1024, 2048, 1024, fill_rstd_tab(F, S); fill_gate_tab(F, S), (pg8::bf16_t*)(ws + WS_V1), tab, (const LAS pg8::f32x2*)(F.lds + STAB_OFF)), GEMM_PHASE(EpiNull, XB, (const pg8::bf16_t*)(ws + WS_WRI) + (size_t)4096 * 1024, 2048, 1024, (void)0, 0))
#else
    RUN_PHASE(9, GEMM_PHASE(EpiGate, XB, (const pg8::bf16_t*)(ws + WS_WRI) + (size_t)4096 * 1024, 2048, 1024, fill_rstd_tab(F, S); fill_gate_tab(F, S), (pg8::bf16_t*)(ws + WS_V1), tab, (const LAS pg8::f32x2*)(F.lds + STAB_OFF)))
#endif
    RUN_PHASE2(10, GEMM_PHASE(EpiRes, ws + WS_V1, ws + WS_WRO, 1024, 2048, (void)0, XB, SSQ), GEMM_PHASE(EpiRes, ws + WS_V1, ws + WS_WRO, 1024, 2048, (void)0, (pg8::bf16_t*)F_out, (float*)F_out + 8388608))
    RUN_PHASE(11, GEMM_PHASE(EpiSwiGLU, XB, ws + WS_WFI1, 2 * DFF, 1024, fill_rstd_tab(F, S), (pg8::bf16_t*)(ws + WS_HID), tab))
    RUN_PHASE2(12, GEMM_PHASE(EpiRes, ws + WS_HID, ws + WS_WFO1, 1024, DFF, (void)0, XB, SSQ), GEMM_PHASE(EpiRes, ws + WS_HID, ws + WS_WFO1, 1024, DFF, (void)0, (pg8::bf16_t*)F_out, (float*)F_out + 8388608))
    if (IN(13)) final_norm_phase(F);
#undef RUN_PHASE
#undef RUN_PHASE2
#undef GEMM_PHASE
#undef IN
#undef ws
#undef XB
#undef SSQ
#undef BOTH
#undef GRID_BAR
}

extern "C" void kernel_launch(void* const* d_in, const int* in_sizes, int n_in, void* d_out, int out_size, void* d_ws, size_t ws_size, hipStream_t stream) {
    static int grid = 0;
    if (grid == 0) {
        if (n_in != 11 || in_sizes[0] != M * D || out_size != M * D || ws_size < WS_END) { fprintf(stderr, "kernel_launch: shape/workspace mismatch (n_in %d, in0 %d, out %d, ws %zu, need %zu)\n", n_in, n_in > 0 ? in_sizes[0] : -1, out_size, ws_size, (size_t)WS_END); grid = -1; return; }
        int dev = 0, cus = 0, per_cu = 0;
        if (hipGetDevice(&dev) != hipSuccess || hipDeviceGetAttribute(&cus, hipDeviceAttributeMultiprocessorCount, dev) != hipSuccess) { fprintf(stderr, "kernel_launch: device query failed\n"); grid = -1; return; }
        if (hipFuncSetAttribute((const void*)fox_ret_fwd, hipFuncAttributeMaxDynamicSharedMemorySize, LDS_BYTES) != hipSuccess) { fprintf(stderr, "kernel_launch: hipFuncSetAttribute failed\n"); grid = -1; return; }
        if (hipOccupancyMaxActiveBlocksPerMultiprocessor(&per_cu, (const void*)fox_ret_fwd, NWAVES * 64, LDS_BYTES) != hipSuccess || per_cu < 1) { fprintf(stderr, "kernel_launch: occupancy query reports %d workgroups per CU\n", per_cu); per_cu = 1; }
        (void)hipGetLastError();
        grid = cus;
        if (grid > 256) grid = 256;
    }
    if (grid < 0) return;
    if (hipMemsetAsync((char*)d_ws + WS_CTL, 0, CTL_ZERO_BYTES, stream) != hipSuccess) { fprintf(stderr, "kernel_launch: hipMemsetAsync failed\n"); return; }
    Args a{};
    for (int i = 0; i < 11; ++i) a.in[i] = (const float*)d_in[i];
    a.out = (float*)d_out; a.wsp = (unsigned char*)d_ws;
    for (int li = 0; li < N_LAUNCHES; ++li) {
        a.ph_lo = (N_LAUNCHES == 1) ? 0 : li; a.ph_hi = (N_LAUNCHES == 1) ? NPHASE : li + 1; a.li = li;
        hipLaunchKernelGGL(fox_ret_fwd, dim3(grid), dim3(NWAVES * 64), LDS_BYTES, stream, a);
        const hipError_t le = hipPeekAtLastError();
        if (le != hipSuccess) { fprintf(stderr, "kernel_launch: launch %d failed: %s\n", li, hipGetErrorName(le)); break; }
    }
}
```

```cpp
#define MK_N_LAUNCHES 1
#define FAST_ATTN 1
#define FAST_RET 1
#include <hip/hip_runtime.h>
#include <cstdio>
#include <cstdint>
#include <cmath>
__device__ __forceinline__ int hw_lane_id() { int l; asm volatile("v_mbcnt_lo_u32_b32 %0, -1, 0\n\tv_mbcnt_hi_u32_b32 %0, -1, %0" : "=v"(l)); return l; }
namespace pg8 {
#define PG8_LAS __attribute__((address_space(3)))
typedef unsigned short bf16_t;
typedef short bf16x8 __attribute__((ext_vector_type(8)));
typedef float f32x4 __attribute__((ext_vector_type(4)));
typedef unsigned u32x4 __attribute__((ext_vector_type(4)));
constexpr int BM = 256, BK = 64, HALF = 128, HTB = HALF * BK * 2  , STAGE_BYTES = 8 * HTB, NXCD = 8, WGM = 8;

__host__ __device__ __forceinline__ int lds_byte(int r, int c) { const int st = (r >> 4) * 2 + (c >> 5), rr = r & 15, cc = c & 31, ob = rr * 64 + cc * 2; return st * 1024 + (ob ^ (((ob >> 9) & 1) << 5)); }
__host__ __device__ __forceinline__ void stage_rc(int b, int& R, int& C) { const int st = b / 1024, sb = b % 1024, swz = sb ^ (((sb >> 9) & 1) << 5); R = (st >> 1) * 16 + swz / 64; C = (st & 1) * 32 + (swz % 64) / 2; }
__host__ __device__ __forceinline__ int perm32(int rho) { const int n = rho >> 4, i = rho & 15; return 8 * (i >> 2) + 4 * n + (i & 3); }

struct Unit { int pm, pn; };
struct Gemm { const bf16_t* A; const bf16_t* Bt; int M, N, K; };

struct StaticOrder {
    int nM, nN, nwg, G, c;
    __host__ __device__ void init(int M, int N, int G_, int c_) { nM = M / BM; nN = N / BM; nwg = nM * nN; G = G_; c = c_; }
    __host__ __device__ bool next(int i, Unit& u) const {
        const long L = (long)i * G + c; if (L >= nwg) return false;
        int wgid = (int)L; { const int q = nwg / NXCD, r = nwg % NXCD, xcd = wgid % NXCD, off = wgid / NXCD; wgid = (xcd < r ? xcd * (q + 1) : r * (q + 1) + (xcd - r) * q) + off; }
        const int nig = WGM * nN, gid = wgid / nig, fm = gid * WGM, gsz = (nM - fm) < WGM ? (nM - fm) : WGM;
        u.pm = fm + ((wgid % nig) % gsz); u.pn = (wgid % nig) / gsz; return true;
    }
    __device__ __forceinline__ void a_ready(const Unit&) const {}
    __device__ __forceinline__ void done(const Unit&) const {}
};

__device__ __forceinline__ unsigned cvt_pk_bf16(float lo, float hi) { unsigned r; asm volatile("v_cvt_pk_bf16_f32 %0, %1, %2" : "=v"(r) : "v"(lo), "v"(hi)); return r; }
typedef float f32x2 __attribute__((ext_vector_type(2)));
__device__ __forceinline__ float silu_f(float x) { return x * __builtin_amdgcn_rcpf(1.0f + __builtin_amdgcn_exp2f(-1.4426950408889634f * x)); }
__device__ __forceinline__ u32x4 pack8f(const f32x4 v0, const f32x4 v1) { u32x4 w; w.x = cvt_pk_bf16(v0[0], v0[1]); w.y = cvt_pk_bf16(v0[2], v0[3]); w.z = cvt_pk_bf16(v1[0], v1[1]); w.w = cvt_pk_bf16(v1[2], v1[3]); return w; }
__device__ __forceinline__ float bf_lo(unsigned w) { return __builtin_bit_cast(float, w << 16); }
__device__ __forceinline__ float bf_hi(unsigned w) { return __builtin_bit_cast(float, w & 0xffff0000u); }

struct EpiQKV0 {
    static constexpr bool PERM = true, AFTER_DRAIN = false;
    bf16_t* Q; const PG8_LAS float* tab; float qscale; float* nrm;
    __device__ __forceinline__ void operator()(const f32x4 (&acc)[2][2][4][2], const Unit& u, int ui, int wr, int wc, int fr, int fq) const {
        const int colt = u.pn * BM, t = colt >> 10; bf16_t* base = Q + (size_t)t * ((size_t)16384 * 1024);
        const int cb = (colt & 1023) + wc * 32 + 8 * fq; const float sc = t == 0 ? qscale : 1.f;
        float mx0 = 0.f, mx1 = 0.f;
#pragma unroll
        for (int ai = 0; ai < 2; ++ai)
#pragma unroll
            for (int m = 0; m < 4; ++m) { const int rl = ai * HALF + wr * 64 + m * 16 + fr; const float rs = tab[ui * 256 + rl] * sc;
                bf16_t* rowp = base + (size_t)(u.pm * BM + rl) * 1024 + cb;
#pragma unroll
                for (int bj = 0; bj < 2; ++bj) { const u32x4 w = pack8f(acc[ai][bj][m][0] * rs, acc[ai][bj][m][1] * rs); *(u32x4*)(rowp + bj * HALF) = w;
                    if (t < 2) { float q = (bf_lo(w.x) * bf_lo(w.x) + bf_hi(w.x) * bf_hi(w.x)) + (bf_lo(w.y) * bf_lo(w.y) + bf_hi(w.y) * bf_hi(w.y));
                        q += (bf_lo(w.z) * bf_lo(w.z) + bf_hi(w.z) * bf_hi(w.z)) + (bf_lo(w.w) * bf_lo(w.w) + bf_hi(w.w) * bf_hi(w.w));
                        q += __shfl_xor(q, 16); q += __shfl_xor(q, 32);
                        if (bj == 0) mx0 = fmaxf(mx0, q); else mx1 = fmaxf(mx1, q); } } }
        if (t < 2) {
#pragma unroll
            for (int o = 1; o < 16; o <<= 1) { mx0 = fmaxf(mx0, __shfl_xor(mx0, o)); mx1 = fmaxf(mx1, __shfl_xor(mx1, o)); }
            if (fr == 0 && fq == 0) { const int head = ((colt & 1023) >> 7); float* d = nrm + ((((size_t)t * 64 + u.pm) * 8 + head) * 4 + wc) * 2 + wr; d[0] = mx0; d[8] = mx1; }
        }
    }
};
struct EpiRes {
    static constexpr bool PERM = true, AFTER_DRAIN = false;
    bf16_t* xb; float* ssq;
    __device__ __forceinline__ void operator()(const f32x4 (&acc)[2][2][4][2], const Unit& u, int ui, int wr, int wc, int fr, int fq) const {
        const int col0 = u.pn * BM + wc * 32 + 8 * fq;
#pragma unroll
        for (int ai = 0; ai < 2; ++ai)
#pragma unroll
            for (int m = 0; m < 4; ++m) { const int row = u.pm * BM + ai * HALF + wr * 64 + m * 16 + fr; bf16_t* rowp = xb + (size_t)row * 1024 + col0; float s = 0.f;
#pragma unroll
                for (int bj = 0; bj < 2; ++bj) { const u32x4 b = *(const u32x4*)(rowp + bj * HALF); f32x4 o0, o1;
                    o0[0] = bf_lo(b.x); o0[1] = bf_hi(b.x); o0[2] = bf_lo(b.y); o0[3] = bf_hi(b.y); o1[0] = bf_lo(b.z); o1[1] = bf_hi(b.z); o1[2] = bf_lo(b.w); o1[3] = bf_hi(b.w);
                    o0 = o0 + acc[ai][bj][m][0]; o1 = o1 + acc[ai][bj][m][1];
                    s += ((o0[0] * o0[0] + o0[1] * o0[1]) + (o0[2] * o0[2] + o0[3] * o0[3])) + ((o1[0] * o1[0] + o1[1] * o1[1]) + (o1[2] * o1[2] + o1[3] * o1[3]));
                    *(u32x4*)(rowp + bj * HALF) = pack8f(o0, o1); }
                s += __shfl_xor(s, 16); s += __shfl_xor(s, 32);
                if (fq == 0) ssq[(size_t)row * 16 + u.pn * 4 + wc] = s; }
    }
};
struct EpiSwiGLU {
    static constexpr bool PERM = true, AFTER_DRAIN = false;
    bf16_t* Hd; const PG8_LAS float* tab;
    __device__ __forceinline__ void operator()(const f32x4 (&acc)[2][2][4][2], const Unit& u, int ui, int wr, int wc, int fr, int fq) const {
        const int hc0 = u.pn * HALF + wc * 32 + 8 * fq;
#pragma unroll
        for (int ai = 0; ai < 2; ++ai)
#pragma unroll
            for (int m = 0; m < 4; ++m) { const int rl = ai * HALF + wr * 64 + m * 16 + fr; const float rs = tab[ui * 256 + rl];
                f32x4 h0, h1;
#pragma unroll
                for (int e = 0; e < 4; ++e) { h0[e] = silu_f(acc[ai][0][m][0][e] * rs) * (acc[ai][1][m][0][e] * rs); h1[e] = silu_f(acc[ai][0][m][1][e] * rs) * (acc[ai][1][m][1][e] * rs); }
                *(u32x4*)(Hd + (size_t)(u.pm * BM + rl) * 2816 + hc0) = pack8f(h0, h1); }
    }
};
struct EpiRet {
    static constexpr bool PERM = true, AFTER_DRAIN = false;
    bf16_t* Q; bf16_t* Kp; bf16_t* V; const float* rope; const PG8_LAS float* tab;
    __device__ __forceinline__ void operator()(const f32x4 (&acc)[2][2][4][2], const Unit& u, int ui, int wr, int wc, int fr, int fq) const {
        if (u.pn < 8) {
            const bool isk = u.pn >= 4; const int head = u.pn & 3; bf16_t* dst = isk ? Kp : Q; const float sc = isk ? 0.0625f : 1.f; const int i0 = wc * 32 + 8 * fq;
#pragma unroll
            for (int ai = 0; ai < 2; ++ai)
#pragma unroll
                for (int m = 0; m < 4; ++m) { const int rl = ai * HALF + wr * 64 + m * 16 + fr, row = u.pm * BM + rl; const float rs = tab[ui * 256 + rl] * sc;
                    const f32x4* rp = (const f32x4*)(rope + ((size_t)(row & 8191) * 128 + i0) * 2);
                    f32x4 o1[2], o2[2];
#pragma unroll
                    for (int n = 0; n < 2; ++n) { const f32x4 t1 = acc[ai][0][m][n] * rs, t2 = acc[ai][1][m][n] * rs; const f32x4 ca = rp[2 * n], cb = rp[2 * n + 1];
                        o1[n][0] = t1[0] * ca[0] - t2[0] * ca[1]; o2[n][0] = t1[0] * ca[1] + t2[0] * ca[0];
                        o1[n][1] = t1[1] * ca[2] - t2[1] * ca[3]; o2[n][1] = t1[1] * ca[3] + t2[1] * ca[2];
                        o1[n][2] = t1[2] * cb[0] - t2[2] * cb[1]; o2[n][2] = t1[2] * cb[1] + t2[2] * cb[0];
                        o1[n][3] = t1[3] * cb[2] - t2[3] * cb[3]; o2[n][3] = t1[3] * cb[3] + t2[3] * cb[2]; }
                    bf16_t* rowp = dst + (size_t)row * 1024 + head * 256 + i0;
                    *(u32x4*)(rowp) = pack8f(o1[0], o1[1]); *(u32x4*)(rowp + HALF) = pack8f(o2[0], o2[1]);
                    if (m & 1) asm volatile("" ::: "memory"); }
        } else {
            const int cb = (u.pn - 8) * BM + wc * 32 + 8 * fq;
#pragma unroll
            for (int ai = 0; ai < 2; ++ai)
#pragma unroll
                for (int m = 0; m < 4; ++m) { const int rl = ai * HALF + wr * 64 + m * 16 + fr; const float rs = tab[ui * 256 + rl];
                    bf16_t* rowp = V + (size_t)(u.pm * BM + rl) * 2048 + cb;
#pragma unroll
                    for (int bj = 0; bj < 2; ++bj) *(u32x4*)(rowp + bj * HALF) = pack8f(acc[ai][bj][m][0] * rs, acc[ai][bj][m][1] * rs); }
        }
    }
};
struct EpiGate {
    static constexpr bool PERM = true, AFTER_DRAIN = false;
    bf16_t* Y; const PG8_LAS float* tab; const PG8_LAS f32x2* stab;
    __device__ __forceinline__ void operator()(const f32x4 (&acc)[2][2][4][2], const Unit& u, int ui, int wr, int wc, int fr, int fq) const {
        const int cb = u.pn * BM + wc * 32 + 8 * fq;
#pragma unroll
        for (int ai = 0; ai < 2; ++ai)
#pragma unroll
            for (int m = 0; m < 4; ++m) { const int rl = ai * HALF + wr * 64 + m * 16 + fr; const float rs = tab[ui * 256 + rl]; const f32x2 st = stab[ui * 256 + rl];
                bf16_t* rowp = Y + (size_t)(u.pm * BM + rl) * 2048 + cb;
#pragma unroll
                for (int bj = 0; bj < 2; ++bj) { const u32x4 yv = *(const u32x4*)(rowp + bj * HALF); f32x4 y0, y1;
                    y0[0] = bf_lo(yv.x); y0[1] = bf_hi(yv.x); y0[2] = bf_lo(yv.y); y0[3] = bf_hi(yv.y); y1[0] = bf_lo(yv.z); y1[1] = bf_hi(yv.z); y1[2] = bf_lo(yv.w); y1[3] = bf_hi(yv.w);
                    f32x4 g0 = acc[ai][bj][m][0] * rs, g1 = acc[ai][bj][m][1] * rs;
#pragma unroll
                    for (int e = 0; e < 4; ++e) { g0[e] = silu_f(g0[e]) * ((y0[e] - st.x) * st.y); g1[e] = silu_f(g1[e]) * ((y1[e] - st.x) * st.y); }
                    *(u32x4*)(rowp + bj * HALF) = pack8f(g0, g1); } }
    }
};
struct EpiNull {
    static constexpr bool PERM = true, AFTER_DRAIN = false;
    int dummy;
    __device__ __forceinline__ void operator()(const f32x4 (&acc)[2][2][4][2], const Unit& u, int ui, int wr, int wc, int fr, int fq) const {
#pragma unroll
        for (int ai = 0; ai < 2; ++ai)
#pragma unroll
            for (int bj = 0; bj < 2; ++bj)
#pragma unroll
                for (int m = 0; m < 4; ++m) { asm volatile("" :: "v"(acc[ai][bj][m][0]), "v"(acc[ai][bj][m][1])); }
    }
};
template <class Epi, class Sched, bool ALIGN_EPI = false, bool SP2 = false>
__device__ __forceinline__ void gemm_phase(PG8_LAS unsigned char* lds, const Gemm g, const Sched& S, const Epi& E, int wave_in) {
    int tid_ = wave_in * 64 + hw_lane_id(); asm volatile("" : "+v"(tid_));
    const int tid = tid_, wid = __builtin_amdgcn_readfirstlane(tid >> 6), lane = tid & 63, wr = wid >> 2, wc = wid & 3, fr = lane & 15, fq = lane >> 4;
    const int K = g.K, nt = K / BK;
    unsigned voffA[2], voffB[2];
#pragma unroll
    for (int i = 0; i < 2; ++i) { int R, C; stage_rc(tid * 16 + i * 8192, R, C); const int Rb = Epi::PERM ? ((R & ~31) + perm32(R & 31)) : R;
        voffA[i] = (unsigned)(R * K + C) * 2u; voffB[i] = (unsigned)(Rb * K + C) * 2u; }
    const size_t kstep = (size_t)(BK * 2);
    const size_t hstep = (size_t)HALF * K * 2;
    const size_t tstep = 2 * hstep;
    const unsigned ldsw = (unsigned)wid * 1024u;
    const int aoff = lds_byte(wr * 64 + fr, fq * 8), boff = lds_byte(wc * 32 + fr, fq * 8);
#define PG8_SA(b, h) (((b) * 2 + (h)) * HTB)
#define PG8_SB(b, h) ((4 + (b) * 2 + (h)) * HTB)
#define PG8_STAGE(bufoff, gbase, voff) do { _Pragma("unroll") for (int _i = 0; _i < 2; ++_i) \
        __builtin_amdgcn_global_load_lds((const unsigned*)((const char*)(gbase) + (voff)[_i]), (PG8_LAS unsigned*)(lds + (bufoff) + ldsw + _i * 8192), 16, 0, 0); } while (0)
#define PG8_LDA(dst, b, h) do { _Pragma("unroll") for (int m = 0; m < 4; ++m) _Pragma("unroll") for (int k = 0; k < 2; ++k) dst[m][k] = *(const PG8_LAS bf16x8*)(lds + PG8_SA(b, h) + aoff + m * 2048 + k * 1024); } while (0)
#define PG8_LDB(dst, b, h) do { _Pragma("unroll") for (int n = 0; n < 2; ++n) _Pragma("unroll") for (int k = 0; k < 2; ++k) dst[n][k] = *(const PG8_LAS bf16x8*)(lds + PG8_SB(b, h) + boff + n * 2048 + k * 1024); } while (0)
#define PG8_MMA(ai, bj, At, Bt) do { __builtin_amdgcn_s_setprio(1); _Pragma("unroll") for (int m = 0; m < 4; ++m) _Pragma("unroll") for (int n = 0; n < 2; ++n) _Pragma("unroll") for (int k = 0; k < 2; ++k) \
        acc[ai][bj][m][n] = __builtin_amdgcn_mfma_f32_16x16x32_bf16(Bt[n][k], At[m][k], acc[ai][bj][m][n], 0, 0, 0); __builtin_amdgcn_s_setprio(0); } while (0)
#define PG8_WAIT_V(n) asm volatile("s_waitcnt vmcnt(" #n ")" ::: "memory")
#define PG8_WAIT_L(n) asm volatile("s_waitcnt lgkmcnt(" #n ")" ::: "memory")
#define PG8_BAR __builtin_amdgcn_s_barrier()
#define PG8_SCHED __builtin_amdgcn_sched_barrier(0)
    Unit cur, nxt; int ui = 0;
    if (!S.next(0, cur)) return;
    f32x4 acc[2][2][4][2];
#pragma unroll
    for (int a = 0; a < 2; ++a)
#pragma unroll
        for (int b = 0; b < 2; ++b)
#pragma unroll
            for (int m = 0; m < 4; ++m)
#pragma unroll
                for (int n = 0; n < 2; ++n) acc[a][b][m][n] = (f32x4){0.f, 0.f, 0.f, 0.f};
    bf16x8 At[4][2], B0[2][2], B1[2][2];
    const char* cA = (const char*)g.A + (size_t)cur.pm * tstep; const char* cB = (const char*)g.Bt + (size_t)cur.pn * tstep;
    S.a_ready(cur);
    if constexpr (SP2) {
        PG8_STAGE(PG8_SB(0, 0), cB, voffB); PG8_STAGE(PG8_SB(0, 1), cB + hstep, voffB); PG8_STAGE(PG8_SA(0, 0), cA, voffA); PG8_STAGE(PG8_SA(0, 1), cA + hstep, voffA);
        if (wr == 1) PG8_BAR;
        PG8_WAIT_V(2); PG8_BAR;
        PG8_STAGE(PG8_SB(1, 0), cB + kstep, voffB); PG8_STAGE(PG8_SA(1, 0), cA + kstep, voffA); PG8_STAGE(PG8_SB(1, 1), cB + hstep + kstep, voffB);
        PG8_WAIT_V(6); PG8_BAR;
    } else {
        PG8_STAGE(PG8_SB(0, 0), cB, voffB); PG8_STAGE(PG8_SA(0, 0), cA, voffA); PG8_STAGE(PG8_SB(0, 1), cB + hstep, voffB); PG8_STAGE(PG8_SA(0, 1), cA + hstep, voffA);
        if (wr == 1) PG8_BAR;
        PG8_WAIT_V(4); PG8_BAR;
        PG8_STAGE(PG8_SB(1, 0), cB + kstep, voffB); PG8_STAGE(PG8_SA(1, 0), cA + kstep, voffA); PG8_STAGE(PG8_SB(1, 1), cB + hstep + kstep, voffB);
        PG8_WAIT_V(6); PG8_BAR;
    }
    for (;;) {
        const bool has_next = S.next(ui + 1, nxt);
        const char* nA = has_next ? (const char*)g.A + (size_t)nxt.pm * tstep : cA; const char* nB = has_next ? (const char*)g.Bt + (size_t)nxt.pn * tstep : cB;
        for (int t = 0; t < nt; t += 2) {
            const bool last = (t == nt - 2);
            const char* a1 = cA + (size_t)(t + 1) * kstep;
            const char* a2 = last ? nA : cA + (size_t)(t + 2) * kstep; const char* b2 = last ? nB : cB + (size_t)(t + 2) * kstep;
            const char* a3 = a2 + kstep; const char* b3 = b2 + kstep;
            if (last && has_next) S.a_ready(nxt);
            if constexpr (SP2) {
            PG8_LDB(B0, 0, 0); PG8_LDB(B1, 0, 1); PG8_SCHED; PG8_LDA(At, 0, 0); PG8_STAGE(PG8_SA(1, 1), a1 + hstep, voffA);
            PG8_WAIT_V(8); PG8_WAIT_L(0); PG8_BAR; PG8_MMA(0, 0, At, B0); PG8_MMA(0, 1, At, B1); PG8_BAR; PG8_SCHED;
            PG8_LDA(At, 0, 1); PG8_STAGE(PG8_SB(0, 0), b2, voffB); PG8_STAGE(PG8_SB(0, 1), b2 + hstep, voffB); PG8_STAGE(PG8_SA(0, 0), a2, voffA);
            PG8_WAIT_V(8); PG8_WAIT_L(0); PG8_BAR; PG8_MMA(1, 0, At, B0); PG8_MMA(1, 1, At, B1); PG8_BAR; PG8_SCHED;
            PG8_LDB(B0, 1, 0); PG8_LDB(B1, 1, 1); PG8_SCHED; PG8_LDA(At, 1, 0); PG8_STAGE(PG8_SA(0, 1), a2 + hstep, voffA);
            PG8_WAIT_V(8); PG8_WAIT_L(0); PG8_BAR; PG8_MMA(0, 0, At, B0); PG8_MMA(0, 1, At, B1); PG8_BAR; PG8_SCHED;
            PG8_LDA(At, 1, 1); PG8_STAGE(PG8_SB(1, 0), b3, voffB); PG8_STAGE(PG8_SB(1, 1), b3 + hstep, voffB); PG8_STAGE(PG8_SA(1, 0), a3, voffA);
            PG8_WAIT_V(8); PG8_WAIT_L(0); PG8_BAR; PG8_MMA(1, 0, At, B0); PG8_MMA(1, 1, At, B1); PG8_BAR; PG8_SCHED;
            } else {
            PG8_LDB(B0, 0, 0); PG8_SCHED; PG8_LDA(At, 0, 0); PG8_STAGE(PG8_SA(1, 1), a1 + hstep, voffA);
            PG8_WAIT_L(8); PG8_BAR; PG8_WAIT_L(0); PG8_MMA(0, 0, At, B0); PG8_BAR; PG8_SCHED;
            PG8_LDB(B1, 0, 1); PG8_STAGE(PG8_SB(0, 0), b2, voffB);
            PG8_BAR; PG8_WAIT_L(0); PG8_MMA(0, 1, At, B1); PG8_BAR;
            PG8_LDA(At, 0, 1); PG8_STAGE(PG8_SA(0, 0), a2, voffA);
            PG8_BAR; PG8_WAIT_L(0); PG8_MMA(1, 0, At, B0); PG8_BAR; PG8_SCHED;
            PG8_STAGE(PG8_SB(0, 1), b2 + hstep, voffB);
            PG8_WAIT_V(6); PG8_BAR; PG8_MMA(1, 1, At, B1); PG8_BAR;
            PG8_LDB(B0, 1, 0); PG8_SCHED; PG8_LDA(At, 1, 0); PG8_STAGE(PG8_SA(0, 1), a2 + hstep, voffA);
            PG8_WAIT_L(8); PG8_BAR; PG8_WAIT_L(0); PG8_MMA(0, 0, At, B0); PG8_BAR; PG8_SCHED;
            PG8_LDB(B1, 1, 1); PG8_STAGE(PG8_SB(1, 0), b3, voffB);
            PG8_BAR; PG8_WAIT_L(0); PG8_MMA(0, 1, At, B1); PG8_BAR;
            PG8_LDA(At, 1, 1); PG8_STAGE(PG8_SA(1, 0), a3, voffA);
            PG8_BAR; PG8_WAIT_L(0); PG8_MMA(1, 0, At, B0); PG8_BAR; PG8_SCHED;
            PG8_STAGE(PG8_SB(1, 1), b3 + hstep, voffB);
            PG8_WAIT_V(6); PG8_BAR; PG8_MMA(1, 1, At, B1); PG8_BAR;
            }
        }
        if constexpr (ALIGN_EPI) { if (wr == 0) PG8_BAR; }
        if constexpr (!Epi::AFTER_DRAIN) { E(acc, cur, ui, wr, wc, fr, fq); S.done(cur); }
        if (!has_next) break;
#pragma unroll
        for (int a = 0; a < 2; ++a)
#pragma unroll
            for (int b = 0; b < 2; ++b)
#pragma unroll
                for (int m = 0; m < 4; ++m)
#pragma unroll
                    for (int n = 0; n < 2; ++n) acc[a][b][m][n] = (f32x4){0.f, 0.f, 0.f, 0.f};
        cur = nxt; cA = nA; cB = nB; ++ui;
        if constexpr (ALIGN_EPI) { if (wr == 1) PG8_BAR; }
    }
    PG8_WAIT_V(0);
    if constexpr (!ALIGN_EPI) { if (wr == 0) PG8_BAR; }
    PG8_BAR;
    if constexpr (Epi::AFTER_DRAIN) { E.fused(acc, cur, wr, wc, fr, fq, lds, wid, lane); S.done(cur); }
#undef PG8_SA
#undef PG8_SB
#undef PG8_STAGE
#undef PG8_LDA
#undef PG8_LDB
#undef PG8_MMA
#undef PG8_WAIT_V
#undef PG8_WAIT_L
#undef PG8_BAR
#undef PG8_SCHED
}
}
constexpr int NWAVES = 8;
constexpr int BATCH = 2, SEQ = 8192, D = 1024, M = BATCH * SEQ;
constexpr int FH = 8, FDH = 128;
constexpr int RH = 4, RDK = 256, RDV = 512, CH = 64, NCH = SEQ / CH;
constexpr int DFF = 2816;
constexpr float EPS = 1e-6f;
constexpr float LOG2E = 1.4426950408889634f;
constexpr float QSCALE = 0.08838834764831845f * LOG2E;
constexpr int NPHASE = 14;

constexpr size_t MiB = 1u << 20;
constexpr size_t WS_CTL = 0, CTL_ZERO_BYTES = 32768;
constexpr size_t WS_SSQ = 1 * MiB;
constexpr size_t WS_LC = 2 * MiB;
constexpr size_t WS_TT = 2 * MiB + 512 * 1024;
constexpr size_t WS_NRM = 2 * MiB + 512 * 1024 + 16384;
constexpr size_t WS_ROPE = 3 * MiB;
constexpr size_t WS_WQKV0 = 11 * MiB;
constexpr size_t WS_WO0 = 17 * MiB;
constexpr size_t WS_WFI0 = 19 * MiB;
constexpr size_t WS_WFO0 = 30 * MiB;
constexpr size_t WS_WRI = 36 * MiB;
constexpr size_t WS_WRO = 48 * MiB;
constexpr size_t WS_WFI1 = 52 * MiB;
constexpr size_t WS_WFO1 = 63 * MiB;
constexpr size_t WS_XB = 69 * MiB;
constexpr size_t WS_ACT = 101 * MiB;
constexpr size_t WS_Q0 = WS_ACT, WS_K0 = WS_ACT + 32 * MiB, WS_V0 = WS_ACT + 64 * MiB;
constexpr size_t WS_O0 = WS_ACT + 96 * MiB;
constexpr size_t WS_HID = WS_ACT;
constexpr size_t WS_Q1 = WS_ACT, WS_K1 = WS_ACT + 32 * MiB, WS_V1 = WS_ACT + 64 * MiB;
constexpr size_t WS_PST = WS_ACT + 128 * MiB;
constexpr size_t WS_CBG = WS_PST;
constexpr size_t WS_LBUF = WS_WQKV0;
constexpr size_t WS_END = WS_PST + 8 * MiB;
static_assert(WS_WFO1 + (size_t)1024 * 2816 * 2 <= WS_XB && WS_HID + (size_t)M * DFF * 2 <= WS_PST && WS_END <= 256 * MiB, "d_ws map");
constexpr int CW_TMO = 0, CW_CODE = 1;
constexpr int CW_BAR = 4096;
constexpr int CW_ATT = 2048;

constexpr int RING_OFF = 0, RING_BYTES = 131072;
constexpr int LDSCTL_OFF = RING_BYTES, MISC_OFF = LDSCTL_OFF + 320;
constexpr int TAB_OFF = RING_BYTES + 512;
constexpr int STAB_OFF = TAB_OFF + 8192;
constexpr int LDS_BYTES = 147456;
static_assert(STAB_OFF + 4096 <= LDS_BYTES, "LDS map");
#define GAS __attribute__((address_space(1)))
#define LAS __attribute__((address_space(3)))
typedef unsigned short bf16;
typedef unsigned v4u __attribute__((ext_vector_type(4)));
typedef float f32x4 __attribute__((ext_vector_type(4)));
typedef short bf16x8 __attribute__((ext_vector_type(8)));
typedef GAS unsigned gu32;
typedef GAS unsigned long long gu64;
#define RLX_AGENT __ATOMIC_RELAXED, __HIP_MEMORY_SCOPE_AGENT
#define LDS_WAIT() asm volatile("s_waitcnt lgkmcnt(0)" ::: "memory")
#define VM_WAIT() asm volatile("s_waitcnt vmcnt(0)" ::: "memory")
__device__ __forceinline__ unsigned long long rt() { return __builtin_amdgcn_s_memrealtime(); }
__device__ __forceinline__ unsigned f2bf(float f) { unsigned u = __builtin_bit_cast(unsigned, f); return (u + 0x7fffu + ((u >> 16) & 1u)) >> 16; }
__device__ __forceinline__ unsigned pk2(float lo, float hi) { return f2bf(lo) | (f2bf(hi) << 16); }
typedef float f32x2 __attribute__((ext_vector_type(2)));
#define XB_TMO      128
#define XB_XCNT(j)  (256  + 64 * (j))
#define XB_XSUB(j)  (1280 + 64 * (j))
#define XB_XGEN(j)  (2304 + 64 * (j))
#define XB_TOP      3328
#define XB_TOPGEN   3392
#define XCD_BAR_WORDS 3456
#define XB_SPIN_CAP (1u << 18)

__device__ __forceinline__ unsigned xb_ld(unsigned* p)              { return __hip_atomic_load(p, __ATOMIC_RELAXED, __HIP_MEMORY_SCOPE_AGENT); }
__device__ __forceinline__ unsigned xb_add(unsigned* p, unsigned v) { return __hip_atomic_fetch_add(p, v, __ATOMIC_RELAXED, __HIP_MEMORY_SCOPE_AGENT); }
__device__ __forceinline__ unsigned xb_xcc_id() { return (unsigned)__builtin_amdgcn_s_getreg((3 << 11) | 20) & 0xFu; }
#define XB_SPIN(cond, bar) do { unsigned _sp = 0; while (cond) { __builtin_amdgcn_s_sleep(1); \
    if ((++_sp & 255u) == 0u) { if (xb_ld(&(bar)[XB_TMO])) break; if (_sp > XB_SPIN_CAP) { atomicAdd(&(bar)[XB_TMO], 1u); break; } } } } while (0)

struct XcdBarrier {
    unsigned* bar; unsigned x;
    volatile LAS unsigned* st;
};

__device__ __forceinline__ XcdBarrier xcd_barrier_post(unsigned* bar, volatile LAS unsigned* st) {
    XcdBarrier b; b.bar = bar; b.x = xb_xcc_id(); b.st = st;
    if (threadIdx.x == 0) (void)xb_add(&bar[XB_XCNT(b.x)], 1u);
    return b;
}
__device__ __forceinline__ void xcd_barrier_complete(unsigned* bar, unsigned x, unsigned& nloc, unsigned& nx) {
    const unsigned G = gridDim.x * gridDim.y * gridDim.z;
    unsigned sum, cnt, mine, sp = 0u;
    for (;;) {
        sum = 0u; cnt = 0u; mine = 0u;
#pragma unroll
        for (unsigned j = 0; j < 16; ++j) { const unsigned c = xb_ld(&bar[XB_XCNT(j)]); sum += c; cnt += (c > 0u) ? 1u : 0u; mine = (j == x) ? c : mine; }
        if (sum == G) break;
        __builtin_amdgcn_s_sleep(1);
        if ((++sp & 255u) == 0u) { if (xb_ld(&bar[XB_TMO])) break; if (sp > XB_SPIN_CAP) { atomicAdd(&bar[XB_TMO], 1u); break; } }
    }
    nloc = mine > 0u ? mine : 1u; nx = cnt > 0u ? cnt : 1u;
}

__device__ __forceinline__ void xcd_barrier(const XcdBarrier& b) {
    asm volatile("s_waitcnt vmcnt(0)" ::: "memory");
    __syncthreads();
    if (threadIdx.x == 0) {
        unsigned* bar = b.bar;
        __builtin_amdgcn_s_waitcnt(0);
        unsigned nloc = b.st[0], nx = b.st[1];
        if (nloc == 0u) { xcd_barrier_complete(bar, b.x, nloc, nx); b.st[0] = nloc; b.st[1] = nx; }
        const unsigned old = xb_add(&bar[XB_XSUB(b.x)], 1u);
        const unsigned gen = old / nloc;
        if (old + 1u == (gen + 1u) * nloc) {
            __builtin_amdgcn_fence(__ATOMIC_RELEASE, "agent");
            asm volatile("s_waitcnt vmcnt(0)" ::: "memory");
            const unsigned og = xb_add(&bar[XB_TOP], 1u);
            const unsigned tg = og / nx;
            if (og + 1u == (tg + 1u) * nx) xb_add(&bar[XB_TOPGEN], 1u);
            else XB_SPIN(xb_ld(&bar[XB_TOPGEN]) == tg, bar);
            __builtin_amdgcn_fence(__ATOMIC_ACQUIRE, "agent");
            xb_add(&bar[XB_XGEN(b.x)], 1u);
            asm volatile("s_waitcnt vmcnt(0)" ::: "memory");
        } else {
            XB_SPIN(xb_ld(&bar[XB_XGEN(b.x)]) == gen, bar);
            __builtin_amdgcn_fence(__ATOMIC_ACQUIRE, "agent");
            asm volatile("s_waitcnt vmcnt(0)" ::: "memory");
        }
    }
    __syncthreads();
}
namespace fa {
constexpr int D = 128, LDQ = 1024;
constexpr float THR = 8.f;
constexpr bool WSKIP = false;
constexpr int NW = 8, QBLK = 32, KVBLK = 64, QB = NW * QBLK;
constexpr int SHM_V = KVBLK * D * 2, SHM_K = KVBLK * D * 2;
constexpr int LDS_BYTES = 131072;
using bf16 = unsigned short;
typedef short bf16x8 __attribute__((ext_vector_type(8)));
typedef short s16x4 __attribute__((ext_vector_type(4)));
typedef float f32x16 __attribute__((ext_vector_type(16)));
typedef float f32x4 __attribute__((ext_vector_type(4)));
typedef unsigned u32x4 __attribute__((ext_vector_type(4)));
#define KSWZ(row, colB) ((row) * 256 + ((colB) ^ (((row) & 7) << 4)))
#define SBAR() __builtin_amdgcn_sched_barrier(0)
__device__ __forceinline__ int v_st(int k, int c) { const int kk = (k & ~0xC) | ((k & 4) << 1) | ((k & 8) >> 1); return ((kk >> 3) * 4 + (c >> 5)) * 512 + ((kk & 7) * 32 + (c & 31)) * 2; }
__device__ __forceinline__ int v_rd_base(int lane) { return ((lane & 3) << 3) | (((lane >> 2) & 3) << 6) | (((lane >> 4) & 1) << 5) | (((lane >> 5) & 1) << 8); }
constexpr int v_rd_off(int d0, int ks, int half) { return d0 * 512 + ks * 4096 + half * 2048; }
__device__ __forceinline__ int crow(int r, int hi) { return (r & 3) + 8 * (r >> 2) + 4 * hi; }
__device__ __forceinline__ unsigned cvtpk(float lo, float hi) {
    unsigned r; asm volatile("v_cvt_pk_bf16_f32 %0, %1, %2" : "=v"(r) : "v"(lo), "v"(hi)); return r;
}
__device__ __forceinline__ bf16x8 pack8(f32x4 a, f32x4 b) {
    u32x4 w = {cvtpk(a[0], a[1]), cvtpk(a[2], a[3]), cvtpk(b[0], b[1]), cvtpk(b[2], b[3])};
    return *reinterpret_cast<bf16x8*>(&w);
}
__device__ __forceinline__ bf16x8 load8(const bf16* p) { return *reinterpret_cast<const bf16x8*>(p); }
__device__ __forceinline__ void mask_tile(f32x16& p0, f32x16& p1, int dq, unsigned W) {
    const float NEG = -__builtin_inff();
#pragma unroll
    for (int r = 0; r < 16; ++r) {
        const int c = (r & 3) + 8 * (r >> 2);
        if ((unsigned)(dq - c) >= W) p0[r] = NEG;
        if ((unsigned)(dq - c - 32) >= W) p1[r] = NEG;
    }
}
__device__ __forceinline__ void partialSM(f32x16& p0, f32x16& p1, float& m_reg, float& mn, float& alpha) {
    float pmax = p0[0]; for (int r = 1; r < 16; ++r) pmax = fmaxf(pmax, p0[r]); for (int r = 0; r < 16; ++r) pmax = fmaxf(pmax, p1[r]);
    { auto rr = __builtin_amdgcn_permlane32_swap(__float_as_uint(pmax), __float_as_uint(pmax), false, false);
      pmax = fmaxf(__uint_as_float(rr[0]), __uint_as_float(rr[1])); }
    if (__builtin_expect(__all((pmax - m_reg) <= THR), 1)) { mn = m_reg; alpha = 1.f; }
    else { mn = fmaxf(m_reg, pmax); alpha = __builtin_amdgcn_exp2f(m_reg - mn); m_reg = mn; }
    for (int r = 0; r < 16; ++r) p0[r] = p0[r] - mn; for (int r = 0; r < 16; ++r) p1[r] = p1[r] - mn;
    for (int r = 0; r < 16; ++r) p0[r] = __builtin_amdgcn_exp2f(p0[r]);
}
__device__ __forceinline__ void finishSM(f32x16& p0, f32x16& p1, float alpha, float& l_reg, bf16x8& pa0, bf16x8& pa1, bf16x8& pa2, bf16x8& pa3) {
    for (int r = 0; r < 16; ++r) p1[r] = __builtin_amdgcn_exp2f(p1[r]);
    float ps = 0; for (int r = 0; r < 16; ++r) ps += p0[r]; for (int r = 0; r < 16; ++r) ps += p1[r];
    { auto rr = __builtin_amdgcn_permlane32_swap(__float_as_uint(ps), __float_as_uint(ps), false, false);
      ps = __uint_as_float(rr[0]) + __uint_as_float(rr[1]); }
    l_reg = l_reg * alpha + ps;
#define PK4(P, B_, OUT) do { unsigned a0 = cvtpk(P[B_+0], P[B_+1]), a1 = cvtpk(P[B_+2], P[B_+3]);                          \
        unsigned b0 = cvtpk(P[B_+4], P[B_+5]), b1 = cvtpk(P[B_+6], P[B_+7]);                                             \
        auto r0 = __builtin_amdgcn_permlane32_swap(a0, b0, false, false); auto r1 = __builtin_amdgcn_permlane32_swap(a1, b1, false, false); \
        u32x4 w = {r0[0], r1[0], r0[1], r1[1]}; OUT = *reinterpret_cast<bf16x8*>(&w); } while (0)
    PK4(p0, 0, pa0); PK4(p0, 8, pa1); PK4(p1, 0, pa2); PK4(p1, 8, pa3);
#undef PK4
}
__device__ __forceinline__ void qkt(f32x16& p0, f32x16& p1, const char* K_slot, int r32, int hi, const bf16x8* qr, const float* cbt) {
#pragma unroll
    for (int g = 0; g < 4; ++g) { const f32x4 a = *(const f32x4*)(cbt + 8 * g + 4 * hi), b = *(const f32x4*)(cbt + 32 + 8 * g + 4 * hi);
        p0[4 * g] = a[0]; p0[4 * g + 1] = a[1]; p0[4 * g + 2] = a[2]; p0[4 * g + 3] = a[3]; p1[4 * g] = b[0]; p1[4 * g + 1] = b[1]; p1[4 * g + 2] = b[2]; p1[4 * g + 3] = b[3]; }
    const char* kb[4];
#pragma unroll
    for (int dd = 0; dd < 4; ++dd) kb[dd] = K_slot + KSWZ(r32, (dd * 16 + hi * 8) * 2);
#pragma unroll
    for (int d0 = 0; d0 < 8; ++d0) { const char* a = kb[d0 & 3] + (d0 >> 2) * 128;
        bf16x8 b0 = *reinterpret_cast<const bf16x8*>(a);
        bf16x8 b1 = *reinterpret_cast<const bf16x8*>(a + 32 * 256);
        p0 = __builtin_amdgcn_mfma_f32_32x32x16_bf16(b0, qr[d0], p0, 0, 0, 0);
        p1 = __builtin_amdgcn_mfma_f32_32x32x16_bf16(b1, qr[d0], p1, 0, 0, 0); }
}
__device__ __forceinline__ void pv_tile(f32x16* o, int vbs, bf16x8 pa0, bf16x8 pa1, bf16x8 pa2, bf16x8 pa3) {
#define TRRD(dst, off) asm volatile("ds_read_b64_tr_b16 %0, %1 offset:%2" : "=&v"(dst) : "v"(vbs), "i"(off) : "memory")
#define PV_D0(d0) do { s16x4 l0, l1, l2, l3, h0, h1, h2, h3; constexpr int b_ = v_rd_off(d0, 0, 0);     \
        TRRD(l0, b_); TRRD(h0, b_ + 2048); TRRD(l1, b_ + 4096); TRRD(h1, b_ + 6144); TRRD(l2, b_ + 8192); TRRD(h2, b_ + 10240); TRRD(l3, b_ + 12288); TRRD(h3, b_ + 14336); \
        asm volatile("s_waitcnt lgkmcnt(0)" ::: "memory"); SBAR();                 \
        o[d0] = __builtin_amdgcn_mfma_f32_32x32x16_bf16(pa0, (bf16x8){l0[0], l0[1], l0[2], l0[3], h0[0], h0[1], h0[2], h0[3]}, o[d0], 0, 0, 0);   \
        o[d0] = __builtin_amdgcn_mfma_f32_32x32x16_bf16(pa1, (bf16x8){l1[0], l1[1], l1[2], l1[3], h1[0], h1[1], h1[2], h1[3]}, o[d0], 0, 0, 0);   \
        o[d0] = __builtin_amdgcn_mfma_f32_32x32x16_bf16(pa2, (bf16x8){l2[0], l2[1], l2[2], l2[3], h2[0], h2[1], h2[2], h2[3]}, o[d0], 0, 0, 0);   \
        o[d0] = __builtin_amdgcn_mfma_f32_32x32x16_bf16(pa3, (bf16x8){l3[0], l3[1], l3[2], l3[3], h3[0], h3[1], h3[2], h3[3]}, o[d0], 0, 0, 0); } while (0)
    PV_D0(0); PV_D0(1); PV_D0(2); PV_D0(3);
#undef PV_D0
#undef TRRD
}

#define FGAS __attribute__((address_space(1)))
struct BlockRef { FGAS char* base; unsigned qo, ko, vo, oo, cbo; int P0, kb0, khi, mode, slot; float Bq; FGAS char* part; FGAS float* pml; FGAS unsigned* cnt; };
constexpr int LDS_VR = 0, LDS_KR = 3 * SHM_V, LDS_CBR = 3 * SHM_V + 3 * SHM_K, LDS_WSR = 131584;
__device__ __forceinline__ void glds16(const FGAS char* gsrc, unsigned lds_dst) {
    unsigned keep; asm volatile("s_mov_b32 %0, m0\n\ts_mov_b32 m0, %2\n\ts_nop 0\n\tglobal_load_lds_dwordx4 %1, off\n\ts_mov_b32 m0, %0" : "=&s"(keep) : "v"(gsrc), "s"(lds_dst) : "memory");
}
#define WAIT_BAR(N) asm volatile("s_waitcnt vmcnt(" #N ") lgkmcnt(0)\n\ts_barrier" ::: "memory")
__device__ __forceinline__ void fa_block(const BlockRef& cur, char* lds, int tid_in) {
    int tid = tid_in; asm volatile("" : "+v"(tid));
    const int wid = __builtin_amdgcn_readfirstlane(tid >> 6), lane = tid & 63, r32 = lane & 31, hi = lane >> 5;
    const int kb0 = cur.kb0, NT0 = (cur.khi - kb0) / KVBLK;
    const int NT = NT0;
    const int qlo = cur.P0 + wid * QBLK, qm = qlo + r32 - 4 * hi;
    float* CBA = (float*)(lds + LDS_CBR);
    float* ws = (float*)(lds + LDS_WSR) + wid * 64; float* li_l = ws, * al_l = ws + 32; float* mm_l = (float*)(lds + LDS_WSR + 2048);
    const unsigned lds0 = (unsigned)(uintptr_t)lds;
    for (int i = tid; i < (cur.khi - kb0) / 4; i += NW * 64) ((f32x4*)CBA)[i] = *(const FGAS f32x4*)(cur.base + cur.cbo + (unsigned)(kb0 * 4) + (unsigned)i * 16u);
    bf16x8 qr[8];
    { const unsigned qoff = (unsigned)(((wid * QBLK + r32) * LDQ + hi * 8) * 2);
#pragma unroll
      for (int d0 = 0; d0 < 8; ++d0) qr[d0] = *(const FGAS bf16x8*)(cur.base + cur.qo + qoff + d0 * 32); }
    asm volatile("s_waitcnt vmcnt(0)" ::: "memory");
    unsigned kso[2], vso[2];
#pragma unroll
    for (int i = 0; i < 2; ++i) { const int p = 2 * wid + i, row = 4 * p + (lane >> 4), c = (lane & 15) ^ (row & 7); kso[i] = (unsigned)(row * (LDQ * 2) + c * 16);
        const int sub = 2 * p + (lane >> 5), kk = 8 * (sub >> 2) + ((lane & 31) >> 2), k = (kk & ~0xC) | ((kk & 4) << 1) | ((kk & 8) >> 1), cc = 32 * (sub & 3) + 8 * (lane & 3); vso[i] = (unsigned)(k * (LDQ * 2) + cc * 2); }
    const FGAS char* Kt = cur.base + cur.ko + (size_t)kb0 * (LDQ * 2); const FGAS char* Vt = cur.base + cur.vo + (size_t)kb0 * (LDQ * 2);
#define DMA_K(t, slot) do { const FGAS char* g_ = Kt + (size_t)(NT0 - 1 - (t)) * (KVBLK * LDQ * 2); const unsigned d_ = (unsigned)__builtin_amdgcn_readfirstlane(lds0 + LDS_KR + (slot) + 2048 * wid); glds16(g_ + kso[0], d_); glds16(g_ + kso[1], d_ + 1024); } while (0)
#define DMA_V(t, slot) do { const FGAS char* g_ = Vt + (size_t)(NT0 - 1 - (t)) * (KVBLK * LDQ * 2); const unsigned d_ = (unsigned)__builtin_amdgcn_readfirstlane(lds0 + LDS_VR + (slot) + 2048 * wid); glds16(g_ + vso[0], d_); glds16(g_ + vso[1], d_ + 1024); } while (0)
    DMA_K(0, 0); DMA_V(0, 0); DMA_K(1, SHM_K);
    float m_reg = -1e30f, l_reg = 0; f32x16 o[4] = {};
    const int vb0 = (int)lds0 + LDS_VR + v_rd_base(lane);
#define RESC(a) do { if (__any((a) < 1.f)) { if (hi == 0) al_l[r32] = (a); asm volatile("s_waitcnt lgkmcnt(0)" ::: "memory");              \
                     for (int d_ = 0; d_ < 4; ++d_) for (int r = 0; r < 16; ++r) o[d_][r] *= al_l[crow(r, hi)]; } } while (0)
#define KBASE(t) (kb0 + (NT0 - 1 - (t)) * KVBLK)
#define MASKT(P0_, P1_, t) do { const int kb_ = KBASE(t); if (kb_ + KVBLK - 1 > qlo) mask_tile(P0_, P1_, qm - kb_, 0x40000000u); } while (0)
    f32x16 pA0, pA1, pB0, pB1; float mnA, mnB, alA, alB; bf16x8 pa0, pa1, pa2, pa3;
    int s_prev = 0, s_cur = 0, s_next = SHM_K;
#define ROT() do { s_prev = s_cur; s_cur = s_next; s_next = (s_next == 2 * SHM_K) ? 0 : s_next + SHM_K; } while (0)
    WAIT_BAR(4);
    DMA_K(2, 2 * SHM_K); DMA_V(1, SHM_V);
    SBAR(); qkt(pA0, pA1, lds + LDS_KR, r32, hi, qr, CBA + (NT0 - 1) * KVBLK);
    MASKT(pA0, pA1, 0); partialSM(pA0, pA1, m_reg, mnA, alA);
    WAIT_BAR(4);
    ROT();
#define STEP(PX0, PX1, mnX, alX, PY0, PY1, alY, t) do {                                                                       \
        { const int s_nn = (s_next == 2 * SHM_K) ? 0 : s_next + SHM_K;                  \
          if ((t) + 2 < NT) DMA_K((t) + 2, s_nn); if ((t) + 1 < NT) DMA_V((t) + 1, s_next); }                                  \
        SBAR(); qkt(PX0, PX1, lds + LDS_KR + s_cur, r32, hi, qr, CBA + (NT0 - 1 - (t)) * KVBLK);                                           \
        finishSM(PY0, PY1, alY, l_reg, pa0, pa1, pa2, pa3); SBAR();                                                           \
        pv_tile(o, vb0 + s_prev, pa0, pa1, pa2, pa3); MASKT(PX0, PX1, (t)); partialSM(PX0, PX1, m_reg, mnX, alX);             \
        RESC(alX);                                                                                                            \
        if ((t) + 2 < NT) WAIT_BAR(4); else if ((t) + 1 < NT) WAIT_BAR(2); else WAIT_BAR(0);                                   \
        ROT(); } while (0)
    int t = 1;
    for (; t + 1 < NT; t += 2) {
        STEP(pB0, pB1, mnB, alB, pA0, pA1, alA, t);
        STEP(pA0, pA1, mnA, alA, pB0, pB1, alB, t + 1);
    }
    if (t < NT) {
        STEP(pB0, pB1, mnB, alB, pA0, pA1, alA, t);
        finishSM(pB0, pB1, alB, l_reg, pa0, pa1, pa2, pa3); SBAR();
    } else {
        finishSM(pA0, pA1, alA, l_reg, pa0, pa1, pa2, pa3); SBAR();
    }
    pv_tile(o, vb0 + s_prev, pa0, pa1, pa2, pa3);
    if (hi == 0) li_l[r32] = l_reg; asm volatile("s_waitcnt lgkmcnt(0)" ::: "memory");
#pragma unroll
    for (int r = 0; r < 16; ++r) { const float rl = __builtin_amdgcn_rcpf(li_l[crow(r, hi)]);
#pragma unroll
        for (int d0 = 0; d0 < 4; ++d0) o[d0][r] *= rl; }
    bool store_o = true;
    if (cur.mode == 1) {
        FGAS char* pp = cur.part + (size_t)cur.slot * 65536 + (unsigned)(wid * 8192 + lane * 16);
#pragma unroll
        for (int q = 0; q < 8; ++q) { u32x4 w;
            w.x = cvtpk(o[q >> 1][8 * (q & 1)], o[q >> 1][8 * (q & 1) + 1]); w.y = cvtpk(o[q >> 1][8 * (q & 1) + 2], o[q >> 1][8 * (q & 1) + 3]);
            w.z = cvtpk(o[q >> 1][8 * (q & 1) + 4], o[q >> 1][8 * (q & 1) + 5]); w.w = cvtpk(o[q >> 1][8 * (q & 1) + 6], o[q >> 1][8 * (q & 1) + 7]);
            *(FGAS u32x4*)(pp + q * 1024) = w; }
        typedef float f32x2 __attribute__((ext_vector_type(2)));
        if (hi == 0) { f32x2 ml; ml.x = m_reg; ml.y = l_reg; *(FGAS f32x2*)(cur.pml + ((size_t)cur.slot * 256 + wid * QBLK + r32) * 2) = ml; }
        asm volatile("s_waitcnt vmcnt(0) lgkmcnt(0)\n\ts_barrier" ::: "memory");
        int* hf = (int*)(lds + LDS_WSR + 2048);
        if (tid == 0) { __builtin_amdgcn_fence(__ATOMIC_RELEASE, "agent"); asm volatile("s_waitcnt vmcnt(0)" ::: "memory");
            const unsigned old = __hip_atomic_fetch_add(cur.cnt, 1u, __ATOMIC_RELAXED, __HIP_MEMORY_SCOPE_AGENT);
            if (old == 1u) { __builtin_amdgcn_fence(__ATOMIC_ACQUIRE, "agent"); asm volatile("s_waitcnt vmcnt(0)" ::: "memory"); }
            hf[0] = (int)old; }
        asm volatile("s_waitcnt vmcnt(0) lgkmcnt(0)\n\ts_barrier" ::: "memory");
        store_o = __builtin_amdgcn_readfirstlane(hf[0]) == 1;
        if (store_o) {
            const int oslot = cur.slot ^ 1;
            if (hi == 0) { const f32x2 mo = *(const FGAS f32x2*)(cur.pml + ((size_t)oslot * 256 + wid * QBLK + r32) * 2);
                const float M = fmaxf(m_reg, mo.x), a = l_reg * __builtin_amdgcn_exp2f(m_reg - M), b = mo.y * __builtin_amdgcn_exp2f(mo.x - M), inv = 1.0f / (a + b);
                li_l[r32] = a * inv; al_l[r32] = b * inv; }
            const FGAS char* po = cur.part + (size_t)oslot * 65536 + (unsigned)(wid * 8192 + lane * 16);
            u32x4 ov[8];
#pragma unroll
            for (int q = 0; q < 8; ++q) ov[q] = *(const FGAS u32x4*)(po + q * 1024);
            asm volatile("s_waitcnt lgkmcnt(0)" ::: "memory");
#pragma unroll
            for (int r = 0; r < 16; ++r) { const float ws_ = li_l[crow(r, hi)], wo_ = al_l[crow(r, hi)];
#pragma unroll
                for (int d0 = 0; d0 < 4; ++d0) { const u32x4 w = ov[2 * d0 + (r >> 3)]; const unsigned wd = (r & 7) < 2 ? w.x : ((r & 7) < 4 ? w.y : ((r & 7) < 6 ? w.z : w.w));
                    const float other = (r & 1) ? __builtin_bit_cast(float, wd & 0xffff0000u) : __builtin_bit_cast(float, wd << 16);
                    o[d0][r] = ws_ * o[d0][r] + wo_ * other; } }
        }
    }
    if (store_o) {
        const unsigned ooff = (unsigned)(((wid * QBLK + 4 * hi) * LDQ + r32) * 2);
#pragma unroll
        for (int r = 0; r < 16; ++r) { FGAS char* orow = cur.base + cur.oo + ((r & 3) + 8 * (r >> 2)) * (LDQ * 2);
#pragma unroll
            for (int d0 = 0; d0 < 4; ++d0) { const float v = o[d0][r]; const float vn = __shfl_xor(v, 1);
                if ((r32 & 1) == 0) *(FGAS unsigned*)(orow + ooff + d0 * 64) = cvtpk(v, vn); } }
    }
    asm volatile("s_waitcnt vmcnt(0) lgkmcnt(0)\n\ts_barrier" ::: "memory");
#undef RESC
#undef KBASE
#undef MASKT
#undef STEP
#undef ROT
#undef DMA_K
#undef DMA_V
}
#undef WAIT_BAR
#undef FGAS
#undef SBAR
#undef KSWZ
}
namespace rtn {
#define RLAS __attribute__((address_space(3)))
#define RGAS __attribute__((address_space(1)))
typedef short bf16x8 __attribute__((ext_vector_type(8)));
typedef short v4i16_t __attribute__((ext_vector_type(4)));
typedef float f32x16 __attribute__((ext_vector_type(16)));
typedef float f32x4 __attribute__((ext_vector_type(4)));
typedef unsigned u32x4 __attribute__((ext_vector_type(4)));
typedef unsigned u32x2 __attribute__((ext_vector_type(2)));
constexpr int NG = 16, RG = 8;
constexpr int LQ = 0, LK = 32768, LV = 65536, LK2 = 98304, LS = 132096, LPW = 140288;
constexpr int LDS_BYTES = LPW + 1024;
__device__ __forceinline__ int crow(int r, int hi) { return (r & 3) + 8 * (r >> 2) + 4 * hi; }
__device__ __forceinline__ unsigned cvtpk(float lo, float hi) { unsigned r; asm volatile("v_cvt_pk_bf16_f32 %0, %1, %2" : "=v"(r) : "v"(lo), "v"(hi)); return r; }
__device__ __forceinline__ float bflo(unsigned w) { return __builtin_bit_cast(float, w << 16); }
__device__ __forceinline__ float bfhi(unsigned w) { return __builtin_bit_cast(float, w & 0xffff0000u); }
__device__ __forceinline__ int off512(int row, int ch) { return 512 * row + 16 * (ch ^ (((row & 3) << 2) | ((row >> 2) & 3))); }
__device__ __forceinline__ int offS(int row, int ch8) { return 128 * row + 16 * (ch8 ^ ((row >> 1) & 7)); }
__device__ __forceinline__ bf16x8 lds128(unsigned a) { return *(const RLAS bf16x8*)(uintptr_t)a; }
__device__ __forceinline__ v4i16_t ldstr(unsigned a) { return __builtin_amdgcn_ds_read_tr16_b64_v4i16((RLAS v4i16_t*)(uintptr_t)a); }
__device__ __forceinline__ void glds16(const RGAS char* gsrc, unsigned lds_dst) {
    unsigned keep; asm volatile("s_mov_b32 %0, m0\n\ts_mov_b32 m0, %2\n\ts_nop 0\n\tglobal_load_lds_dwordx4 %1, off\n\ts_mov_b32 m0, %0" : "=&s"(keep) : "v"(gsrc), "s"(lds_dst) : "memory");
}
__device__ __forceinline__ void stage_tile(const RGAS char* g, unsigned ld_bytes, unsigned lbase, int wave, int lane) {
#pragma unroll
    for (int i = 0; i < 4; ++i) { const int pid = wave * 4 + i, row = 2 * pid + (lane >> 5), ch = (lane & 31) ^ (((row & 3) << 2) | ((row >> 2) & 3));
        glds16(g + (unsigned)row * ld_bytes + (unsigned)ch * 16u, (unsigned)__builtin_amdgcn_readfirstlane(lbase + 1024u * (unsigned)pid)); }
}
struct Ptrs { const RGAS char* Q; const RGAS char* K; RGAS char* V; RGAS char* L; RGAS float* PST; };
__device__ __forceinline__ void load_vfrags(bf16x8 (&vf)[4], unsigned vb0, unsigned vb1) {
#pragma unroll
    for (int s = 0; s < 4; ++s) { const v4i16_t lo = ldstr(vb0 + 8192 * s), hi = ldstr(vb1 + 8192 * s + 2048); vf[s] = (bf16x8){lo[0], lo[1], lo[2], lo[3], hi[0], hi[1], hi[2], hi[3]}; }
}
__device__ __forceinline__ void update_state(f32x16 (&X)[8], const bf16x8 (&vf)[4], unsigned kt0, unsigned kt1, unsigned lds0, int hh, float scl) {
    const RLAS float* pwr = (const RLAS float*)(uintptr_t)(lds0 + LPW + 144 * 4);
    v4i16_t fa[3][2][2];
#define RT_LOADB(buf, b) do { _Pragma("unroll") for (int j = 0; j < 2; ++j) { const int dt_ = 2 * ((b) & 3) + j, s_ = (b) >> 2; \
        fa[buf][j][0] = ldstr((kt0 ^ (unsigned)(64 * dt_)) + 8192 * s_); fa[buf][j][1] = ldstr((kt1 ^ (unsigned)(64 * dt_)) + 8192 * s_ + 2048); } } while (0)
    RT_LOADB(0, 0); RT_LOADB(1, 1);
    bf16x8 vs;
#pragma unroll
    for (int b = 0; b < 16; ++b) {
        if (b + 2 < 16) RT_LOADB((b + 2) % 3, b + 2);
        if ((b & 3) == 0) { const int s = b >> 2; const f32x4 f0 = *(const RLAS f32x4*)(pwr + 16 * s + 8 * hh), f1 = *(const RLAS f32x4*)(pwr + 16 * s + 8 * hh + 4);
            const u32x4 w = __builtin_bit_cast(u32x4, vf[s]); u32x4 o;
            o.x = cvtpk(bflo(w.x) * f0[0] * scl, bfhi(w.x) * f0[1] * scl); o.y = cvtpk(bflo(w.y) * f0[2] * scl, bfhi(w.y) * f0[3] * scl);
            o.z = cvtpk(bflo(w.z) * f1[0] * scl, bfhi(w.z) * f1[1] * scl); o.w = cvtpk(bflo(w.w) * f1[2] * scl, bfhi(w.w) * f1[3] * scl);
            vs = __builtin_bit_cast(bf16x8, o); }
        __builtin_amdgcn_sched_barrier(0);
#pragma unroll
        for (int j = 0; j < 2; ++j) { const v4i16_t lo = fa[b % 3][j][0], hi = fa[b % 3][j][1]; const int dt = 2 * (b & 3) + j;
            X[dt] = __builtin_amdgcn_mfma_f32_32x32x16_bf16((bf16x8){lo[0], lo[1], lo[2], lo[3], hi[0], hi[1], hi[2], hi[3]}, vs, X[dt], 0, 0, 0); }
        __builtin_amdgcn_sched_barrier(0);
    }
#undef RT_LOADB
}
__device__ __forceinline__ void dump_state(const f32x16 (&X)[8], RGAS char* L, int wave, int lane, float scl) {
#pragma unroll
    for (int dt = 0; dt < 8; ++dt)
#pragma unroll
        for (int s = 0; s < 2; ++s) { u32x4 o; o.x = cvtpk(X[dt][8 * s] * scl, X[dt][8 * s + 1] * scl); o.y = cvtpk(X[dt][8 * s + 2] * scl, X[dt][8 * s + 3] * scl);
            o.z = cvtpk(X[dt][8 * s + 4] * scl, X[dt][8 * s + 5] * scl); o.w = cvtpk(X[dt][8 * s + 6] * scl, X[dt][8 * s + 7] * scl);
            *(RGAS u32x4*)(L + (unsigned)(wave * 16384 + (2 * dt + s) * 1024 + lane * 16)) = o; }
}
__device__ __forceinline__ void accum_state(f32x16 (&X)[8], const RGAS char* L, int wave, int lane, float dec) {
#pragma unroll
    for (int dt = 0; dt < 8; ++dt)
#pragma unroll
        for (int s = 0; s < 2; ++s) { const u32x4 w = *(const RGAS u32x4*)(L + (unsigned)(wave * 16384 + (2 * dt + s) * 1024 + lane * 16));
            X[dt][8 * s] = X[dt][8 * s] * dec + bflo(w.x); X[dt][8 * s + 1] = X[dt][8 * s + 1] * dec + bfhi(w.x); X[dt][8 * s + 2] = X[dt][8 * s + 2] * dec + bflo(w.y); X[dt][8 * s + 3] = X[dt][8 * s + 3] * dec + bfhi(w.y);
            X[dt][8 * s + 4] = X[dt][8 * s + 4] * dec + bflo(w.z); X[dt][8 * s + 5] = X[dt][8 * s + 5] * dec + bfhi(w.z); X[dt][8 * s + 6] = X[dt][8 * s + 6] * dec + bflo(w.w); X[dt][8 * s + 7] = X[dt][8 * s + 7] * dec + bfhi(w.w); }
}
template <bool FULL>
__device__ __forceinline__ void run_item(const Ptrs& P, int bh, int half, int g, unsigned lds0, int wave_in) {
    int lane0_ = hw_lane_id(); asm volatile("" : "+v"(lane0_));
    const int lane0 = lane0_, wave = wave_in, tid = wave * 64 + lane0;
    const int b = bh >> 2, h = bh & 3;
    const float lg = __logf(1.0f - __builtin_amdgcn_exp2f(-5.0f - (float)h));
    const float cd = __expf(lg * 64.f), cdinv = __expf(-lg * 64.f);
    RLAS float* pw = (RLAS float*)(uintptr_t)(lds0 + LPW);
    __syncthreads();
    if (tid <= 64) pw[tid] = __expf(lg * (float)tid);
    if (tid < 64) { pw[80 + tid] = __expf(lg * (float)(tid + 1)); pw[144 + tid] = __expf(lg * (float)(63 - tid)); }
    const int g16 = lane0 >> 4, blk = g16 & 1, q4 = (lane0 & 15) >> 2, p4 = lane0 & 3, sp = ((p4 & 1) << 1) | (p4 >> 1), hh0 = lane0 >> 5;
    const unsigned trrow = (unsigned)(512 * (8 * hh0 + q4));
    const int fl = (q4 << 2) | (hh0 << 1);
    unsigned vb0_ = lds0 + LV + trrow + 16u * (unsigned)((4 * wave + 2 * blk + (p4 >> 1)) ^ fl) + 8u * (unsigned)(p4 & 1);
    unsigned kt0_ = lds0 + LK + trrow + 16u * (unsigned)((2 * blk + (sp >> 1)) ^ fl) + 8u * (unsigned)(sp & 1);
    unsigned lane_ = (unsigned)lane0;
    const size_t tok0 = (size_t)b * 8192 + (size_t)g * (RG * 64);
    const RGAS char* Qg = P.Q + (tok0 * 1024 + (size_t)h * 256) * 2; const RGAS char* Kg = P.K + (tok0 * 1024 + (size_t)h * 256) * 2;
    RGAS char* Vg = P.V + (tok0 * 2048 + (size_t)h * 512 + (size_t)half * 256) * 2;
    f32x16 X[8];
#pragma unroll
    for (int dt = 0; dt < 8; ++dt) X[dt] = f32x16{};
    if constexpr (FULL) {
        const float cdg = __expf(lg * (float)(RG * 64));
        for (int gp = 0; gp < g; ++gp) accum_state(X, P.L + (size_t)((bh * (NG - 1) + gp) * 2 + half) * 131072, wave, lane0, cdg);
    }
    float cdm = 1.f, cdim = cdinv;
    __syncthreads();
    if constexpr (FULL) { stage_tile(Qg, 2048, lds0 + LQ, wave, lane0); stage_tile(Vg, 4096, lds0 + LV, wave, lane0); } else { stage_tile(Vg, 4096, lds0 + LV, wave, lane0); }
    stage_tile(Kg, 2048, lds0 + LK, wave, lane0);
    for (int m = 0; m < RG; ++m) {
        const unsigned kb = (m & 1) ? (unsigned)(LK2 - LK) : 0u, vbuf = (!FULL && (m & 1)) ? (unsigned)(LQ - LV) : 0u;
        asm volatile("s_waitcnt vmcnt(0)" ::: "memory");
        __syncthreads();
        asm volatile("" : "+v"(vb0_), "+v"(kt0_), "+v"(lane_));
        const unsigned vb0 = vb0_ + vbuf, vb1 = vb0 ^ 16u, kt0 = kt0_ + kb, kt1 = kt0 ^ 16u; const int lane = (int)lane_, hh = lane >> 5, c32 = lane & 31, i16 = lane & 15;
        if (m + 1 < RG) { stage_tile(Kg + (size_t)(m + 1) * (64 * 2048), 2048, lds0 + LK + ((m & 1) ? 0u : (unsigned)(LK2 - LK)), wave, lane);
            if constexpr (!FULL) stage_tile(Vg + (size_t)(m + 1) * (64 * 4096), 4096, lds0 + ((m & 1) ? (unsigned)LV : (unsigned)LQ), wave, lane); }
        bf16x8 vf[4];
        if constexpr (FULL) {
            {
                const int itile = wave >> 1, jt0 = 2 * (wave & 1), qq = lane >> 4;
                const int fS = ((i16 & 3) << 2) | ((i16 >> 2) & 3);
                const unsigned qa = lds0 + LQ + (unsigned)(512 * (16 * itile + i16)) + 16u * (unsigned)(qq ^ fS), ka = lds0 + LK + kb + (unsigned)(512 * (16 * jt0 + i16)) + 16u * (unsigned)(qq ^ fS);
                f32x4 s0 = {0.f, 0.f, 0.f, 0.f}, s1 = {0.f, 0.f, 0.f, 0.f};
#pragma unroll
                for (int s = 0; s < 8; ++s) { const bf16x8 qf = lds128(qa ^ (unsigned)(64 * s)), k0 = lds128(ka ^ (unsigned)(64 * s)), k1 = lds128((ka ^ (unsigned)(64 * s)) + 8192);
                    s0 = __builtin_amdgcn_mfma_f32_16x16x32_bf16(k0, qf, s0, 0, 0, 0); s1 = __builtin_amdgcn_mfma_f32_16x16x32_bf16(k1, qf, s1, 0, 0, 0);
                    if ((s & 3) == 3) asm volatile("" ::: "memory"); }
                const int irow = 16 * itile + i16;
#pragma unroll
                for (int tt = 0; tt < 2; ++tt) { const f32x4 sv = tt ? s1 : s0; const int jb = 16 * (jt0 + tt) + 4 * qq; float e[4];
#pragma unroll
                    for (int r = 0; r < 4; ++r) { const int dj = irow - (jb + r); e[r] = sv[r] * pw[dj < 0 ? -dj : dj]; }
                    u32x2 o; o.x = cvtpk(e[0], e[1]); o.y = cvtpk(e[2], e[3]);
                    *(RLAS u32x2*)(uintptr_t)(lds0 + LS + offS(irow, 2 * (jt0 + tt) + (qq >> 1)) + 8 * (qq & 1)) = o; }
            }
            load_vfrags(vf, vb0, vb1);
            f32x16 Y[2]; Y[0] = f32x16{}; Y[1] = f32x16{};
            const int fQ = ((c32 & 3) << 2) | ((c32 >> 2) & 3);
            const unsigned qr0 = lds0 + LQ + (unsigned)(512 * c32) + 16u * (unsigned)(hh ^ fQ);
#pragma unroll
            for (int dt = 0; dt < 8; ++dt)
#pragma unroll
                for (int s = 0; s < 2; ++s) { u32x4 pb; pb.x = cvtpk(X[dt][8 * s], X[dt][8 * s + 1]); pb.y = cvtpk(X[dt][8 * s + 2], X[dt][8 * s + 3]); pb.z = cvtpk(X[dt][8 * s + 4], X[dt][8 * s + 5]); pb.w = cvtpk(X[dt][8 * s + 6], X[dt][8 * s + 7]);
                    const bf16x8 bq = __builtin_bit_cast(bf16x8, pb); const unsigned a = qr0 ^ (unsigned)(16 * (4 * dt + 2 * s));
                    Y[0] = __builtin_amdgcn_mfma_f32_32x32x16_bf16(lds128(a), bq, Y[0], 0, 0, 0); Y[1] = __builtin_amdgcn_mfma_f32_32x32x16_bf16(lds128(a + 16384), bq, Y[1], 0, 0, 0);
                    if (s == 1 && (dt & 1)) asm volatile("" ::: "memory"); }
#pragma unroll
            for (int it = 0; it < 2; ++it)
#pragma unroll
                for (int rg = 0; rg < 4; ++rg) { const f32x4 f = *(const RLAS f32x4*)(pw + 80 + 32 * it + 8 * rg + 4 * hh);
                    Y[it][4 * rg] *= f[0] * cdm; Y[it][4 * rg + 1] *= f[1] * cdm; Y[it][4 * rg + 2] *= f[2] * cdm; Y[it][4 * rg + 3] *= f[3] * cdm; }
            asm volatile("s_waitcnt lgkmcnt(0)" ::: "memory"); __builtin_amdgcn_s_barrier(); asm volatile("" ::: "memory");
            if (m + 1 < RG) { stage_tile(Qg + (size_t)(m + 1) * (64 * 2048), 2048, lds0 + LQ, wave, lane); stage_tile(Vg + (size_t)(m + 1) * (64 * 4096), 4096, lds0 + LV, wave, lane); }
            const unsigned sr0 = lds0 + LS + (unsigned)(128 * c32) + 16u * (unsigned)(hh ^ ((c32 >> 1) & 7));
            const unsigned sr1 = lds0 + LS + (unsigned)(128 * (32 + c32)) + 16u * (unsigned)(hh ^ (((32 + c32) >> 1) & 7));
#pragma unroll
            for (int s = 0; s < 4; ++s) { Y[0] = __builtin_amdgcn_mfma_f32_32x32x16_bf16(lds128(sr0 ^ (unsigned)(32 * s)), vf[s], Y[0], 0, 0, 0);
                Y[1] = __builtin_amdgcn_mfma_f32_32x32x16_bf16(lds128(sr1 ^ (unsigned)(32 * s)), vf[s], Y[1], 0, 0, 0); }
            const size_t tokm = tok0 + (size_t)m * 64;
            RGAS char* yb = P.V + ((tokm * 2048 + (size_t)h * 512 + (size_t)half * 256 + (size_t)wave * 32) * 2);
#pragma unroll
            for (int it = 0; it < 2; ++it) {
#pragma unroll
                for (int r = 0; r < 16; ++r) { const float v = Y[it][r], vn = __shfl_xor(v, 1);
                    if ((c32 & 1) == 0) *(RGAS unsigned*)(yb + (unsigned)(32 * it + crow(r, hh)) * 4096u + (unsigned)c32 * 2u) = cvtpk(v, vn); }
                const bool b4 = (c32 & 16) != 0, b3 = (c32 & 8) != 0, b2 = (c32 & 4) != 0, b1 = (c32 & 2) != 0;
                float c1[8], c2[8], d1[4], d2[4], e1[2], e2[2];
#pragma unroll
                for (int k = 0; k < 8; ++k) { const float lo = Y[it][k], hi = Y[it][8 + k], lo2 = lo * lo, hi2 = hi * hi;
                    c1[k] = (b4 ? hi : lo) + __shfl_xor(b4 ? lo : hi, 16); c2[k] = (b4 ? hi2 : lo2) + __shfl_xor(b4 ? lo2 : hi2, 16); }
#pragma unroll
                for (int k = 0; k < 4; ++k) { d1[k] = (b3 ? c1[4 + k] : c1[k]) + __shfl_xor(b3 ? c1[k] : c1[4 + k], 8); d2[k] = (b3 ? c2[4 + k] : c2[k]) + __shfl_xor(b3 ? c2[k] : c2[4 + k], 8); }
#pragma unroll
                for (int k = 0; k < 2; ++k) { e1[k] = (b2 ? d1[2 + k] : d1[k]) + __shfl_xor(b2 ? d1[k] : d1[2 + k], 4); e2[k] = (b2 ? d2[2 + k] : d2[k]) + __shfl_xor(b2 ? d2[k] : d2[2 + k], 4); }
                float s1 = (b1 ? e1[1] : e1[0]) + __shfl_xor(b1 ? e1[0] : e1[1], 2), s2 = (b1 ? e2[1] : e2[0]) + __shfl_xor(b1 ? e2[0] : e2[1], 2);
                s1 += __shfl_xor(s1, 1); s2 += __shfl_xor(s2, 1);
                if ((c32 & 1) == 0) { typedef float f32x2 __attribute__((ext_vector_type(2))); f32x2 st; st.x = s1; st.y = s2; const int row = 32 * it + crow((c32 >> 1) & 15, hh);
                    *(RGAS f32x2*)(P.PST + (((tokm + row) * 4 + h) * 16 + half * 8 + wave) * 2) = st; }
            }
        } else {
            load_vfrags(vf, vb0, vb1);
        }
        update_state(X, vf, kt0, kt1, lds0, hh, cdim);
        cdm *= cd; cdim *= cdinv;
    }
    __syncthreads();
    if constexpr (!FULL) dump_state(X, P.L + (size_t)((bh * (NG - 1) + g) * 2 + half) * 131072, wave, lane0, cdm);
}
#undef RLAS
#undef RGAS
}
struct Args { const float* in[11]; float* out; unsigned char* wsp; int ph_lo, ph_hi, li, pad; };
struct Frame {
    LAS unsigned char* lds;
    volatile LAS unsigned* MISC;
    int tid, lane, wave;
    int vcu, G;
    const __attribute__((address_space(4))) Args* ap;
};
#define FP(i) (F.ap->in[i])
#define F_x FP(0)
#define F_norm_mix FP(1)
#define F_norm_ffn FP(2)
#define F_fox_w_in FP(3)
#define F_fox_b_f FP(4)
#define F_fox_w_out FP(5)
#define F_ret_w_in FP(6)
#define F_ret_w_out FP(7)
#define F_ffn_w_in FP(8)
#define F_ffn_w_out FP(9)
#define F_final_norm FP(10)
#define F_out (F.ap->out)
#define F_ws (F.ap->wsp)
__device__ __forceinline__ float wave_sum(float v) {
#pragma unroll
    for (int o = 1; o < 64; o <<= 1) v += __shfl_xor(v, o);
    return v;
}

__device__ __forceinline__ void p0_item(const float* W, int K, int Nsrc, int scol0, bf16* WT, int drow0, int k0, const float* g, LAS float* scr, int lane) {
    const int nq = lane & 7, kr = lane >> 3;
    f32x4 v[8];
#pragma unroll
    for (int i = 0; i < 8; ++i) v[i] = *(const GAS f32x4*)(W + (size_t)(k0 + kr + 8 * i) * Nsrc + scol0 + 4 * nq);
#pragma unroll
    for (int i = 0; i < 8; ++i) { const int kk = kr + 8 * i; const float gv = g ? g[k0 + kk] : 1.f; LAS float* d = scr + kk * 33 + 4 * nq;
        d[0] = v[i].x * gv; d[1] = v[i].y * gv; d[2] = v[i].z * gv; d[3] = v[i].w * gv; }
    LDS_WAIT(); asm volatile("" ::: "memory");
    const int c = lane & 7;
#pragma unroll
    for (int j = 0; j < 4; ++j) { const int n = (lane >> 3) + 8 * j; const LAS float* s = scr + (8 * c) * 33 + n;
        v4u o; o.x = pk2(s[0 * 33], s[1 * 33]); o.y = pk2(s[2 * 33], s[3 * 33]); o.z = pk2(s[4 * 33], s[5 * 33]); o.w = pk2(s[6 * 33], s[7 * 33]);
        *(GAS v4u*)(WT + (size_t)(drow0 + n) * K + k0 + 8 * c) = o; }
    LDS_WAIT(); asm volatile("" ::: "memory");
}
__device__ __forceinline__ void p0_matrix(int r, const float* W, int K, int N, int Nsrc, bool swiglu, bf16* WT, const float* g, LAS float* scr, int lane) {
    const int nblk = N / 32, kb = r / nblk, nb = r % nblk, drow0 = 32 * nb;
    int scol0 = drow0;
    if (swiglu) { const int t = drow0 >> 8, rr = drow0 & 255; scol0 = (rr < 128) ? t * 128 + rr : DFF + t * 128 + (rr - 128); }
    p0_item(W, K, Nsrc, scol0, WT, drow0, 64 * kb, g, scr, lane);
}
__device__ __forceinline__ void p0_xtile(Frame& F, int tile) {
    LAS float* wfs = (LAS float*)(F.lds);
    LAS float* tot = (LAS float*)(F.lds + 32768);
#pragma unroll
    for (int kk = 0; kk < 2; ++kk) { const int k = F.tid + 512 * kk; const float gk = F_norm_mix[k];
        const f32x4 w0 = *(const GAS f32x4*)(F_fox_w_in + (size_t)k * 3080 + 3072), w1 = *(const GAS f32x4*)(F_fox_w_in + (size_t)k * 3080 + 3076);
        wfs[k] = w0.x * gk; wfs[1024 + k] = w0.y * gk; wfs[2048 + k] = w0.z * gk; wfs[3072 + k] = w0.w * gk; wfs[4096 + k] = w1.x * gk; wfs[5120 + k] = w1.y * gk; wfs[6144 + k] = w1.z * gk; wfs[7168 + k] = w1.w * gk; }
    __syncthreads();
    const int myh = (F.lane >> 3) & 7;
    const float bfv = F_fox_b_f[myh];
    bf16* XB = (bf16*)(F_ws + WS_XB); float* SSQ = (float*)(F_ws + WS_SSQ);
    const int row0 = tile * 64 + F.wave * 8;
    const bool b5 = (F.lane & 32) != 0, b4 = (F.lane & 16) != 0, b3 = (F.lane & 8) != 0;
    float run = 0.f, mine[8];
    f32x4 v[4], vn[4];
    { const GAS f32x4* xr = (const GAS f32x4*)(F_x + (size_t)row0 * D) + F.lane;
#pragma unroll
      for (int j = 0; j < 4; ++j) vn[j] = xr[64 * j]; }
#pragma unroll
    for (int i = 0; i < 8; ++i) {
        const int row = row0 + i;
#pragma unroll
        for (int j = 0; j < 4; ++j) v[j] = vn[j];
        if (i < 7) { const GAS f32x4* xr = (const GAS f32x4*)(F_x + (size_t)(row + 1) * D) + F.lane;
#pragma unroll
            for (int j = 0; j < 4; ++j) vn[j] = xr[64 * j]; }
        float ss = 0.f;
#pragma unroll
        for (int j = 0; j < 4; ++j) ss += (v[j].x * v[j].x + v[j].y * v[j].y) + (v[j].z * v[j].z + v[j].w * v[j].w);
        GAS unsigned long long* o8 = (GAS unsigned long long*)(XB + (size_t)row * D) + F.lane;
#pragma unroll
        for (int j = 0; j < 4; ++j) o8[64 * j] = (unsigned long long)pk2(v[j].x, v[j].y) | ((unsigned long long)pk2(v[j].z, v[j].w) << 32);
        float a[8];
#pragma unroll
        for (int h = 0; h < 8; ++h) { float acc = 0.f;
#pragma unroll
            for (int j = 0; j < 4; ++j) { const f32x4 w = *(const LAS f32x4*)(wfs + h * 1024 + 4 * (F.lane + 64 * j)); acc += (v[j].x * w.x + v[j].y * w.y) + (v[j].z * w.z + v[j].w * w.w); }
            a[h] = acc; }
        ss = wave_sum(ss);
        float c[4], d[2];
#pragma unroll
        for (int k = 0; k < 4; ++k) c[k] = (b5 ? a[4 + k] : a[k]) + __shfl_xor(b5 ? a[k] : a[4 + k], 32);
#pragma unroll
        for (int k = 0; k < 2; ++k) d[k] = (b4 ? c[2 + k] : c[k]) + __shfl_xor(b4 ? c[k] : c[2 + k], 16);
        float e = (b3 ? d[1] : d[0]) + __shfl_xor(b3 ? d[0] : d[1], 8);
        e += __shfl_xor(e, 4); e += __shfl_xor(e, 2); e += __shfl_xor(e, 1);
        const float rstd = 1.0f / sqrtf(ss * (1.f / D) + EPS);
        if (F.lane < 16) SSQ[(size_t)row * 16 + F.lane] = (F.lane == 0) ? ss : 0.f;
        const float z = e * rstd + bfv; const float lf = fminf(z, 0.f) - log1pf(__expf(-fabsf(z)));
        run += lf; mine[i] = run;
    }
    if ((F.lane & 7) == 0) tot[F.wave * 8 + myh] = run;
    __syncthreads();
    float* LC = (float*)(F_ws + WS_LC); float* TT = (float*)(F_ws + WS_TT);
    if ((F.lane & 7) == 0) { float off = 0.f; for (int w = 0; w < F.wave; ++w) off += tot[w * 8 + myh];
#pragma unroll
        for (int i = 0; i < 8; ++i) LC[(size_t)(row0 + i) * 8 + myh] = mine[i] + off; }
    if (F.tid < 8) { float s = 0.f; for (int w = 0; w < 8; ++w) s += tot[w * 8 + F.tid]; TT[tile * 8 + F.tid] = s; }
    __syncthreads();
}
__device__ __forceinline__ void p0_prologue(Frame& F) {
    for (int t = (int)blockIdx.x; t < M / 64; t += F.G) p0_xtile(F, t);
    LAS float* scr = (LAS float*)(F.lds + RING_OFF + F.wave * 16384);
    const int gw = F.vcu * NWAVES + F.wave, NGW = F.G * NWAVES;
    constexpr int I0 = 16 * 96, I1 = 16 * 32, I2 = 16 * 176, I3 = 44 * 32, I4 = 16 * 192, I5 = 32 * 32;
    constexpr int NITEMS = I0 + I1 + I2 + I3 + I4 + I5;
    unsigned char* ws = F_ws;
    for (int it = gw; it < NITEMS; it += NGW) {
        int r = it;
        if (r < I0) { p0_matrix(r, F_fox_w_in, 1024, 3072, 3080, false, (bf16*)(ws + WS_WQKV0), F_norm_mix, scr, F.lane); continue; } r -= I0;
        if (r < I1) { p0_matrix(r, F_fox_w_out, 1024, 1024, 1024, false, (bf16*)(ws + WS_WO0), nullptr, scr, F.lane); continue; } r -= I1;
        if (r < I2) { p0_matrix(r, F_ffn_w_in, 1024, 2 * DFF, 2 * DFF, true, (bf16*)(ws + WS_WFI0), F_norm_ffn, scr, F.lane); continue; } r -= I2;
        if (r < I3) { p0_matrix(r, F_ffn_w_out, DFF, 1024, 1024, false, (bf16*)(ws + WS_WFO0), nullptr, scr, F.lane); continue; } r -= I3;
        if (r < I4) { p0_matrix(r, F_ret_w_in, 1024, 6144, 6144, false, (bf16*)(ws + WS_WRI), F_norm_mix + D, scr, F.lane); continue; } r -= I4;
        p0_matrix(r, F_ret_w_out, 2048, 1024, 1024, false, (bf16*)(ws + WS_WRO), nullptr, scr, F.lane);
    }
    float* rope = (float*)(ws + WS_ROPE);
    {
        const int idx0 = F.vcu * (NWAVES * 64) + F.tid;
        const float inv = (float)exp2(-(double)(idx0 & 127) * (13.287712379549449 / 128.0));
        for (int idx = idx0; idx < SEQ * 128; idx += F.G * NWAVES * 64) {
            const float ang = (float)(idx >> 7) * inv;
            const double t = (double)ang * 0.15915494309189535; const float fr = (float)(t - rint(t));
            f32x2 cs; cs.x = __builtin_amdgcn_cosf(fr); cs.y = __builtin_amdgcn_sinf(fr);
            *(f32x2*)(rope + (size_t)idx * 2) = cs;
        }
    }
}

__device__ __forceinline__ void p0_late_weights(Frame& F, int first) {
    const int nwg = F.G - first; if ((int)blockIdx.x < first || nwg <= 0) return;
    LAS float* scr = (LAS float*)(F.lds + RING_OFF + F.wave * 16384);
    const int gw = ((int)blockIdx.x - first) * NWAVES + F.wave, NGW = nwg * NWAVES;
    constexpr int I6 = 16 * 176, I7 = 44 * 32;
    unsigned char* ws = F_ws;
    for (int it = gw; it < I6 + I7; it += NGW) {
        if (it < I6) p0_matrix(it, F_ffn_w_in + (size_t)D * 2 * DFF, 1024, 2 * DFF, 2 * DFF, true, (bf16*)(ws + WS_WFI1), F_norm_ffn + D, scr, F.lane);
        else p0_matrix(it - I6, F_ffn_w_out + (size_t)DFF * D, DFF, 1024, 1024, false, (bf16*)(ws + WS_WFO1), nullptr, scr, F.lane);
    }
}

__device__ __forceinline__ void fill_rstd_tab(Frame& F, const pg8::StaticOrder& S) {
    LAS float* tab = (LAS float*)(F.lds + TAB_OFF); const float* SSQ = (const float*)(F_ws + WS_SSQ);
    pg8::Unit u;
    for (int i = 0; i < 8 && S.next(i, u); ++i) if (F.tid < 256) {
        const f32x4* p = (const f32x4*)(SSQ + (size_t)(u.pm * 256 + F.tid) * 16); const f32x4 a = p[0], b = p[1], c = p[2], d = p[3];
        const float s = ((a.x + a.y) + (a.z + a.w)) + ((b.x + b.y) + (b.z + b.w)) + ((c.x + c.y) + (c.z + c.w)) + ((d.x + d.y) + (d.z + d.w));
        tab[i * 256 + F.tid] = 1.0f / sqrtf(s * (1.f / D) + EPS); }
    __syncthreads();
}
__device__ __forceinline__ void fill_gate_tab(Frame& F, const pg8::StaticOrder& S) {
    LAS f32x2* stab = (LAS f32x2*)(F.lds + STAB_OFF); const float* PST = (const float*)(F_ws + WS_PST);
    pg8::Unit u;
    for (int i = 0; i < 2 && S.next(i, u); ++i) if (F.tid < 256) {
        const f32x4* p = (const f32x4*)(PST + ((size_t)(u.pm * 256 + F.tid) * 4 + (u.pn >> 1)) * 32); float s = 0.f, q = 0.f;
#pragma unroll
        for (int j = 0; j < 8; ++j) { const f32x4 v = p[j]; s += v.x + v.z; q += v.y + v.w; }
        const float mu = s * (1.f / RDV), var = fmaxf(q * (1.f / RDV) - mu * mu, 0.f);
        f32x2 st; st.x = mu; st.y = 1.0f / sqrtf(var + EPS); stab[i * 256 + F.tid] = st; }
    __syncthreads();
}


__device__ __forceinline__ void cbg_phase(Frame& F) {
    const float* LC = (const float*)(F_ws + WS_LC); const float* TT = (const float*)(F_ws + WS_TT); float* CBG = (float*)(F_ws + WS_CBG);
    LAS float* pre = (LAS float*)(F.lds);
    for (int item = (int)blockIdx.x; item < 16 * 16; item += F.G) {
        const int bh = item >> 4, seg = item & 15, b = bh >> 3, h = bh & 7, s = seg * 512 + F.tid;
        __syncthreads();
        if (F.tid < 128) pre[F.tid] = TT[(b * 128 + F.tid) * 8 + h];
        __syncthreads();
        if (F.tid == 0) { float p = 0.f; for (int t = 0; t < 128; ++t) { const float v = pre[t]; pre[t] = p; p += v; } }
        __syncthreads();
        CBG[(size_t)bh * SEQ + s] = -(pre[s >> 6] + LC[(size_t)(b * SEQ + s) * 8 + h]) * LOG2E;
    }
    __syncthreads();
}
constexpr size_t WS_PML = WS_END;
static_assert(WS_PML + 2 * MiB <= 256 * MiB, "pml");
constexpr int CW_SPL = 3072;
__device__ __forceinline__ fa::BlockRef fa_ref(Frame& F, int bh, int qb, int kb0, int khi, int mode, int half, float Bq) {
    const int b = bh >> 3, h = bh & 7; fa::BlockRef r; r.base = (GAS char*)F_ws;
    const unsigned ro = (unsigned)(((b * SEQ + qb * 256) * 1024 + h * 128) * 2), ho = (unsigned)((b * SEQ * 1024 + h * 128) * 2);
    r.qo = (unsigned)WS_Q0 + ro; r.oo = (unsigned)WS_O0 + ro; r.ko = (unsigned)WS_K0 + ho; r.vo = (unsigned)WS_V0 + ho;
    r.cbo = (unsigned)WS_CBG + (unsigned)(bh * SEQ * 4); r.P0 = qb * 256; r.kb0 = kb0; r.Bq = Bq; r.khi = khi; r.mode = mode; r.slot = (bh * 32 + qb) * 2 + half;
    r.part = (GAS char*)F_out; r.pml = (GAS float*)(F_ws + WS_PML); r.cnt = (GAS unsigned*)(F_ws + WS_CTL) + CW_SPL + bh * 32 + qb; return r;
}
constexpr float SKIP_LOG2 = 148.f;
constexpr int SPLIT_MIN = 40;
constexpr int ATT_LDS_DESC = 133632 + 64;
__device__ __forceinline__ void fa_describe(Frame& F, int n, int xq, LAS float* kmax2, LAS int* desc) {
    const int half = n & 1, bi = n >> 1;
    const int bh = (bi & 1) ? 8 + ((xq + 4) & 7) : xq, qb = 31 - (bi >> 1), b = bh >> 3, h = bh & 7;
    const float* nq = (const float*)(F_ws + WS_NRM) + ((size_t)(b * 32 + qb) * 8 + h) * 8;
    float q2 = 0.f;
#pragma unroll
    for (int wc = 0; wc < 4; ++wc) q2 += fmaxf(nq[2 * wc], nq[2 * wc + 1]);
    const float B = sqrtf(q2 * kmax2[bh]) * 1.01f, th = 2.f * B + SKIP_LOG2;
    const float* cb = (const float*)(F_ws + WS_CBG) + (size_t)bh * SEQ;
    const float cbi = cb[qb * 256];
    const float c0 = cb[64 * F.lane + 63], c1 = cb[64 * (F.lane + 64) + 63];
    const unsigned long long m0 = __ballot(cbi - c0 <= th), m1 = __ballot(cbi - c1 <= th);
    int t = m0 ? (int)__builtin_ctzll(m0) : (m1 ? 64 + (int)__builtin_ctzll(m1) : 4 * qb);
    if (t > 4 * qb) t = 4 * qb;
    const int nt = 4 * qb + 4 - t, tmid = t + (nt >> 1);
    int lo = 64 * t, top = qb * 256 + 256, mode = 0;
    if (nt >= SPLIT_MIN) { mode = 1; if (half) top = 64 * tmid; else lo = 64 * tmid; } else if (half) mode = 2;
    if (F.lane == 0) { desc[0] = bh; desc[1] = qb; desc[2] = lo; desc[5] = (int)__float_as_uint(B); desc[6] = top; desc[7] = mode; desc[8] = half; }
}
__device__ __forceinline__ void attn_fast_phase(Frame& F, char* shm) {
    LAS float* kmax2 = (LAS float*)(F.lds + ATT_LDS_DESC); LAS int* desc = (LAS int*)(F.lds + ATT_LDS_DESC + 64);
    const int total = 128, xq = (int)blockIdx.x & 7;
    __syncthreads();
    if (F.tid < 64) { const int bh = F.tid >> 2, wc = F.tid & 3, b = bh >> 3, h = bh & 7; const float* nk = (const float*)(F_ws + WS_NRM) + (size_t)64 * 64;
        float m = 0.f; for (int pm = 0; pm < 32; ++pm) { const float* p = nk + (((size_t)(b * 32 + pm) * 8 + h) * 4 + wc) * 2; m = fmaxf(m, fmaxf(p[0], p[1])); }
        m += __shfl_xor(m, 1); m += __shfl_xor(m, 2); if (wc == 0) kmax2[bh] = m; }
    __syncthreads();
    gu32* ctr0 = (gu32*)(F_ws + WS_CTL) + CW_ATT;
    int n = (int)blockIdx.x >> 3, qsel = xq;
    while (n < total) {
        if (F.wave == 0) fa_describe(F, n, qsel, kmax2, desc);
        __syncthreads();
        const int mode = __builtin_amdgcn_readfirstlane(desc[7]);
        if (mode != 2) {
            const fa::BlockRef cur = fa_ref(F, __builtin_amdgcn_readfirstlane(desc[0]), __builtin_amdgcn_readfirstlane(desc[1]), __builtin_amdgcn_readfirstlane(desc[2]), __builtin_amdgcn_readfirstlane(desc[6]), mode,
                                            __builtin_amdgcn_readfirstlane(desc[8]), __uint_as_float((unsigned)__builtin_amdgcn_readfirstlane(desc[5])));
            fa::fa_block(cur, shm, F.tid);
        }
        if (F.wave == 0) { int nn = total, qs = xq;
            for (int k = 0; k < 8; ++k) { const int q = (xq + k) & 7; int v = 0;
                if (F.lane == 0) v = (((int)F.G + 7 - q) >> 3) + (int)__hip_atomic_fetch_add(ctr0 + 64 * q, 1u, __ATOMIC_RELAXED, __HIP_MEMORY_SCOPE_AGENT);
                v = __builtin_amdgcn_readfirstlane(v); if (v < total) { nn = v; qs = q; break; } }
            if (F.lane == 0) { desc[3] = nn; desc[4] = qs; } }
        __syncthreads();
        n = __builtin_amdgcn_readfirstlane(desc[3]); qsel = __builtin_amdgcn_readfirstlane(desc[4]);
    }
}

__device__ __forceinline__ void attn_ref_phase(Frame& F) {
    const bf16* Q = (const bf16*)(F_ws + WS_Q0); const bf16* K = (const bf16*)(F_ws + WS_K0); const bf16* V = (const bf16*)(F_ws + WS_V0); bf16* O = (bf16*)(F_ws + WS_O0);
    const float* LC = (const float*)(F_ws + WS_LC); const float* TT = (const float*)(F_ws + WS_TT);
    LAS float* Ks = (LAS float*)(F.lds); LAS float* Vs = (LAS float*)(F.lds + 32768); LAS float* cbs = (LAS float*)(F.lds + 65536); LAS float* Pp = (LAS float*)(F.lds + 65536 + 256);
    const int r = F.tid >> 3, part = F.tid & 7;
    const int NU = BATCH * FH * (SEQ / 64);
    for (int unit = (int)blockIdx.x; unit < NU; unit += F.G) {
        const int bh = unit & 15, qb = unit >> 4, b = bh >> 3, h = bh & 7, q0 = qb * 64;
        __syncthreads();
        if (F.tid == 0) { float s = 0.f; for (int t = 0; t < 32; ++t) { Pp[t] = s; s += TT[(b * 32 + t) * 8 + h]; } }
        float q[16], o[16]; float m = -1e30f, l = 0.f;
        { const bf16* qp = Q + (size_t)(b * SEQ + q0 + r) * D + h * FDH + part * 16; const v4u a = *(const v4u*)qp, c = *(const v4u*)(qp + 8);
          q[0] = pg8::bf_lo(a.x); q[1] = pg8::bf_hi(a.x); q[2] = pg8::bf_lo(a.y); q[3] = pg8::bf_hi(a.y); q[4] = pg8::bf_lo(a.z); q[5] = pg8::bf_hi(a.z); q[6] = pg8::bf_lo(a.w); q[7] = pg8::bf_hi(a.w);
          q[8] = pg8::bf_lo(c.x); q[9] = pg8::bf_hi(c.x); q[10] = pg8::bf_lo(c.y); q[11] = pg8::bf_hi(c.y); q[12] = pg8::bf_lo(c.z); q[13] = pg8::bf_hi(c.z); q[14] = pg8::bf_lo(c.w); q[15] = pg8::bf_hi(c.w); }
#pragma unroll
        for (int d = 0; d < 16; ++d) o[d] = 0.f;
        for (int kt = 0; kt <= qb; ++kt) {
            __syncthreads();
            { const size_t go = (size_t)(b * SEQ + kt * 64 + r) * D + h * FDH + part * 16;
              const v4u a = *(const v4u*)(K + go), c = *(const v4u*)(K + go + 8), e = *(const v4u*)(V + go), f = *(const v4u*)(V + go + 8);
              LAS float* kd = Ks + r * 128 + part * 16; LAS float* vd = Vs + r * 128 + part * 16;
              kd[0] = pg8::bf_lo(a.x); kd[1] = pg8::bf_hi(a.x); kd[2] = pg8::bf_lo(a.y); kd[3] = pg8::bf_hi(a.y); kd[4] = pg8::bf_lo(a.z); kd[5] = pg8::bf_hi(a.z); kd[6] = pg8::bf_lo(a.w); kd[7] = pg8::bf_hi(a.w);
              kd[8] = pg8::bf_lo(c.x); kd[9] = pg8::bf_hi(c.x); kd[10] = pg8::bf_lo(c.y); kd[11] = pg8::bf_hi(c.y); kd[12] = pg8::bf_lo(c.z); kd[13] = pg8::bf_hi(c.z); kd[14] = pg8::bf_lo(c.w); kd[15] = pg8::bf_hi(c.w);
              vd[0] = pg8::bf_lo(e.x); vd[1] = pg8::bf_hi(e.x); vd[2] = pg8::bf_lo(e.y); vd[3] = pg8::bf_hi(e.y); vd[4] = pg8::bf_lo(e.z); vd[5] = pg8::bf_hi(e.z); vd[6] = pg8::bf_lo(e.w); vd[7] = pg8::bf_hi(e.w);
              vd[8] = pg8::bf_lo(f.x); vd[9] = pg8::bf_hi(f.x); vd[10] = pg8::bf_lo(f.y); vd[11] = pg8::bf_hi(f.y); vd[12] = pg8::bf_lo(f.z); vd[13] = pg8::bf_hi(f.z); vd[14] = pg8::bf_lo(f.w); vd[15] = pg8::bf_hi(f.w); }
            if (F.tid < 64) { const int key = kt * 64 + F.tid; cbs[F.tid] = ((const float*)(F_ws + WS_CBG))[(size_t)bh * SEQ + key]; }
            __syncthreads();
            const int jmax = (kt == qb) ? r : 63;
            for (int j = 0; j <= jmax; ++j) {
                const LAS float* kr = Ks + j * 128 + part * 16; float dot = 0.f;
#pragma unroll
                for (int d = 0; d < 16; ++d) dot += q[d] * kr[d];
                dot += __shfl_xor(dot, 1); dot += __shfl_xor(dot, 2); dot += __shfl_xor(dot, 4);
                const float s = dot + cbs[j], mn = fmaxf(m, s), al = __builtin_amdgcn_exp2f(m - mn), p = __builtin_amdgcn_exp2f(s - mn);
                l = l * al + p; m = mn;
                const LAS float* vr = Vs + j * 128 + part * 16;
#pragma unroll
                for (int d = 0; d < 16; ++d) o[d] = o[d] * al + p * vr[d];
            }
        }
        const float il = 1.0f / l;
        v4u w0, w1; w0.x = pk2(o[0] * il, o[1] * il); w0.y = pk2(o[2] * il, o[3] * il); w0.z = pk2(o[4] * il, o[5] * il); w0.w = pk2(o[6] * il, o[7] * il);
        w1.x = pk2(o[8] * il, o[9] * il); w1.y = pk2(o[10] * il, o[11] * il); w1.z = pk2(o[12] * il, o[13] * il); w1.w = pk2(o[14] * il, o[15] * il);
        bf16* op = O + (size_t)(b * SEQ + q0 + r) * D + h * FDH + part * 16; *(v4u*)op = w0; *(v4u*)(op + 8) = w1;
    }
    __syncthreads();
}

__device__ __forceinline__ void ret_ref_phase(Frame& F) {
    const bf16* Q1 = (const bf16*)(F_ws + WS_Q1); const bf16* K1 = (const bf16*)(F_ws + WS_K1); bf16* V1 = (bf16*)(F_ws + WS_V1); float* PST = (float*)(F_ws + WS_PST);
    LAS bf16* Qs = (LAS bf16*)(F.lds); LAS bf16* Ks = (LAS bf16*)(F.lds + 32768); LAS float* Sm = (LAS float*)(F.lds + 65536); LAS float* St = (LAS float*)(F.lds + 81920);
    LAS float* Vs = (LAS float*)(F.lds + 114688); LAS float* pw = (LAS float*)(F.lds + 122880);
    for (int unit = (int)blockIdx.x; unit < BATCH * RH * 16; unit += F.G) {
        const int b = unit >> 6, h = (unit >> 4) & 3, vs = unit & 15, v0 = vs * 32;
        const float lg = logf(1.0f - exp2f(-5.0f - (float)h));
        __syncthreads();
        for (int i = F.tid; i < 256 * 32; i += NWAVES * 64) St[i] = 0.f;
        if (F.tid <= 64) pw[F.tid] = expf(lg * (float)F.tid);
        for (int n = 0; n < NCH; ++n) {
            const size_t t0 = (size_t)b * SEQ + (size_t)n * CH;
            __syncthreads();
#pragma unroll
            for (int i = 0; i < 4; ++i) { const int p = F.tid + 512 * i, row = p >> 5, c = p & 31;
                *(LAS v4u*)(Qs + row * 256 + c * 8) = *(const v4u*)(Q1 + (t0 + row) * 1024 + h * 256 + c * 8);
                *(LAS v4u*)(Ks + row * 256 + c * 8) = *(const v4u*)(K1 + (t0 + row) * 1024 + h * 256 + c * 8); }
            { const int idx = F.tid * 4, row = idx >> 5, c = idx & 31; const unsigned long long vv = *(const unsigned long long*)(V1 + (t0 + row) * 2048 + h * 512 + v0 + c);
              const unsigned lo = (unsigned)vv, hi = (unsigned)(vv >> 32); LAS float* d = Vs + row * 32 + c; d[0] = pg8::bf_lo(lo); d[1] = pg8::bf_hi(lo); d[2] = pg8::bf_lo(hi); d[3] = pg8::bf_hi(hi); }
            __syncthreads();
            {
                const int i = F.tid >> 3, j0 = (F.tid & 7) * 8; float a[8];
#pragma unroll
                for (int jj = 0; jj < 8; ++jj) a[jj] = 0.f;
                for (int d = 0; d < 256; d += 2) { const unsigned qw = *(const LAS unsigned*)(Qs + i * 256 + d); const float qa = pg8::bf_lo(qw), qb = pg8::bf_hi(qw);
#pragma unroll
                    for (int jj = 0; jj < 8; ++jj) { const unsigned kw = *(const LAS unsigned*)(Ks + (j0 + jj) * 256 + d); a[jj] += qa * pg8::bf_lo(kw) + qb * pg8::bf_hi(kw); } }
#pragma unroll
                for (int jj = 0; jj < 8; ++jj) { const int dj = i - (j0 + jj); Sm[i * 64 + j0 + jj] = a[jj] * pw[dj < 0 ? -dj : dj]; }
            }
            __syncthreads();
            {
                const int i = F.tid >> 3, vv0 = (F.tid & 7) * 4; float y[4] = {0.f, 0.f, 0.f, 0.f};
                for (int d = 0; d < 256; d += 2) { const unsigned qw = *(const LAS unsigned*)(Qs + i * 256 + d); const float qa = pg8::bf_lo(qw), qb = pg8::bf_hi(qw);
                    const f32x4 s0 = *(const LAS f32x4*)(St + d * 32 + vv0), s1 = *(const LAS f32x4*)(St + (d + 1) * 32 + vv0);
                    y[0] += qa * s0.x + qb * s1.x; y[1] += qa * s0.y + qb * s1.y; y[2] += qa * s0.z + qb * s1.z; y[3] += qa * s0.w + qb * s1.w; }
                const float qd = pw[i + 1];
#pragma unroll
                for (int e = 0; e < 4; ++e) y[e] *= qd;
                for (int j = 0; j < 64; ++j) { const float s = Sm[i * 64 + j]; const f32x4 vv = *(const LAS f32x4*)(Vs + j * 32 + vv0); y[0] += s * vv.x; y[1] += s * vv.y; y[2] += s * vv.z; y[3] += s * vv.w; }
                float ps = (y[0] + y[1]) + (y[2] + y[3]), pq = (y[0] * y[0] + y[1] * y[1]) + (y[2] * y[2] + y[3] * y[3]);
                ps += __shfl_xor(ps, 1); pq += __shfl_xor(pq, 1); ps += __shfl_xor(ps, 2); pq += __shfl_xor(pq, 2); ps += __shfl_xor(ps, 4); pq += __shfl_xor(pq, 4);
                if ((F.tid & 7) == 0) { f32x2 st; st.x = ps; st.y = pq; *(f32x2*)(PST + (((t0 + i) * 4 + h) * 16 + vs) * 2) = st; }
                *(unsigned long long*)(V1 + (t0 + i) * 2048 + h * 512 + v0 + vv0) = (unsigned long long)pk2(y[0], y[1]) | ((unsigned long long)pk2(y[2], y[3]) << 32);
            }
            __syncthreads();
            {
                const int d = F.tid >> 1, vv0 = (F.tid & 1) * 16; float a[16]; const float cd = pw[64];
#pragma unroll
                for (int e = 0; e < 16; ++e) a[e] = St[d * 32 + vv0 + e] * cd;
                for (int j = 0; j < 64; ++j) { const float kd = pg8::bf_lo((unsigned)Ks[j * 256 + d]) * pw[63 - j];
#pragma unroll
                    for (int e = 0; e < 16; e += 4) { const f32x4 vv = *(const LAS f32x4*)(Vs + j * 32 + vv0 + e); a[e] += kd * vv.x; a[e + 1] += kd * vv.y; a[e + 2] += kd * vv.z; a[e + 3] += kd * vv.w; } }
#pragma unroll
                for (int e = 0; e < 16; ++e) St[d * 32 + vv0 + e] = a[e];
            }
        }
    }
    __syncthreads();
}


__device__ __forceinline__ rtn::Ptrs rt_ptrs(Frame& F) {
    rtn::Ptrs P; GAS char* w = (GAS char*)F_ws;
    P.Q = w + WS_Q1; P.K = w + WS_K1; P.V = w + WS_V1; P.L = (GAS char*)F_out; P.PST = (GAS float*)(w + WS_PST); return P;
}
__device__ __forceinline__ void ret_pass1_phase(Frame& F) {
    const rtn::Ptrs P = rt_ptrs(F);
    { const int nit = 8 * (rtn::NG - 1) * 2; p0_late_weights(F, F.G > nit + 16 ? nit : 0); }
    for (int it = (int)blockIdx.x; it < 8 * (rtn::NG - 1) * 2; it += F.G) { const int half = it & 1, r = it >> 1, g = r % (rtn::NG - 1), bh = r / (rtn::NG - 1); rtn::run_item<false>(P, bh, half, g, 0u, F.wave); }
}
__device__ __forceinline__ void ret_pass2_phase(Frame& F) {
    const rtn::Ptrs P = rt_ptrs(F);
    for (int it = (int)blockIdx.x; it < 8 * rtn::NG * 2; it += F.G) { const int half = it & 1, r = it >> 1, g = r % rtn::NG, bh = r / rtn::NG; rtn::run_item<true>(P, bh, half, g, 0u, F.wave); }
}

__device__ __forceinline__ void final_norm_phase(Frame& F) {
    const float* SSQ = (const float*)(F_ws + WS_SSQ); const bf16* XB = (const bf16*)(F_ws + WS_XB);
    const int gw = F.vcu * NWAVES + F.wave, NGW = F.G * NWAVES;
    f32x4 gv[4];
#pragma unroll
    for (int j = 0; j < 4; ++j) gv[j] = ((const f32x4*)F_final_norm)[F.lane + 64 * j];
    for (int row = gw; row < M; row += NGW) {
        float s = (F.lane < 16) ? SSQ[(size_t)row * 16 + F.lane] : 0.f; s = wave_sum(s);
        const float rstd = 1.0f / sqrtf(s * (1.f / D) + EPS);
        const GAS unsigned long long* xr = (const GAS unsigned long long*)(XB + (size_t)row * D) + F.lane;
        GAS f32x4* orow = (GAS f32x4*)(F_out + (size_t)row * D) + F.lane;
#pragma unroll
        for (int j = 0; j < 4; ++j) { const unsigned long long w = xr[64 * j]; const unsigned lo = (unsigned)w, hi = (unsigned)(w >> 32); f32x4 v;
            v.x = pg8::bf_lo(lo); v.y = pg8::bf_hi(lo); v.z = pg8::bf_lo(hi); v.w = pg8::bf_hi(hi); orow[64 * j] = v * rstd * gv[j]; }
    }
}
#ifndef MK_N_LAUNCHES
#define MK_N_LAUNCHES 1
#endif
constexpr int N_LAUNCHES = MK_N_LAUNCHES;
#ifndef REP_PHASE
#define REP_PHASE -1
#endif
#define REPS(k) ((k) == REP_PHASE ? 2 : 1)
#ifndef FAST_ATTN
#define FAST_ATTN 0
#endif
#ifndef FAST_RET
#define FAST_RET 0
#endif
__device__ __forceinline__ bool relaunder(Frame& F) { int t = F.wave * 64 + hw_lane_id(); asm volatile("" : "+v"(t));     F.tid = t; F.lane = t & 63; F.wave = __builtin_amdgcn_readfirstlane(t >> 6); const __attribute__((address_space(4))) Args* a = F.ap; asm volatile("" : "+s"(a)); F.ap = a; return true; }
__global__ void __launch_bounds__(NWAVES * 64, 2) fox_ret_fwd(Args args) {
    extern __shared__ __attribute__((aligned(16))) unsigned char lds[];
    Frame F;
    F.lds = (LAS unsigned char*)lds;
    F.MISC = (volatile LAS unsigned*)(F.lds + MISC_OFF);
    F.tid = threadIdx.x; F.lane = F.tid & 63; F.wave = __builtin_amdgcn_readfirstlane(F.tid >> 6);
    F.G = gridDim.x; { const int bx = blockIdx.x; F.vcu = (F.G % 8 == 0) ? (bx % 8) * (F.G / 8) + bx / 8 : bx; }
    F.ap = (const __attribute__((address_space(4))) Args*)__builtin_amdgcn_kernarg_segment_ptr();
    for (int u = F.tid; u < (LDS_BYTES - LDSCTL_OFF) / 4; u += NWAVES * 64) ((LAS unsigned*)(F.lds + LDSCTL_OFF))[u] = 0u;
    __syncthreads();
    XcdBarrier bar; bar.bar = (unsigned*)(F_ws + WS_CTL) + CW_BAR; bar.x = 0; bar.st = nullptr;
    if (N_LAUNCHES == 1) bar = xcd_barrier_post((unsigned*)(F_ws + WS_CTL) + CW_BAR, F.MISC + 8);
#define GRID_BAR() do { if (N_LAUNCHES == 1) { xcd_barrier(bar); if (REP_PHASE == -2) xcd_barrier(bar); } } while (0)
    const int lo = F.ap->ph_lo, hi = F.ap->ph_hi;
#define IN(k) (lo <= (k) && (k) < hi && relaunder(F))
#define BOTH(k) (IN(k) && IN((k) + 1))
#define ws F_ws
#define XB ((pg8::bf16_t*)(F_ws + WS_XB))
#define SSQ ((float*)(F_ws + WS_SSQ))
    const LAS float* const tab = (const LAS float*)(F.lds + TAB_OFF);

#define RUN_PHASE(k, BODY) if (IN(k)) { BODY; if (REP_PHASE == (k)) { GRID_BAR(); relaunder(F); BODY; } if (BOTH(k)) GRID_BAR(); }
#define RUN_PHASE2(k, BODY, BODY2) if (IN(k)) { BODY; if (REP_PHASE == (k) || REP_PHASE == 100 + (k)) { GRID_BAR(); relaunder(F); BODY2; } if (BOTH(k)) GRID_BAR(); }
#define GEMM_PHASE(EPI, Aptr, Bptr, N_, K_, PRE, ...) do { \
        pg8::Gemm g{(const pg8::bf16_t*)(Aptr), (const pg8::bf16_t*)(Bptr), M, (N_), (K_)}; pg8::StaticOrder S; S.init(M, (N_), F.G, (int)blockIdx.x); \
        PRE; pg8::EPI E{__VA_ARGS__}; \
        pg8::gemm_phase<pg8::EPI, pg8::StaticOrder, true, true>(F.lds + RING_OFF, g, S, E, F.wave); } while (0)
    RUN_PHASE(0, p0_prologue(F))
    RUN_PHASE(1, GEMM_PHASE(EpiQKV0, XB, ws + WS_WQKV0, 3072, 1024, cbg_phase(F); fill_rstd_tab(F, S), (pg8::bf16_t*)(ws + WS_Q0), tab, QSCALE, (float*)(ws + WS_NRM)))
#if FAST_ATTN
    RUN_PHASE(2, attn_fast_phase(F, (char*)lds))
#else
    RUN_PHASE(2, attn_ref_phase(F))
#endif
    RUN_PHASE2(3, GEMM_PHASE(EpiRes, ws + WS_O0, ws + WS_WO0, 1024, 1024, (void)0, XB, SSQ), GEMM_PHASE(EpiRes, ws + WS_O0, ws + WS_WO0, 1024, 1024, (void)0, (pg8::bf16_t*)F_out, (float*)F_out + 8388608))
#if REP_PHASE == 104
    RUN_PHASE2(4, GEMM_PHASE(EpiSwiGLU, XB, ws + WS_WFI0, 2 * DFF, 1024, fill_rstd_tab(F, S), (pg8::bf16_t*)(ws + WS_HID), tab), GEMM_PHASE(EpiNull, XB, ws + WS_WFI0, 2 * DFF, 1024, (void)0, 0))
#else
    RUN_PHASE(4, GEMM_PHASE(EpiSwiGLU, XB, ws + WS_WFI0, 2 * DFF, 1024, fill_rstd_tab(F, S), (pg8::bf16_t*)(ws + WS_HID), tab))
#endif
#if REP_PHASE == 105
    RUN_PHASE2(5, GEMM_PHASE(EpiRes, ws + WS_HID, ws + WS_WFO0, 1024, DFF, (void)0, XB, SSQ), GEMM_PHASE(EpiNull, ws + WS_HID, ws + WS_WFO0, 1024, DFF, (void)0, 0))
#else
    RUN_PHASE2(5, GEMM_PHASE(EpiRes, ws + WS_HID, ws + WS_WFO0, 1024, DFF, (void)0, XB, SSQ), GEMM_PHASE(EpiRes, ws + WS_HID, ws + WS_WFO0, 1024, DFF, (void)0, (pg8::bf16_t*)F_out, (float*)F_out + 8388608))
#endif
    RUN_PHASE(6, GEMM_PHASE(EpiRet, XB, ws + WS_WRI, 4096, 1024, fill_rstd_tab(F, S), (pg8::bf16_t*)(ws + WS_Q1), (pg8::bf16_t*)(ws + WS_K1), (pg8::bf16_t*)(ws + WS_V1), (const float*)(ws + WS_ROPE), tab))
#if FAST_RET
    RUN_PHASE(7, ret_pass1_phase(F))
    RUN_PHASE(8, ret_pass2_phase(F))
#else
    RUN_PHASE(7, (void)0)
    RUN_PHASE(8, ret_ref_phase(F))
#endif
#if REP_PHASE == 109
    RUN_PHASE2(9, GEMM_PHASE(EpiGate, XB, (const pg8::bf16_t*)(ws + WS_WRI) + (size_t)4096 * 1024, 2048, 1024, fill_rstd_tab(F, S); fill_gate_tab(F, S), (pg8::bf16_t*)(ws + WS_V1), tab, (const LAS pg8::f32x2*)(F.lds + STAB_OFF)), GEMM_PHASE(EpiNull, XB, (const pg8::bf16_t*)(ws + WS_WRI) + (size_t)4096 * 1024, 2048, 1024, (void)0, 0))
#else
    RUN_PHASE(9, GEMM_PHASE(EpiGate, XB, (const pg8::bf16_t*)(ws + WS_WRI) + (size_t)4096 * 1024, 2048, 1024, fill_rstd_tab(F, S); fill_gate_tab(F, S), (pg8::bf16_t*)(ws + WS_V1), tab, (const LAS pg8::f32x2*)(F.lds + STAB_OFF)))
#endif
    RUN_PHASE2(10, GEMM_PHASE(EpiRes, ws + WS_V1, ws + WS_WRO, 1024, 2048, (void)0, XB, SSQ), GEMM_PHASE(EpiRes, ws + WS_V1, ws + WS_WRO, 1024, 2048, (void)0, (pg8::bf16_t*)F_out, (float*)F_out + 8388608))
    RUN_PHASE(11, GEMM_PHASE(EpiSwiGLU, XB, ws + WS_WFI1, 2 * DFF, 1024, fill_rstd_tab(F, S), (pg8::bf16_t*)(ws + WS_HID), tab))
    RUN_PHASE2(12, GEMM_PHASE(EpiRes, ws + WS_HID, ws + WS_WFO1, 1024, DFF, (void)0, XB, SSQ), GEMM_PHASE(EpiRes, ws + WS_HID, ws + WS_WFO1, 1024, DFF, (void)0, (pg8::bf16_t*)F_out, (float*)F_out + 8388608))
    if (IN(13)) final_norm_phase(F);
#undef RUN_PHASE
#undef RUN_PHASE2
#undef GEMM_PHASE
#undef IN
#undef ws
#undef XB
#undef SSQ
#undef BOTH
#undef GRID_BAR
}

extern "C" void kernel_launch(void* const* d_in, const int* in_sizes, int n_in, void* d_out, int out_size, void* d_ws, size_t ws_size, hipStream_t stream) {
    static int grid = 0;
    if (grid == 0) {
        if (n_in != 11 || in_sizes[0] != M * D || out_size != M * D || ws_size < WS_END) { fprintf(stderr, "kernel_launch: shape/workspace mismatch (n_in %d, in0 %d, out %d, ws %zu, need %zu)\n", n_in, n_in > 0 ? in_sizes[0] : -1, out_size, ws_size, (size_t)WS_END); grid = -1; return; }
        int dev = 0, cus = 0, per_cu = 0;
        if (hipGetDevice(&dev) != hipSuccess || hipDeviceGetAttribute(&cus, hipDeviceAttributeMultiprocessorCount, dev) != hipSuccess) { fprintf(stderr, "kernel_launch: device query failed\n"); grid = -1; return; }
        if (hipFuncSetAttribute((const void*)fox_ret_fwd, hipFuncAttributeMaxDynamicSharedMemorySize, LDS_BYTES) != hipSuccess) { fprintf(stderr, "kernel_launch: hipFuncSetAttribute failed\n"); grid = -1; return; }
        if (hipOccupancyMaxActiveBlocksPerMultiprocessor(&per_cu, (const void*)fox_ret_fwd, NWAVES * 64, LDS_BYTES) != hipSuccess || per_cu < 1) { fprintf(stderr, "kernel_launch: occupancy query reports %d workgroups per CU\n", per_cu); per_cu = 1; }
        (void)hipGetLastError();
        grid = cus;
        if (grid > 256) grid = 256;
    }
    if (grid < 0) return;
    if (hipMemsetAsync((char*)d_ws + WS_CTL, 0, CTL_ZERO_BYTES, stream) != hipSuccess) { fprintf(stderr, "kernel_launch: hipMemsetAsync failed\n"); return; }
    Args a{};
    for (int i = 0; i < 11; ++i) a.in[i] = (const float*)d_in[i];
    a.out = (float*)d_out; a.wsp = (unsigned char*)d_ws;
    for (int li = 0; li < N_LAUNCHES; ++li) {
        a.ph_lo = (N_LAUNCHES == 1) ? 0 : li; a.ph_hi = (N_LAUNCHES == 1) ? NPHASE : li + 1; a.li = li;
        hipLaunchKernelGGL(fox_ret_fwd, dim3(grid), dim3(NWAVES * 64), LDS_BYTES, stream, a);
        const hipError_t le = hipPeekAtLastError();
        if (le != hipSuccess) { fprintf(stderr, "kernel_launch: launch %d failed: %s\n", li, hipGetErrorName(le)); break; }
    }
}
```

```cpp
#define MK_N_LAUNCHES 1
#define FAST_ATTN 1
#define FAST_RET 1
#include <hip/hip_runtime.h>
#include <cstdio>
#include <cstdint>
#include <cmath>
__device__ __forceinline__ int hw_lane_id() { int l; asm volatile("v_mbcnt_lo_u32_b32 %0, -1, 0\n\tv_mbcnt_hi_u32_b32 %0, -1, %0" : "=v"(l)); return l; }
namespace pg8 {
#define PG8_LAS __attribute__((address_space(3)))
typedef unsigned short bf16_t;
typedef short bf16x8 __attribute__((ext_vector_type(8)));
typedef float f32x4 __attribute__((ext_vector_type(4)));
typedef unsigned u32x4 __attribute__((ext_vector_type(4)));
constexpr int BM = 256, BK = 64, HALF = 128, HTB = HALF * BK * 2  , STAGE_BYTES = 8 * HTB, NXCD = 8, WGM = 8;

__host__ __device__ __forceinline__ int lds_byte(int r, int c) { const int st = (r >> 4) * 2 + (c >> 5), rr = r & 15, cc = c & 31, ob = rr * 64 + cc * 2; return st * 1024 + (ob ^ (((ob >> 9) & 1) << 5)); }
__host__ __device__ __forceinline__ void stage_rc(int b, int& R, int& C) { const int st = b / 1024, sb = b % 1024, swz = sb ^ (((sb >> 9) & 1) << 5); R = (st >> 1) * 16 + swz / 64; C = (st & 1) * 32 + (swz % 64) / 2; }
__host__ __device__ __forceinline__ int perm32(int rho) { const int n = rho >> 4, i = rho & 15; return 8 * (i >> 2) + 4 * n + (i & 3); }

struct Unit { int pm, pn; };
struct Gemm { const bf16_t* A; const bf16_t* Bt; int M, N, K; };

struct StaticOrder {
    int nM, nN, nwg, G, c;
    __host__ __device__ void init(int M, int N, int G_, int c_) { nM = M / BM; nN = N / BM; nwg = nM * nN; G = G_; c = c_; }
    __host__ __device__ bool next(int i, Unit& u) const {
        const long L = (long)i * G + c; if (L >= nwg) return false;
        int wgid = (int)L; { const int q = nwg / NXCD, r = nwg % NXCD, xcd = wgid % NXCD, off = wgid / NXCD; wgid = (xcd < r ? xcd * (q + 1) : r * (q + 1) + (xcd - r) * q) + off; }
        const int nig = WGM * nN, gid = wgid / nig, fm = gid * WGM, gsz = (nM - fm) < WGM ? (nM - fm) : WGM;
        u.pm = fm + ((wgid % nig) % gsz); u.pn = (wgid % nig) / gsz; return true;
    }
    __device__ __forceinline__ void a_ready(const Unit&) const {}
    __device__ __forceinline__ void done(const Unit&) const {}
};
struct StaticOrderHot : StaticOrder {
    __host__ __device__ bool next(int i, Unit& u) const { const bool ok = StaticOrder::next(i, u); u.pm = 0; return ok; }
};

__device__ __forceinline__ unsigned cvt_pk_bf16(float lo, float hi) { unsigned r; asm volatile("v_cvt_pk_bf16_f32 %0, %1, %2" : "=v"(r) : "v"(lo), "v"(hi)); return r; }
typedef float f32x2 __attribute__((ext_vector_type(2)));
__device__ __forceinline__ float silu_f(float x) { return x * __builtin_amdgcn_rcpf(1.0f + __builtin_amdgcn_exp2f(-1.4426950408889634f * x)); }
__device__ __forceinline__ u32x4 pack8f(const f32x4 v0, const f32x4 v1) { u32x4 w; w.x = cvt_pk_bf16(v0[0], v0[1]); w.y = cvt_pk_bf16(v0[2], v0[3]); w.z = cvt_pk_bf16(v1[0], v1[1]); w.w = cvt_pk_bf16(v1[2], v1[3]); return w; }
#ifndef EPI_WT
#define EPI_WT 1
#endif
__device__ __forceinline__ __amdgpu_buffer_rsrc_t epi_rsrc(const void* base, unsigned bytes) { return __builtin_amdgcn_make_buffer_rsrc((void*)base, (short)0, (int)bytes, 0x00020000); }
__device__ __forceinline__ void st16(__amdgpu_buffer_rsrc_t r, unsigned byte_off, u32x4 v) { __builtin_amdgcn_raw_buffer_store_b128(v, r, byte_off, 0, EPI_WT ? 16 : 0); }
__device__ __forceinline__ float bf_lo(unsigned w) { return __builtin_bit_cast(float, w << 16); }
__device__ __forceinline__ float bf_hi(unsigned w) { return __builtin_bit_cast(float, w & 0xffff0000u); }

struct EpiQKV0 {
    static constexpr bool PERM = true, AFTER_DRAIN = false, ACC_INIT = false;
    bf16_t* Q; const PG8_LAS float* tab; float qscale; float* nrm;
    __device__ __forceinline__ void operator()(const f32x4 (&acc)[2][2][4][2], const Unit& u, int ui, int wr, int wc, int fr, int fq) const {
        const int colt = u.pn * BM, t = colt >> 10; const __amdgpu_buffer_rsrc_t rs_ = epi_rsrc(Q + (size_t)t * ((size_t)16384 * 1024), 16384u * 2048u);
        const int cb = (colt & 1023) + wc * 32 + 8 * fq; const float sc = t == 0 ? qscale : 1.f;
        float mx0 = 0.f, mx1 = 0.f;
#pragma unroll
        for (int ai = 0; ai < 2; ++ai)
#pragma unroll
            for (int m = 0; m < 4; ++m) { const int rl = ai * HALF + wr * 64 + m * 16 + fr; const float rs = tab[ui * 256 + rl] * sc;
                const unsigned rowo = (unsigned)((u.pm * BM + rl) * 1024 + cb) * 2u;
#pragma unroll
                for (int bj = 0; bj < 2; ++bj) { const u32x4 w = pack8f(acc[ai][bj][m][0] * rs, acc[ai][bj][m][1] * rs); st16(rs_, rowo + bj * HALF * 2, w);
                    if (t < 2) { float q = (bf_lo(w.x) * bf_lo(w.x) + bf_hi(w.x) * bf_hi(w.x)) + (bf_lo(w.y) * bf_lo(w.y) + bf_hi(w.y) * bf_hi(w.y));
                        q += (bf_lo(w.z) * bf_lo(w.z) + bf_hi(w.z) * bf_hi(w.z)) + (bf_lo(w.w) * bf_lo(w.w) + bf_hi(w.w) * bf_hi(w.w));
                        q += __shfl_xor(q, 16); q += __shfl_xor(q, 32);
                        if (bj == 0) mx0 = fmaxf(mx0, q); else mx1 = fmaxf(mx1, q); } } }
        if (t < 2) {
#pragma unroll
            for (int o = 1; o < 16; o <<= 1) { mx0 = fmaxf(mx0, __shfl_xor(mx0, o)); mx1 = fmaxf(mx1, __shfl_xor(mx1, o)); }
            if (fr == 0 && fq == 0) { const int head = ((colt & 1023) >> 7); float* d = nrm + ((((size_t)t * 64 + u.pm) * 8 + head) * 4 + wc) * 2 + wr; d[0] = mx0; d[8] = mx1; }
        }
    }
};
struct EpiRes {
    static constexpr bool PERM = true, AFTER_DRAIN = false, ACC_INIT = true;
    bf16_t* xb; float* ssq;
    __device__ __forceinline__ void init_issue(u32x4 (&raw)[2][2][4], const Unit& u, int wr, int wc, int fr, int fq) const {
        const int col0 = u.pn * BM + wc * 32 + 8 * fq;
#pragma unroll
        for (int ai = 0; ai < 2; ++ai)
#pragma unroll
            for (int m = 0; m < 4; ++m) { const int row = u.pm * BM + ai * HALF + wr * 64 + m * 16 + fr; const bf16_t* rowp = xb + (size_t)row * 1024 + col0;
#pragma unroll
                for (int bj = 0; bj < 2; ++bj) raw[ai][bj][m] = *(const u32x4*)(rowp + bj * HALF); }
    }
    __device__ __forceinline__ void init_finish(f32x4 (&acc)[2][2][4][2], const u32x4 (&raw)[2][2][4]) const {
#pragma unroll
        for (int ai = 0; ai < 2; ++ai)
#pragma unroll
            for (int bj = 0; bj < 2; ++bj)
#pragma unroll
                for (int m = 0; m < 4; ++m) { const u32x4 b = raw[ai][bj][m];
                    acc[ai][bj][m][0] = (f32x4){bf_lo(b.x), bf_hi(b.x), bf_lo(b.y), bf_hi(b.y)}; acc[ai][bj][m][1] = (f32x4){bf_lo(b.z), bf_hi(b.z), bf_lo(b.w), bf_hi(b.w)}; }
    }
    __device__ __forceinline__ void operator()(const f32x4 (&acc)[2][2][4][2], const Unit& u, int ui, int wr, int wc, int fr, int fq) const {
        const int col0 = u.pn * BM + wc * 32 + 8 * fq; const __amdgpu_buffer_rsrc_t rs_ = epi_rsrc(xb, 16384u * 2048u);
#pragma unroll
        for (int ai = 0; ai < 2; ++ai)
#pragma unroll
            for (int m = 0; m < 4; ++m) { const int row = u.pm * BM + ai * HALF + wr * 64 + m * 16 + fr; const unsigned rowo = (unsigned)(row * 1024 + col0) * 2u; float s = 0.f;
#pragma unroll
                for (int bj = 0; bj < 2; ++bj) { const f32x4 o0 = acc[ai][bj][m][0], o1 = acc[ai][bj][m][1];
                    s += ((o0[0] * o0[0] + o0[1] * o0[1]) + (o0[2] * o0[2] + o0[3] * o0[3])) + ((o1[0] * o1[0] + o1[1] * o1[1]) + (o1[2] * o1[2] + o1[3] * o1[3]));
                    st16(rs_, rowo + bj * HALF * 2, pack8f(o0, o1)); }
                s += __shfl_xor(s, 16); s += __shfl_xor(s, 32);
                if (fq == 0) ssq[(size_t)row * 16 + u.pn * 4 + wc] = s; }
    }
};
struct EpiSwiGLU {
    static constexpr bool PERM = true, AFTER_DRAIN = false, ACC_INIT = false;
    bf16_t* Hd; const PG8_LAS float* tab;
    __device__ __forceinline__ void operator()(const f32x4 (&acc)[2][2][4][2], const Unit& u, int ui, int wr, int wc, int fr, int fq) const {
        const int hc0 = u.pn * HALF + wc * 32 + 8 * fq; const __amdgpu_buffer_rsrc_t rs_ = epi_rsrc(Hd, 16384u * 5632u);
#pragma unroll
        for (int ai = 0; ai < 2; ++ai)
#pragma unroll
            for (int m = 0; m < 4; ++m) { const int rl = ai * HALF + wr * 64 + m * 16 + fr; const float rs = tab[ui * 256 + rl];
                f32x4 h0, h1;
#pragma unroll
                for (int e = 0; e < 4; ++e) { h0[e] = silu_f(acc[ai][0][m][0][e] * rs) * (acc[ai][1][m][0][e] * rs); h1[e] = silu_f(acc[ai][0][m][1][e] * rs) * (acc[ai][1][m][1][e] * rs); }
                st16(rs_, (unsigned)((u.pm * BM + rl) * 2816 + hc0) * 2u, pack8f(h0, h1)); }
    }
};
struct EpiRet {
    static constexpr bool PERM = true, AFTER_DRAIN = false, ACC_INIT = false;
    bf16_t* Q; bf16_t* Kp; bf16_t* V; const float* rope; const PG8_LAS float* tab;
    __device__ __forceinline__ void operator()(const f32x4 (&acc)[2][2][4][2], const Unit& u, int ui, int wr, int wc, int fr, int fq) const {
        if (u.pn < 8) {
            const bool isk = u.pn >= 4; const int head = u.pn & 3; const __amdgpu_buffer_rsrc_t rs_ = epi_rsrc(isk ? Kp : Q, 16384u * 2048u); const float sc = isk ? 0.0625f : 1.f; const int i0 = wc * 32 + 8 * fq;
#pragma unroll
            for (int ai = 0; ai < 2; ++ai)
#pragma unroll
                for (int m = 0; m < 4; ++m) { const int rl = ai * HALF + wr * 64 + m * 16 + fr, row = u.pm * BM + rl; const float rs = tab[ui * 256 + rl] * sc;
                    const f32x4* rp = (const f32x4*)(rope + ((size_t)(row & 8191) * 128 + i0) * 2);
                    f32x4 o1[2], o2[2];
#pragma unroll
                    for (int n = 0; n < 2; ++n) { const f32x4 t1 = acc[ai][0][m][n] * rs, t2 = acc[ai][1][m][n] * rs; const f32x4 ca = rp[2 * n], cb = rp[2 * n + 1];
                        o1[n][0] = t1[0] * ca[0] - t2[0] * ca[1]; o2[n][0] = t1[0] * ca[1] + t2[0] * ca[0];
                        o1[n][1] = t1[1] * ca[2] - t2[1] * ca[3]; o2[n][1] = t1[1] * ca[3] + t2[1] * ca[2];
                        o1[n][2] = t1[2] * cb[0] - t2[2] * cb[1]; o2[n][2] = t1[2] * cb[1] + t2[2] * cb[0];
                        o1[n][3] = t1[3] * cb[2] - t2[3] * cb[3]; o2[n][3] = t1[3] * cb[3] + t2[3] * cb[2]; }
                    const unsigned rowo = (unsigned)(row * 1024 + head * 256 + i0) * 2u;
                    st16(rs_, rowo, pack8f(o1[0], o1[1])); st16(rs_, rowo + HALF * 2, pack8f(o2[0], o2[1]));
                    if (m & 1) asm volatile("" ::: "memory"); }
        } else {
            const int cb = (u.pn - 8) * BM + wc * 32 + 8 * fq; const __amdgpu_buffer_rsrc_t rs_ = epi_rsrc(V, 16384u * 4096u);
#pragma unroll
            for (int ai = 0; ai < 2; ++ai)
#pragma unroll
                for (int m = 0; m < 4; ++m) { const int rl = ai * HALF + wr * 64 + m * 16 + fr; const float rs = tab[ui * 256 + rl];
                    const unsigned rowo = (unsigned)((u.pm * BM + rl) * 2048 + cb) * 2u;
#pragma unroll
                    for (int bj = 0; bj < 2; ++bj) st16(rs_, rowo + bj * HALF * 2, pack8f(acc[ai][bj][m][0] * rs, acc[ai][bj][m][1] * rs)); }
        }
    }
};
struct EpiGate {
    static constexpr bool PERM = true, AFTER_DRAIN = false, ACC_INIT = false;
    bf16_t* Y; const PG8_LAS float* tab; const PG8_LAS f32x2* stab;
    __device__ __forceinline__ void operator()(const f32x4 (&acc)[2][2][4][2], const Unit& u, int ui, int wr, int wc, int fr, int fq) const {
        const int cb = u.pn * BM + wc * 32 + 8 * fq; const __amdgpu_buffer_rsrc_t rs_ = epi_rsrc(Y, 16384u * 4096u);
#pragma unroll
        for (int ai = 0; ai < 2; ++ai)
#pragma unroll
            for (int m = 0; m < 4; ++m) { const int rl = ai * HALF + wr * 64 + m * 16 + fr; const float rs = tab[ui * 256 + rl]; const f32x2 st = stab[ui * 256 + rl];
                bf16_t* rowp = Y + (size_t)(u.pm * BM + rl) * 2048 + cb;
#pragma unroll
                for (int bj = 0; bj < 2; ++bj) { const u32x4 yv = *(const u32x4*)(rowp + bj * HALF); f32x4 y0, y1;
                    y0[0] = bf_lo(yv.x); y0[1] = bf_hi(yv.x); y0[2] = bf_lo(yv.y); y0[3] = bf_hi(yv.y); y1[0] = bf_lo(yv.z); y1[1] = bf_hi(yv.z); y1[2] = bf_lo(yv.w); y1[3] = bf_hi(yv.w);
                    f32x4 g0 = acc[ai][bj][m][0] * rs, g1 = acc[ai][bj][m][1] * rs;
#pragma unroll
                    for (int e = 0; e < 4; ++e) { g0[e] = silu_f(g0[e]) * ((y0[e] - st.x) * st.y); g1[e] = silu_f(g1[e]) * ((y1[e] - st.x) * st.y); }
                    st16(rs_, (unsigned)((u.pm * BM + rl) * 2048 + cb + bj * HALF) * 2u, pack8f(g0, g1)); } }
    }
};
struct EpiNull {
    static constexpr bool PERM = true, AFTER_DRAIN = false, ACC_INIT = false;
    int dummy;
    __device__ __forceinline__ void operator()(const f32x4 (&acc)[2][2][4][2], const Unit& u, int ui, int wr, int wc, int fr, int fq) const {
#pragma unroll
        for (int ai = 0; ai < 2; ++ai)
#pragma unroll
            for (int bj = 0; bj < 2; ++bj)
#pragma unroll
                for (int m = 0; m < 4; ++m) { asm volatile("" :: "v"(acc[ai][bj][m][0]), "v"(acc[ai][bj][m][1])); }
    }
};
template <class Epi, class Sched, bool ALIGN_EPI = false, bool SP2 = false>
__device__ __forceinline__ void gemm_phase(PG8_LAS unsigned char* lds, const Gemm g, const Sched& S, const Epi& E, int wave_in) {
    int tid_ = wave_in * 64 + hw_lane_id(); asm volatile("" : "+v"(tid_));
    const int tid = tid_, wid = __builtin_amdgcn_readfirstlane(tid >> 6), lane = tid & 63, wr = wid >> 2, wc = wid & 3, fr = lane & 15, fq = lane >> 4;
    const int K = g.K, nt = K / BK;
    unsigned voffA[2], voffB[2];
#pragma unroll
    for (int i = 0; i < 2; ++i) { int R, C; stage_rc(tid * 16 + i * 8192, R, C); const int Rb = Epi::PERM ? ((R & ~31) + perm32(R & 31)) : R;
        voffA[i] = (unsigned)(R * K + C) * 2u; voffB[i] = (unsigned)(Rb * K + C) * 2u; }
    const size_t kstep = (size_t)(BK * 2);
    const size_t hstep = (size_t)HALF * K * 2;
    const size_t tstep = 2 * hstep;
    const unsigned ldsw = (unsigned)wid * 1024u;
    const int aoff = lds_byte(wr * 64 + fr, fq * 8), boff = lds_byte(wc * 32 + fr, fq * 8);
#define PG8_SA(b, h) (((b) * 2 + (h)) * HTB)
#define PG8_SB(b, h) ((4 + (b) * 2 + (h)) * HTB)
#define PG8_STAGE(bufoff, gbase, voff) do { _Pragma("unroll") for (int _i = 0; _i < 2; ++_i) \
        __builtin_amdgcn_global_load_lds((const unsigned*)((const char*)(gbase) + (voff)[_i]), (PG8_LAS unsigned*)(lds + (bufoff) + ldsw + _i * 8192), 16, 0, 0); } while (0)
#define PG8_LDA(dst, b, h) do { _Pragma("unroll") for (int m = 0; m < 4; ++m) _Pragma("unroll") for (int k = 0; k < 2; ++k) dst[m][k] = *(const PG8_LAS bf16x8*)(lds + PG8_SA(b, h) + aoff + m * 2048 + k * 1024); } while (0)
#define PG8_LDB(dst, b, h) do { _Pragma("unroll") for (int n = 0; n < 2; ++n) _Pragma("unroll") for (int k = 0; k < 2; ++k) dst[n][k] = *(const PG8_LAS bf16x8*)(lds + PG8_SB(b, h) + boff + n * 2048 + k * 1024); } while (0)
#define PG8_MMA(ai, bj, At, Bt) do { __builtin_amdgcn_s_setprio(1); _Pragma("unroll") for (int m = 0; m < 4; ++m) _Pragma("unroll") for (int n = 0; n < 2; ++n) _Pragma("unroll") for (int k = 0; k < 2; ++k) \
        acc[ai][bj][m][n] = __builtin_amdgcn_mfma_f32_16x16x32_bf16(Bt[n][k], At[m][k], acc[ai][bj][m][n], 0, 0, 0); __builtin_amdgcn_s_setprio(0); } while (0)
#define PG8_WAIT_V(n) asm volatile("s_waitcnt vmcnt(" #n ")" ::: "memory")
#define PG8_WAIT_L(n) asm volatile("s_waitcnt lgkmcnt(" #n ")" ::: "memory")
#define PG8_BAR __builtin_amdgcn_s_barrier()
#define PG8_SCHED __builtin_amdgcn_sched_barrier(0)
    Unit cur, nxt; int ui = 0;
    if (!S.next(0, cur)) return;
    f32x4 acc[2][2][4][2];
    u32x4 raw[2][2][4];
    if constexpr (Epi::ACC_INIT) E.init_issue(raw, cur, wr, wc, fr, fq);
    bf16x8 At[4][2], B0[2][2], B1[2][2];
    const char* cA = (const char*)g.A + (size_t)cur.pm * tstep; const char* cB = (const char*)g.Bt + (size_t)cur.pn * tstep;
    S.a_ready(cur);
    if constexpr (SP2) {
        PG8_STAGE(PG8_SB(0, 0), cB, voffB); PG8_STAGE(PG8_SB(0, 1), cB + hstep, voffB); PG8_STAGE(PG8_SA(0, 0), cA, voffA); PG8_STAGE(PG8_SA(0, 1), cA + hstep, voffA);
        if (wr == 1) PG8_BAR;
        PG8_WAIT_V(2); PG8_BAR;
        PG8_STAGE(PG8_SB(1, 0), cB + kstep, voffB); PG8_STAGE(PG8_SA(1, 0), cA + kstep, voffA); PG8_STAGE(PG8_SB(1, 1), cB + hstep + kstep, voffB);
        PG8_WAIT_V(6); PG8_BAR;
    } else {
        PG8_STAGE(PG8_SB(0, 0), cB, voffB); PG8_STAGE(PG8_SA(0, 0), cA, voffA); PG8_STAGE(PG8_SB(0, 1), cB + hstep, voffB); PG8_STAGE(PG8_SA(0, 1), cA + hstep, voffA);
        if (wr == 1) PG8_BAR;
        PG8_WAIT_V(4); PG8_BAR;
        PG8_STAGE(PG8_SB(1, 0), cB + kstep, voffB); PG8_STAGE(PG8_SA(1, 0), cA + kstep, voffA); PG8_STAGE(PG8_SB(1, 1), cB + hstep + kstep, voffB);
        PG8_WAIT_V(6); PG8_BAR;
    }
    if constexpr (Epi::ACC_INIT) E.init_finish(acc, raw);
    else {
#pragma unroll
        for (int a = 0; a < 2; ++a)
#pragma unroll
            for (int b = 0; b < 2; ++b)
#pragma unroll
                for (int m = 0; m < 4; ++m)
#pragma unroll
                    for (int n = 0; n < 2; ++n) acc[a][b][m][n] = (f32x4){0.f, 0.f, 0.f, 0.f};
    }
    for (;;) {
        const bool has_next = S.next(ui + 1, nxt);
        const char* nA = has_next ? (const char*)g.A + (size_t)nxt.pm * tstep : cA; const char* nB = has_next ? (const char*)g.Bt + (size_t)nxt.pn * tstep : cB;
        for (int t = 0; t < nt; t += 2) {
            const bool last = (t == nt - 2);
            const char* a1 = cA + (size_t)(t + 1) * kstep;
            const char* a2 = last ? nA : cA + (size_t)(t + 2) * kstep; const char* b2 = last ? nB : cB + (size_t)(t + 2) * kstep;
            const char* a3 = a2 + kstep; const char* b3 = b2 + kstep;
            if (last && has_next) S.a_ready(nxt);
            if constexpr (SP2) {
            PG8_LDB(B0, 0, 0); PG8_LDB(B1, 0, 1); PG8_SCHED; PG8_LDA(At, 0, 0); PG8_STAGE(PG8_SA(1, 1), a1 + hstep, voffA);
            PG8_WAIT_V(8); PG8_WAIT_L(0); PG8_BAR; PG8_MMA(0, 0, At, B0); PG8_MMA(0, 1, At, B1); PG8_BAR; PG8_SCHED;
            PG8_LDA(At, 0, 1); PG8_STAGE(PG8_SB(0, 0), b2, voffB); PG8_STAGE(PG8_SB(0, 1), b2 + hstep, voffB); PG8_STAGE(PG8_SA(0, 0), a2, voffA);
            PG8_WAIT_V(8); PG8_WAIT_L(0); PG8_BAR; PG8_MMA(1, 0, At, B0); PG8_MMA(1, 1, At, B1); PG8_BAR; PG8_SCHED;
            PG8_LDB(B0, 1, 0); PG8_LDB(B1, 1, 1); PG8_SCHED; PG8_LDA(At, 1, 0); PG8_STAGE(PG8_SA(0, 1), a2 + hstep, voffA);
            PG8_WAIT_V(8); PG8_WAIT_L(0); PG8_BAR; PG8_MMA(0, 0, At, B0); PG8_MMA(0, 1, At, B1); PG8_BAR; PG8_SCHED;
            PG8_LDA(At, 1, 1); PG8_STAGE(PG8_SB(1, 0), b3, voffB); PG8_STAGE(PG8_SB(1, 1), b3 + hstep, voffB); PG8_STAGE(PG8_SA(1, 0), a3, voffA);
            PG8_WAIT_V(8); PG8_WAIT_L(0); PG8_BAR; PG8_MMA(1, 0, At, B0); PG8_MMA(1, 1, At, B1); PG8_BAR; PG8_SCHED;
            } else {
            PG8_LDB(B0, 0, 0); PG8_SCHED; PG8_LDA(At, 0, 0); PG8_STAGE(PG8_SA(1, 1), a1 + hstep, voffA);
            PG8_WAIT_L(8); PG8_BAR; PG8_WAIT_L(0); PG8_MMA(0, 0, At, B0); PG8_BAR; PG8_SCHED;
            PG8_LDB(B1, 0, 1); PG8_STAGE(PG8_SB(0, 0), b2, voffB);
            PG8_BAR; PG8_WAIT_L(0); PG8_MMA(0, 1, At, B1); PG8_BAR;
            PG8_LDA(At, 0, 1); PG8_STAGE(PG8_SA(0, 0), a2, voffA);
            PG8_BAR; PG8_WAIT_L(0); PG8_MMA(1, 0, At, B0); PG8_BAR; PG8_SCHED;
            PG8_STAGE(PG8_SB(0, 1), b2 + hstep, voffB);
            PG8_WAIT_V(6); PG8_BAR; PG8_MMA(1, 1, At, B1); PG8_BAR;
            PG8_LDB(B0, 1, 0); PG8_SCHED; PG8_LDA(At, 1, 0); PG8_STAGE(PG8_SA(0, 1), a2 + hstep, voffA);
            PG8_WAIT_L(8); PG8_BAR; PG8_WAIT_L(0); PG8_MMA(0, 0, At, B0); PG8_BAR; PG8_SCHED;
            PG8_LDB(B1, 1, 1); PG8_STAGE(PG8_SB(1, 0), b3, voffB);
            PG8_BAR; PG8_WAIT_L(0); PG8_MMA(0, 1, At, B1); PG8_BAR;
            PG8_LDA(At, 1, 1); PG8_STAGE(PG8_SA(1, 0), a3, voffA);
            PG8_BAR; PG8_WAIT_L(0); PG8_MMA(1, 0, At, B0); PG8_BAR; PG8_SCHED;
            PG8_STAGE(PG8_SB(1, 1), b3 + hstep, voffB);
            PG8_WAIT_V(6); PG8_BAR; PG8_MMA(1, 1, At, B1); PG8_BAR;
            }
        }
        if constexpr (ALIGN_EPI) { if (wr == 0) PG8_BAR; }
        if constexpr (!Epi::AFTER_DRAIN) { E(acc, cur, ui, wr, wc, fr, fq); S.done(cur); }
        if (!has_next) break;
        cur = nxt; cA = nA; cB = nB; ++ui;
        if constexpr (Epi::ACC_INIT) { E.init_issue(raw, cur, wr, wc, fr, fq); E.init_finish(acc, raw); }
        else {
#pragma unroll
            for (int a = 0; a < 2; ++a)
#pragma unroll
                for (int b = 0; b < 2; ++b)
#pragma unroll
                    for (int m = 0; m < 4; ++m)
#pragma unroll
                        for (int n = 0; n < 2; ++n) acc[a][b][m][n] = (f32x4){0.f, 0.f, 0.f, 0.f};
        }
        if constexpr (ALIGN_EPI) { if (wr == 1) PG8_BAR; }
    }
    PG8_WAIT_V(0);
    if constexpr (!ALIGN_EPI) { if (wr == 0) PG8_BAR; }
    PG8_BAR;
    if constexpr (Epi::AFTER_DRAIN) { E.fused(acc, cur, wr, wc, fr, fq, lds, wid, lane); S.done(cur); }
#undef PG8_SA
#undef PG8_SB
#undef PG8_STAGE
#undef PG8_LDA
#undef PG8_LDB
#undef PG8_MMA
#undef PG8_WAIT_V
#undef PG8_WAIT_L
#undef PG8_BAR
#undef PG8_SCHED
}
}
constexpr int NWAVES = 8;
constexpr int BATCH = 2, SEQ = 8192, D = 1024, M = BATCH * SEQ;
constexpr int FH = 8, FDH = 128;
constexpr int RH = 4, RDK = 256, RDV = 512, CH = 64, NCH = SEQ / CH;
constexpr int DFF = 2816;
constexpr float EPS = 1e-6f;
constexpr float LOG2E = 1.4426950408889634f;
constexpr float QSCALE = 0.08838834764831845f * LOG2E;
constexpr int NPHASE = 15;

constexpr size_t MiB = 1u << 20;
constexpr size_t WS_CTL = 0, CTL_ZERO_BYTES = 32768;
constexpr size_t WS_SSQ = 1 * MiB;
constexpr size_t WS_LC = 2 * MiB;
constexpr size_t WS_TT = 2 * MiB + 512 * 1024;
constexpr size_t WS_NRM = 2 * MiB + 512 * 1024 + 16384;
constexpr size_t WS_ROPE = 3 * MiB;
constexpr size_t WS_WQKV0 = 11 * MiB;
constexpr size_t WS_WO0 = 17 * MiB;
constexpr size_t WS_WFI0 = 19 * MiB;
constexpr size_t WS_WFO0 = 30 * MiB;
constexpr size_t WS_WRI = 36 * MiB;
constexpr size_t WS_WRO = 48 * MiB;
constexpr size_t WS_WFI1 = 52 * MiB;
constexpr size_t WS_WFO1 = 63 * MiB;
constexpr size_t WS_XB = 69 * MiB;
constexpr size_t WS_ACT = 101 * MiB;
constexpr size_t WS_Q0 = WS_ACT, WS_K0 = WS_ACT + 32 * MiB, WS_V0 = WS_ACT + 64 * MiB;
constexpr size_t WS_O0 = WS_ACT + 96 * MiB;
constexpr size_t WS_HID = WS_ACT;
constexpr size_t WS_Q1 = WS_ACT, WS_K1 = WS_ACT + 32 * MiB, WS_V1 = WS_ACT + 64 * MiB;
constexpr size_t WS_PST = WS_ACT + 128 * MiB;
constexpr size_t WS_CBG = WS_PST;
constexpr size_t WS_LBUF = WS_WQKV0;
constexpr size_t WS_END = WS_PST + 8 * MiB;
static_assert(WS_WFO1 + (size_t)1024 * 2816 * 2 <= WS_XB && WS_HID + (size_t)M * DFF * 2 <= WS_PST && WS_END <= 256 * MiB, "d_ws map");
constexpr int CW_TMO = 0, CW_CODE = 1;
constexpr int CW_BAR = 4096;
constexpr int CW_ATT = 2048;

constexpr int RING_OFF = 0, RING_BYTES = 131072;
constexpr int LDSCTL_OFF = RING_BYTES, MISC_OFF = LDSCTL_OFF + 320;
constexpr int TAB_OFF = RING_BYTES + 512;
constexpr int STAB_OFF = TAB_OFF + 8192;
constexpr int LDS_BYTES = 147456;
static_assert(STAB_OFF + 4096 <= LDS_BYTES, "LDS map");
#define GAS __attribute__((address_space(1)))
#define LAS __attribute__((address_space(3)))
typedef unsigned short bf16;
typedef unsigned v4u __attribute__((ext_vector_type(4)));
typedef float f32x4 __attribute__((ext_vector_type(4)));
typedef short bf16x8 __attribute__((ext_vector_type(8)));
typedef GAS unsigned gu32;
typedef GAS unsigned long long gu64;
#define RLX_AGENT __ATOMIC_RELAXED, __HIP_MEMORY_SCOPE_AGENT
#define LDS_WAIT() asm volatile("s_waitcnt lgkmcnt(0)" ::: "memory")
#define VM_WAIT() asm volatile("s_waitcnt vmcnt(0)" ::: "memory")
__device__ __forceinline__ unsigned long long rt() { return __builtin_amdgcn_s_memrealtime(); }
__device__ __forceinline__ unsigned f2bf(float f) { unsigned u = __builtin_bit_cast(unsigned, f); return (u + 0x7fffu + ((u >> 16) & 1u)) >> 16; }
__device__ __forceinline__ unsigned pk2(float lo, float hi) { return f2bf(lo) | (f2bf(hi) << 16); }
typedef float f32x2 __attribute__((ext_vector_type(2)));
#define XB_TMO      128
#define XB_XCNT(j)  (256  + 64 * (j))
#define XB_XSUB(j)  (1280 + 64 * (j))
#define XB_XGEN(j)  (2304 + 64 * (j))
#define XB_TOP      3328
#define XB_TOPGEN   3392
#define XCD_BAR_WORDS 3456
#define XB_SPIN_CAP (1u << 18)

__device__ __forceinline__ unsigned xb_ld(unsigned* p)              { return __hip_atomic_load(p, __ATOMIC_RELAXED, __HIP_MEMORY_SCOPE_AGENT); }
__device__ __forceinline__ unsigned xb_add(unsigned* p, unsigned v) { return __hip_atomic_fetch_add(p, v, __ATOMIC_RELAXED, __HIP_MEMORY_SCOPE_AGENT); }
__device__ __forceinline__ unsigned xb_xcc_id() { return (unsigned)__builtin_amdgcn_s_getreg((3 << 11) | 20) & 0xFu; }
#define XB_SPIN(cond, bar) do { unsigned _sp = 0; while (cond) { __builtin_amdgcn_s_sleep(1); \
    if ((++_sp & 255u) == 0u) { if (xb_ld(&(bar)[XB_TMO])) break; if (_sp > XB_SPIN_CAP) { atomicAdd(&(bar)[XB_TMO], 1u); break; } } } } while (0)

struct XcdBarrier {
    unsigned* bar; unsigned x;
    volatile LAS unsigned* st;
};

__device__ __forceinline__ XcdBarrier xcd_barrier_post(unsigned* bar, volatile LAS unsigned* st) {
    XcdBarrier b; b.bar = bar; b.x = xb_xcc_id(); b.st = st;
    if (threadIdx.x == 0) (void)xb_add(&bar[XB_XCNT(b.x)], 1u);
    return b;
}
__device__ __forceinline__ void xcd_barrier_complete(unsigned* bar, unsigned x, unsigned& nloc, unsigned& nx) {
    const unsigned G = gridDim.x * gridDim.y * gridDim.z;
    unsigned sum, cnt, mine, sp = 0u;
    for (;;) {
        sum = 0u; cnt = 0u; mine = 0u;
#pragma unroll
        for (unsigned j = 0; j < 16; ++j) { const unsigned c = xb_ld(&bar[XB_XCNT(j)]); sum += c; cnt += (c > 0u) ? 1u : 0u; mine = (j == x) ? c : mine; }
        if (sum == G) break;
        __builtin_amdgcn_s_sleep(1);
        if ((++sp & 255u) == 0u) { if (xb_ld(&bar[XB_TMO])) break; if (sp > XB_SPIN_CAP) { atomicAdd(&bar[XB_TMO], 1u); break; } }
    }
    nloc = mine > 0u ? mine : 1u; nx = cnt > 0u ? cnt : 1u;
}

__device__ __forceinline__ void xcd_barrier(const XcdBarrier& b) {
    asm volatile("s_waitcnt vmcnt(0)" ::: "memory");
    __syncthreads();
    if (threadIdx.x == 0) {
        unsigned* bar = b.bar;
        __builtin_amdgcn_s_waitcnt(0);
        unsigned nloc = b.st[0], nx = b.st[1];
        if (nloc == 0u) { xcd_barrier_complete(bar, b.x, nloc, nx); b.st[0] = nloc; b.st[1] = nx; }
        const unsigned old = xb_add(&bar[XB_XSUB(b.x)], 1u);
        const unsigned gen = old / nloc;
        if (old + 1u == (gen + 1u) * nloc) {
            __builtin_amdgcn_fence(__ATOMIC_RELEASE, "agent");
            asm volatile("s_waitcnt vmcnt(0)" ::: "memory");
            const unsigned og = xb_add(&bar[XB_TOP], 1u);
            const unsigned tg = og / nx;
            if (og + 1u == (tg + 1u) * nx) xb_add(&bar[XB_TOPGEN], 1u);
            else XB_SPIN(xb_ld(&bar[XB_TOPGEN]) == tg, bar);
            __builtin_amdgcn_fence(__ATOMIC_ACQUIRE, "agent");
            xb_add(&bar[XB_XGEN(b.x)], 1u);
            asm volatile("s_waitcnt vmcnt(0)" ::: "memory");
        } else {
            XB_SPIN(xb_ld(&bar[XB_XGEN(b.x)]) == gen, bar);
            __builtin_amdgcn_fence(__ATOMIC_ACQUIRE, "agent");
            asm volatile("s_waitcnt vmcnt(0)" ::: "memory");
        }
    }
    __syncthreads();
}
namespace fa {
constexpr int D = 128, LDQ = 1024;
constexpr float THR = 8.f;
constexpr bool WSKIP = false;
constexpr int NW = 8, QBLK = 32, KVBLK = 64, QB = NW * QBLK;
constexpr int SHM_V = KVBLK * D * 2, SHM_K = KVBLK * D * 2;
constexpr int LDS_BYTES = 131072;
using bf16 = unsigned short;
typedef short bf16x8 __attribute__((ext_vector_type(8)));
typedef short s16x4 __attribute__((ext_vector_type(4)));
typedef float f32x16 __attribute__((ext_vector_type(16)));
typedef float f32x4 __attribute__((ext_vector_type(4)));
typedef unsigned u32x4 __attribute__((ext_vector_type(4)));
#define KSWZ(row, colB) ((row) * 256 + ((colB) ^ (((row) & 7) << 4)))
#define SBAR() __builtin_amdgcn_sched_barrier(0)
__device__ __forceinline__ int v_st(int k, int c) { const int kk = (k & ~0xC) | ((k & 4) << 1) | ((k & 8) >> 1); return ((kk >> 3) * 4 + (c >> 5)) * 512 + ((kk & 7) * 32 + (c & 31)) * 2; }
__device__ __forceinline__ int v_rd_base(int lane) { return ((lane & 3) << 3) | (((lane >> 2) & 3) << 6) | (((lane >> 4) & 1) << 5) | (((lane >> 5) & 1) << 8); }
constexpr int v_rd_off(int d0, int ks, int half) { return d0 * 512 + ks * 4096 + half * 2048; }
__device__ __forceinline__ int crow(int r, int hi) { return (r & 3) + 8 * (r >> 2) + 4 * hi; }
__device__ __forceinline__ unsigned cvtpk(float lo, float hi) {
    unsigned r; asm volatile("v_cvt_pk_bf16_f32 %0, %1, %2" : "=v"(r) : "v"(lo), "v"(hi)); return r;
}
__device__ __forceinline__ bf16x8 pack8(f32x4 a, f32x4 b) {
    u32x4 w = {cvtpk(a[0], a[1]), cvtpk(a[2], a[3]), cvtpk(b[0], b[1]), cvtpk(b[2], b[3])};
    return *reinterpret_cast<bf16x8*>(&w);
}
__device__ __forceinline__ bf16x8 load8(const bf16* p) { return *reinterpret_cast<const bf16x8*>(p); }
__device__ __forceinline__ void mask_tile(f32x16& p0, f32x16& p1, int dq, unsigned W) {
    const float NEG = -__builtin_inff();
#pragma unroll
    for (int r = 0; r < 16; ++r) {
        const int c = (r & 3) + 8 * (r >> 2);
        if ((unsigned)(dq - c) >= W) p0[r] = NEG;
        if ((unsigned)(dq - c - 32) >= W) p1[r] = NEG;
    }
}
__device__ __forceinline__ void partialSM(f32x16& p0, f32x16& p1, float& m_reg, float& mn, float& alpha) {
    float pmax = p0[0]; for (int r = 1; r < 16; ++r) pmax = fmaxf(pmax, p0[r]); for (int r = 0; r < 16; ++r) pmax = fmaxf(pmax, p1[r]);
    { auto rr = __builtin_amdgcn_permlane32_swap(__float_as_uint(pmax), __float_as_uint(pmax), false, false);
      pmax = fmaxf(__uint_as_float(rr[0]), __uint_as_float(rr[1])); }
    if (__builtin_expect(__all((pmax - m_reg) <= THR), 1)) { mn = m_reg; alpha = 1.f; }
    else { mn = fmaxf(m_reg, pmax); alpha = __builtin_amdgcn_exp2f(m_reg - mn); m_reg = mn; }
    for (int r = 0; r < 16; ++r) p0[r] = p0[r] - mn; for (int r = 0; r < 16; ++r) p1[r] = p1[r] - mn;
    for (int r = 0; r < 16; ++r) p0[r] = __builtin_amdgcn_exp2f(p0[r]);
}
__device__ __forceinline__ void finishSM(f32x16& p0, f32x16& p1, float alpha, float& l_reg, bf16x8& pa0, bf16x8& pa1, bf16x8& pa2, bf16x8& pa3) {
    for (int r = 0; r < 16; ++r) p1[r] = __builtin_amdgcn_exp2f(p1[r]);
    float ps = 0; for (int r = 0; r < 16; ++r) ps += p0[r]; for (int r = 0; r < 16; ++r) ps += p1[r];
    { auto rr = __builtin_amdgcn_permlane32_swap(__float_as_uint(ps), __float_as_uint(ps), false, false);
      ps = __uint_as_float(rr[0]) + __uint_as_float(rr[1]); }
    l_reg = l_reg * alpha + ps;
#define PK4(P, B_, OUT) do { unsigned a0 = cvtpk(P[B_+0], P[B_+1]), a1 = cvtpk(P[B_+2], P[B_+3]);                          \
        unsigned b0 = cvtpk(P[B_+4], P[B_+5]), b1 = cvtpk(P[B_+6], P[B_+7]);                                             \
        auto r0 = __builtin_amdgcn_permlane32_swap(a0, b0, false, false); auto r1 = __builtin_amdgcn_permlane32_swap(a1, b1, false, false); \
        u32x4 w = {r0[0], r1[0], r0[1], r1[1]}; OUT = *reinterpret_cast<bf16x8*>(&w); } while (0)
    PK4(p0, 0, pa0); PK4(p0, 8, pa1); PK4(p1, 0, pa2); PK4(p1, 8, pa3);
#undef PK4
}
__device__ __forceinline__ void qkt(f32x16& p0, f32x16& p1, const char* K_slot, int r32, int hi, const bf16x8* qr, const float* cbt) {
#pragma unroll
    for (int g = 0; g < 4; ++g) { const f32x4 a = *(const f32x4*)(cbt + 8 * g + 4 * hi), b = *(const f32x4*)(cbt + 32 + 8 * g + 4 * hi);
        p0[4 * g] = a[0]; p0[4 * g + 1] = a[1]; p0[4 * g + 2] = a[2]; p0[4 * g + 3] = a[3]; p1[4 * g] = b[0]; p1[4 * g + 1] = b[1]; p1[4 * g + 2] = b[2]; p1[4 * g + 3] = b[3]; }
    const char* kb[4];
#pragma unroll
    for (int dd = 0; dd < 4; ++dd) kb[dd] = K_slot + KSWZ(r32, (dd * 16 + hi * 8) * 2);
#pragma unroll
    for (int d0 = 0; d0 < 8; ++d0) { const char* a = kb[d0 & 3] + (d0 >> 2) * 128;
        bf16x8 b0 = *reinterpret_cast<const bf16x8*>(a);
        bf16x8 b1 = *reinterpret_cast<const bf16x8*>(a + 32 * 256);
        p0 = __builtin_amdgcn_mfma_f32_32x32x16_bf16(b0, qr[d0], p0, 0, 0, 0);
        p1 = __builtin_amdgcn_mfma_f32_32x32x16_bf16(b1, qr[d0], p1, 0, 0, 0); }
}
__device__ __forceinline__ void pv_tile(f32x16* o, int vbs, bf16x8 pa0, bf16x8 pa1, bf16x8 pa2, bf16x8 pa3) {
#define TRRD(dst, off) asm volatile("ds_read_b64_tr_b16 %0, %1 offset:%2" : "=&v"(dst) : "v"(vbs), "i"(off) : "memory")
#define PV_D0(d0) do { s16x4 l0, l1, l2, l3, h0, h1, h2, h3; constexpr int b_ = v_rd_off(d0, 0, 0);     \
        TRRD(l0, b_); TRRD(h0, b_ + 2048); TRRD(l1, b_ + 4096); TRRD(h1, b_ + 6144); TRRD(l2, b_ + 8192); TRRD(h2, b_ + 10240); TRRD(l3, b_ + 12288); TRRD(h3, b_ + 14336); \
        asm volatile("s_waitcnt lgkmcnt(0)" ::: "memory"); SBAR();                 \
        o[d0] = __builtin_amdgcn_mfma_f32_32x32x16_bf16(pa0, (bf16x8){l0[0], l0[1], l0[2], l0[3], h0[0], h0[1], h0[2], h0[3]}, o[d0], 0, 0, 0);   \
        o[d0] = __builtin_amdgcn_mfma_f32_32x32x16_bf16(pa1, (bf16x8){l1[0], l1[1], l1[2], l1[3], h1[0], h1[1], h1[2], h1[3]}, o[d0], 0, 0, 0);   \
        o[d0] = __builtin_amdgcn_mfma_f32_32x32x16_bf16(pa2, (bf16x8){l2[0], l2[1], l2[2], l2[3], h2[0], h2[1], h2[2], h2[3]}, o[d0], 0, 0, 0);   \
        o[d0] = __builtin_amdgcn_mfma_f32_32x32x16_bf16(pa3, (bf16x8){l3[0], l3[1], l3[2], l3[3], h3[0], h3[1], h3[2], h3[3]}, o[d0], 0, 0, 0); } while (0)
    PV_D0(0); PV_D0(1); PV_D0(2); PV_D0(3);
#undef PV_D0
#undef TRRD
}

#define FGAS __attribute__((address_space(1)))
struct BlockRef { FGAS char* base; unsigned qo, ko, vo, oo, cbo; int P0, kb0, khi, mode, slot; float Bq; FGAS char* part; FGAS float* pml; FGAS unsigned* cnt; };
constexpr int LDS_VR = 0, LDS_KR = 3 * SHM_V, LDS_CBR = 3 * SHM_V + 3 * SHM_K, LDS_WSR = 131584;
__device__ __forceinline__ void glds16(const FGAS char* gsrc, unsigned lds_dst) {
    unsigned keep; asm volatile("s_mov_b32 %0, m0\n\ts_mov_b32 m0, %2\n\ts_nop 0\n\tglobal_load_lds_dwordx4 %1, off\n\ts_mov_b32 m0, %0" : "=&s"(keep) : "v"(gsrc), "s"(lds_dst) : "memory");
}
#define WAIT_BAR(N) asm volatile("s_waitcnt vmcnt(" #N ") lgkmcnt(0)\n\ts_barrier" ::: "memory")
__device__ __forceinline__ void fa_block(const BlockRef& cur, char* lds, int tid_in) {
    int tid = tid_in; asm volatile("" : "+v"(tid));
    const int wid = __builtin_amdgcn_readfirstlane(tid >> 6), lane = tid & 63, r32 = lane & 31, hi = lane >> 5;
    const int kb0 = cur.kb0, NT0 = (cur.khi - kb0) / KVBLK;
    const int NT = NT0;
    const int qlo = cur.P0 + wid * QBLK, qm = qlo + r32 - 4 * hi;
    float* CBA = (float*)(lds + LDS_CBR);
    float* ws = (float*)(lds + LDS_WSR) + wid * 64; float* li_l = ws, * al_l = ws + 32; float* mm_l = (float*)(lds + LDS_WSR + 2048);
    const unsigned lds0 = (unsigned)(uintptr_t)lds;
    for (int i = tid; i < (cur.khi - kb0) / 4; i += NW * 64) ((f32x4*)CBA)[i] = *(const FGAS f32x4*)(cur.base + cur.cbo + (unsigned)(kb0 * 4) + (unsigned)i * 16u);
    bf16x8 qr[8];
    { const unsigned qoff = (unsigned)(((wid * QBLK + r32) * LDQ + hi * 8) * 2);
#pragma unroll
      for (int d0 = 0; d0 < 8; ++d0) qr[d0] = *(const FGAS bf16x8*)(cur.base + cur.qo + qoff + d0 * 32); }
    asm volatile("s_waitcnt vmcnt(0)" ::: "memory");
    unsigned kso[2], vso[2];
#pragma unroll
    for (int i = 0; i < 2; ++i) { const int p = 2 * wid + i, row = 4 * p + (lane >> 4), c = (lane & 15) ^ (row & 7); kso[i] = (unsigned)(row * (LDQ * 2) + c * 16);
        const int sub = 2 * p + (lane >> 5), kk = 8 * (sub >> 2) + ((lane & 31) >> 2), k = (kk & ~0xC) | ((kk & 4) << 1) | ((kk & 8) >> 1), cc = 32 * (sub & 3) + 8 * (lane & 3); vso[i] = (unsigned)(k * (LDQ * 2) + cc * 2); }
    const FGAS char* Kt = cur.base + cur.ko + (size_t)kb0 * (LDQ * 2); const FGAS char* Vt = cur.base + cur.vo + (size_t)kb0 * (LDQ * 2);
#define DMA_K(t, slot) do { const FGAS char* g_ = Kt + (size_t)(NT0 - 1 - (t)) * (KVBLK * LDQ * 2); const unsigned d_ = (unsigned)__builtin_amdgcn_readfirstlane(lds0 + LDS_KR + (slot) + 2048 * wid); glds16(g_ + kso[0], d_); glds16(g_ + kso[1], d_ + 1024); } while (0)
#define DMA_V(t, slot) do { const FGAS char* g_ = Vt + (size_t)(NT0 - 1 - (t)) * (KVBLK * LDQ * 2); const unsigned d_ = (unsigned)__builtin_amdgcn_readfirstlane(lds0 + LDS_VR + (slot) + 2048 * wid); glds16(g_ + vso[0], d_); glds16(g_ + vso[1], d_ + 1024); } while (0)
    DMA_K(0, 0); DMA_V(0, 0); DMA_K(1, SHM_K);
    float m_reg = -1e30f, l_reg = 0; f32x16 o[4] = {};
    const int vb0 = (int)lds0 + LDS_VR + v_rd_base(lane);
#define RESC(a) do { if (__any((a) < 1.f)) { if (hi == 0) al_l[r32] = (a); asm volatile("s_waitcnt lgkmcnt(0)" ::: "memory");              \
                     for (int d_ = 0; d_ < 4; ++d_) for (int r = 0; r < 16; ++r) o[d_][r] *= al_l[crow(r, hi)]; } } while (0)
#define KBASE(t) (kb0 + (NT0 - 1 - (t)) * KVBLK)
#define MASKT(P0_, P1_, t) do { const int kb_ = KBASE(t); if (kb_ + KVBLK - 1 > qlo) mask_tile(P0_, P1_, qm - kb_, 0x40000000u); } while (0)
    f32x16 pA0, pA1, pB0, pB1; float mnA, mnB, alA, alB; bf16x8 pa0, pa1, pa2, pa3;
    int s_prev = 0, s_cur = 0, s_next = SHM_K;
#define ROT() do { s_prev = s_cur; s_cur = s_next; s_next = (s_next == 2 * SHM_K) ? 0 : s_next + SHM_K; } while (0)
    WAIT_BAR(4);
    DMA_K(2, 2 * SHM_K); DMA_V(1, SHM_V);
    SBAR(); qkt(pA0, pA1, lds + LDS_KR, r32, hi, qr, CBA + (NT0 - 1) * KVBLK);
    MASKT(pA0, pA1, 0); partialSM(pA0, pA1, m_reg, mnA, alA);
    WAIT_BAR(4);
    ROT();
#define STEP(PX0, PX1, mnX, alX, PY0, PY1, alY, t) do {                                                                       \
        { const int s_nn = (s_next == 2 * SHM_K) ? 0 : s_next + SHM_K;                  \
          if ((t) + 2 < NT) DMA_K((t) + 2, s_nn); if ((t) + 1 < NT) DMA_V((t) + 1, s_next); }                                  \
        SBAR(); qkt(PX0, PX1, lds + LDS_KR + s_cur, r32, hi, qr, CBA + (NT0 - 1 - (t)) * KVBLK);                                           \
        finishSM(PY0, PY1, alY, l_reg, pa0, pa1, pa2, pa3); SBAR();                                                           \
        pv_tile(o, vb0 + s_prev, pa0, pa1, pa2, pa3); MASKT(PX0, PX1, (t)); partialSM(PX0, PX1, m_reg, mnX, alX);             \
        RESC(alX);                                                                                                            \
        if ((t) + 2 < NT) WAIT_BAR(4); else if ((t) + 1 < NT) WAIT_BAR(2); else WAIT_BAR(0);                                   \
        ROT(); } while (0)
    int t = 1;
    for (; t + 1 < NT; t += 2) {
        STEP(pB0, pB1, mnB, alB, pA0, pA1, alA, t);
        STEP(pA0, pA1, mnA, alA, pB0, pB1, alB, t + 1);
    }
    if (t < NT) {
        STEP(pB0, pB1, mnB, alB, pA0, pA1, alA, t);
        finishSM(pB0, pB1, alB, l_reg, pa0, pa1, pa2, pa3); SBAR();
    } else {
        finishSM(pA0, pA1, alA, l_reg, pa0, pa1, pa2, pa3); SBAR();
    }
    pv_tile(o, vb0 + s_prev, pa0, pa1, pa2, pa3);
    if (hi == 0) li_l[r32] = l_reg; asm volatile("s_waitcnt lgkmcnt(0)" ::: "memory");
#pragma unroll
    for (int r = 0; r < 16; ++r) { const float rl = __builtin_amdgcn_rcpf(li_l[crow(r, hi)]);
#pragma unroll
        for (int d0 = 0; d0 < 4; ++d0) o[d0][r] *= rl; }
    bool store_o = true;
    if (cur.mode == 1) {
        FGAS char* pp = cur.part + (size_t)cur.slot * 65536 + (unsigned)(wid * 8192 + lane * 16);
#pragma unroll
        for (int q = 0; q < 8; ++q) { u32x4 w;
            w.x = cvtpk(o[q >> 1][8 * (q & 1)], o[q >> 1][8 * (q & 1) + 1]); w.y = cvtpk(o[q >> 1][8 * (q & 1) + 2], o[q >> 1][8 * (q & 1) + 3]);
            w.z = cvtpk(o[q >> 1][8 * (q & 1) + 4], o[q >> 1][8 * (q & 1) + 5]); w.w = cvtpk(o[q >> 1][8 * (q & 1) + 6], o[q >> 1][8 * (q & 1) + 7]);
            *(FGAS u32x4*)(pp + q * 1024) = w; }
        typedef float f32x2 __attribute__((ext_vector_type(2)));
        if (hi == 0) { f32x2 ml; ml.x = m_reg; ml.y = l_reg; *(FGAS f32x2*)(cur.pml + ((size_t)cur.slot * 256 + wid * QBLK + r32) * 2) = ml; }
        asm volatile("s_waitcnt vmcnt(0) lgkmcnt(0)\n\ts_barrier" ::: "memory");
        int* hf = (int*)(lds + LDS_WSR + 2048);
        if (tid == 0) { __builtin_amdgcn_fence(__ATOMIC_RELEASE, "agent"); asm volatile("s_waitcnt vmcnt(0)" ::: "memory");
            const unsigned old = __hip_atomic_fetch_add(cur.cnt, 1u, __ATOMIC_RELAXED, __HIP_MEMORY_SCOPE_AGENT);
            if (old == 1u) { __builtin_amdgcn_fence(__ATOMIC_ACQUIRE, "agent"); asm volatile("s_waitcnt vmcnt(0)" ::: "memory"); }
            hf[0] = (int)old; }
        asm volatile("s_waitcnt vmcnt(0) lgkmcnt(0)\n\ts_barrier" ::: "memory");
        store_o = __builtin_amdgcn_readfirstlane(hf[0]) == 1;
        if (store_o) {
            const int oslot = cur.slot ^ 1;
            if (hi == 0) { const f32x2 mo = *(const FGAS f32x2*)(cur.pml + ((size_t)oslot * 256 + wid * QBLK + r32) * 2);
                const float M = fmaxf(m_reg, mo.x), a = l_reg * __builtin_amdgcn_exp2f(m_reg - M), b = mo.y * __builtin_amdgcn_exp2f(mo.x - M), inv = 1.0f / (a + b);
                li_l[r32] = a * inv; al_l[r32] = b * inv; }
            const FGAS char* po = cur.part + (size_t)oslot * 65536 + (unsigned)(wid * 8192 + lane * 16);
            u32x4 ov[8];
#pragma unroll
            for (int q = 0; q < 8; ++q) ov[q] = *(const FGAS u32x4*)(po + q * 1024);
            asm volatile("s_waitcnt lgkmcnt(0)" ::: "memory");
#pragma unroll
            for (int r = 0; r < 16; ++r) { const float ws_ = li_l[crow(r, hi)], wo_ = al_l[crow(r, hi)];
#pragma unroll
                for (int d0 = 0; d0 < 4; ++d0) { const u32x4 w = ov[2 * d0 + (r >> 3)]; const unsigned wd = (r & 7) < 2 ? w.x : ((r & 7) < 4 ? w.y : ((r & 7) < 6 ? w.z : w.w));
                    const float other = (r & 1) ? __builtin_bit_cast(float, wd & 0xffff0000u) : __builtin_bit_cast(float, wd << 16);
                    o[d0][r] = ws_ * o[d0][r] + wo_ * other; } }
        }
    }
    if (store_o) {
        const unsigned ooff = (unsigned)(((wid * QBLK + 4 * hi) * LDQ + r32) * 2);
#pragma unroll
        for (int r = 0; r < 16; ++r) { FGAS char* orow = cur.base + cur.oo + ((r & 3) + 8 * (r >> 2)) * (LDQ * 2);
#pragma unroll
            for (int d0 = 0; d0 < 4; ++d0) { const float v = o[d0][r]; const float vn = __shfl_xor(v, 1);
                if ((r32 & 1) == 0) *(FGAS unsigned*)(orow + ooff + d0 * 64) = cvtpk(v, vn); } }
    }
    asm volatile("s_waitcnt vmcnt(0) lgkmcnt(0)\n\ts_barrier" ::: "memory");
#undef RESC
#undef KBASE
#undef MASKT
#undef STEP
#undef ROT
#undef DMA_K
#undef DMA_V
}
#undef WAIT_BAR
#undef FGAS
#undef SBAR
#undef KSWZ
}
namespace rtn {
#define RLAS __attribute__((address_space(3)))
#define RGAS __attribute__((address_space(1)))
typedef short bf16x8 __attribute__((ext_vector_type(8)));
typedef short v4i16_t __attribute__((ext_vector_type(4)));
typedef float f32x16 __attribute__((ext_vector_type(16)));
typedef float f32x4 __attribute__((ext_vector_type(4)));
typedef unsigned u32x4 __attribute__((ext_vector_type(4)));
typedef unsigned u32x2 __attribute__((ext_vector_type(2)));
constexpr int NG = 16, RG = 8;
constexpr int LQ = 0, LK = 32768, LV = 65536, LK2 = 98304, LS = 132096, LPW = 140288;
constexpr int LDS_BYTES = LPW + 1024;
__device__ __forceinline__ int crow(int r, int hi) { return (r & 3) + 8 * (r >> 2) + 4 * hi; }
__device__ __forceinline__ unsigned cvtpk(float lo, float hi) { unsigned r; asm volatile("v_cvt_pk_bf16_f32 %0, %1, %2" : "=v"(r) : "v"(lo), "v"(hi)); return r; }
__device__ __forceinline__ float bflo(unsigned w) { return __builtin_bit_cast(float, w << 16); }
__device__ __forceinline__ float bfhi(unsigned w) { return __builtin_bit_cast(float, w & 0xffff0000u); }
__device__ __forceinline__ int off512(int row, int ch) { return 512 * row + 16 * (ch ^ (((row & 3) << 2) | ((row >> 2) & 3))); }
__device__ __forceinline__ int offS(int row, int ch8) { return 128 * row + 16 * (ch8 ^ ((row >> 1) & 7)); }
__device__ __forceinline__ bf16x8 lds128(unsigned a) { return *(const RLAS bf16x8*)(uintptr_t)a; }
__device__ __forceinline__ v4i16_t ldstr(unsigned a) { return __builtin_amdgcn_ds_read_tr16_b64_v4i16((RLAS v4i16_t*)(uintptr_t)a); }
__device__ __forceinline__ void glds16(const RGAS char* gsrc, unsigned lds_dst) {
    unsigned keep; asm volatile("s_mov_b32 %0, m0\n\ts_mov_b32 m0, %2\n\ts_nop 0\n\tglobal_load_lds_dwordx4 %1, off\n\ts_mov_b32 m0, %0" : "=&s"(keep) : "v"(gsrc), "s"(lds_dst) : "memory");
}
__device__ __forceinline__ void stage_tile(const RGAS char* g, unsigned ld_bytes, unsigned lbase, int wave, int lane) {
#pragma unroll
    for (int i = 0; i < 4; ++i) { const int pid = wave * 4 + i, row = 2 * pid + (lane >> 5), ch = (lane & 31) ^ (((row & 3) << 2) | ((row >> 2) & 3));
        glds16(g + (unsigned)row * ld_bytes + (unsigned)ch * 16u, (unsigned)__builtin_amdgcn_readfirstlane(lbase + 1024u * (unsigned)pid)); }
}
#ifndef RT_TOUCH
#define RT_TOUCH 0
#endif
#ifndef RT_TPROBE
#define RT_TPROBE 0
#endif
constexpr int LDUMMY = 145408;
__device__ __forceinline__ void glds4(const RGAS char* gsrc, unsigned lds_dst) {
    unsigned keep; asm volatile("s_mov_b32 %0, m0\n\ts_mov_b32 m0, %2\n\ts_nop 0\n\tglobal_load_lds_dword %1, off\n\ts_mov_b32 m0, %0" : "=&s"(keep) : "v"(gsrc), "s"(lds_dst) : "memory");
}
__device__ __forceinline__ void touch_tile(const RGAS char* g, unsigned ld_bytes, unsigned lds0, int wave, int lane) {
    const unsigned line = (unsigned)((wave & 3) * 64 + lane);
    glds4(g + (line >> 2) * ld_bytes + (line & 3) * 128u, (unsigned)__builtin_amdgcn_readfirstlane(lds0 + LDUMMY + 256u * (unsigned)wave));
}
struct Ptrs { const RGAS char* Q; const RGAS char* K; RGAS char* V; RGAS char* L; RGAS float* PST; };
__device__ __forceinline__ void load_vfrags(bf16x8 (&vf)[4], unsigned vb0, unsigned vb1) {
#pragma unroll
    for (int s = 0; s < 4; ++s) { const v4i16_t lo = ldstr(vb0 + 8192 * s), hi = ldstr(vb1 + 8192 * s + 2048); vf[s] = (bf16x8){lo[0], lo[1], lo[2], lo[3], hi[0], hi[1], hi[2], hi[3]}; }
}
__device__ __forceinline__ void update_state(f32x16 (&X)[8], const bf16x8 (&vf)[4], unsigned kt0, unsigned kt1, unsigned lds0, int hh, float scl) {
    const RLAS float* pwr = (const RLAS float*)(uintptr_t)(lds0 + LPW + 144 * 4);
    v4i16_t fa[3][2][2];
#define RT_LOADB(buf, b) do { _Pragma("unroll") for (int j = 0; j < 2; ++j) { const int dt_ = 2 * ((b) & 3) + j, s_ = (b) >> 2; \
        fa[buf][j][0] = ldstr((kt0 ^ (unsigned)(64 * dt_)) + 8192 * s_); fa[buf][j][1] = ldstr((kt1 ^ (unsigned)(64 * dt_)) + 8192 * s_ + 2048); } } while (0)
    RT_LOADB(0, 0); RT_LOADB(1, 1);
    bf16x8 vs;
#pragma unroll
    for (int b = 0; b < 16; ++b) {
        if (b + 2 < 16) RT_LOADB((b + 2) % 3, b + 2);
        if ((b & 3) == 0) { const int s = b >> 2; const f32x4 f0 = *(const RLAS f32x4*)(pwr + 16 * s + 8 * hh), f1 = *(const RLAS f32x4*)(pwr + 16 * s + 8 * hh + 4);
            const u32x4 w = __builtin_bit_cast(u32x4, vf[s]); u32x4 o;
            o.x = cvtpk(bflo(w.x) * f0[0] * scl, bfhi(w.x) * f0[1] * scl); o.y = cvtpk(bflo(w.y) * f0[2] * scl, bfhi(w.y) * f0[3] * scl);
            o.z = cvtpk(bflo(w.z) * f1[0] * scl, bfhi(w.z) * f1[1] * scl); o.w = cvtpk(bflo(w.w) * f1[2] * scl, bfhi(w.w) * f1[3] * scl);
            vs = __builtin_bit_cast(bf16x8, o); }
        __builtin_amdgcn_sched_barrier(0);
#pragma unroll
        for (int j = 0; j < 2; ++j) { const v4i16_t lo = fa[b % 3][j][0], hi = fa[b % 3][j][1]; const int dt = 2 * (b & 3) + j;
            X[dt] = __builtin_amdgcn_mfma_f32_32x32x16_bf16((bf16x8){lo[0], lo[1], lo[2], lo[3], hi[0], hi[1], hi[2], hi[3]}, vs, X[dt], 0, 0, 0); }
        __builtin_amdgcn_sched_barrier(0);
    }
#undef RT_LOADB
}
__device__ __forceinline__ void dump_state(const f32x16 (&X)[8], RGAS char* L, int wave, int lane, float scl) {
#pragma unroll
    for (int dt = 0; dt < 8; ++dt)
#pragma unroll
        for (int s = 0; s < 2; ++s) { u32x4 o; o.x = cvtpk(X[dt][8 * s] * scl, X[dt][8 * s + 1] * scl); o.y = cvtpk(X[dt][8 * s + 2] * scl, X[dt][8 * s + 3] * scl);
            o.z = cvtpk(X[dt][8 * s + 4] * scl, X[dt][8 * s + 5] * scl); o.w = cvtpk(X[dt][8 * s + 6] * scl, X[dt][8 * s + 7] * scl);
            *(RGAS u32x4*)(L + (unsigned)(wave * 16384 + (2 * dt + s) * 1024 + lane * 16)) = o; }
}
__device__ __forceinline__ void accum_state(f32x16 (&X)[8], const RGAS char* L, int wave, int lane, float dec) {
#pragma unroll
    for (int dt = 0; dt < 8; ++dt)
#pragma unroll
        for (int s = 0; s < 2; ++s) { const u32x4 w = *(const RGAS u32x4*)(L + (unsigned)(wave * 16384 + (2 * dt + s) * 1024 + lane * 16));
            X[dt][8 * s] = X[dt][8 * s] * dec + bflo(w.x); X[dt][8 * s + 1] = X[dt][8 * s + 1] * dec + bfhi(w.x); X[dt][8 * s + 2] = X[dt][8 * s + 2] * dec + bflo(w.y); X[dt][8 * s + 3] = X[dt][8 * s + 3] * dec + bfhi(w.y);
            X[dt][8 * s + 4] = X[dt][8 * s + 4] * dec + bflo(w.z); X[dt][8 * s + 5] = X[dt][8 * s + 5] * dec + bfhi(w.z); X[dt][8 * s + 6] = X[dt][8 * s + 6] * dec + bflo(w.w); X[dt][8 * s + 7] = X[dt][8 * s + 7] * dec + bfhi(w.w); }
}
template <bool FULL>
__device__ __forceinline__ void run_item(const Ptrs& P, int bh, int half, int g, unsigned lds0, int wave_in) {
    int lane0_ = hw_lane_id(); asm volatile("" : "+v"(lane0_));
    const int lane0 = lane0_, wave = wave_in, tid = wave * 64 + lane0;
    const int b = bh >> 2, h = bh & 3;
    const float lg = __logf(1.0f - __builtin_amdgcn_exp2f(-5.0f - (float)h));
    const float cd = __expf(lg * 64.f), cdinv = __expf(-lg * 64.f);
    RLAS float* pw = (RLAS float*)(uintptr_t)(lds0 + LPW);
    __syncthreads();
    if (tid <= 64) pw[tid] = __expf(lg * (float)tid);
    if (tid < 64) { pw[80 + tid] = __expf(lg * (float)(tid + 1)); pw[144 + tid] = __expf(lg * (float)(63 - tid)); }
    const int g16 = lane0 >> 4, blk = g16 & 1, q4 = (lane0 & 15) >> 2, p4 = lane0 & 3, sp = ((p4 & 1) << 1) | (p4 >> 1), hh0 = lane0 >> 5;
    const unsigned trrow = (unsigned)(512 * (8 * hh0 + q4));
    const int fl = (q4 << 2) | (hh0 << 1);
    unsigned vb0_ = lds0 + LV + trrow + 16u * (unsigned)((4 * wave + 2 * blk + (p4 >> 1)) ^ fl) + 8u * (unsigned)(p4 & 1);
    unsigned kt0_ = lds0 + LK + trrow + 16u * (unsigned)((2 * blk + (sp >> 1)) ^ fl) + 8u * (unsigned)(sp & 1);
    unsigned lane_ = (unsigned)lane0;
    const size_t tok0 = (size_t)b * 8192 + (size_t)g * (RG * 64);
    const RGAS char* Qg = P.Q + (tok0 * 1024 + (size_t)h * 256) * 2; const RGAS char* Kg = P.K + (tok0 * 1024 + (size_t)h * 256) * 2;
    RGAS char* Vg = P.V + (tok0 * 2048 + (size_t)h * 512 + (size_t)half * 256) * 2;
    f32x16 X[8];
#pragma unroll
    for (int dt = 0; dt < 8; ++dt) X[dt] = f32x16{};
    if constexpr (FULL) {
        if (g > 0) accum_state(X, P.L + (size_t)((bh * (NG - 1) + g - 1) * 2 + half) * 131072, wave, lane0, 0.f);
    }
#if RT_TPROBE == 3 || RT_TPROBE == 5
    unsigned tq3_ = 0; if (FULL && tid == 0) tq3_ = (unsigned)__builtin_amdgcn_s_memrealtime();
#endif
    float cdm = 1.f, cdim = cdinv;
    __syncthreads();
    if constexpr (FULL) { stage_tile(Qg, 2048, lds0 + LQ, wave, lane0); stage_tile(Vg, 4096, lds0 + LV, wave, lane0); } else { stage_tile(Vg, 4096, lds0 + LV, wave, lane0); }
    stage_tile(Kg, 2048, lds0 + LK, wave, lane0);
    for (int m = 0; m < RG; ++m) {
        const unsigned kb = (m & 1) ? (unsigned)(LK2 - LK) : 0u, vbuf = (!FULL && (m & 1)) ? (unsigned)(LQ - LV) : 0u;
#if RT_TPROBE == 1 || RT_TPROBE == 4
        unsigned tq0_ = 0; if (FULL && tid == 0) tq0_ = (unsigned)__builtin_amdgcn_s_memrealtime();
#endif
        asm volatile("s_waitcnt vmcnt(0)" ::: "memory");
#if RT_TPROBE == 1
        if (FULL && tid == 0) *(RLAS unsigned*)(uintptr_t)(lds0 + 131480) += (unsigned)__builtin_amdgcn_s_memrealtime() - tq0_;
#endif
        __syncthreads();
#if RT_TPROBE == 4
        if (FULL && tid == 0) *(RLAS unsigned*)(uintptr_t)(lds0 + 131480) += (unsigned)__builtin_amdgcn_s_memrealtime() - tq0_;
#endif
#if RT_TPROBE == 5
        if (FULL && tid == 0 && m == 0) *(RLAS unsigned*)(uintptr_t)(lds0 + 131480) += (unsigned)__builtin_amdgcn_s_memrealtime() - tq3_;
#endif
        asm volatile("" : "+v"(vb0_), "+v"(kt0_), "+v"(lane_));
        const unsigned vb0 = vb0_ + vbuf, vb1 = vb0 ^ 16u, kt0 = kt0_ + kb, kt1 = kt0 ^ 16u; const int lane = (int)lane_, hh = lane >> 5, c32 = lane & 31, i16 = lane & 15;
#if RT_TPROBE == 7
        unsigned tq7_ = 0; if (FULL && tid == 0) tq7_ = (unsigned)__builtin_amdgcn_s_memrealtime();
#endif
        if (m + 1 < RG) { stage_tile(Kg + (size_t)(m + 1) * (64 * 2048), 2048, lds0 + LK + ((m & 1) ? 0u : (unsigned)(LK2 - LK)), wave, lane);
            if constexpr (!FULL) stage_tile(Vg + (size_t)(m + 1) * (64 * 4096), 4096, lds0 + ((m & 1) ? (unsigned)LV : (unsigned)LQ), wave, lane); }
        if (RT_TOUCH && m + 2 < RG) {
            if (wave < 4) { if constexpr (FULL) touch_tile(Qg + (size_t)(m + 2) * (64 * 2048), 2048, lds0, wave, lane); touch_tile(Vg + (size_t)(m + 2) * (64 * 4096), 4096, lds0, wave, lane); }
            else touch_tile(Kg + (size_t)(m + 2) * (64 * 2048), 2048, lds0, wave, lane); }
#if RT_TPROBE == 7
        if (FULL && tid == 0) *(RLAS unsigned*)(uintptr_t)(lds0 + 131480) += (unsigned)__builtin_amdgcn_s_memrealtime() - tq7_;
#endif
        bf16x8 vf[4];
        if constexpr (FULL) {
#if RT_TPROBE == 8
            unsigned tq8_ = 0; if (tid == 0) tq8_ = (unsigned)__builtin_amdgcn_s_memrealtime();
#endif
            {
                const int itile = wave >> 1, jt0 = 2 * (wave & 1), qq = lane >> 4;
                const int fS = ((i16 & 3) << 2) | ((i16 >> 2) & 3);
                const unsigned qa = lds0 + LQ + (unsigned)(512 * (16 * itile + i16)) + 16u * (unsigned)(qq ^ fS), ka = lds0 + LK + kb + (unsigned)(512 * (16 * jt0 + i16)) + 16u * (unsigned)(qq ^ fS);
                f32x4 s0 = {0.f, 0.f, 0.f, 0.f}, s1 = {0.f, 0.f, 0.f, 0.f};
#pragma unroll
                for (int s = 0; s < 8; ++s) { const bf16x8 qf = lds128(qa ^ (unsigned)(64 * s)), k0 = lds128(ka ^ (unsigned)(64 * s)), k1 = lds128((ka ^ (unsigned)(64 * s)) + 8192);
                    s0 = __builtin_amdgcn_mfma_f32_16x16x32_bf16(k0, qf, s0, 0, 0, 0); s1 = __builtin_amdgcn_mfma_f32_16x16x32_bf16(k1, qf, s1, 0, 0, 0);
                    if ((s & 3) == 3) asm volatile("" ::: "memory"); }
                const int irow = 16 * itile + i16;
#pragma unroll
                for (int tt = 0; tt < 2; ++tt) { const f32x4 sv = tt ? s1 : s0; const int jb = 16 * (jt0 + tt) + 4 * qq; float e[4];
#pragma unroll
                    for (int r = 0; r < 4; ++r) { const int dj = irow - (jb + r); e[r] = sv[r] * pw[dj < 0 ? -dj : dj]; }
                    u32x2 o; o.x = cvtpk(e[0], e[1]); o.y = cvtpk(e[2], e[3]);
                    *(RLAS u32x2*)(uintptr_t)(lds0 + LS + offS(irow, 2 * (jt0 + tt) + (qq >> 1)) + 8 * (qq & 1)) = o; }
            }
            load_vfrags(vf, vb0, vb1);
            f32x16 Y[2]; Y[0] = f32x16{}; Y[1] = f32x16{};
            const int fQ = ((c32 & 3) << 2) | ((c32 >> 2) & 3);
            const unsigned qr0 = lds0 + LQ + (unsigned)(512 * c32) + 16u * (unsigned)(hh ^ fQ);
#pragma unroll
            for (int dt = 0; dt < 8; ++dt)
#pragma unroll
                for (int s = 0; s < 2; ++s) { u32x4 pb; pb.x = cvtpk(X[dt][8 * s], X[dt][8 * s + 1]); pb.y = cvtpk(X[dt][8 * s + 2], X[dt][8 * s + 3]); pb.z = cvtpk(X[dt][8 * s + 4], X[dt][8 * s + 5]); pb.w = cvtpk(X[dt][8 * s + 6], X[dt][8 * s + 7]);
                    const bf16x8 bq = __builtin_bit_cast(bf16x8, pb); const unsigned a = qr0 ^ (unsigned)(16 * (4 * dt + 2 * s));
                    Y[0] = __builtin_amdgcn_mfma_f32_32x32x16_bf16(lds128(a), bq, Y[0], 0, 0, 0); Y[1] = __builtin_amdgcn_mfma_f32_32x32x16_bf16(lds128(a + 16384), bq, Y[1], 0, 0, 0);
                    if (s == 1 && (dt & 1)) asm volatile("" ::: "memory"); }
#pragma unroll
            for (int it = 0; it < 2; ++it)
#pragma unroll
                for (int rg = 0; rg < 4; ++rg) { const f32x4 f = *(const RLAS f32x4*)(pw + 80 + 32 * it + 8 * rg + 4 * hh);
                    Y[it][4 * rg] *= f[0] * cdm; Y[it][4 * rg + 1] *= f[1] * cdm; Y[it][4 * rg + 2] *= f[2] * cdm; Y[it][4 * rg + 3] *= f[3] * cdm; }
#if RT_TPROBE == 8
            if (tid == 0) *(RLAS unsigned*)(uintptr_t)(lds0 + 131480) += (unsigned)__builtin_amdgcn_s_memrealtime() - tq8_;
#endif
#if RT_TPROBE == 2
            unsigned tq1_ = 0; if (tid == 0) tq1_ = (unsigned)__builtin_amdgcn_s_memrealtime();
#endif
            asm volatile("s_waitcnt lgkmcnt(0)" ::: "memory"); __builtin_amdgcn_s_barrier(); asm volatile("" ::: "memory");
#if RT_TPROBE == 2
            if (tid == 0) *(RLAS unsigned*)(uintptr_t)(lds0 + 131480) += (unsigned)__builtin_amdgcn_s_memrealtime() - tq1_;
#endif
            if (m + 1 < RG) { stage_tile(Qg + (size_t)(m + 1) * (64 * 2048), 2048, lds0 + LQ, wave, lane); stage_tile(Vg + (size_t)(m + 1) * (64 * 4096), 4096, lds0 + LV, wave, lane); }
            const unsigned sr0 = lds0 + LS + (unsigned)(128 * c32) + 16u * (unsigned)(hh ^ ((c32 >> 1) & 7));
            const unsigned sr1 = lds0 + LS + (unsigned)(128 * (32 + c32)) + 16u * (unsigned)(hh ^ (((32 + c32) >> 1) & 7));
#pragma unroll
            for (int s = 0; s < 4; ++s) { Y[0] = __builtin_amdgcn_mfma_f32_32x32x16_bf16(lds128(sr0 ^ (unsigned)(32 * s)), vf[s], Y[0], 0, 0, 0);
                Y[1] = __builtin_amdgcn_mfma_f32_32x32x16_bf16(lds128(sr1 ^ (unsigned)(32 * s)), vf[s], Y[1], 0, 0, 0); }
#if RT_TPROBE == 6
            unsigned tq6_ = 0; if (tid == 0) tq6_ = (unsigned)__builtin_amdgcn_s_memrealtime();
#endif
            const size_t tokm = tok0 + (size_t)m * 64;
            RGAS char* yb = P.V + ((tokm * 2048 + (size_t)h * 512 + (size_t)half * 256 + (size_t)wave * 32) * 2);
#pragma unroll
            for (int it = 0; it < 2; ++it) {
#pragma unroll
                for (int r = 0; r < 16; ++r) { const float v = Y[it][r], vn = __shfl_xor(v, 1);
                    if ((c32 & 1) == 0) *(RGAS unsigned*)(yb + (unsigned)(32 * it + crow(r, hh)) * 4096u + (unsigned)c32 * 2u) = cvtpk(v, vn); }
                const bool b4 = (c32 & 16) != 0, b3 = (c32 & 8) != 0, b2 = (c32 & 4) != 0, b1 = (c32 & 2) != 0;
                float c1[8], c2[8], d1[4], d2[4], e1[2], e2[2];
#pragma unroll
                for (int k = 0; k < 8; ++k) { const float lo = Y[it][k], hi = Y[it][8 + k], lo2 = lo * lo, hi2 = hi * hi;
                    c1[k] = (b4 ? hi : lo) + __shfl_xor(b4 ? lo : hi, 16); c2[k] = (b4 ? hi2 : lo2) + __shfl_xor(b4 ? lo2 : hi2, 16); }
#pragma unroll
                for (int k = 0; k < 4; ++k) { d1[k] = (b3 ? c1[4 + k] : c1[k]) + __shfl_xor(b3 ? c1[k] : c1[4 + k], 8); d2[k] = (b3 ? c2[4 + k] : c2[k]) + __shfl_xor(b3 ? c2[k] : c2[4 + k], 8); }
#pragma unroll
                for (int k = 0; k < 2; ++k) { e1[k] = (b2 ? d1[2 + k] : d1[k]) + __shfl_xor(b2 ? d1[k] : d1[2 + k], 4); e2[k] = (b2 ? d2[2 + k] : d2[k]) + __shfl_xor(b2 ? d2[k] : d2[2 + k], 4); }
                float s1 = (b1 ? e1[1] : e1[0]) + __shfl_xor(b1 ? e1[0] : e1[1], 2), s2 = (b1 ? e2[1] : e2[0]) + __shfl_xor(b1 ? e2[0] : e2[1], 2);
                s1 += __shfl_xor(s1, 1); s2 += __shfl_xor(s2, 1);
                if ((c32 & 1) == 0) { typedef float f32x2 __attribute__((ext_vector_type(2))); f32x2 st; st.x = s1; st.y = s2; const int row = 32 * it + crow((c32 >> 1) & 15, hh);
                    *(RGAS f32x2*)(P.PST + (((tokm + row) * 4 + h) * 16 + half * 8 + wave) * 2) = st; }
            }
#if RT_TPROBE == 6
            if (tid == 0) *(RLAS unsigned*)(uintptr_t)(lds0 + 131480) += (unsigned)__builtin_amdgcn_s_memrealtime() - tq6_;
#endif
        } else {
            load_vfrags(vf, vb0, vb1);
        }
#if RT_TPROBE == 9
        unsigned tq9_ = 0; if (FULL && tid == 0) tq9_ = (unsigned)__builtin_amdgcn_s_memrealtime();
#endif
        update_state(X, vf, kt0, kt1, lds0, hh, cdim);
#if RT_TPROBE == 9
        if (FULL && tid == 0) *(RLAS unsigned*)(uintptr_t)(lds0 + 131480) += (unsigned)__builtin_amdgcn_s_memrealtime() - tq9_;
#endif
        cdm *= cd; cdim *= cdinv;
    }
    __syncthreads();
#if RT_TPROBE == 3
    if (FULL && tid == 0) *(RLAS unsigned*)(uintptr_t)(lds0 + 131480) += (unsigned)__builtin_amdgcn_s_memrealtime() - tq3_;
#endif
    if constexpr (!FULL) dump_state(X, P.L + (size_t)((bh * (NG - 1) + g) * 2 + half) * 131072, wave, lane0, cdm);
}
#undef RLAS
#undef RGAS
}
struct Args { const float* in[11]; float* out; unsigned char* wsp; int ph_lo, ph_hi, li, pad; };
struct Frame {
    LAS unsigned char* lds;
    volatile LAS unsigned* MISC;
    int tid, lane, wave;
    int vcu, G;
    const __attribute__((address_space(4))) Args* ap;
};
#define FP(i) (F.ap->in[i])
#define F_x FP(0)
#define F_norm_mix FP(1)
#define F_norm_ffn FP(2)
#define F_fox_w_in FP(3)
#define F_fox_b_f FP(4)
#define F_fox_w_out FP(5)
#define F_ret_w_in FP(6)
#define F_ret_w_out FP(7)
#define F_ffn_w_in FP(8)
#define F_ffn_w_out FP(9)
#define F_final_norm FP(10)
#define F_out (F.ap->out)
#define F_ws (F.ap->wsp)
__device__ __forceinline__ float wave_sum(float v) {
#pragma unroll
    for (int o = 1; o < 64; o <<= 1) v += __shfl_xor(v, o);
    return v;
}

__device__ __forceinline__ void p0_item(const float* W, int K, int Nsrc, int scol0, bf16* WT, int drow0, int k0, const float* g, LAS float* scr, int lane) {
    const int nq = lane & 7, kr = lane >> 3;
    f32x4 v[8];
#pragma unroll
    for (int i = 0; i < 8; ++i) v[i] = *(const GAS f32x4*)(W + (size_t)(k0 + kr + 8 * i) * Nsrc + scol0 + 4 * nq);
#pragma unroll
    for (int i = 0; i < 8; ++i) { const int kk = kr + 8 * i; const float gv = g ? g[k0 + kk] : 1.f; LAS float* d = scr + kk * 33 + 4 * nq;
        d[0] = v[i].x * gv; d[1] = v[i].y * gv; d[2] = v[i].z * gv; d[3] = v[i].w * gv; }
    LDS_WAIT(); asm volatile("" ::: "memory");
    const int c = lane & 7;
#pragma unroll
    for (int j = 0; j < 4; ++j) { const int n = (lane >> 3) + 8 * j; const LAS float* s = scr + (8 * c) * 33 + n;
        v4u o; o.x = pk2(s[0 * 33], s[1 * 33]); o.y = pk2(s[2 * 33], s[3 * 33]); o.z = pk2(s[4 * 33], s[5 * 33]); o.w = pk2(s[6 * 33], s[7 * 33]);
        *(GAS v4u*)(WT + (size_t)(drow0 + n) * K + k0 + 8 * c) = o; }
    LDS_WAIT(); asm volatile("" ::: "memory");
}
__device__ __forceinline__ void p0_matrix(int r, const float* W, int K, int N, int Nsrc, bool swiglu, bf16* WT, const float* g, LAS float* scr, int lane) {
    const int nblk = N / 32, kb = r / nblk, nb = r % nblk, drow0 = 32 * nb;
    int scol0 = drow0;
    if (swiglu) { const int t = drow0 >> 8, rr = drow0 & 255; scol0 = (rr < 128) ? t * 128 + rr : DFF + t * 128 + (rr - 128); }
    p0_item(W, K, Nsrc, scol0, WT, drow0, 64 * kb, g, scr, lane);
}
__device__ __forceinline__ void p0_xtile(Frame& F, int tile) {
    LAS float* wfs = (LAS float*)(F.lds);
    LAS float* tot = (LAS float*)(F.lds + 32768);
#pragma unroll
    for (int kk = 0; kk < 2; ++kk) { const int k = F.tid + 512 * kk; const float gk = F_norm_mix[k];
        const f32x4 w0 = *(const GAS f32x4*)(F_fox_w_in + (size_t)k * 3080 + 3072), w1 = *(const GAS f32x4*)(F_fox_w_in + (size_t)k * 3080 + 3076);
        wfs[k] = w0.x * gk; wfs[1024 + k] = w0.y * gk; wfs[2048 + k] = w0.z * gk; wfs[3072 + k] = w0.w * gk; wfs[4096 + k] = w1.x * gk; wfs[5120 + k] = w1.y * gk; wfs[6144 + k] = w1.z * gk; wfs[7168 + k] = w1.w * gk; }
    __syncthreads();
    const int myh = (F.lane >> 3) & 7;
    const float bfv = F_fox_b_f[myh];
    bf16* XB = (bf16*)(F_ws + WS_XB); float* SSQ = (float*)(F_ws + WS_SSQ);
    const int row0 = tile * 64 + F.wave * 8;
    const bool b5 = (F.lane & 32) != 0, b4 = (F.lane & 16) != 0, b3 = (F.lane & 8) != 0;
    float run = 0.f, mine[8];
    f32x4 v[4], vn[4];
    { const GAS f32x4* xr = (const GAS f32x4*)(F_x + (size_t)row0 * D) + F.lane;
#pragma unroll
      for (int j = 0; j < 4; ++j) vn[j] = xr[64 * j]; }
#pragma unroll
    for (int i = 0; i < 8; ++i) {
        const int row = row0 + i;
#pragma unroll
        for (int j = 0; j < 4; ++j) v[j] = vn[j];
        if (i < 7) { const GAS f32x4* xr = (const GAS f32x4*)(F_x + (size_t)(row + 1) * D) + F.lane;
#pragma unroll
            for (int j = 0; j < 4; ++j) vn[j] = xr[64 * j]; }
        float ss = 0.f;
#pragma unroll
        for (int j = 0; j < 4; ++j) ss += (v[j].x * v[j].x + v[j].y * v[j].y) + (v[j].z * v[j].z + v[j].w * v[j].w);
        GAS unsigned long long* o8 = (GAS unsigned long long*)(XB + (size_t)row * D) + F.lane;
#pragma unroll
        for (int j = 0; j < 4; ++j) o8[64 * j] = (unsigned long long)pk2(v[j].x, v[j].y) | ((unsigned long long)pk2(v[j].z, v[j].w) << 32);
        float a[8];
#pragma unroll
        for (int h = 0; h < 8; ++h) { float acc = 0.f;
#pragma unroll
            for (int j = 0; j < 4; ++j) { const f32x4 w = *(const LAS f32x4*)(wfs + h * 1024 + 4 * (F.lane + 64 * j)); acc += (v[j].x * w.x + v[j].y * w.y) + (v[j].z * w.z + v[j].w * w.w); }
            a[h] = acc; }
        ss = wave_sum(ss);
        float c[4], d[2];
#pragma unroll
        for (int k = 0; k < 4; ++k) c[k] = (b5 ? a[4 + k] : a[k]) + __shfl_xor(b5 ? a[k] : a[4 + k], 32);
#pragma unroll
        for (int k = 0; k < 2; ++k) d[k] = (b4 ? c[2 + k] : c[k]) + __shfl_xor(b4 ? c[k] : c[2 + k], 16);
        float e = (b3 ? d[1] : d[0]) + __shfl_xor(b3 ? d[0] : d[1], 8);
        e += __shfl_xor(e, 4); e += __shfl_xor(e, 2); e += __shfl_xor(e, 1);
        const float rstd = 1.0f / sqrtf(ss * (1.f / D) + EPS);
        if (F.lane < 16) SSQ[(size_t)row * 16 + F.lane] = (F.lane == 0) ? ss : 0.f;
        const float z = e * rstd + bfv; const float lf = fminf(z, 0.f) - log1pf(__expf(-fabsf(z)));
        run += lf; mine[i] = run;
    }
    if ((F.lane & 7) == 0) tot[F.wave * 8 + myh] = run;
    __syncthreads();
    float* LC = (float*)(F_ws + WS_LC); float* TT = (float*)(F_ws + WS_TT);
    if ((F.lane & 7) == 0) { float off = 0.f; for (int w = 0; w < F.wave; ++w) off += tot[w * 8 + myh];
#pragma unroll
        for (int i = 0; i < 8; ++i) LC[(size_t)(row0 + i) * 8 + myh] = mine[i] + off; }
    if (F.tid < 8) { float s = 0.f; for (int w = 0; w < 8; ++w) s += tot[w * 8 + F.tid]; TT[tile * 8 + F.tid] = s; }
    __syncthreads();
}
__device__ __forceinline__ void p0_prologue(Frame& F) {
    for (int t = (int)blockIdx.x; t < M / 64; t += F.G) p0_xtile(F, t);
    LAS float* scr = (LAS float*)(F.lds + RING_OFF + F.wave * 16384);
    const int gw = F.vcu * NWAVES + F.wave, NGW = F.G * NWAVES;
    constexpr int I0 = 16 * 96, I1 = 16 * 32, I2 = 16 * 176, I3 = 44 * 32, I4 = 16 * 192, I5 = 32 * 32;
    constexpr int NITEMS = I0 + I1 + I2 + I3 + I4 + I5;
    unsigned char* ws = F_ws;
    for (int it = gw; it < NITEMS; it += NGW) {
        int r = it;
        if (r < I0) { p0_matrix(r, F_fox_w_in, 1024, 3072, 3080, false, (bf16*)(ws + WS_WQKV0), F_norm_mix, scr, F.lane); continue; } r -= I0;
        if (r < I1) { p0_matrix(r, F_fox_w_out, 1024, 1024, 1024, false, (bf16*)(ws + WS_WO0), nullptr, scr, F.lane); continue; } r -= I1;
        if (r < I2) { p0_matrix(r, F_ffn_w_in, 1024, 2 * DFF, 2 * DFF, true, (bf16*)(ws + WS_WFI0), F_norm_ffn, scr, F.lane); continue; } r -= I2;
        if (r < I3) { p0_matrix(r, F_ffn_w_out, DFF, 1024, 1024, false, (bf16*)(ws + WS_WFO0), nullptr, scr, F.lane); continue; } r -= I3;
        if (r < I4) { p0_matrix(r, F_ret_w_in, 1024, 6144, 6144, false, (bf16*)(ws + WS_WRI), F_norm_mix + D, scr, F.lane); continue; } r -= I4;
        p0_matrix(r, F_ret_w_out, 2048, 1024, 1024, false, (bf16*)(ws + WS_WRO), nullptr, scr, F.lane);
    }
    float* rope = (float*)(ws + WS_ROPE);
    {
        const int idx0 = F.vcu * (NWAVES * 64) + F.tid;
        const float inv = (float)exp2(-(double)(idx0 & 127) * (13.287712379549449 / 128.0));
        for (int idx = idx0; idx < SEQ * 128; idx += F.G * NWAVES * 64) {
            const float ang = (float)(idx >> 7) * inv;
            const double t = (double)ang * 0.15915494309189535; const float fr = (float)(t - rint(t));
            f32x2 cs; cs.x = __builtin_amdgcn_cosf(fr); cs.y = __builtin_amdgcn_sinf(fr);
            *(f32x2*)(rope + (size_t)idx * 2) = cs;
        }
    }
}

__device__ __forceinline__ void p0_late_weights(Frame& F, int first) {
    const int nwg = F.G - first; if ((int)blockIdx.x < first || nwg <= 0) return;
    LAS float* scr = (LAS float*)(F.lds + RING_OFF + F.wave * 16384);
    const int gw = ((int)blockIdx.x - first) * NWAVES + F.wave, NGW = nwg * NWAVES;
    constexpr int I6 = 16 * 176, I7 = 44 * 32;
    unsigned char* ws = F_ws;
    for (int it = gw; it < I6 + I7; it += NGW) {
        if (it < I6) p0_matrix(it, F_ffn_w_in + (size_t)D * 2 * DFF, 1024, 2 * DFF, 2 * DFF, true, (bf16*)(ws + WS_WFI1), F_norm_ffn + D, scr, F.lane);
        else p0_matrix(it - I6, F_ffn_w_out + (size_t)DFF * D, DFF, 1024, 1024, false, (bf16*)(ws + WS_WFO1), nullptr, scr, F.lane);
    }
}

__device__ __forceinline__ void fill_rstd_tab(Frame& F, const pg8::StaticOrder& S) {
    LAS float* tab = (LAS float*)(F.lds + TAB_OFF); const float* SSQ = (const float*)(F_ws + WS_SSQ);
    pg8::Unit u;
    for (int i = 0; i < 8 && S.next(i, u); ++i) if (F.tid < 256) {
        const f32x4* p = (const f32x4*)(SSQ + (size_t)(u.pm * 256 + F.tid) * 16); const f32x4 a = p[0], b = p[1], c = p[2], d = p[3];
        const float s = ((a.x + a.y) + (a.z + a.w)) + ((b.x + b.y) + (b.z + b.w)) + ((c.x + c.y) + (c.z + c.w)) + ((d.x + d.y) + (d.z + d.w));
        tab[i * 256 + F.tid] = 1.0f / sqrtf(s * (1.f / D) + EPS); }
    __syncthreads();
}
__device__ __forceinline__ void fill_gate_tab(Frame& F, const pg8::StaticOrder& S) {
    LAS f32x2* stab = (LAS f32x2*)(F.lds + STAB_OFF); const float* PST = (const float*)(F_ws + WS_PST);
    pg8::Unit u;
    for (int i = 0; i < 2 && S.next(i, u); ++i) if (F.tid < 256) {
        const f32x4* p = (const f32x4*)(PST + ((size_t)(u.pm * 256 + F.tid) * 4 + (u.pn >> 1)) * 32); float s = 0.f, q = 0.f;
#pragma unroll
        for (int j = 0; j < 8; ++j) { const f32x4 v = p[j]; s += v.x + v.z; q += v.y + v.w; }
        const float mu = s * (1.f / RDV), var = fmaxf(q * (1.f / RDV) - mu * mu, 0.f);
        f32x2 st; st.x = mu; st.y = 1.0f / sqrtf(var + EPS); stab[i * 256 + F.tid] = st; }
    __syncthreads();
}


__device__ __forceinline__ void cbg_phase(Frame& F) {
    const float* LC = (const float*)(F_ws + WS_LC); const float* TT = (const float*)(F_ws + WS_TT); float* CBG = (float*)(F_ws + WS_CBG);
    LAS float* pre = (LAS float*)(F.lds);
    for (int item = (int)blockIdx.x; item < 16 * 16; item += F.G) {
        const int bh = item >> 4, seg = item & 15, b = bh >> 3, h = bh & 7, s = seg * 512 + F.tid;
        __syncthreads();
        if (F.tid < 128) pre[F.tid] = TT[(b * 128 + F.tid) * 8 + h];
        __syncthreads();
        if (F.tid == 0) { float p = 0.f; for (int t = 0; t < 128; ++t) { const float v = pre[t]; pre[t] = p; p += v; } }
        __syncthreads();
        CBG[(size_t)bh * SEQ + s] = -(pre[s >> 6] + LC[(size_t)(b * SEQ + s) * 8 + h]) * LOG2E;
    }
    __syncthreads();
}
constexpr size_t WS_PML = WS_END;
static_assert(WS_PML + 2 * MiB <= 256 * MiB, "pml");
constexpr int CW_SPL = 3072;
__device__ __forceinline__ fa::BlockRef fa_ref(Frame& F, int bh, int qb, int kb0, int khi, int mode, int half, float Bq, int rep) {
    const int b = bh >> 3, h = bh & 7; fa::BlockRef r; r.base = (GAS char*)F_ws;
    const unsigned ro = (unsigned)(((b * SEQ + qb * 256) * 1024 + h * 128) * 2), ho = (unsigned)((b * SEQ * 1024 + h * 128) * 2);
    r.qo = (unsigned)WS_Q0 + ro; r.oo = (unsigned)WS_O0 + ro; r.ko = (unsigned)WS_K0 + ho; r.vo = (unsigned)WS_V0 + ho;
    r.cbo = (unsigned)WS_CBG + (unsigned)(bh * SEQ * 4); r.P0 = qb * 256; r.kb0 = kb0; r.Bq = Bq; r.khi = khi; r.mode = mode; r.slot = (bh * 32 + qb) * 2 + half;
    r.part = (GAS char*)F_out; r.pml = (GAS float*)(F_ws + WS_PML); r.cnt = (GAS unsigned*)(F_ws + WS_CTL) + CW_SPL + rep * 512 + bh * 32 + qb; return r;
}
constexpr float SKIP_LOG2 = 148.f;
constexpr int SPLIT_MIN = 40;
constexpr int ATT_LDS_DESC = 133632 + 64;
__device__ __forceinline__ void fa_describe(Frame& F, int n, int xq, LAS float* kmax2, LAS int* desc) {
    const int half = n & 1, bi = n >> 1;
    const int bh = (bi & 1) ? 8 + ((xq + 4) & 7) : xq, qb = 31 - (bi >> 1), b = bh >> 3, h = bh & 7;
    const float* nq = (const float*)(F_ws + WS_NRM) + ((size_t)(b * 32 + qb) * 8 + h) * 8;
    float q2 = 0.f;
#pragma unroll
    for (int wc = 0; wc < 4; ++wc) q2 += fmaxf(nq[2 * wc], nq[2 * wc + 1]);
    const float B = sqrtf(q2 * kmax2[bh]) * 1.01f, th = 2.f * B + SKIP_LOG2;
    const float* cb = (const float*)(F_ws + WS_CBG) + (size_t)bh * SEQ;
    const float cbi = cb[qb * 256];
    const float c0 = cb[64 * F.lane + 63], c1 = cb[64 * (F.lane + 64) + 63];
    const unsigned long long m0 = __ballot(cbi - c0 <= th), m1 = __ballot(cbi - c1 <= th);
    int t = m0 ? (int)__builtin_ctzll(m0) : (m1 ? 64 + (int)__builtin_ctzll(m1) : 4 * qb);
    if (t > 4 * qb) t = 4 * qb;
    const int nt = 4 * qb + 4 - t, tmid = t + (nt >> 1);
    int lo = 64 * t, top = qb * 256 + 256, mode = 0;
    if (nt >= SPLIT_MIN) { mode = 1; if (half) top = 64 * tmid; else lo = 64 * tmid; } else if (half) mode = 2;
    if (F.lane == 0) { desc[0] = bh; desc[1] = qb; desc[2] = lo; desc[5] = (int)__float_as_uint(B); desc[6] = top; desc[7] = mode; desc[8] = half; }
}
__device__ __forceinline__ void attn_fast_phase(Frame& F, char* shm, int rep = 0) {
    LAS float* kmax2 = (LAS float*)(F.lds + ATT_LDS_DESC); LAS int* desc = (LAS int*)(F.lds + ATT_LDS_DESC + 64);
    const int total = 128, xq = (int)blockIdx.x & 7;
    __syncthreads();
    if (F.tid < 64) { const int bh = F.tid >> 2, wc = F.tid & 3, b = bh >> 3, h = bh & 7; const float* nk = (const float*)(F_ws + WS_NRM) + (size_t)64 * 64;
        float m = 0.f; for (int pm = 0; pm < 32; ++pm) { const float* p = nk + (((size_t)(b * 32 + pm) * 8 + h) * 4 + wc) * 2; m = fmaxf(m, fmaxf(p[0], p[1])); }
        m += __shfl_xor(m, 1); m += __shfl_xor(m, 2); if (wc == 0) kmax2[bh] = m; }
    __syncthreads();
    gu32* ctr0 = (gu32*)(F_ws + WS_CTL) + CW_ATT + rep * 8;
    int n = (int)blockIdx.x >> 3, qsel = xq;
    while (n < total) {
        if (F.wave == 0) fa_describe(F, n, qsel, kmax2, desc);
        __syncthreads();
        const int mode = __builtin_amdgcn_readfirstlane(desc[7]);
        if (mode != 2) {
            const fa::BlockRef cur = fa_ref(F, __builtin_amdgcn_readfirstlane(desc[0]), __builtin_amdgcn_readfirstlane(desc[1]), __builtin_amdgcn_readfirstlane(desc[2]), __builtin_amdgcn_readfirstlane(desc[6]), mode,
                                            __builtin_amdgcn_readfirstlane(desc[8]), __uint_as_float((unsigned)__builtin_amdgcn_readfirstlane(desc[5])), rep);
            fa::fa_block(cur, shm, F.tid);
        }
        if (F.wave == 0) { int nn = total, qs = xq;
            for (int k = 0; k < 8; ++k) { const int q = (xq + k) & 7; int v = 0;
                if (F.lane == 0) v = (((int)F.G + 7 - q) >> 3) + (int)__hip_atomic_fetch_add(ctr0 + 64 * q, 1u, __ATOMIC_RELAXED, __HIP_MEMORY_SCOPE_AGENT);
                v = __builtin_amdgcn_readfirstlane(v); if (v < total) { nn = v; qs = q; break; } }
            if (F.lane == 0) { desc[3] = nn; desc[4] = qs; } }
        __syncthreads();
        n = __builtin_amdgcn_readfirstlane(desc[3]); qsel = __builtin_amdgcn_readfirstlane(desc[4]);
    }
}

__device__ __forceinline__ void attn_ref_phase(Frame& F) {
    const bf16* Q = (const bf16*)(F_ws + WS_Q0); const bf16* K = (const bf16*)(F_ws + WS_K0); const bf16* V = (const bf16*)(F_ws + WS_V0); bf16* O = (bf16*)(F_ws + WS_O0);
    const float* LC = (const float*)(F_ws + WS_LC); const float* TT = (const float*)(F_ws + WS_TT);
    LAS float* Ks = (LAS float*)(F.lds); LAS float* Vs = (LAS float*)(F.lds + 32768); LAS float* cbs = (LAS float*)(F.lds + 65536); LAS float* Pp = (LAS float*)(F.lds + 65536 + 256);
    const int r = F.tid >> 3, part = F.tid & 7;
    const int NU = BATCH * FH * (SEQ / 64);
    for (int unit = (int)blockIdx.x; unit < NU; unit += F.G) {
        const int bh = unit & 15, qb = unit >> 4, b = bh >> 3, h = bh & 7, q0 = qb * 64;
        __syncthreads();
        if (F.tid == 0) { float s = 0.f; for (int t = 0; t < 32; ++t) { Pp[t] = s; s += TT[(b * 32 + t) * 8 + h]; } }
        float q[16], o[16]; float m = -1e30f, l = 0.f;
        { const bf16* qp = Q + (size_t)(b * SEQ + q0 + r) * D + h * FDH + part * 16; const v4u a = *(const v4u*)qp, c = *(const v4u*)(qp + 8);
          q[0] = pg8::bf_lo(a.x); q[1] = pg8::bf_hi(a.x); q[2] = pg8::bf_lo(a.y); q[3] = pg8::bf_hi(a.y); q[4] = pg8::bf_lo(a.z); q[5] = pg8::bf_hi(a.z); q[6] = pg8::bf_lo(a.w); q[7] = pg8::bf_hi(a.w);
          q[8] = pg8::bf_lo(c.x); q[9] = pg8::bf_hi(c.x); q[10] = pg8::bf_lo(c.y); q[11] = pg8::bf_hi(c.y); q[12] = pg8::bf_lo(c.z); q[13] = pg8::bf_hi(c.z); q[14] = pg8::bf_lo(c.w); q[15] = pg8::bf_hi(c.w); }
#pragma unroll
        for (int d = 0; d < 16; ++d) o[d] = 0.f;
        for (int kt = 0; kt <= qb; ++kt) {
            __syncthreads();
            { const size_t go = (size_t)(b * SEQ + kt * 64 + r) * D + h * FDH + part * 16;
              const v4u a = *(const v4u*)(K + go), c = *(const v4u*)(K + go + 8), e = *(const v4u*)(V + go), f = *(const v4u*)(V + go + 8);
              LAS float* kd = Ks + r * 128 + part * 16; LAS float* vd = Vs + r * 128 + part * 16;
              kd[0] = pg8::bf_lo(a.x); kd[1] = pg8::bf_hi(a.x); kd[2] = pg8::bf_lo(a.y); kd[3] = pg8::bf_hi(a.y); kd[4] = pg8::bf_lo(a.z); kd[5] = pg8::bf_hi(a.z); kd[6] = pg8::bf_lo(a.w); kd[7] = pg8::bf_hi(a.w);
              kd[8] = pg8::bf_lo(c.x); kd[9] = pg8::bf_hi(c.x); kd[10] = pg8::bf_lo(c.y); kd[11] = pg8::bf_hi(c.y); kd[12] = pg8::bf_lo(c.z); kd[13] = pg8::bf_hi(c.z); kd[14] = pg8::bf_lo(c.w); kd[15] = pg8::bf_hi(c.w);
              vd[0] = pg8::bf_lo(e.x); vd[1] = pg8::bf_hi(e.x); vd[2] = pg8::bf_lo(e.y); vd[3] = pg8::bf_hi(e.y); vd[4] = pg8::bf_lo(e.z); vd[5] = pg8::bf_hi(e.z); vd[6] = pg8::bf_lo(e.w); vd[7] = pg8::bf_hi(e.w);
              vd[8] = pg8::bf_lo(f.x); vd[9] = pg8::bf_hi(f.x); vd[10] = pg8::bf_lo(f.y); vd[11] = pg8::bf_hi(f.y); vd[12] = pg8::bf_lo(f.z); vd[13] = pg8::bf_hi(f.z); vd[14] = pg8::bf_lo(f.w); vd[15] = pg8::bf_hi(f.w); }
            if (F.tid < 64) { const int key = kt * 64 + F.tid; cbs[F.tid] = ((const float*)(F_ws + WS_CBG))[(size_t)bh * SEQ + key]; }
            __syncthreads();
            const int jmax = (kt == qb) ? r : 63;
            for (int j = 0; j <= jmax; ++j) {
                const LAS float* kr = Ks + j * 128 + part * 16; float dot = 0.f;
#pragma unroll
                for (int d = 0; d < 16; ++d) dot += q[d] * kr[d];
                dot += __shfl_xor(dot, 1); dot += __shfl_xor(dot, 2); dot += __shfl_xor(dot, 4);
                const float s = dot + cbs[j], mn = fmaxf(m, s), al = __builtin_amdgcn_exp2f(m - mn), p = __builtin_amdgcn_exp2f(s - mn);
                l = l * al + p; m = mn;
                const LAS float* vr = Vs + j * 128 + part * 16;
#pragma unroll
                for (int d = 0; d < 16; ++d) o[d] = o[d] * al + p * vr[d];
            }
        }
        const float il = 1.0f / l;
        v4u w0, w1; w0.x = pk2(o[0] * il, o[1] * il); w0.y = pk2(o[2] * il, o[3] * il); w0.z = pk2(o[4] * il, o[5] * il); w0.w = pk2(o[6] * il, o[7] * il);
        w1.x = pk2(o[8] * il, o[9] * il); w1.y = pk2(o[10] * il, o[11] * il); w1.z = pk2(o[12] * il, o[13] * il); w1.w = pk2(o[14] * il, o[15] * il);
        bf16* op = O + (size_t)(b * SEQ + q0 + r) * D + h * FDH + part * 16; *(v4u*)op = w0; *(v4u*)(op + 8) = w1;
    }
    __syncthreads();
}

__device__ __forceinline__ void ret_ref_phase(Frame& F) {
    const bf16* Q1 = (const bf16*)(F_ws + WS_Q1); const bf16* K1 = (const bf16*)(F_ws + WS_K1); bf16* V1 = (bf16*)(F_ws + WS_V1); float* PST = (float*)(F_ws + WS_PST);
    LAS bf16* Qs = (LAS bf16*)(F.lds); LAS bf16* Ks = (LAS bf16*)(F.lds + 32768); LAS float* Sm = (LAS float*)(F.lds + 65536); LAS float* St = (LAS float*)(F.lds + 81920);
    LAS float* Vs = (LAS float*)(F.lds + 114688); LAS float* pw = (LAS float*)(F.lds + 122880);
    for (int unit = (int)blockIdx.x; unit < BATCH * RH * 16; unit += F.G) {
        const int b = unit >> 6, h = (unit >> 4) & 3, vs = unit & 15, v0 = vs * 32;
        const float lg = logf(1.0f - exp2f(-5.0f - (float)h));
        __syncthreads();
        for (int i = F.tid; i < 256 * 32; i += NWAVES * 64) St[i] = 0.f;
        if (F.tid <= 64) pw[F.tid] = expf(lg * (float)F.tid);
        for (int n = 0; n < NCH; ++n) {
            const size_t t0 = (size_t)b * SEQ + (size_t)n * CH;
            __syncthreads();
#pragma unroll
            for (int i = 0; i < 4; ++i) { const int p = F.tid + 512 * i, row = p >> 5, c = p & 31;
                *(LAS v4u*)(Qs + row * 256 + c * 8) = *(const v4u*)(Q1 + (t0 + row) * 1024 + h * 256 + c * 8);
                *(LAS v4u*)(Ks + row * 256 + c * 8) = *(const v4u*)(K1 + (t0 + row) * 1024 + h * 256 + c * 8); }
            { const int idx = F.tid * 4, row = idx >> 5, c = idx & 31; const unsigned long long vv = *(const unsigned long long*)(V1 + (t0 + row) * 2048 + h * 512 + v0 + c);
              const unsigned lo = (unsigned)vv, hi = (unsigned)(vv >> 32); LAS float* d = Vs + row * 32 + c; d[0] = pg8::bf_lo(lo); d[1] = pg8::bf_hi(lo); d[2] = pg8::bf_lo(hi); d[3] = pg8::bf_hi(hi); }
            __syncthreads();
            {
                const int i = F.tid >> 3, j0 = (F.tid & 7) * 8; float a[8];
#pragma unroll
                for (int jj = 0; jj < 8; ++jj) a[jj] = 0.f;
                for (int d = 0; d < 256; d += 2) { const unsigned qw = *(const LAS unsigned*)(Qs + i * 256 + d); const float qa = pg8::bf_lo(qw), qb = pg8::bf_hi(qw);
#pragma unroll
                    for (int jj = 0; jj < 8; ++jj) { const unsigned kw = *(const LAS unsigned*)(Ks + (j0 + jj) * 256 + d); a[jj] += qa * pg8::bf_lo(kw) + qb * pg8::bf_hi(kw); } }
#pragma unroll
                for (int jj = 0; jj < 8; ++jj) { const int dj = i - (j0 + jj); Sm[i * 64 + j0 + jj] = a[jj] * pw[dj < 0 ? -dj : dj]; }
            }
            __syncthreads();
            {
                const int i = F.tid >> 3, vv0 = (F.tid & 7) * 4; float y[4] = {0.f, 0.f, 0.f, 0.f};
                for (int d = 0; d < 256; d += 2) { const unsigned qw = *(const LAS unsigned*)(Qs + i * 256 + d); const float qa = pg8::bf_lo(qw), qb = pg8::bf_hi(qw);
                    const f32x4 s0 = *(const LAS f32x4*)(St + d * 32 + vv0), s1 = *(const LAS f32x4*)(St + (d + 1) * 32 + vv0);
                    y[0] += qa * s0.x + qb * s1.x; y[1] += qa * s0.y + qb * s1.y; y[2] += qa * s0.z + qb * s1.z; y[3] += qa * s0.w + qb * s1.w; }
                const float qd = pw[i + 1];
#pragma unroll
                for (int e = 0; e < 4; ++e) y[e] *= qd;
                for (int j = 0; j < 64; ++j) { const float s = Sm[i * 64 + j]; const f32x4 vv = *(const LAS f32x4*)(Vs + j * 32 + vv0); y[0] += s * vv.x; y[1] += s * vv.y; y[2] += s * vv.z; y[3] += s * vv.w; }
                float ps = (y[0] + y[1]) + (y[2] + y[3]), pq = (y[0] * y[0] + y[1] * y[1]) + (y[2] * y[2] + y[3] * y[3]);
                ps += __shfl_xor(ps, 1); pq += __shfl_xor(pq, 1); ps += __shfl_xor(ps, 2); pq += __shfl_xor(pq, 2); ps += __shfl_xor(ps, 4); pq += __shfl_xor(pq, 4);
                if ((F.tid & 7) == 0) { f32x2 st; st.x = ps; st.y = pq; *(f32x2*)(PST + (((t0 + i) * 4 + h) * 16 + vs) * 2) = st; }
                *(unsigned long long*)(V1 + (t0 + i) * 2048 + h * 512 + v0 + vv0) = (unsigned long long)pk2(y[0], y[1]) | ((unsigned long long)pk2(y[2], y[3]) << 32);
            }
            __syncthreads();
            {
                const int d = F.tid >> 1, vv0 = (F.tid & 1) * 16; float a[16]; const float cd = pw[64];
#pragma unroll
                for (int e = 0; e < 16; ++e) a[e] = St[d * 32 + vv0 + e] * cd;
                for (int j = 0; j < 64; ++j) { const float kd = pg8::bf_lo((unsigned)Ks[j * 256 + d]) * pw[63 - j];
#pragma unroll
                    for (int e = 0; e < 16; e += 4) { const f32x4 vv = *(const LAS f32x4*)(Vs + j * 32 + vv0 + e); a[e] += kd * vv.x; a[e + 1] += kd * vv.y; a[e + 2] += kd * vv.z; a[e + 3] += kd * vv.w; } }
#pragma unroll
                for (int e = 0; e < 16; ++e) St[d * 32 + vv0 + e] = a[e];
            }
        }
    }
    __syncthreads();
}


__device__ __forceinline__ rtn::Ptrs rt_ptrs(Frame& F) {
    rtn::Ptrs P; GAS char* w = (GAS char*)F_ws;
    P.Q = w + WS_Q1; P.K = w + WS_K1; P.V = w + WS_V1; P.L = (GAS char*)F_out; P.PST = (GAS float*)(w + WS_PST); return P;
}
#ifndef RT_PAIR
#define RT_PAIR 1
#endif
__device__ __forceinline__ void ret_pass1_phase(Frame& F) {
    const rtn::Ptrs P = rt_ptrs(F);
    { const int nit = 8 * (rtn::NG - 1) * 2; p0_late_weights(F, F.G > nit + 16 ? nit : 0); }
    for (int it = (int)blockIdx.x; it < 8 * (rtn::NG - 1) * 2; it += F.G) { const int half = RT_PAIR ? (it >> 3) & 1 : it & 1, r = RT_PAIR ? (it & 7) | ((it >> 4) << 3) : it >> 1, g = r % (rtn::NG - 1), bh = r / (rtn::NG - 1); rtn::run_item<false>(P, bh, half, g, 0u, F.wave); }
}
__device__ __forceinline__ void ret_scan_phase(Frame& F) {
    GAS char* L = (GAS char*)F_out;
    for (int i = (int)blockIdx.x * (NWAVES * 64) + F.tid; i < 16 * 8192; i += F.G * (NWAVES * 64)) {
        const int c = i & 8191, bhh = i >> 13, half = bhh & 1, bh = bhh >> 1, h = bh & 3;
        const float lg = __logf(1.0f - __builtin_amdgcn_exp2f(-5.0f - (float)h)), cdg = __expf(lg * (float)(rtn::RG * 64));
        GAS char* p = L + ((size_t)(bh * (rtn::NG - 1)) * 2 + half) * 131072 + (size_t)c * 16;
        pg8::u32x4 w[rtn::NG - 1];
#pragma unroll
        for (int gp = 0; gp < rtn::NG - 1; ++gp) w[gp] = *(const GAS pg8::u32x4*)(p + (size_t)gp * 262144);
        float x[8] = {0.f, 0.f, 0.f, 0.f, 0.f, 0.f, 0.f, 0.f};
#pragma unroll
        for (int gp = 0; gp < rtn::NG - 1; ++gp) {
            x[0] = x[0] * cdg + pg8::bf_lo(w[gp].x); x[1] = x[1] * cdg + pg8::bf_hi(w[gp].x); x[2] = x[2] * cdg + pg8::bf_lo(w[gp].y); x[3] = x[3] * cdg + pg8::bf_hi(w[gp].y);
            x[4] = x[4] * cdg + pg8::bf_lo(w[gp].z); x[5] = x[5] * cdg + pg8::bf_hi(w[gp].z); x[6] = x[6] * cdg + pg8::bf_lo(w[gp].w); x[7] = x[7] * cdg + pg8::bf_hi(w[gp].w);
            if (gp > 0) { pg8::u32x4 o; o.x = pg8::cvt_pk_bf16(x[0], x[1]); o.y = pg8::cvt_pk_bf16(x[2], x[3]); o.z = pg8::cvt_pk_bf16(x[4], x[5]); o.w = pg8::cvt_pk_bf16(x[6], x[7]); *(GAS pg8::u32x4*)(p + (size_t)gp * 262144) = o; }
        }
    }
}
__device__ __forceinline__ void ret_pass2_phase(Frame& F) {
    const rtn::Ptrs P = rt_ptrs(F);
    for (int it = (int)blockIdx.x; it < 8 * rtn::NG * 2; it += F.G) { const int half = RT_PAIR ? (it >> 3) & 1 : it & 1, r = RT_PAIR ? (it & 7) | ((it >> 4) << 3) : it >> 1, g = r % rtn::NG, bh = r / rtn::NG; rtn::run_item<true>(P, bh, half, g, 0u, F.wave); }
}

__device__ __forceinline__ void final_norm_phase(Frame& F) {
    const float* SSQ = (const float*)(F_ws + WS_SSQ); const bf16* XB = (const bf16*)(F_ws + WS_XB);
    const int gw = F.vcu * NWAVES + F.wave, NGW = F.G * NWAVES;
    f32x4 gv[4];
#pragma unroll
    for (int j = 0; j < 4; ++j) gv[j] = ((const f32x4*)F_final_norm)[F.lane + 64 * j];
    for (int row = gw; row < M; row += NGW) {
        float s = (F.lane < 16) ? SSQ[(size_t)row * 16 + F.lane] : 0.f; s = wave_sum(s);
        const float rstd = 1.0f / sqrtf(s * (1.f / D) + EPS);
        const GAS unsigned long long* xr = (const GAS unsigned long long*)(XB + (size_t)row * D) + F.lane;
        GAS f32x4* orow = (GAS f32x4*)(F_out + (size_t)row * D) + F.lane;
#pragma unroll
        for (int j = 0; j < 4; ++j) { const unsigned long long w = xr[64 * j]; const unsigned lo = (unsigned)w, hi = (unsigned)(w >> 32); f32x4 v;
            v.x = pg8::bf_lo(lo); v.y = pg8::bf_hi(lo); v.z = pg8::bf_lo(hi); v.w = pg8::bf_hi(hi); orow[64 * j] = v * rstd * gv[j]; }
    }
}
#ifndef MK_N_LAUNCHES
#define MK_N_LAUNCHES 1
#endif
constexpr int N_LAUNCHES = MK_N_LAUNCHES;
#ifndef REP_PHASE
#define REP_PHASE -1
#endif
#define REPS(k) ((k) == REP_PHASE ? 2 : 1)
#ifndef FAST_ATTN
#define FAST_ATTN 0
#endif
#ifndef FAST_RET
#define FAST_RET 0
#endif
__device__ __forceinline__ bool relaunder(Frame& F) { int t = F.wave * 64 + hw_lane_id(); asm volatile("" : "+v"(t));     F.tid = t; F.lane = t & 63; F.wave = __builtin_amdgcn_readfirstlane(t >> 6); const __attribute__((address_space(4))) Args* a = F.ap; asm volatile("" : "+s"(a)); F.ap = a; return true; }
__global__ void __launch_bounds__(NWAVES * 64, 2) fox_ret_fwd(Args args) {
    extern __shared__ __attribute__((aligned(16))) unsigned char lds[];
    Frame F;
    F.lds = (LAS unsigned char*)lds;
    F.MISC = (volatile LAS unsigned*)(F.lds + MISC_OFF);
    F.tid = threadIdx.x; F.lane = F.tid & 63; F.wave = __builtin_amdgcn_readfirstlane(F.tid >> 6);
    F.G = gridDim.x; { const int bx = blockIdx.x; F.vcu = (F.G % 8 == 0) ? (bx % 8) * (F.G / 8) + bx / 8 : bx; }
    F.ap = (const __attribute__((address_space(4))) Args*)__builtin_amdgcn_kernarg_segment_ptr();
    for (int u = F.tid; u < (LDS_BYTES - LDSCTL_OFF) / 4; u += NWAVES * 64) ((LAS unsigned*)(F.lds + LDSCTL_OFF))[u] = 0u;
    __syncthreads();
    XcdBarrier bar; bar.bar = (unsigned*)(F_ws + WS_CTL) + CW_BAR; bar.x = 0; bar.st = nullptr;
    if (N_LAUNCHES == 1) bar = xcd_barrier_post((unsigned*)(F_ws + WS_CTL) + CW_BAR, F.MISC + 8);
#define GRID_BAR() do { if (N_LAUNCHES == 1) { xcd_barrier(bar); if (REP_PHASE == -2) xcd_barrier(bar); } } while (0)
    const int lo = F.ap->ph_lo, hi = F.ap->ph_hi;
#define IN(k) (lo <= (k) && (k) < hi && relaunder(F))
#define BOTH(k) (IN(k) && IN((k) + 1))
#define ws F_ws
#define XB ((pg8::bf16_t*)(F_ws + WS_XB))
#define SSQ ((float*)(F_ws + WS_SSQ))
    const LAS float* const tab = (const LAS float*)(F.lds + TAB_OFF);

#ifndef TPROBE
#define TPROBE -1
#endif
#define TP(k) if (TPROBE == (k) && F.tid == 0) F.MISC[21] = (unsigned)__builtin_amdgcn_s_memrealtime();
    if (TPROBE >= 0 && F.tid == 0) F.MISC[20] = (unsigned)__builtin_amdgcn_s_memrealtime();
#define RUN_PHASE(k, BODY) TP(k) if (IN(k)) { BODY; if (REP_PHASE == (k)) { GRID_BAR(); relaunder(F); BODY; } if (BOTH(k)) GRID_BAR(); }
#define RUN_PHASE2(k, BODY, BODY2) TP(k) if (IN(k)) { BODY; if (REP_PHASE == (k) || REP_PHASE == 100 + (k) || REP_PHASE == 200 + (k)) { GRID_BAR(); relaunder(F); BODY2; } if (BOTH(k)) GRID_BAR(); }
#define GEMM_PHASE(EPI, Aptr, Bptr, N_, K_, PRE, ...) do { \
        pg8::Gemm g{(const pg8::bf16_t*)(Aptr), (const pg8::bf16_t*)(Bptr), M, (N_), (K_)}; pg8::StaticOrder S; S.init(M, (N_), F.G, (int)blockIdx.x); \
        PRE; pg8::EPI E{__VA_ARGS__}; \
        pg8::gemm_phase<pg8::EPI, pg8::StaticOrder, true, true>(F.lds + RING_OFF, g, S, E, F.wave); } while (0)
#define GEMM_PHASE_HOT(EPI, Aptr, Bptr, N_, K_, PRE, ...) do { \
        pg8::Gemm g{(const pg8::bf16_t*)(Aptr), (const pg8::bf16_t*)(Bptr), M, (N_), (K_)}; pg8::StaticOrderHot S; S.init(M, (N_), F.G, (int)blockIdx.x); \
        PRE; pg8::EPI E{__VA_ARGS__}; \
        pg8::gemm_phase<pg8::EPI, pg8::StaticOrderHot, true, true>(F.lds + RING_OFF, g, S, E, F.wave); } while (0)
    RUN_PHASE(0, p0_prologue(F))
    RUN_PHASE(1, GEMM_PHASE(EpiQKV0, XB, ws + WS_WQKV0, 3072, 1024, cbg_phase(F); fill_rstd_tab(F, S), (pg8::bf16_t*)(ws + WS_Q0), tab, QSCALE, (float*)(ws + WS_NRM)))
#if FAST_ATTN
    RUN_PHASE2(2, attn_fast_phase(F, (char*)lds), attn_fast_phase(F, (char*)lds, 1))
#else
    RUN_PHASE(2, attn_ref_phase(F))
#endif
    RUN_PHASE2(3, GEMM_PHASE(EpiRes, ws + WS_O0, ws + WS_WO0, 1024, 1024, (void)0, XB, SSQ), GEMM_PHASE(EpiRes, ws + WS_O0, ws + WS_WO0, 1024, 1024, (void)0, (pg8::bf16_t*)F_out, (float*)F_out + 8388608))
#if REP_PHASE == 104
    RUN_PHASE2(4, GEMM_PHASE(EpiSwiGLU, XB, ws + WS_WFI0, 2 * DFF, 1024, fill_rstd_tab(F, S), (pg8::bf16_t*)(ws + WS_HID), tab), GEMM_PHASE(EpiNull, XB, ws + WS_WFI0, 2 * DFF, 1024, (void)0, 0))
#else
    RUN_PHASE(4, GEMM_PHASE(EpiSwiGLU, XB, ws + WS_WFI0, 2 * DFF, 1024, fill_rstd_tab(F, S), (pg8::bf16_t*)(ws + WS_HID), tab))
#endif
#if REP_PHASE == 205
    RUN_PHASE2(5, GEMM_PHASE(EpiRes, ws + WS_HID, ws + WS_WFO0, 1024, DFF, (void)0, XB, SSQ), GEMM_PHASE_HOT(EpiNull, ws + WS_HID, ws + WS_WFO0, 1024, DFF, (void)0, 0))
#elif REP_PHASE == 105
    RUN_PHASE2(5, GEMM_PHASE(EpiRes, ws + WS_HID, ws + WS_WFO0, 1024, DFF, (void)0, XB, SSQ), GEMM_PHASE(EpiNull, ws + WS_HID, ws + WS_WFO0, 1024, DFF, (void)0, 0))
#else
    RUN_PHASE2(5, GEMM_PHASE(EpiRes, ws + WS_HID, ws + WS_WFO0, 1024, DFF, (void)0, XB, SSQ), GEMM_PHASE(EpiRes, ws + WS_HID, ws + WS_WFO0, 1024, DFF, (void)0, (pg8::bf16_t*)F_out, (float*)F_out + 8388608))
#endif
    RUN_PHASE(6, GEMM_PHASE(EpiRet, XB, ws + WS_WRI, 4096, 1024, fill_rstd_tab(F, S), (pg8::bf16_t*)(ws + WS_Q1), (pg8::bf16_t*)(ws + WS_K1), (pg8::bf16_t*)(ws + WS_V1), (const float*)(ws + WS_ROPE), tab))
#if FAST_RET
    RUN_PHASE(7, ret_pass1_phase(F))
    RUN_PHASE(8, ret_scan_phase(F))
    RUN_PHASE(9, ret_pass2_phase(F))
#else
    RUN_PHASE(7, (void)0)
    RUN_PHASE(8, (void)0)
    RUN_PHASE(9, ret_ref_phase(F))
#endif
#if REP_PHASE == 110
    RUN_PHASE2(10, GEMM_PHASE(EpiGate, XB, (const pg8::bf16_t*)(ws + WS_WRI) + (size_t)4096 * 1024, 2048, 1024, fill_rstd_tab(F, S); fill_gate_tab(F, S), (pg8::bf16_t*)(ws + WS_V1), tab, (const LAS pg8::f32x2*)(F.lds + STAB_OFF)), GEMM_PHASE(EpiNull, XB, (const pg8::bf16_t*)(ws + WS_WRI) + (size_t)4096 * 1024, 2048, 1024, (void)0, 0))
#else
    RUN_PHASE(10, GEMM_PHASE(EpiGate, XB, (const pg8::bf16_t*)(ws + WS_WRI) + (size_t)4096 * 1024, 2048, 1024, fill_rstd_tab(F, S); fill_gate_tab(F, S), (pg8::bf16_t*)(ws + WS_V1), tab, (const LAS pg8::f32x2*)(F.lds + STAB_OFF)))
#endif
    RUN_PHASE2(11, GEMM_PHASE(EpiRes, ws + WS_V1, ws + WS_WRO, 1024, 2048, (void)0, XB, SSQ), GEMM_PHASE(EpiRes, ws + WS_V1, ws + WS_WRO, 1024, 2048, (void)0, (pg8::bf16_t*)F_out, (float*)F_out + 8388608))
    RUN_PHASE(12, GEMM_PHASE(EpiSwiGLU, XB, ws + WS_WFI1, 2 * DFF, 1024, fill_rstd_tab(F, S), (pg8::bf16_t*)(ws + WS_HID), tab))
    RUN_PHASE2(13, GEMM_PHASE(EpiRes, ws + WS_HID, ws + WS_WFO1, 1024, DFF, (void)0, XB, SSQ), GEMM_PHASE(EpiRes, ws + WS_HID, ws + WS_WFO1, 1024, DFF, (void)0, (pg8::bf16_t*)F_out, (float*)F_out + 8388608))
    TP(14) if (IN(14)) final_norm_phase(F);
    TP(15)
    if (TPROBE >= 0 && blockIdx.x == 0 && F.tid == 0) { const unsigned d = (TPROBE == 100) ? F.MISC[22] : F.MISC[21] - F.MISC[20], t0 = (unsigned)__builtin_amdgcn_s_memrealtime();
        while ((unsigned)__builtin_amdgcn_s_memrealtime() - t0 < d) __builtin_amdgcn_s_sleep(8); }
#undef RUN_PHASE
#undef RUN_PHASE2
#undef GEMM_PHASE
#undef IN
#undef ws
#undef XB
#undef SSQ
#undef BOTH
#undef GRID_BAR
}

extern "C" void kernel_launch(void* const* d_in, const int* in_sizes, int n_in, void* d_out, int out_size, void* d_ws, size_t ws_size, hipStream_t stream) {
    static int grid = 0;
    if (grid == 0) {
        if (n_in != 11 || in_sizes[0] != M * D || out_size != M * D || ws_size < WS_END) { fprintf(stderr, "kernel_launch: shape/workspace mismatch (n_in %d, in0 %d, out %d, ws %zu, need %zu)\n", n_in, n_in > 0 ? in_sizes[0] : -1, out_size, ws_size, (size_t)WS_END); grid = -1; return; }
        int dev = 0, cus = 0, per_cu = 0;
        if (hipGetDevice(&dev) != hipSuccess || hipDeviceGetAttribute(&cus, hipDeviceAttributeMultiprocessorCount, dev) != hipSuccess) { fprintf(stderr, "kernel_launch: device query failed\n"); grid = -1; return; }
        if (hipFuncSetAttribute((const void*)fox_ret_fwd, hipFuncAttributeMaxDynamicSharedMemorySize, LDS_BYTES) != hipSuccess) { fprintf(stderr, "kernel_launch: hipFuncSetAttribute failed\n"); grid = -1; return; }
        if (hipOccupancyMaxActiveBlocksPerMultiprocessor(&per_cu, (const void*)fox_ret_fwd, NWAVES * 64, LDS_BYTES) != hipSuccess || per_cu < 1) { fprintf(stderr, "kernel_launch: occupancy query reports %d workgroups per CU\n", per_cu); per_cu = 1; }
        (void)hipGetLastError();
        grid = cus;
        if (grid > 256) grid = 256;
    }
    if (grid < 0) return;
    if (hipMemsetAsync((char*)d_ws + WS_CTL, 0, CTL_ZERO_BYTES, stream) != hipSuccess) { fprintf(stderr, "kernel_launch: hipMemsetAsync failed\n"); return; }
    Args a{};
    for (int i = 0; i < 11; ++i) a.in[i] = (const float*)d_in[i];
    a.out = (float*)d_out; a.wsp = (unsigned char*)d_ws;
    for (int li = 0; li < N_LAUNCHES; ++li) {
        a.ph_lo = (N_LAUNCHES == 1) ? 0 : li; a.ph_hi = (N_LAUNCHES == 1) ? NPHASE : li + 1; a.li = li;
        hipLaunchKernelGGL(fox_ret_fwd, dim3(grid), dim3(NWAVES * 64), LDS_BYTES, stream, a);
        const hipError_t le = hipPeekAtLastError();
        if (le != hipSuccess) { fprintf(stderr, "kernel_launch: launch %d failed: %s\n", li, hipGetErrorName(le)); break; }
    }
}
```

```cpp
#define MK_N_LAUNCHES 1
#define FAST_ATTN 1
#define FAST_RET 1
#include <hip/hip_runtime.h>
#include <cstdio>
#include <cstdint>
#include <cmath>
__device__ __forceinline__ int hw_lane_id() { int l; asm volatile("v_mbcnt_lo_u32_b32 %0, -1, 0\n\tv_mbcnt_hi_u32_b32 %0, -1, %0" : "=v"(l)); return l; }
namespace pg8 {
#define PG8_LAS __attribute__((address_space(3)))
typedef unsigned short bf16_t;
typedef short bf16x8 __attribute__((ext_vector_type(8)));
typedef float f32x4 __attribute__((ext_vector_type(4)));
typedef unsigned u32x4 __attribute__((ext_vector_type(4)));
constexpr int BM = 256, BK = 64, HALF = 128, HTB = HALF * BK * 2  , STAGE_BYTES = 8 * HTB, NXCD = 8, WGM = 8;

__host__ __device__ __forceinline__ int lds_byte(int r, int c) { const int st = (r >> 4) * 2 + (c >> 5), rr = r & 15, cc = c & 31, ob = rr * 64 + cc * 2; return st * 1024 + (ob ^ (((ob >> 9) & 1) << 5)); }
__host__ __device__ __forceinline__ void stage_rc(int b, int& R, int& C) { const int st = b / 1024, sb = b % 1024, swz = sb ^ (((sb >> 9) & 1) << 5); R = (st >> 1) * 16 + swz / 64; C = (st & 1) * 32 + (swz % 64) / 2; }
__host__ __device__ __forceinline__ int perm32(int rho) { const int n = rho >> 4, i = rho & 15; return 8 * (i >> 2) + 4 * n + (i & 3); }

struct Unit { int pm, pn; };
struct Gemm { const bf16_t* A; const bf16_t* Bt; int M, N, K; };

struct StaticOrder {
    int nM, nN, nwg, G, c;
    __host__ __device__ void init(int M, int N, int G_, int c_) { nM = M / BM; nN = N / BM; nwg = nM * nN; G = G_; c = c_; }
    __host__ __device__ bool next(int i, Unit& u) const {
        const long L = (long)i * G + c; if (L >= nwg) return false;
        int wgid = (int)L; { const int q = nwg / NXCD, r = nwg % NXCD, xcd = wgid % NXCD, off = wgid / NXCD; wgid = (xcd < r ? xcd * (q + 1) : r * (q + 1) + (xcd - r) * q) + off; }
        const int nig = WGM * nN, gid = wgid / nig, fm = gid * WGM, gsz = (nM - fm) < WGM ? (nM - fm) : WGM;
        u.pm = fm + ((wgid % nig) % gsz); u.pn = (wgid % nig) / gsz; return true;
    }
    __device__ __forceinline__ void a_ready(const Unit&) const {}
    __device__ __forceinline__ void done(const Unit&) const {}
};
struct StaticOrderHot : StaticOrder {
    __host__ __device__ bool next(int i, Unit& u) const { const bool ok = StaticOrder::next(i, u); u.pm = 0; return ok; }
};

__device__ __forceinline__ unsigned cvt_pk_bf16(float lo, float hi) { unsigned r; asm volatile("v_cvt_pk_bf16_f32 %0, %1, %2" : "=v"(r) : "v"(lo), "v"(hi)); return r; }
typedef float f32x2 __attribute__((ext_vector_type(2)));
__device__ __forceinline__ float silu_f(float x) { return x * __builtin_amdgcn_rcpf(1.0f + __builtin_amdgcn_exp2f(-1.4426950408889634f * x)); }
__device__ __forceinline__ u32x4 pack8f(const f32x4 v0, const f32x4 v1) { u32x4 w; w.x = cvt_pk_bf16(v0[0], v0[1]); w.y = cvt_pk_bf16(v0[2], v0[3]); w.z = cvt_pk_bf16(v1[0], v1[1]); w.w = cvt_pk_bf16(v1[2], v1[3]); return w; }
#ifndef EPI_WT
#define EPI_WT 1
#endif
__device__ __forceinline__ __amdgpu_buffer_rsrc_t epi_rsrc(const void* base, unsigned bytes) { return __builtin_amdgcn_make_buffer_rsrc((void*)base, (short)0, (int)bytes, 0x00020000); }
__device__ __forceinline__ void st16(__amdgpu_buffer_rsrc_t r, unsigned byte_off, u32x4 v) { __builtin_amdgcn_raw_buffer_store_b128(v, r, byte_off, 0, EPI_WT ? 16 : 0); }
__device__ __forceinline__ float bf_lo(unsigned w) { return __builtin_bit_cast(float, w << 16); }
__device__ __forceinline__ float bf_hi(unsigned w) { return __builtin_bit_cast(float, w & 0xffff0000u); }

struct EpiQKV0 {
    static constexpr bool PERM = true, AFTER_DRAIN = false, ACC_INIT = false;
    bf16_t* Q; const PG8_LAS float* tab; float qscale; float* nrm;
    __device__ __forceinline__ void operator()(const f32x4 (&acc)[2][2][4][2], const Unit& u, int ui, int wr, int wc, int fr, int fq) const {
        const int colt = u.pn * BM, t = colt >> 10; const __amdgpu_buffer_rsrc_t rs_ = epi_rsrc(Q + (size_t)t * ((size_t)16384 * 1024), 16384u * 2048u);
        const int cb = (colt & 1023) + wc * 32 + 8 * fq; const float sc = t == 0 ? qscale : 1.f;
        float mx0 = 0.f, mx1 = 0.f;
#pragma unroll
        for (int ai = 0; ai < 2; ++ai)
#pragma unroll
            for (int m = 0; m < 4; ++m) { const int rl = ai * HALF + wr * 64 + m * 16 + fr; const float rs = tab[ui * 256 + rl] * sc;
                const unsigned rowo = (unsigned)((u.pm * BM + rl) * 1024 + cb) * 2u;
#pragma unroll
                for (int bj = 0; bj < 2; ++bj) { const u32x4 w = pack8f(acc[ai][bj][m][0] * rs, acc[ai][bj][m][1] * rs); st16(rs_, rowo + bj * HALF * 2, w);
                    if (t < 2) { float q = (bf_lo(w.x) * bf_lo(w.x) + bf_hi(w.x) * bf_hi(w.x)) + (bf_lo(w.y) * bf_lo(w.y) + bf_hi(w.y) * bf_hi(w.y));
                        q += (bf_lo(w.z) * bf_lo(w.z) + bf_hi(w.z) * bf_hi(w.z)) + (bf_lo(w.w) * bf_lo(w.w) + bf_hi(w.w) * bf_hi(w.w));
                        q += __shfl_xor(q, 16); q += __shfl_xor(q, 32);
                        if (bj == 0) mx0 = fmaxf(mx0, q); else mx1 = fmaxf(mx1, q); } } }
        if (t < 2) {
#pragma unroll
            for (int o = 1; o < 16; o <<= 1) { mx0 = fmaxf(mx0, __shfl_xor(mx0, o)); mx1 = fmaxf(mx1, __shfl_xor(mx1, o)); }
            if (fr == 0 && fq == 0) { const int head = ((colt & 1023) >> 7); float* d = nrm + ((((size_t)t * 64 + u.pm) * 8 + head) * 4 + wc) * 2 + wr; d[0] = mx0; d[8] = mx1; }
        }
    }
};
struct EpiRes {
    static constexpr bool PERM = true, AFTER_DRAIN = false, ACC_INIT = true;
    bf16_t* xb; float* ssq;
    __device__ __forceinline__ void init_issue(u32x4 (&raw)[2][2][4], const Unit& u, int wr, int wc, int fr, int fq) const {
        const int col0 = u.pn * BM + wc * 32 + 8 * fq;
#pragma unroll
        for (int ai = 0; ai < 2; ++ai)
#pragma unroll
            for (int m = 0; m < 4; ++m) { const int row = u.pm * BM + ai * HALF + wr * 64 + m * 16 + fr; const bf16_t* rowp = xb + (size_t)row * 1024 + col0;
#pragma unroll
                for (int bj = 0; bj < 2; ++bj) raw[ai][bj][m] = *(const u32x4*)(rowp + bj * HALF); }
    }
    __device__ __forceinline__ void init_finish(f32x4 (&acc)[2][2][4][2], const u32x4 (&raw)[2][2][4]) const {
#pragma unroll
        for (int ai = 0; ai < 2; ++ai)
#pragma unroll
            for (int bj = 0; bj < 2; ++bj)
#pragma unroll
                for (int m = 0; m < 4; ++m) { const u32x4 b = raw[ai][bj][m];
                    acc[ai][bj][m][0] = (f32x4){bf_lo(b.x), bf_hi(b.x), bf_lo(b.y), bf_hi(b.y)}; acc[ai][bj][m][1] = (f32x4){bf_lo(b.z), bf_hi(b.z), bf_lo(b.w), bf_hi(b.w)}; }
    }
    __device__ __forceinline__ void operator()(const f32x4 (&acc)[2][2][4][2], const Unit& u, int ui, int wr, int wc, int fr, int fq) const {
        const int col0 = u.pn * BM + wc * 32 + 8 * fq; const __amdgpu_buffer_rsrc_t rs_ = epi_rsrc(xb, 16384u * 2048u);
#pragma unroll
        for (int ai = 0; ai < 2; ++ai)
#pragma unroll
            for (int m = 0; m < 4; ++m) { const int row = u.pm * BM + ai * HALF + wr * 64 + m * 16 + fr; const unsigned rowo = (unsigned)(row * 1024 + col0) * 2u; float s = 0.f;
#pragma unroll
                for (int bj = 0; bj < 2; ++bj) { const f32x4 o0 = acc[ai][bj][m][0], o1 = acc[ai][bj][m][1];
                    s += ((o0[0] * o0[0] + o0[1] * o0[1]) + (o0[2] * o0[2] + o0[3] * o0[3])) + ((o1[0] * o1[0] + o1[1] * o1[1]) + (o1[2] * o1[2] + o1[3] * o1[3]));
                    st16(rs_, rowo + bj * HALF * 2, pack8f(o0, o1)); }
                s += __shfl_xor(s, 16); s += __shfl_xor(s, 32);
                if (fq == 0) ssq[(size_t)row * 16 + u.pn * 4 + wc] = s; }
    }
};
struct EpiSwiGLU {
    static constexpr bool PERM = true, AFTER_DRAIN = false, ACC_INIT = false;
    bf16_t* Hd; const PG8_LAS float* tab;
    __device__ __forceinline__ void operator()(const f32x4 (&acc)[2][2][4][2], const Unit& u, int ui, int wr, int wc, int fr, int fq) const {
        const int hc0 = u.pn * HALF + wc * 32 + 8 * fq; const __amdgpu_buffer_rsrc_t rs_ = epi_rsrc(Hd, 16384u * 5632u);
#pragma unroll
        for (int ai = 0; ai < 2; ++ai)
#pragma unroll
            for (int m = 0; m < 4; ++m) { const int rl = ai * HALF + wr * 64 + m * 16 + fr; const float rs = tab[ui * 256 + rl];
                f32x4 h0, h1;
#pragma unroll
                for (int e = 0; e < 4; ++e) { h0[e] = silu_f(acc[ai][0][m][0][e] * rs) * (acc[ai][1][m][0][e] * rs); h1[e] = silu_f(acc[ai][0][m][1][e] * rs) * (acc[ai][1][m][1][e] * rs); }
                st16(rs_, (unsigned)((u.pm * BM + rl) * 2816 + hc0) * 2u, pack8f(h0, h1)); }
    }
};
struct EpiRet {
    static constexpr bool PERM = true, AFTER_DRAIN = false, ACC_INIT = false;
    bf16_t* Q; bf16_t* Kp; bf16_t* V; const float* rope; const PG8_LAS float* tab;
    __device__ __forceinline__ void operator()(const f32x4 (&acc)[2][2][4][2], const Unit& u, int ui, int wr, int wc, int fr, int fq) const {
        if (u.pn < 8) {
            const bool isk = u.pn >= 4; const int head = u.pn & 3; const __amdgpu_buffer_rsrc_t rs_ = epi_rsrc(isk ? Kp : Q, 16384u * 2048u); const float sc = isk ? 0.0625f : 1.f; const int i0 = wc * 32 + 8 * fq;
#pragma unroll
            for (int ai = 0; ai < 2; ++ai)
#pragma unroll
                for (int m = 0; m < 4; ++m) { const int rl = ai * HALF + wr * 64 + m * 16 + fr, row = u.pm * BM + rl; const float rs = tab[ui * 256 + rl] * sc;
                    const f32x4* rp = (const f32x4*)(rope + ((size_t)(row & 8191) * 128 + i0) * 2);
                    f32x4 o1[2], o2[2];
#pragma unroll
                    for (int n = 0; n < 2; ++n) { const f32x4 t1 = acc[ai][0][m][n] * rs, t2 = acc[ai][1][m][n] * rs; const f32x4 ca = rp[2 * n], cb = rp[2 * n + 1];
                        o1[n][0] = t1[0] * ca[0] - t2[0] * ca[1]; o2[n][0] = t1[0] * ca[1] + t2[0] * ca[0];
                        o1[n][1] = t1[1] * ca[2] - t2[1] * ca[3]; o2[n][1] = t1[1] * ca[3] + t2[1] * ca[2];
                        o1[n][2] = t1[2] * cb[0] - t2[2] * cb[1]; o2[n][2] = t1[2] * cb[1] + t2[2] * cb[0];
                        o1[n][3] = t1[3] * cb[2] - t2[3] * cb[3]; o2[n][3] = t1[3] * cb[3] + t2[3] * cb[2]; }
                    const unsigned rowo = (unsigned)(row * 1024 + head * 256 + i0) * 2u;
                    st16(rs_, rowo, pack8f(o1[0], o1[1])); st16(rs_, rowo + HALF * 2, pack8f(o2[0], o2[1]));
                    if (m & 1) asm volatile("" ::: "memory"); }
        } else {
            const int cb = (u.pn - 8) * BM + wc * 32 + 8 * fq; const __amdgpu_buffer_rsrc_t rs_ = epi_rsrc(V, 16384u * 4096u);
#pragma unroll
            for (int ai = 0; ai < 2; ++ai)
#pragma unroll
                for (int m = 0; m < 4; ++m) { const int rl = ai * HALF + wr * 64 + m * 16 + fr; const float rs = tab[ui * 256 + rl];
                    const unsigned rowo = (unsigned)((u.pm * BM + rl) * 2048 + cb) * 2u;
#pragma unroll
                    for (int bj = 0; bj < 2; ++bj) st16(rs_, rowo + bj * HALF * 2, pack8f(acc[ai][bj][m][0] * rs, acc[ai][bj][m][1] * rs)); }
        }
    }
};
struct EpiGate {
    static constexpr bool PERM = true, AFTER_DRAIN = false, ACC_INIT = false;
    bf16_t* Y; const PG8_LAS float* tab; const PG8_LAS f32x2* stab;
    __device__ __forceinline__ void operator()(const f32x4 (&acc)[2][2][4][2], const Unit& u, int ui, int wr, int wc, int fr, int fq) const {
        const int cb = u.pn * BM + wc * 32 + 8 * fq; const __amdgpu_buffer_rsrc_t rs_ = epi_rsrc(Y, 16384u * 4096u);
#pragma unroll
        for (int ai = 0; ai < 2; ++ai)
#pragma unroll
            for (int m = 0; m < 4; ++m) { const int rl = ai * HALF + wr * 64 + m * 16 + fr; const float rs = tab[ui * 256 + rl]; const f32x2 st = stab[ui * 256 + rl];
                bf16_t* rowp = Y + (size_t)(u.pm * BM + rl) * 2048 + cb;
#pragma unroll
                for (int bj = 0; bj < 2; ++bj) { const u32x4 yv = *(const u32x4*)(rowp + bj * HALF); f32x4 y0, y1;
                    y0[0] = bf_lo(yv.x); y0[1] = bf_hi(yv.x); y0[2] = bf_lo(yv.y); y0[3] = bf_hi(yv.y); y1[0] = bf_lo(yv.z); y1[1] = bf_hi(yv.z); y1[2] = bf_lo(yv.w); y1[3] = bf_hi(yv.w);
                    f32x4 g0 = acc[ai][bj][m][0] * rs, g1 = acc[ai][bj][m][1] * rs;
#pragma unroll
                    for (int e = 0; e < 4; ++e) { g0[e] = silu_f(g0[e]) * ((y0[e] - st.x) * st.y); g1[e] = silu_f(g1[e]) * ((y1[e] - st.x) * st.y); }
                    st16(rs_, (unsigned)((u.pm * BM + rl) * 2048 + cb + bj * HALF) * 2u, pack8f(g0, g1)); } }
    }
};
struct EpiNull {
    static constexpr bool PERM = true, AFTER_DRAIN = false, ACC_INIT = false;
    int dummy;
    __device__ __forceinline__ void operator()(const f32x4 (&acc)[2][2][4][2], const Unit& u, int ui, int wr, int wc, int fr, int fq) const {
#pragma unroll
        for (int ai = 0; ai < 2; ++ai)
#pragma unroll
            for (int bj = 0; bj < 2; ++bj)
#pragma unroll
                for (int m = 0; m < 4; ++m) { asm volatile("" :: "v"(acc[ai][bj][m][0]), "v"(acc[ai][bj][m][1])); }
    }
};
template <class Epi, class Sched, bool ALIGN_EPI = false, bool SP2 = false>
__device__ __forceinline__ void gemm_phase(PG8_LAS unsigned char* lds, const Gemm g, const Sched& S, const Epi& E, int wave_in) {
    int tid_ = wave_in * 64 + hw_lane_id(); asm volatile("" : "+v"(tid_));
    const int tid = tid_, wid = __builtin_amdgcn_readfirstlane(tid >> 6), lane = tid & 63, wr = wid >> 2, wc = wid & 3, fr = lane & 15, fq = lane >> 4;
    const int K = g.K, nt = K / BK;
    unsigned voffA[2], voffB[2];
#pragma unroll
    for (int i = 0; i < 2; ++i) { int R, C; stage_rc(tid * 16 + i * 8192, R, C); const int Rb = Epi::PERM ? ((R & ~31) + perm32(R & 31)) : R;
        voffA[i] = (unsigned)(R * K + C) * 2u; voffB[i] = (unsigned)(Rb * K + C) * 2u; }
    const size_t kstep = (size_t)(BK * 2);
    const size_t hstep = (size_t)HALF * K * 2;
    const size_t tstep = 2 * hstep;
    const unsigned ldsw = (unsigned)wid * 1024u;
    const int aoff = lds_byte(wr * 64 + fr, fq * 8), boff = lds_byte(wc * 32 + fr, fq * 8);
#define PG8_SA(b, h) (((b) * 2 + (h)) * HTB)
#define PG8_SB(b, h) ((4 + (b) * 2 + (h)) * HTB)
#define PG8_STAGE(bufoff, gbase, voff) do { _Pragma("unroll") for (int _i = 0; _i < 2; ++_i) \
        __builtin_amdgcn_global_load_lds((const unsigned*)((const char*)(gbase) + (voff)[_i]), (PG8_LAS unsigned*)(lds + (bufoff) + ldsw + _i * 8192), 16, 0, 0); } while (0)
#define PG8_LDA(dst, b, h) do { _Pragma("unroll") for (int m = 0; m < 4; ++m) _Pragma("unroll") for (int k = 0; k < 2; ++k) dst[m][k] = *(const PG8_LAS bf16x8*)(lds + PG8_SA(b, h) + aoff + m * 2048 + k * 1024); } while (0)
#define PG8_LDB(dst, b, h) do { _Pragma("unroll") for (int n = 0; n < 2; ++n) _Pragma("unroll") for (int k = 0; k < 2; ++k) dst[n][k] = *(const PG8_LAS bf16x8*)(lds + PG8_SB(b, h) + boff + n * 2048 + k * 1024); } while (0)
#define PG8_MMA(ai, bj, At, Bt) do { __builtin_amdgcn_s_setprio(1); _Pragma("unroll") for (int m = 0; m < 4; ++m) _Pragma("unroll") for (int n = 0; n < 2; ++n) _Pragma("unroll") for (int k = 0; k < 2; ++k) \
        acc[ai][bj][m][n] = __builtin_amdgcn_mfma_f32_16x16x32_bf16(Bt[n][k], At[m][k], acc[ai][bj][m][n], 0, 0, 0); __builtin_amdgcn_s_setprio(0); } while (0)
#define PG8_WAIT_V(n) asm volatile("s_waitcnt vmcnt(" #n ")" ::: "memory")
#define PG8_WAIT_L(n) asm volatile("s_waitcnt lgkmcnt(" #n ")" ::: "memory")
#define PG8_BAR __builtin_amdgcn_s_barrier()
#define PG8_SCHED __builtin_amdgcn_sched_barrier(0)
    Unit cur, nxt; int ui = 0;
    if (!S.next(0, cur)) return;
    f32x4 acc[2][2][4][2];
    u32x4 raw[2][2][4];
    if constexpr (Epi::ACC_INIT) E.init_issue(raw, cur, wr, wc, fr, fq);
    bf16x8 At[4][2], B0[2][2], B1[2][2];
    const char* cA = (const char*)g.A + (size_t)cur.pm * tstep; const char* cB = (const char*)g.Bt + (size_t)cur.pn * tstep;
    S.a_ready(cur);
    if constexpr (SP2) {
        PG8_STAGE(PG8_SB(0, 0), cB, voffB); PG8_STAGE(PG8_SB(0, 1), cB + hstep, voffB); PG8_STAGE(PG8_SA(0, 0), cA, voffA); PG8_STAGE(PG8_SA(0, 1), cA + hstep, voffA);
        if (wr == 1) PG8_BAR;
        PG8_WAIT_V(2); PG8_BAR;
        PG8_STAGE(PG8_SB(1, 0), cB + kstep, voffB); PG8_STAGE(PG8_SA(1, 0), cA + kstep, voffA); PG8_STAGE(PG8_SB(1, 1), cB + hstep + kstep, voffB);
        PG8_WAIT_V(6); PG8_BAR;
    } else {
        PG8_STAGE(PG8_SB(0, 0), cB, voffB); PG8_STAGE(PG8_SA(0, 0), cA, voffA); PG8_STAGE(PG8_SB(0, 1), cB + hstep, voffB); PG8_STAGE(PG8_SA(0, 1), cA + hstep, voffA);
        if (wr == 1) PG8_BAR;
        PG8_WAIT_V(4); PG8_BAR;
        PG8_STAGE(PG8_SB(1, 0), cB + kstep, voffB); PG8_STAGE(PG8_SA(1, 0), cA + kstep, voffA); PG8_STAGE(PG8_SB(1, 1), cB + hstep + kstep, voffB);
        PG8_WAIT_V(6); PG8_BAR;
    }
    if constexpr (Epi::ACC_INIT) E.init_finish(acc, raw);
    else {
#pragma unroll
        for (int a = 0; a < 2; ++a)
#pragma unroll
            for (int b = 0; b < 2; ++b)
#pragma unroll
                for (int m = 0; m < 4; ++m)
#pragma unroll
                    for (int n = 0; n < 2; ++n) acc[a][b][m][n] = (f32x4){0.f, 0.f, 0.f, 0.f};
    }
    for (;;) {
        const bool has_next = S.next(ui + 1, nxt);
        const char* nA = has_next ? (const char*)g.A + (size_t)nxt.pm * tstep : cA; const char* nB = has_next ? (const char*)g.Bt + (size_t)nxt.pn * tstep : cB;
        for (int t = 0; t < nt; t += 2) {
            const bool last = (t == nt - 2);
            const char* a1 = cA + (size_t)(t + 1) * kstep;
            const char* a2 = last ? nA : cA + (size_t)(t + 2) * kstep; const char* b2 = last ? nB : cB + (size_t)(t + 2) * kstep;
            const char* a3 = a2 + kstep; const char* b3 = b2 + kstep;
            if (last && has_next) S.a_ready(nxt);
            if constexpr (SP2) {
            PG8_LDB(B0, 0, 0); PG8_LDB(B1, 0, 1); PG8_SCHED; PG8_LDA(At, 0, 0); PG8_STAGE(PG8_SA(1, 1), a1 + hstep, voffA);
            PG8_WAIT_V(8); PG8_WAIT_L(0); PG8_BAR; PG8_MMA(0, 0, At, B0); PG8_MMA(0, 1, At, B1); PG8_BAR; PG8_SCHED;
            PG8_LDA(At, 0, 1); PG8_STAGE(PG8_SB(0, 0), b2, voffB); PG8_STAGE(PG8_SB(0, 1), b2 + hstep, voffB); PG8_STAGE(PG8_SA(0, 0), a2, voffA);
            PG8_WAIT_V(8); PG8_WAIT_L(0); PG8_BAR; PG8_MMA(1, 0, At, B0); PG8_MMA(1, 1, At, B1); PG8_BAR; PG8_SCHED;
            PG8_LDB(B0, 1, 0); PG8_LDB(B1, 1, 1); PG8_SCHED; PG8_LDA(At, 1, 0); PG8_STAGE(PG8_SA(0, 1), a2 + hstep, voffA);
            PG8_WAIT_V(8); PG8_WAIT_L(0); PG8_BAR; PG8_MMA(0, 0, At, B0); PG8_MMA(0, 1, At, B1); PG8_BAR; PG8_SCHED;
            PG8_LDA(At, 1, 1); PG8_STAGE(PG8_SB(1, 0), b3, voffB); PG8_STAGE(PG8_SB(1, 1), b3 + hstep, voffB); PG8_STAGE(PG8_SA(1, 0), a3, voffA);
            PG8_WAIT_V(8); PG8_WAIT_L(0); PG8_BAR; PG8_MMA(1, 0, At, B0); PG8_MMA(1, 1, At, B1); PG8_BAR; PG8_SCHED;
            } else {
            PG8_LDB(B0, 0, 0); PG8_SCHED; PG8_LDA(At, 0, 0); PG8_STAGE(PG8_SA(1, 1), a1 + hstep, voffA);
            PG8_WAIT_L(8); PG8_BAR; PG8_WAIT_L(0); PG8_MMA(0, 0, At, B0); PG8_BAR; PG8_SCHED;
            PG8_LDB(B1, 0, 1); PG8_STAGE(PG8_SB(0, 0), b2, voffB);
            PG8_BAR; PG8_WAIT_L(0); PG8_MMA(0, 1, At, B1); PG8_BAR;
            PG8_LDA(At, 0, 1); PG8_STAGE(PG8_SA(0, 0), a2, voffA);
            PG8_BAR; PG8_WAIT_L(0); PG8_MMA(1, 0, At, B0); PG8_BAR; PG8_SCHED;
            PG8_STAGE(PG8_SB(0, 1), b2 + hstep, voffB);
            PG8_WAIT_V(6); PG8_BAR; PG8_MMA(1, 1, At, B1); PG8_BAR;
            PG8_LDB(B0, 1, 0); PG8_SCHED; PG8_LDA(At, 1, 0); PG8_STAGE(PG8_SA(0, 1), a2 + hstep, voffA);
            PG8_WAIT_L(8); PG8_BAR; PG8_WAIT_L(0); PG8_MMA(0, 0, At, B0); PG8_BAR; PG8_SCHED;
            PG8_LDB(B1, 1, 1); PG8_STAGE(PG8_SB(1, 0), b3, voffB);
            PG8_BAR; PG8_WAIT_L(0); PG8_MMA(0, 1, At, B1); PG8_BAR;
            PG8_LDA(At, 1, 1); PG8_STAGE(PG8_SA(1, 0), a3, voffA);
            PG8_BAR; PG8_WAIT_L(0); PG8_MMA(1, 0, At, B0); PG8_BAR; PG8_SCHED;
            PG8_STAGE(PG8_SB(1, 1), b3 + hstep, voffB);
            PG8_WAIT_V(6); PG8_BAR; PG8_MMA(1, 1, At, B1); PG8_BAR;
            }
        }
        if constexpr (ALIGN_EPI) { if (wr == 0) PG8_BAR; }
        if constexpr (!Epi::AFTER_DRAIN) { E(acc, cur, ui, wr, wc, fr, fq); S.done(cur); }
        if (!has_next) break;
        cur = nxt; cA = nA; cB = nB; ++ui;
        if constexpr (Epi::ACC_INIT) { E.init_issue(raw, cur, wr, wc, fr, fq); E.init_finish(acc, raw); }
        else {
#pragma unroll
            for (int a = 0; a < 2; ++a)
#pragma unroll
                for (int b = 0; b < 2; ++b)
#pragma unroll
                    for (int m = 0; m < 4; ++m)
#pragma unroll
                        for (int n = 0; n < 2; ++n) acc[a][b][m][n] = (f32x4){0.f, 0.f, 0.f, 0.f};
        }
        if constexpr (ALIGN_EPI) { if (wr == 1) PG8_BAR; }
    }
    PG8_WAIT_V(0);
    if constexpr (!ALIGN_EPI) { if (wr == 0) PG8_BAR; }
    PG8_BAR;
    if constexpr (Epi::AFTER_DRAIN) { E.fused(acc, cur, wr, wc, fr, fq, lds, wid, lane); S.done(cur); }
#undef PG8_SA
#undef PG8_SB
#undef PG8_STAGE
#undef PG8_LDA
#undef PG8_LDB
#undef PG8_MMA
#undef PG8_WAIT_V
#undef PG8_WAIT_L
#undef PG8_BAR
#undef PG8_SCHED
}
}
constexpr int NWAVES = 8;
constexpr int BATCH = 2, SEQ = 8192, D = 1024, M = BATCH * SEQ;
constexpr int FH = 8, FDH = 128;
constexpr int RH = 4, RDK = 256, RDV = 512, CH = 64, NCH = SEQ / CH;
constexpr int DFF = 2816;
constexpr float EPS = 1e-6f;
constexpr float LOG2E = 1.4426950408889634f;
constexpr float QSCALE = 0.08838834764831845f * LOG2E;
constexpr int NPHASE = 15;

constexpr size_t MiB = 1u << 20;
constexpr size_t WS_CTL = 0, CTL_ZERO_BYTES = 32768;
constexpr size_t WS_SSQ = 1 * MiB;
constexpr size_t WS_LC = 2 * MiB;
constexpr size_t WS_TT = 2 * MiB + 512 * 1024;
constexpr size_t WS_NRM = 2 * MiB + 512 * 1024 + 16384;
constexpr size_t WS_ROPE = 3 * MiB;
constexpr size_t WS_WQKV0 = 11 * MiB;
constexpr size_t WS_WO0 = 17 * MiB;
constexpr size_t WS_WFI0 = 19 * MiB;
constexpr size_t WS_WFO0 = 30 * MiB;
constexpr size_t WS_WRI = 36 * MiB;
constexpr size_t WS_WRO = 48 * MiB;
constexpr size_t WS_WFI1 = 52 * MiB;
constexpr size_t WS_WFO1 = 63 * MiB;
constexpr size_t WS_XB = 69 * MiB;
constexpr size_t WS_ACT = 101 * MiB;
constexpr size_t WS_Q0 = WS_ACT, WS_K0 = WS_ACT + 32 * MiB, WS_V0 = WS_ACT + 64 * MiB;
constexpr size_t WS_O0 = WS_ACT + 96 * MiB;
constexpr size_t WS_HID = WS_ACT;
constexpr size_t WS_Q1 = WS_ACT, WS_K1 = WS_ACT + 32 * MiB, WS_V1 = WS_ACT + 64 * MiB;
constexpr size_t WS_PST = WS_ACT + 128 * MiB;
constexpr size_t WS_CBG = WS_PST;
constexpr size_t WS_LBUF = WS_WQKV0;
constexpr size_t WS_END = WS_PST + 8 * MiB;
static_assert(WS_WFO1 + (size_t)1024 * 2816 * 2 <= WS_XB && WS_HID + (size_t)M * DFF * 2 <= WS_PST && WS_END <= 256 * MiB, "d_ws map");
constexpr int CW_TMO = 0, CW_CODE = 1;
constexpr int CW_BAR = 4096;
constexpr int CW_ATT = 2048;

constexpr int RING_OFF = 0, RING_BYTES = 131072;
constexpr int LDSCTL_OFF = RING_BYTES, MISC_OFF = LDSCTL_OFF + 320;
constexpr int TAB_OFF = RING_BYTES + 512;
constexpr int STAB_OFF = TAB_OFF + 8192;
constexpr int LDS_BYTES = 147456;
static_assert(STAB_OFF + 4096 <= LDS_BYTES, "LDS map");
#define GAS __attribute__((address_space(1)))
#define LAS __attribute__((address_space(3)))
typedef unsigned short bf16;
typedef unsigned v4u __attribute__((ext_vector_type(4)));
typedef float f32x4 __attribute__((ext_vector_type(4)));
typedef short bf16x8 __attribute__((ext_vector_type(8)));
typedef GAS unsigned gu32;
typedef GAS unsigned long long gu64;
#define RLX_AGENT __ATOMIC_RELAXED, __HIP_MEMORY_SCOPE_AGENT
#define LDS_WAIT() asm volatile("s_waitcnt lgkmcnt(0)" ::: "memory")
#define VM_WAIT() asm volatile("s_waitcnt vmcnt(0)" ::: "memory")
__device__ __forceinline__ unsigned long long rt() { return __builtin_amdgcn_s_memrealtime(); }
__device__ __forceinline__ unsigned f2bf(float f) { unsigned u = __builtin_bit_cast(unsigned, f); return (u + 0x7fffu + ((u >> 16) & 1u)) >> 16; }
__device__ __forceinline__ unsigned pk2(float lo, float hi) { return f2bf(lo) | (f2bf(hi) << 16); }
typedef float f32x2 __attribute__((ext_vector_type(2)));
#define XB_TMO      128
#define XB_XCNT(j)  (256  + 64 * (j))
#define XB_XSUB(j)  (1280 + 64 * (j))
#define XB_XGEN(j)  (2304 + 64 * (j))
#define XB_TOP      3328
#define XB_TOPGEN   3392
#define XCD_BAR_WORDS 3456
#define XB_SPIN_CAP (1u << 18)

__device__ __forceinline__ unsigned xb_ld(unsigned* p)              { return __hip_atomic_load(p, __ATOMIC_RELAXED, __HIP_MEMORY_SCOPE_AGENT); }
__device__ __forceinline__ unsigned xb_add(unsigned* p, unsigned v) { return __hip_atomic_fetch_add(p, v, __ATOMIC_RELAXED, __HIP_MEMORY_SCOPE_AGENT); }
__device__ __forceinline__ unsigned xb_xcc_id() { return (unsigned)__builtin_amdgcn_s_getreg((3 << 11) | 20) & 0xFu; }
#define XB_SPIN(cond, bar) do { unsigned _sp = 0; while (cond) { __builtin_amdgcn_s_sleep(1); \
    if ((++_sp & 255u) == 0u) { if (xb_ld(&(bar)[XB_TMO])) break; if (_sp > XB_SPIN_CAP) { atomicAdd(&(bar)[XB_TMO], 1u); break; } } } } while (0)

struct XcdBarrier {
    unsigned* bar; unsigned x;
    volatile LAS unsigned* st;
};

__device__ __forceinline__ XcdBarrier xcd_barrier_post(unsigned* bar, volatile LAS unsigned* st) {
    XcdBarrier b; b.bar = bar; b.x = xb_xcc_id(); b.st = st;
    if (threadIdx.x == 0) (void)xb_add(&bar[XB_XCNT(b.x)], 1u);
    return b;
}
__device__ __forceinline__ void xcd_barrier_complete(unsigned* bar, unsigned x, unsigned& nloc, unsigned& nx) {
    const unsigned G = gridDim.x * gridDim.y * gridDim.z;
    unsigned sum, cnt, mine, sp = 0u;
    for (;;) {
        sum = 0u; cnt = 0u; mine = 0u;
#pragma unroll
        for (unsigned j = 0; j < 16; ++j) { const unsigned c = xb_ld(&bar[XB_XCNT(j)]); sum += c; cnt += (c > 0u) ? 1u : 0u; mine = (j == x) ? c : mine; }
        if (sum == G) break;
        __builtin_amdgcn_s_sleep(1);
        if ((++sp & 255u) == 0u) { if (xb_ld(&bar[XB_TMO])) break; if (sp > XB_SPIN_CAP) { atomicAdd(&bar[XB_TMO], 1u); break; } }
    }
    nloc = mine > 0u ? mine : 1u; nx = cnt > 0u ? cnt : 1u;
}

__device__ __forceinline__ void xcd_barrier(const XcdBarrier& b) {
    asm volatile("s_waitcnt vmcnt(0)" ::: "memory");
    __syncthreads();
    if (threadIdx.x == 0) {
        unsigned* bar = b.bar;
        __builtin_amdgcn_s_waitcnt(0);
        unsigned nloc = b.st[0], nx = b.st[1];
        if (nloc == 0u) { xcd_barrier_complete(bar, b.x, nloc, nx); b.st[0] = nloc; b.st[1] = nx; }
        const unsigned old = xb_add(&bar[XB_XSUB(b.x)], 1u);
        const unsigned gen = old / nloc;
        if (old + 1u == (gen + 1u) * nloc) {
            __builtin_amdgcn_fence(__ATOMIC_RELEASE, "agent");
            asm volatile("s_waitcnt vmcnt(0)" ::: "memory");
            const unsigned og = xb_add(&bar[XB_TOP], 1u);
            const unsigned tg = og / nx;
            if (og + 1u == (tg + 1u) * nx) xb_add(&bar[XB_TOPGEN], 1u);
            else XB_SPIN(xb_ld(&bar[XB_TOPGEN]) == tg, bar);
            __builtin_amdgcn_fence(__ATOMIC_ACQUIRE, "agent");
            xb_add(&bar[XB_XGEN(b.x)], 1u);
            asm volatile("s_waitcnt vmcnt(0)" ::: "memory");
        } else {
            XB_SPIN(xb_ld(&bar[XB_XGEN(b.x)]) == gen, bar);
            __builtin_amdgcn_fence(__ATOMIC_ACQUIRE, "agent");
            asm volatile("s_waitcnt vmcnt(0)" ::: "memory");
        }
    }
    __syncthreads();
}
namespace fa {
constexpr int D = 128, LDQ = 1024;
constexpr float THR = 8.f;
constexpr bool WSKIP = false;
constexpr int NW = 8, QBLK = 32, KVBLK = 64, QB = NW * QBLK;
constexpr int SHM_V = KVBLK * D * 2, SHM_K = KVBLK * D * 2;
constexpr int LDS_BYTES = 131072;
using bf16 = unsigned short;
typedef short bf16x8 __attribute__((ext_vector_type(8)));
typedef short s16x4 __attribute__((ext_vector_type(4)));
typedef float f32x16 __attribute__((ext_vector_type(16)));
typedef float f32x4 __attribute__((ext_vector_type(4)));
typedef unsigned u32x4 __attribute__((ext_vector_type(4)));
#define KSWZ(row, colB) ((row) * 256 + ((colB) ^ (((row) & 7) << 4)))
#define SBAR() __builtin_amdgcn_sched_barrier(0)
__device__ __forceinline__ int v_st(int k, int c) { const int kk = (k & ~0xC) | ((k & 4) << 1) | ((k & 8) >> 1); return ((kk >> 3) * 4 + (c >> 5)) * 512 + ((kk & 7) * 32 + (c & 31)) * 2; }
__device__ __forceinline__ int v_rd_base(int lane) { return ((lane & 3) << 3) | (((lane >> 2) & 3) << 6) | (((lane >> 4) & 1) << 5) | (((lane >> 5) & 1) << 8); }
constexpr int v_rd_off(int d0, int ks, int half) { return d0 * 512 + ks * 4096 + half * 2048; }
__device__ __forceinline__ int crow(int r, int hi) { return (r & 3) + 8 * (r >> 2) + 4 * hi; }
__device__ __forceinline__ unsigned cvtpk(float lo, float hi) {
    unsigned r; asm volatile("v_cvt_pk_bf16_f32 %0, %1, %2" : "=v"(r) : "v"(lo), "v"(hi)); return r;
}
__device__ __forceinline__ bf16x8 pack8(f32x4 a, f32x4 b) {
    u32x4 w = {cvtpk(a[0], a[1]), cvtpk(a[2], a[3]), cvtpk(b[0], b[1]), cvtpk(b[2], b[3])};
    return *reinterpret_cast<bf16x8*>(&w);
}
__device__ __forceinline__ bf16x8 load8(const bf16* p) { return *reinterpret_cast<const bf16x8*>(p); }
__device__ __forceinline__ void mask_tile(f32x16& p0, f32x16& p1, int dq, unsigned W) {
    const float NEG = -__builtin_inff();
#pragma unroll
    for (int r = 0; r < 16; ++r) {
        const int c = (r & 3) + 8 * (r >> 2);
        if ((unsigned)(dq - c) >= W) p0[r] = NEG;
        if ((unsigned)(dq - c - 32) >= W) p1[r] = NEG;
    }
}
__device__ __forceinline__ void partialSM(f32x16& p0, f32x16& p1, float& m_reg, float& mn, float& alpha) {
    float pmax = p0[0]; for (int r = 1; r < 16; ++r) pmax = fmaxf(pmax, p0[r]); for (int r = 0; r < 16; ++r) pmax = fmaxf(pmax, p1[r]);
    { auto rr = __builtin_amdgcn_permlane32_swap(__float_as_uint(pmax), __float_as_uint(pmax), false, false);
      pmax = fmaxf(__uint_as_float(rr[0]), __uint_as_float(rr[1])); }
    if (__builtin_expect(__all((pmax - m_reg) <= THR), 1)) { mn = m_reg; alpha = 1.f; }
    else { mn = fmaxf(m_reg, pmax); alpha = __builtin_amdgcn_exp2f(m_reg - mn); m_reg = mn; }
    for (int r = 0; r < 16; ++r) p0[r] = p0[r] - mn; for (int r = 0; r < 16; ++r) p1[r] = p1[r] - mn;
    for (int r = 0; r < 16; ++r) p0[r] = __builtin_amdgcn_exp2f(p0[r]);
}
__device__ __forceinline__ void finishSM(f32x16& p0, f32x16& p1, float alpha, float& l_reg, bf16x8& pa0, bf16x8& pa1, bf16x8& pa2, bf16x8& pa3) {
    for (int r = 0; r < 16; ++r) p1[r] = __builtin_amdgcn_exp2f(p1[r]);
    float ps = 0; for (int r = 0; r < 16; ++r) ps += p0[r]; for (int r = 0; r < 16; ++r) ps += p1[r];
    { auto rr = __builtin_amdgcn_permlane32_swap(__float_as_uint(ps), __float_as_uint(ps), false, false);
      ps = __uint_as_float(rr[0]) + __uint_as_float(rr[1]); }
    l_reg = l_reg * alpha + ps;
#define PK4(P, B_, OUT) do { unsigned a0 = cvtpk(P[B_+0], P[B_+1]), a1 = cvtpk(P[B_+2], P[B_+3]);                          \
        unsigned b0 = cvtpk(P[B_+4], P[B_+5]), b1 = cvtpk(P[B_+6], P[B_+7]);                                             \
        auto r0 = __builtin_amdgcn_permlane32_swap(a0, b0, false, false); auto r1 = __builtin_amdgcn_permlane32_swap(a1, b1, false, false); \
        u32x4 w = {r0[0], r1[0], r0[1], r1[1]}; OUT = *reinterpret_cast<bf16x8*>(&w); } while (0)
    PK4(p0, 0, pa0); PK4(p0, 8, pa1); PK4(p1, 0, pa2); PK4(p1, 8, pa3);
#undef PK4
}
__device__ __forceinline__ void qkt(f32x16& p0, f32x16& p1, const char* K_slot, int r32, int hi, const bf16x8* qr, const float* cbt) {
#pragma unroll
    for (int g = 0; g < 4; ++g) { const f32x4 a = *(const f32x4*)(cbt + 8 * g + 4 * hi), b = *(const f32x4*)(cbt + 32 + 8 * g + 4 * hi);
        p0[4 * g] = a[0]; p0[4 * g + 1] = a[1]; p0[4 * g + 2] = a[2]; p0[4 * g + 3] = a[3]; p1[4 * g] = b[0]; p1[4 * g + 1] = b[1]; p1[4 * g + 2] = b[2]; p1[4 * g + 3] = b[3]; }
    const char* kb[4];
#pragma unroll
    for (int dd = 0; dd < 4; ++dd) kb[dd] = K_slot + KSWZ(r32, (dd * 16 + hi * 8) * 2);
#pragma unroll
    for (int d0 = 0; d0 < 8; ++d0) { const char* a = kb[d0 & 3] + (d0 >> 2) * 128;
        bf16x8 b0 = *reinterpret_cast<const bf16x8*>(a);
        bf16x8 b1 = *reinterpret_cast<const bf16x8*>(a + 32 * 256);
        p0 = __builtin_amdgcn_mfma_f32_32x32x16_bf16(b0, qr[d0], p0, 0, 0, 0);
        p1 = __builtin_amdgcn_mfma_f32_32x32x16_bf16(b1, qr[d0], p1, 0, 0, 0); }
}
__device__ __forceinline__ void pv_tile(f32x16* o, int vbs, bf16x8 pa0, bf16x8 pa1, bf16x8 pa2, bf16x8 pa3) {
#define TRRD(dst, off) asm volatile("ds_read_b64_tr_b16 %0, %1 offset:%2" : "=&v"(dst) : "v"(vbs), "i"(off) : "memory")
#define PV_D0(d0) do { s16x4 l0, l1, l2, l3, h0, h1, h2, h3; constexpr int b_ = v_rd_off(d0, 0, 0);     \
        TRRD(l0, b_); TRRD(h0, b_ + 2048); TRRD(l1, b_ + 4096); TRRD(h1, b_ + 6144); TRRD(l2, b_ + 8192); TRRD(h2, b_ + 10240); TRRD(l3, b_ + 12288); TRRD(h3, b_ + 14336); \
        asm volatile("s_waitcnt lgkmcnt(0)" ::: "memory"); SBAR();                 \
        o[d0] = __builtin_amdgcn_mfma_f32_32x32x16_bf16(pa0, (bf16x8){l0[0], l0[1], l0[2], l0[3], h0[0], h0[1], h0[2], h0[3]}, o[d0], 0, 0, 0);   \
        o[d0] = __builtin_amdgcn_mfma_f32_32x32x16_bf16(pa1, (bf16x8){l1[0], l1[1], l1[2], l1[3], h1[0], h1[1], h1[2], h1[3]}, o[d0], 0, 0, 0);   \
        o[d0] = __builtin_amdgcn_mfma_f32_32x32x16_bf16(pa2, (bf16x8){l2[0], l2[1], l2[2], l2[3], h2[0], h2[1], h2[2], h2[3]}, o[d0], 0, 0, 0);   \
        o[d0] = __builtin_amdgcn_mfma_f32_32x32x16_bf16(pa3, (bf16x8){l3[0], l3[1], l3[2], l3[3], h3[0], h3[1], h3[2], h3[3]}, o[d0], 0, 0, 0); } while (0)
    PV_D0(0); PV_D0(1); PV_D0(2); PV_D0(3);
#undef PV_D0
#undef TRRD
}

#define FGAS __attribute__((address_space(1)))
struct BlockRef { FGAS char* base; unsigned qo, ko, vo, oo, cbo; int P0, kb0, khi, mode, slot; float Bq; FGAS char* part; FGAS float* pml; FGAS unsigned* cnt; };
constexpr int LDS_VR = 0, LDS_KR = 3 * SHM_V, LDS_CBR = 3 * SHM_V + 3 * SHM_K, LDS_WSR = 131584;
__device__ __forceinline__ void glds16(const FGAS char* gsrc, unsigned lds_dst) {
    unsigned keep; asm volatile("s_mov_b32 %0, m0\n\ts_mov_b32 m0, %2\n\ts_nop 0\n\tglobal_load_lds_dwordx4 %1, off\n\ts_mov_b32 m0, %0" : "=&s"(keep) : "v"(gsrc), "s"(lds_dst) : "memory");
}
typedef unsigned u32x2 __attribute__((ext_vector_type(2)));
__device__ __forceinline__ float qx1(float v) { return __builtin_bit_cast(float, __builtin_amdgcn_mov_dpp(__builtin_bit_cast(int, v), 0xB1, 0xF, 0xF, true)); }
__device__ __forceinline__ float qx2(float v) { return __builtin_bit_cast(float, __builtin_amdgcn_mov_dpp(__builtin_bit_cast(int, v), 0x4E, 0xF, 0xF, true)); }
#define WAIT_BAR(N) asm volatile("s_waitcnt vmcnt(" #N ") lgkmcnt(0)\n\ts_barrier" ::: "memory")
__device__ __forceinline__ void fa_block(const BlockRef& cur, char* lds, int tid_in) {
    int tid = tid_in; asm volatile("" : "+v"(tid));
    const int wid = __builtin_amdgcn_readfirstlane(tid >> 6), lane = tid & 63, r32 = lane & 31, hi = lane >> 5;
    const int kb0 = cur.kb0, NT0 = (cur.khi - kb0) / KVBLK;
    const int NT = NT0;
    const int qlo = cur.P0 + wid * QBLK, qm = qlo + r32 - 4 * hi;
    float* CBA = (float*)(lds + LDS_CBR);
    float* ws = (float*)(lds + LDS_WSR) + wid * 64; float* li_l = ws, * al_l = ws + 32; float* mm_l = (float*)(lds + LDS_WSR + 2048);
    const unsigned lds0 = (unsigned)(uintptr_t)lds;
    for (int i = tid; i < (cur.khi - kb0) / 4; i += NW * 64) ((f32x4*)CBA)[i] = *(const FGAS f32x4*)(cur.base + cur.cbo + (unsigned)(kb0 * 4) + (unsigned)i * 16u);
    bf16x8 qr[8];
    { const unsigned qoff = (unsigned)(((wid * QBLK + r32) * LDQ + hi * 8) * 2);
#pragma unroll
      for (int d0 = 0; d0 < 8; ++d0) qr[d0] = *(const FGAS bf16x8*)(cur.base + cur.qo + qoff + d0 * 32); }
    asm volatile("s_waitcnt vmcnt(0)" ::: "memory");
    unsigned kso[2], vso[2];
#pragma unroll
    for (int i = 0; i < 2; ++i) { const int p = 2 * wid + i, row = 4 * p + (lane >> 4), c = (lane & 15) ^ (row & 7); kso[i] = (unsigned)(row * (LDQ * 2) + c * 16);
        const int sub = 2 * p + (lane >> 5), kk = 8 * (sub >> 2) + ((lane & 31) >> 2), k = (kk & ~0xC) | ((kk & 4) << 1) | ((kk & 8) >> 1), cc = 32 * (sub & 3) + 8 * (lane & 3); vso[i] = (unsigned)(k * (LDQ * 2) + cc * 2); }
    const FGAS char* Kt = cur.base + cur.ko + (size_t)kb0 * (LDQ * 2); const FGAS char* Vt = cur.base + cur.vo + (size_t)kb0 * (LDQ * 2);
#define DMA_K(t, slot) do { const FGAS char* g_ = Kt + (size_t)(NT0 - 1 - (t)) * (KVBLK * LDQ * 2); const unsigned d_ = (unsigned)__builtin_amdgcn_readfirstlane(lds0 + LDS_KR + (slot) + 2048 * wid); glds16(g_ + kso[0], d_); glds16(g_ + kso[1], d_ + 1024); } while (0)
#define DMA_V(t, slot) do { const FGAS char* g_ = Vt + (size_t)(NT0 - 1 - (t)) * (KVBLK * LDQ * 2); const unsigned d_ = (unsigned)__builtin_amdgcn_readfirstlane(lds0 + LDS_VR + (slot) + 2048 * wid); glds16(g_ + vso[0], d_); glds16(g_ + vso[1], d_ + 1024); } while (0)
    DMA_K(0, 0); DMA_V(0, 0); DMA_K(1, SHM_K);
    float m_reg = -1e30f, l_reg = 0; f32x16 o[4] = {};
    const int vb0 = (int)lds0 + LDS_VR + v_rd_base(lane);
#define RESC(a) do { if (__any((a) < 1.f)) { if (hi == 0) al_l[r32] = (a); asm volatile("s_waitcnt lgkmcnt(0)" ::: "memory");              \
                     for (int d_ = 0; d_ < 4; ++d_) for (int r = 0; r < 16; ++r) o[d_][r] *= al_l[crow(r, hi)]; } } while (0)
#define KBASE(t) (kb0 + (NT0 - 1 - (t)) * KVBLK)
#define MASKT(P0_, P1_, t) do { const int kb_ = KBASE(t); if (kb_ + KVBLK - 1 > qlo) mask_tile(P0_, P1_, qm - kb_, 0x40000000u); } while (0)
    f32x16 pA0, pA1, pB0, pB1; float mnA, mnB, alA, alB; bf16x8 pa0, pa1, pa2, pa3;
    int s_prev = 0, s_cur = 0, s_next = SHM_K;
#define ROT() do { s_prev = s_cur; s_cur = s_next; s_next = (s_next == 2 * SHM_K) ? 0 : s_next + SHM_K; } while (0)
    WAIT_BAR(4);
    DMA_K(2, 2 * SHM_K); DMA_V(1, SHM_V);
    SBAR(); qkt(pA0, pA1, lds + LDS_KR, r32, hi, qr, CBA + (NT0 - 1) * KVBLK);
    MASKT(pA0, pA1, 0); partialSM(pA0, pA1, m_reg, mnA, alA);
    WAIT_BAR(4);
    ROT();
#define STEP(PX0, PX1, mnX, alX, PY0, PY1, alY, t) do {                                                                       \
        { const int s_nn = (s_next == 2 * SHM_K) ? 0 : s_next + SHM_K;                  \
          if ((t) + 2 < NT) DMA_K((t) + 2, s_nn); if ((t) + 1 < NT) DMA_V((t) + 1, s_next); }                                  \
        SBAR(); qkt(PX0, PX1, lds + LDS_KR + s_cur, r32, hi, qr, CBA + (NT0 - 1 - (t)) * KVBLK);                                           \
        finishSM(PY0, PY1, alY, l_reg, pa0, pa1, pa2, pa3); SBAR();                                                           \
        pv_tile(o, vb0 + s_prev, pa0, pa1, pa2, pa3); MASKT(PX0, PX1, (t)); partialSM(PX0, PX1, m_reg, mnX, alX);             \
        RESC(alX);                                                                                                            \
        if ((t) + 2 < NT) WAIT_BAR(4); else if ((t) + 1 < NT) WAIT_BAR(2); else WAIT_BAR(0);                                   \
        ROT(); } while (0)
    int t = 1;
    for (; t + 1 < NT; t += 2) {
        STEP(pB0, pB1, mnB, alB, pA0, pA1, alA, t);
        STEP(pA0, pA1, mnA, alA, pB0, pB1, alB, t + 1);
    }
    if (t < NT) {
        STEP(pB0, pB1, mnB, alB, pA0, pA1, alA, t);
        finishSM(pB0, pB1, alB, l_reg, pa0, pa1, pa2, pa3); SBAR();
    } else {
        finishSM(pA0, pA1, alA, l_reg, pa0, pa1, pa2, pa3); SBAR();
    }
    pv_tile(o, vb0 + s_prev, pa0, pa1, pa2, pa3);
    if (hi == 0) li_l[r32] = l_reg; asm volatile("s_waitcnt lgkmcnt(0)" ::: "memory");
#pragma unroll
    for (int r = 0; r < 16; ++r) { const float rl = __builtin_amdgcn_rcpf(li_l[crow(r, hi)]);
#pragma unroll
        for (int d0 = 0; d0 < 4; ++d0) o[d0][r] *= rl; }
    bool store_o = true;
    if (cur.mode == 1) {
        FGAS char* pp = cur.part + (size_t)cur.slot * 65536 + (unsigned)(wid * 8192 + lane * 16);
#pragma unroll
        for (int q = 0; q < 8; ++q) { u32x4 w;
            w.x = cvtpk(o[q >> 1][8 * (q & 1)], o[q >> 1][8 * (q & 1) + 1]); w.y = cvtpk(o[q >> 1][8 * (q & 1) + 2], o[q >> 1][8 * (q & 1) + 3]);
            w.z = cvtpk(o[q >> 1][8 * (q & 1) + 4], o[q >> 1][8 * (q & 1) + 5]); w.w = cvtpk(o[q >> 1][8 * (q & 1) + 6], o[q >> 1][8 * (q & 1) + 7]);
            *(FGAS u32x4*)(pp + q * 1024) = w; }
        typedef float f32x2 __attribute__((ext_vector_type(2)));
        if (hi == 0) { f32x2 ml; ml.x = m_reg; ml.y = l_reg; *(FGAS f32x2*)(cur.pml + ((size_t)cur.slot * 256 + wid * QBLK + r32) * 2) = ml; }
        asm volatile("s_waitcnt vmcnt(0) lgkmcnt(0)\n\ts_barrier" ::: "memory");
        int* hf = (int*)(lds + LDS_WSR + 2048);
        if (tid == 0) { __builtin_amdgcn_fence(__ATOMIC_RELEASE, "agent"); asm volatile("s_waitcnt vmcnt(0)" ::: "memory");
            const unsigned old = __hip_atomic_fetch_add(cur.cnt, 1u, __ATOMIC_RELAXED, __HIP_MEMORY_SCOPE_AGENT);
            if (old == 1u) { __builtin_amdgcn_fence(__ATOMIC_ACQUIRE, "agent"); asm volatile("s_waitcnt vmcnt(0)" ::: "memory"); }
            hf[0] = (int)old; }
        asm volatile("s_waitcnt vmcnt(0) lgkmcnt(0)\n\ts_barrier" ::: "memory");
        store_o = __builtin_amdgcn_readfirstlane(hf[0]) == 1;
        if (store_o) {
            const int oslot = cur.slot ^ 1;
            if (hi == 0) { const f32x2 mo = *(const FGAS f32x2*)(cur.pml + ((size_t)oslot * 256 + wid * QBLK + r32) * 2);
                const float M = fmaxf(m_reg, mo.x), a = l_reg * __builtin_amdgcn_exp2f(m_reg - M), b = mo.y * __builtin_amdgcn_exp2f(mo.x - M), inv = 1.0f / (a + b);
                li_l[r32] = a * inv; al_l[r32] = b * inv; }
            const FGAS char* po = cur.part + (size_t)oslot * 65536 + (unsigned)(wid * 8192 + lane * 16);
            u32x4 ov[8];
#pragma unroll
            for (int q = 0; q < 8; ++q) ov[q] = *(const FGAS u32x4*)(po + q * 1024);
            asm volatile("s_waitcnt lgkmcnt(0)" ::: "memory");
#pragma unroll
            for (int r = 0; r < 16; ++r) { const float ws_ = li_l[crow(r, hi)], wo_ = al_l[crow(r, hi)];
#pragma unroll
                for (int d0 = 0; d0 < 4; ++d0) { const u32x4 w = ov[2 * d0 + (r >> 3)]; const unsigned wd = (r & 7) < 2 ? w.x : ((r & 7) < 4 ? w.y : ((r & 7) < 6 ? w.z : w.w));
                    const float other = (r & 1) ? __builtin_bit_cast(float, wd & 0xffff0000u) : __builtin_bit_cast(float, wd << 16);
                    o[d0][r] = ws_ * o[d0][r] + wo_ * other; } }
        }
    }
    if (store_o) {
        const bool l0 = (r32 & 1) != 0, l1 = (r32 & 2) != 0;
        FGAS char* ob = cur.base + cur.oo + (unsigned)(((wid * QBLK + (r32 & 3) + 4 * hi) * LDQ + 4 * (r32 >> 2)) * 2);
#pragma unroll
        for (int d0 = 0; d0 < 4; ++d0)
#pragma unroll
            for (int k = 0; k < 4; ++k) { float a0 = o[d0][4 * k], a1 = o[d0][4 * k + 1], a2 = o[d0][4 * k + 2], a3 = o[d0][4 * k + 3];
                { const float r = qx1(l0 ? a0 : a1); a0 = l0 ? r : a0; a1 = l0 ? a1 : r; }
                { const float r = qx1(l0 ? a2 : a3); a2 = l0 ? r : a2; a3 = l0 ? a3 : r; }
                { const float r = qx2(l1 ? a0 : a2); a0 = l1 ? r : a0; a2 = l1 ? a2 : r; }
                { const float r = qx2(l1 ? a1 : a3); a1 = l1 ? r : a1; a3 = l1 ? a3 : r; }
                u32x2 w; w.x = cvtpk(a0, a1); w.y = cvtpk(a2, a3);
                *(FGAS u32x2*)(ob + (unsigned)(8 * k * LDQ * 2 + d0 * 64)) = w; }
    }
    asm volatile("s_waitcnt vmcnt(0) lgkmcnt(0)\n\ts_barrier" ::: "memory");
#undef RESC
#undef KBASE
#undef MASKT
#undef STEP
#undef ROT
#undef DMA_K
#undef DMA_V
}
#undef WAIT_BAR
#undef FGAS
#undef SBAR
#undef KSWZ
}
namespace rtn {
#define RLAS __attribute__((address_space(3)))
#define RGAS __attribute__((address_space(1)))
typedef short bf16x8 __attribute__((ext_vector_type(8)));
typedef short v4i16_t __attribute__((ext_vector_type(4)));
typedef float f32x16 __attribute__((ext_vector_type(16)));
typedef float f32x4 __attribute__((ext_vector_type(4)));
typedef unsigned u32x4 __attribute__((ext_vector_type(4)));
typedef unsigned u32x2 __attribute__((ext_vector_type(2)));
constexpr int NG = 16, RG = 8;
constexpr int LQ = 0, LK = 32768, LV = 65536, LK2 = 98304, LS = 132096, LPW = 140288;
constexpr int LDS_BYTES = LPW + 1024;
__device__ __forceinline__ int crow(int r, int hi) { return (r & 3) + 8 * (r >> 2) + 4 * hi; }
__device__ __forceinline__ unsigned cvtpk(float lo, float hi) { unsigned r; asm volatile("v_cvt_pk_bf16_f32 %0, %1, %2" : "=v"(r) : "v"(lo), "v"(hi)); return r; }
__device__ __forceinline__ float bflo(unsigned w) { return __builtin_bit_cast(float, w << 16); }
__device__ __forceinline__ float bfhi(unsigned w) { return __builtin_bit_cast(float, w & 0xffff0000u); }
__device__ __forceinline__ int off512(int row, int ch) { return 512 * row + 16 * (ch ^ (((row & 3) << 2) | ((row >> 2) & 3))); }
__device__ __forceinline__ int offS(int row, int ch8) { return 128 * row + 16 * (ch8 ^ ((row >> 1) & 7)); }
__device__ __forceinline__ bf16x8 lds128(unsigned a) { return *(const RLAS bf16x8*)(uintptr_t)a; }
__device__ __forceinline__ v4i16_t ldstr(unsigned a) { return __builtin_amdgcn_ds_read_tr16_b64_v4i16((RLAS v4i16_t*)(uintptr_t)a); }
__device__ __forceinline__ void glds16(const RGAS char* gsrc, unsigned lds_dst) {
    unsigned keep; asm volatile("s_mov_b32 %0, m0\n\ts_mov_b32 m0, %2\n\ts_nop 0\n\tglobal_load_lds_dwordx4 %1, off\n\ts_mov_b32 m0, %0" : "=&s"(keep) : "v"(gsrc), "s"(lds_dst) : "memory");
}
__device__ __forceinline__ void stage_tile(const RGAS char* g, unsigned ld_bytes, unsigned lbase, int wave, int lane) {
#pragma unroll
    for (int i = 0; i < 4; ++i) { const int pid = wave * 4 + i, row = 2 * pid + (lane >> 5), ch = (lane & 31) ^ (((row & 3) << 2) | ((row >> 2) & 3));
        glds16(g + (unsigned)row * ld_bytes + (unsigned)ch * 16u, (unsigned)__builtin_amdgcn_readfirstlane(lbase + 1024u * (unsigned)pid)); }
}
#ifndef RT_TOUCH
#define RT_TOUCH 0
#endif
#ifndef RT_TPROBE
#define RT_TPROBE 0
#endif
constexpr int LDUMMY = 145408;
__device__ __forceinline__ float qx1(float v) { return __builtin_bit_cast(float, __builtin_amdgcn_mov_dpp(__builtin_bit_cast(int, v), 0xB1, 0xF, 0xF, true)); }
__device__ __forceinline__ float qx2(float v) { return __builtin_bit_cast(float, __builtin_amdgcn_mov_dpp(__builtin_bit_cast(int, v), 0x4E, 0xF, 0xF, true)); }
__device__ __forceinline__ void glds4(const RGAS char* gsrc, unsigned lds_dst) {
    unsigned keep; asm volatile("s_mov_b32 %0, m0\n\ts_mov_b32 m0, %2\n\ts_nop 0\n\tglobal_load_lds_dword %1, off\n\ts_mov_b32 m0, %0" : "=&s"(keep) : "v"(gsrc), "s"(lds_dst) : "memory");
}
__device__ __forceinline__ void touch_tile(const RGAS char* g, unsigned ld_bytes, unsigned lds0, int wave, int lane) {
    const unsigned line = (unsigned)((wave & 3) * 64 + lane);
    glds4(g + (line >> 2) * ld_bytes + (line & 3) * 128u, (unsigned)__builtin_amdgcn_readfirstlane(lds0 + LDUMMY + 256u * (unsigned)wave));
}
struct Ptrs { const RGAS char* Q; const RGAS char* K; RGAS char* V; RGAS char* L; RGAS float* PST; };
__device__ __forceinline__ void load_vfrags(bf16x8 (&vf)[4], unsigned vb0, unsigned vb1) {
#pragma unroll
    for (int s = 0; s < 4; ++s) { const v4i16_t lo = ldstr(vb0 + 8192 * s), hi = ldstr(vb1 + 8192 * s + 2048); vf[s] = (bf16x8){lo[0], lo[1], lo[2], lo[3], hi[0], hi[1], hi[2], hi[3]}; }
}
__device__ __forceinline__ void update_state(f32x16 (&X)[8], const bf16x8 (&vf)[4], unsigned kt0, unsigned kt1, unsigned lds0, int hh, float scl) {
    const RLAS float* pwr = (const RLAS float*)(uintptr_t)(lds0 + LPW + 144 * 4);
    v4i16_t fa[3][2][2];
#define RT_LOADB(buf, b) do { _Pragma("unroll") for (int j = 0; j < 2; ++j) { const int dt_ = 2 * ((b) & 3) + j, s_ = (b) >> 2; \
        fa[buf][j][0] = ldstr((kt0 ^ (unsigned)(64 * dt_)) + 8192 * s_); fa[buf][j][1] = ldstr((kt1 ^ (unsigned)(64 * dt_)) + 8192 * s_ + 2048); } } while (0)
    RT_LOADB(0, 0); RT_LOADB(1, 1);
    bf16x8 vs;
#pragma unroll
    for (int b = 0; b < 16; ++b) {
        if (b + 2 < 16) RT_LOADB((b + 2) % 3, b + 2);
        if ((b & 3) == 0) { const int s = b >> 2; const f32x4 f0 = *(const RLAS f32x4*)(pwr + 16 * s + 8 * hh), f1 = *(const RLAS f32x4*)(pwr + 16 * s + 8 * hh + 4);
            const u32x4 w = __builtin_bit_cast(u32x4, vf[s]); u32x4 o;
            o.x = cvtpk(bflo(w.x) * f0[0] * scl, bfhi(w.x) * f0[1] * scl); o.y = cvtpk(bflo(w.y) * f0[2] * scl, bfhi(w.y) * f0[3] * scl);
            o.z = cvtpk(bflo(w.z) * f1[0] * scl, bfhi(w.z) * f1[1] * scl); o.w = cvtpk(bflo(w.w) * f1[2] * scl, bfhi(w.w) * f1[3] * scl);
            vs = __builtin_bit_cast(bf16x8, o); }
        __builtin_amdgcn_sched_barrier(0);
#pragma unroll
        for (int j = 0; j < 2; ++j) { const v4i16_t lo = fa[b % 3][j][0], hi = fa[b % 3][j][1]; const int dt = 2 * (b & 3) + j;
            X[dt] = __builtin_amdgcn_mfma_f32_32x32x16_bf16((bf16x8){lo[0], lo[1], lo[2], lo[3], hi[0], hi[1], hi[2], hi[3]}, vs, X[dt], 0, 0, 0); }
        __builtin_amdgcn_sched_barrier(0);
    }
#undef RT_LOADB
}
__device__ __forceinline__ void dump_state(const f32x16 (&X)[8], RGAS char* L, int wave, int lane, float scl) {
#pragma unroll
    for (int dt = 0; dt < 8; ++dt)
#pragma unroll
        for (int s = 0; s < 2; ++s) { u32x4 o; o.x = cvtpk(X[dt][8 * s] * scl, X[dt][8 * s + 1] * scl); o.y = cvtpk(X[dt][8 * s + 2] * scl, X[dt][8 * s + 3] * scl);
            o.z = cvtpk(X[dt][8 * s + 4] * scl, X[dt][8 * s + 5] * scl); o.w = cvtpk(X[dt][8 * s + 6] * scl, X[dt][8 * s + 7] * scl);
            *(RGAS u32x4*)(L + (unsigned)(wave * 16384 + (2 * dt + s) * 1024 + lane * 16)) = o; }
}
__device__ __forceinline__ void accum_state(f32x16 (&X)[8], const RGAS char* L, int wave, int lane, float dec) {
#pragma unroll
    for (int dt = 0; dt < 8; ++dt)
#pragma unroll
        for (int s = 0; s < 2; ++s) { const u32x4 w = *(const RGAS u32x4*)(L + (unsigned)(wave * 16384 + (2 * dt + s) * 1024 + lane * 16));
            X[dt][8 * s] = X[dt][8 * s] * dec + bflo(w.x); X[dt][8 * s + 1] = X[dt][8 * s + 1] * dec + bfhi(w.x); X[dt][8 * s + 2] = X[dt][8 * s + 2] * dec + bflo(w.y); X[dt][8 * s + 3] = X[dt][8 * s + 3] * dec + bfhi(w.y);
            X[dt][8 * s + 4] = X[dt][8 * s + 4] * dec + bflo(w.z); X[dt][8 * s + 5] = X[dt][8 * s + 5] * dec + bfhi(w.z); X[dt][8 * s + 6] = X[dt][8 * s + 6] * dec + bflo(w.w); X[dt][8 * s + 7] = X[dt][8 * s + 7] * dec + bfhi(w.w); }
}
template <bool FULL>
__device__ __forceinline__ void run_item(const Ptrs& P, int bh, int half, int g, unsigned lds0, int wave_in) {
    int lane0_ = hw_lane_id(); asm volatile("" : "+v"(lane0_));
    const int lane0 = lane0_, wave = wave_in, tid = wave * 64 + lane0;
    const int b = bh >> 2, h = bh & 3;
    const float lg = __logf(1.0f - __builtin_amdgcn_exp2f(-5.0f - (float)h));
    const float cd = __expf(lg * 64.f), cdinv = __expf(-lg * 64.f);
    RLAS float* pw = (RLAS float*)(uintptr_t)(lds0 + LPW);
    __syncthreads();
    if (tid <= 64) pw[tid] = __expf(lg * (float)tid);
    if (tid < 64) { pw[80 + tid] = __expf(lg * (float)(tid + 1)); pw[144 + tid] = __expf(lg * (float)(63 - tid)); }
    const int g16 = lane0 >> 4, blk = g16 & 1, q4 = (lane0 & 15) >> 2, p4 = lane0 & 3, sp = ((p4 & 1) << 1) | (p4 >> 1), hh0 = lane0 >> 5;
    const unsigned trrow = (unsigned)(512 * (8 * hh0 + q4));
    const int fl = (q4 << 2) | (hh0 << 1);
    unsigned vb0_ = lds0 + LV + trrow + 16u * (unsigned)((4 * wave + 2 * blk + (p4 >> 1)) ^ fl) + 8u * (unsigned)(p4 & 1);
    unsigned kt0_ = lds0 + LK + trrow + 16u * (unsigned)((2 * blk + (sp >> 1)) ^ fl) + 8u * (unsigned)(sp & 1);
    unsigned lane_ = (unsigned)lane0;
    const size_t tok0 = (size_t)b * 8192 + (size_t)g * (RG * 64);
    const RGAS char* Qg = P.Q + (tok0 * 1024 + (size_t)h * 256) * 2; const RGAS char* Kg = P.K + (tok0 * 1024 + (size_t)h * 256) * 2;
    RGAS char* Vg = P.V + (tok0 * 2048 + (size_t)h * 512 + (size_t)half * 256) * 2;
    f32x16 X[8];
#pragma unroll
    for (int dt = 0; dt < 8; ++dt) X[dt] = f32x16{};
    if constexpr (FULL) {
        if (g > 0) accum_state(X, P.L + (size_t)((bh * (NG - 1) + g - 1) * 2 + half) * 131072, wave, lane0, 0.f);
    }
#if RT_TPROBE == 3 || RT_TPROBE == 5
    unsigned tq3_ = 0; if (FULL && tid == 0) tq3_ = (unsigned)__builtin_amdgcn_s_memrealtime();
#endif
    float cdm = 1.f, cdim = cdinv;
    __syncthreads();
    if constexpr (FULL) { stage_tile(Qg, 2048, lds0 + LQ, wave, lane0); stage_tile(Vg, 4096, lds0 + LV, wave, lane0); } else { stage_tile(Vg, 4096, lds0 + LV, wave, lane0); }
    stage_tile(Kg, 2048, lds0 + LK, wave, lane0);
    for (int m = 0; m < RG; ++m) {
        const unsigned kb = (m & 1) ? (unsigned)(LK2 - LK) : 0u, vbuf = (!FULL && (m & 1)) ? (unsigned)(LQ - LV) : 0u;
#if RT_TPROBE == 1 || RT_TPROBE == 4
        unsigned tq0_ = 0; if (FULL && tid == 0) tq0_ = (unsigned)__builtin_amdgcn_s_memrealtime();
#endif
        asm volatile("s_waitcnt vmcnt(0)" ::: "memory");
#if RT_TPROBE == 1
        if (FULL && tid == 0) *(RLAS unsigned*)(uintptr_t)(lds0 + 131480) += (unsigned)__builtin_amdgcn_s_memrealtime() - tq0_;
#endif
        __syncthreads();
#if RT_TPROBE == 4
        if (FULL && tid == 0) *(RLAS unsigned*)(uintptr_t)(lds0 + 131480) += (unsigned)__builtin_amdgcn_s_memrealtime() - tq0_;
#endif
#if RT_TPROBE == 5
        if (FULL && tid == 0 && m == 0) *(RLAS unsigned*)(uintptr_t)(lds0 + 131480) += (unsigned)__builtin_amdgcn_s_memrealtime() - tq3_;
#endif
        asm volatile("" : "+v"(vb0_), "+v"(kt0_), "+v"(lane_));
        const unsigned vb0 = vb0_ + vbuf, vb1 = vb0 ^ 16u, kt0 = kt0_ + kb, kt1 = kt0 ^ 16u; const int lane = (int)lane_, hh = lane >> 5, c32 = lane & 31, i16 = lane & 15;
#if RT_TPROBE == 7
        unsigned tq7_ = 0; if (FULL && tid == 0) tq7_ = (unsigned)__builtin_amdgcn_s_memrealtime();
#endif
        if (m + 1 < RG) { stage_tile(Kg + (size_t)(m + 1) * (64 * 2048), 2048, lds0 + LK + ((m & 1) ? 0u : (unsigned)(LK2 - LK)), wave, lane);
            if constexpr (!FULL) stage_tile(Vg + (size_t)(m + 1) * (64 * 4096), 4096, lds0 + ((m & 1) ? (unsigned)LV : (unsigned)LQ), wave, lane); }
        if (RT_TOUCH && m + 2 < RG) {
            if (wave < 4) { if constexpr (FULL) touch_tile(Qg + (size_t)(m + 2) * (64 * 2048), 2048, lds0, wave, lane); touch_tile(Vg + (size_t)(m + 2) * (64 * 4096), 4096, lds0, wave, lane); }
            else touch_tile(Kg + (size_t)(m + 2) * (64 * 2048), 2048, lds0, wave, lane); }
#if RT_TPROBE == 7
        if (FULL && tid == 0) *(RLAS unsigned*)(uintptr_t)(lds0 + 131480) += (unsigned)__builtin_amdgcn_s_memrealtime() - tq7_;
#endif
        bf16x8 vf[4];
        if constexpr (FULL) {
#if RT_TPROBE == 8
            unsigned tq8_ = 0; if (tid == 0) tq8_ = (unsigned)__builtin_amdgcn_s_memrealtime();
#endif
            {
                const int itile = wave >> 1, jt0 = 2 * (wave & 1), qq = lane >> 4;
                const int fS = ((i16 & 3) << 2) | ((i16 >> 2) & 3);
                const unsigned qa = lds0 + LQ + (unsigned)(512 * (16 * itile + i16)) + 16u * (unsigned)(qq ^ fS), ka = lds0 + LK + kb + (unsigned)(512 * (16 * jt0 + i16)) + 16u * (unsigned)(qq ^ fS);
                f32x4 s0 = {0.f, 0.f, 0.f, 0.f}, s1 = {0.f, 0.f, 0.f, 0.f};
#pragma unroll
                for (int s = 0; s < 8; ++s) { const bf16x8 qf = lds128(qa ^ (unsigned)(64 * s)), k0 = lds128(ka ^ (unsigned)(64 * s)), k1 = lds128((ka ^ (unsigned)(64 * s)) + 8192);
                    s0 = __builtin_amdgcn_mfma_f32_16x16x32_bf16(k0, qf, s0, 0, 0, 0); s1 = __builtin_amdgcn_mfma_f32_16x16x32_bf16(k1, qf, s1, 0, 0, 0);
                    if ((s & 3) == 3) asm volatile("" ::: "memory"); }
                const int irow = 16 * itile + i16;
#pragma unroll
                for (int tt = 0; tt < 2; ++tt) { const f32x4 sv = tt ? s1 : s0; const int jb = 16 * (jt0 + tt) + 4 * qq; float e[4];
#pragma unroll
                    for (int r = 0; r < 4; ++r) { const int dj = irow - (jb + r); e[r] = sv[r] * pw[dj < 0 ? -dj : dj]; }
                    u32x2 o; o.x = cvtpk(e[0], e[1]); o.y = cvtpk(e[2], e[3]);
                    *(RLAS u32x2*)(uintptr_t)(lds0 + LS + offS(irow, 2 * (jt0 + tt) + (qq >> 1)) + 8 * (qq & 1)) = o; }
            }
            load_vfrags(vf, vb0, vb1);
            f32x16 Y[2]; Y[0] = f32x16{}; Y[1] = f32x16{};
            const int fQ = ((c32 & 3) << 2) | ((c32 >> 2) & 3);
            const unsigned qr0 = lds0 + LQ + (unsigned)(512 * c32) + 16u * (unsigned)(hh ^ fQ);
#pragma unroll
            for (int dt = 0; dt < 8; ++dt)
#pragma unroll
                for (int s = 0; s < 2; ++s) { u32x4 pb; pb.x = cvtpk(X[dt][8 * s], X[dt][8 * s + 1]); pb.y = cvtpk(X[dt][8 * s + 2], X[dt][8 * s + 3]); pb.z = cvtpk(X[dt][8 * s + 4], X[dt][8 * s + 5]); pb.w = cvtpk(X[dt][8 * s + 6], X[dt][8 * s + 7]);
                    const bf16x8 bq = __builtin_bit_cast(bf16x8, pb); const unsigned a = qr0 ^ (unsigned)(16 * (4 * dt + 2 * s));
                    Y[0] = __builtin_amdgcn_mfma_f32_32x32x16_bf16(lds128(a), bq, Y[0], 0, 0, 0); Y[1] = __builtin_amdgcn_mfma_f32_32x32x16_bf16(lds128(a + 16384), bq, Y[1], 0, 0, 0);
                    if (s == 1 && (dt & 1)) asm volatile("" ::: "memory"); }
#pragma unroll
            for (int it = 0; it < 2; ++it)
#pragma unroll
                for (int rg = 0; rg < 4; ++rg) { const f32x4 f = *(const RLAS f32x4*)(pw + 80 + 32 * it + 8 * rg + 4 * hh);
                    Y[it][4 * rg] *= f[0] * cdm; Y[it][4 * rg + 1] *= f[1] * cdm; Y[it][4 * rg + 2] *= f[2] * cdm; Y[it][4 * rg + 3] *= f[3] * cdm; }
#if RT_TPROBE == 8
            if (tid == 0) *(RLAS unsigned*)(uintptr_t)(lds0 + 131480) += (unsigned)__builtin_amdgcn_s_memrealtime() - tq8_;
#endif
#if RT_TPROBE == 2
            unsigned tq1_ = 0; if (tid == 0) tq1_ = (unsigned)__builtin_amdgcn_s_memrealtime();
#endif
            asm volatile("s_waitcnt lgkmcnt(0)" ::: "memory"); __builtin_amdgcn_s_barrier(); asm volatile("" ::: "memory");
#if RT_TPROBE == 2
            if (tid == 0) *(RLAS unsigned*)(uintptr_t)(lds0 + 131480) += (unsigned)__builtin_amdgcn_s_memrealtime() - tq1_;
#endif
            if (m + 1 < RG) { stage_tile(Qg + (size_t)(m + 1) * (64 * 2048), 2048, lds0 + LQ, wave, lane); stage_tile(Vg + (size_t)(m + 1) * (64 * 4096), 4096, lds0 + LV, wave, lane); }
            const unsigned sr0 = lds0 + LS + (unsigned)(128 * c32) + 16u * (unsigned)(hh ^ ((c32 >> 1) & 7));
            const unsigned sr1 = lds0 + LS + (unsigned)(128 * (32 + c32)) + 16u * (unsigned)(hh ^ (((32 + c32) >> 1) & 7));
#pragma unroll
            for (int s = 0; s < 4; ++s) { Y[0] = __builtin_amdgcn_mfma_f32_32x32x16_bf16(lds128(sr0 ^ (unsigned)(32 * s)), vf[s], Y[0], 0, 0, 0);
                Y[1] = __builtin_amdgcn_mfma_f32_32x32x16_bf16(lds128(sr1 ^ (unsigned)(32 * s)), vf[s], Y[1], 0, 0, 0); }
#if RT_TPROBE == 6
            unsigned tq6_ = 0; if (tid == 0) tq6_ = (unsigned)__builtin_amdgcn_s_memrealtime();
#endif
            const size_t tokm = tok0 + (size_t)m * 64;
            RGAS char* yb = P.V + ((tokm * 2048 + (size_t)h * 512 + (size_t)half * 256 + (size_t)wave * 32) * 2);
            const bool l0 = (c32 & 1) != 0, l1 = (c32 & 2) != 0;
            float p1[8], p2[8];
#pragma unroll
            for (int it = 0; it < 2; ++it)
#pragma unroll
                for (int k = 0; k < 4; ++k) { float a0 = Y[it][4 * k], a1 = Y[it][4 * k + 1], a2 = Y[it][4 * k + 2], a3 = Y[it][4 * k + 3];
                    { const float r = qx1(l0 ? a0 : a1); a0 = l0 ? r : a0; a1 = l0 ? a1 : r; }
                    { const float r = qx1(l0 ? a2 : a3); a2 = l0 ? r : a2; a3 = l0 ? a3 : r; }
                    { const float r = qx2(l1 ? a0 : a2); a0 = l1 ? r : a0; a2 = l1 ? a2 : r; }
                    { const float r = qx2(l1 ? a1 : a3); a1 = l1 ? r : a1; a3 = l1 ? a3 : r; }
                    u32x2 o; o.x = cvtpk(a0, a1); o.y = cvtpk(a2, a3);
                    *(RGAS u32x2*)(yb + (unsigned)(32 * it + 8 * k + (c32 & 3) + 4 * hh) * 4096u + (unsigned)(c32 >> 2) * 8u) = o;
                    p1[4 * it + k] = (a0 + a1) + (a2 + a3); p2[4 * it + k] = (a0 * a0 + a1 * a1) + (a2 * a2 + a3 * a3); }
            {
                const bool b4 = (c32 & 16) != 0, b3 = (c32 & 8) != 0, b2 = (c32 & 4) != 0;
                float q1[4], q2[4], r1[2], r2[2];
#pragma unroll
                for (int j = 0; j < 4; ++j) { q1[j] = (b4 ? p1[4 + j] : p1[j]) + __shfl_xor(b4 ? p1[j] : p1[4 + j], 16); q2[j] = (b4 ? p2[4 + j] : p2[j]) + __shfl_xor(b4 ? p2[j] : p2[4 + j], 16); }
#pragma unroll
                for (int j = 0; j < 2; ++j) { r1[j] = (b3 ? q1[2 + j] : q1[j]) + __shfl_xor(b3 ? q1[j] : q1[2 + j], 8); r2[j] = (b3 ? q2[2 + j] : q2[j]) + __shfl_xor(b3 ? q2[j] : q2[2 + j], 8); }
                typedef float f32x2 __attribute__((ext_vector_type(2))); f32x2 st;
                st.x = (b2 ? r1[1] : r1[0]) + __shfl_xor(b2 ? r1[0] : r1[1], 4); st.y = (b2 ? r2[1] : r2[0]) + __shfl_xor(b2 ? r2[0] : r2[1], 4);
                const int row = 32 * (b4 ? 1 : 0) + 8 * (2 * (b3 ? 1 : 0) + (b2 ? 1 : 0)) + (c32 & 3) + 4 * hh;
                *(RGAS f32x2*)(P.PST + (((tokm + row) * 4 + h) * 16 + half * 8 + wave) * 2) = st;
            }
#if RT_TPROBE == 6
            if (tid == 0) *(RLAS unsigned*)(uintptr_t)(lds0 + 131480) += (unsigned)__builtin_amdgcn_s_memrealtime() - tq6_;
#endif
        } else {
            load_vfrags(vf, vb0, vb1);
        }
#if RT_TPROBE == 9
        unsigned tq9_ = 0; if (FULL && tid == 0) tq9_ = (unsigned)__builtin_amdgcn_s_memrealtime();
#endif
        update_state(X, vf, kt0, kt1, lds0, hh, cdim);
#if RT_TPROBE == 9
        if (FULL && tid == 0) *(RLAS unsigned*)(uintptr_t)(lds0 + 131480) += (unsigned)__builtin_amdgcn_s_memrealtime() - tq9_;
#endif
        cdm *= cd; cdim *= cdinv;
    }
    __syncthreads();
#if RT_TPROBE == 3
    if (FULL && tid == 0) *(RLAS unsigned*)(uintptr_t)(lds0 + 131480) += (unsigned)__builtin_amdgcn_s_memrealtime() - tq3_;
#endif
    if constexpr (!FULL) dump_state(X, P.L + (size_t)((bh * (NG - 1) + g) * 2 + half) * 131072, wave, lane0, cdm);
}
#undef RLAS
#undef RGAS
}
struct Args { const float* in[11]; float* out; unsigned char* wsp; int ph_lo, ph_hi, li, pad; };
struct Frame {
    LAS unsigned char* lds;
    volatile LAS unsigned* MISC;
    int tid, lane, wave;
    int vcu, G;
    const __attribute__((address_space(4))) Args* ap;
};
#define FP(i) (F.ap->in[i])
#define F_x FP(0)
#define F_norm_mix FP(1)
#define F_norm_ffn FP(2)
#define F_fox_w_in FP(3)
#define F_fox_b_f FP(4)
#define F_fox_w_out FP(5)
#define F_ret_w_in FP(6)
#define F_ret_w_out FP(7)
#define F_ffn_w_in FP(8)
#define F_ffn_w_out FP(9)
#define F_final_norm FP(10)
#define F_out (F.ap->out)
#define F_ws (F.ap->wsp)
__device__ __forceinline__ float wave_sum(float v) {
#pragma unroll
    for (int o = 1; o < 64; o <<= 1) v += __shfl_xor(v, o);
    return v;
}

__device__ __forceinline__ void p0_item(const float* W, int K, int Nsrc, int scol0, bf16* WT, int drow0, int k0, const float* g, LAS float* scr, int lane) {
    const int nq = lane & 7, kr = lane >> 3;
    f32x4 v[8];
#pragma unroll
    for (int i = 0; i < 8; ++i) v[i] = *(const GAS f32x4*)(W + (size_t)(k0 + kr + 8 * i) * Nsrc + scol0 + 4 * nq);
#pragma unroll
    for (int i = 0; i < 8; ++i) { const int kk = kr + 8 * i; const float gv = g ? g[k0 + kk] : 1.f; LAS float* d = scr + kk * 33 + 4 * nq;
        d[0] = v[i].x * gv; d[1] = v[i].y * gv; d[2] = v[i].z * gv; d[3] = v[i].w * gv; }
    LDS_WAIT(); asm volatile("" ::: "memory");
    const int c = lane & 7;
#pragma unroll
    for (int j = 0; j < 4; ++j) { const int n = (lane >> 3) + 8 * j; const LAS float* s = scr + (8 * c) * 33 + n;
        v4u o; o.x = pk2(s[0 * 33], s[1 * 33]); o.y = pk2(s[2 * 33], s[3 * 33]); o.z = pk2(s[4 * 33], s[5 * 33]); o.w = pk2(s[6 * 33], s[7 * 33]);
        *(GAS v4u*)(WT + (size_t)(drow0 + n) * K + k0 + 8 * c) = o; }
    LDS_WAIT(); asm volatile("" ::: "memory");
}
__device__ __forceinline__ void p0_matrix(int r, const float* W, int K, int N, int Nsrc, bool swiglu, bf16* WT, const float* g, LAS float* scr, int lane) {
    const int nblk = N / 32, kb = r / nblk, nb = r % nblk, drow0 = 32 * nb;
    int scol0 = drow0;
    if (swiglu) { const int t = drow0 >> 8, rr = drow0 & 255; scol0 = (rr < 128) ? t * 128 + rr : DFF + t * 128 + (rr - 128); }
    p0_item(W, K, Nsrc, scol0, WT, drow0, 64 * kb, g, scr, lane);
}
__device__ __forceinline__ void p0_xtile(Frame& F, int tile) {
    LAS float* wfs = (LAS float*)(F.lds);
    LAS float* tot = (LAS float*)(F.lds + 32768);
#pragma unroll
    for (int kk = 0; kk < 2; ++kk) { const int k = F.tid + 512 * kk; const float gk = F_norm_mix[k];
        const f32x4 w0 = *(const GAS f32x4*)(F_fox_w_in + (size_t)k * 3080 + 3072), w1 = *(const GAS f32x4*)(F_fox_w_in + (size_t)k * 3080 + 3076);
        wfs[k] = w0.x * gk; wfs[1024 + k] = w0.y * gk; wfs[2048 + k] = w0.z * gk; wfs[3072 + k] = w0.w * gk; wfs[4096 + k] = w1.x * gk; wfs[5120 + k] = w1.y * gk; wfs[6144 + k] = w1.z * gk; wfs[7168 + k] = w1.w * gk; }
    __syncthreads();
    const int myh = (F.lane >> 3) & 7;
    const float bfv = F_fox_b_f[myh];
    bf16* XB = (bf16*)(F_ws + WS_XB); float* SSQ = (float*)(F_ws + WS_SSQ);
    const int row0 = tile * 64 + F.wave * 8;
    const bool b5 = (F.lane & 32) != 0, b4 = (F.lane & 16) != 0, b3 = (F.lane & 8) != 0;
    float run = 0.f, mine[8];
    f32x4 v[4], vn[4];
    { const GAS f32x4* xr = (const GAS f32x4*)(F_x + (size_t)row0 * D) + F.lane;
#pragma unroll
      for (int j = 0; j < 4; ++j) vn[j] = xr[64 * j]; }
#pragma unroll
    for (int i = 0; i < 8; ++i) {
        const int row = row0 + i;
#pragma unroll
        for (int j = 0; j < 4; ++j) v[j] = vn[j];
        if (i < 7) { const GAS f32x4* xr = (const GAS f32x4*)(F_x + (size_t)(row + 1) * D) + F.lane;
#pragma unroll
            for (int j = 0; j < 4; ++j) vn[j] = xr[64 * j]; }
        float ss = 0.f;
#pragma unroll
        for (int j = 0; j < 4; ++j) ss += (v[j].x * v[j].x + v[j].y * v[j].y) + (v[j].z * v[j].z + v[j].w * v[j].w);
        GAS unsigned long long* o8 = (GAS unsigned long long*)(XB + (size_t)row * D) + F.lane;
#pragma unroll
        for (int j = 0; j < 4; ++j) o8[64 * j] = (unsigned long long)pk2(v[j].x, v[j].y) | ((unsigned long long)pk2(v[j].z, v[j].w) << 32);
        float a[8];
#pragma unroll
        for (int h = 0; h < 8; ++h) { float acc = 0.f;
#pragma unroll
            for (int j = 0; j < 4; ++j) { const f32x4 w = *(const LAS f32x4*)(wfs + h * 1024 + 4 * (F.lane + 64 * j)); acc += (v[j].x * w.x + v[j].y * w.y) + (v[j].z * w.z + v[j].w * w.w); }
            a[h] = acc; }
        ss = wave_sum(ss);
        float c[4], d[2];
#pragma unroll
        for (int k = 0; k < 4; ++k) c[k] = (b5 ? a[4 + k] : a[k]) + __shfl_xor(b5 ? a[k] : a[4 + k], 32);
#pragma unroll
        for (int k = 0; k < 2; ++k) d[k] = (b4 ? c[2 + k] : c[k]) + __shfl_xor(b4 ? c[k] : c[2 + k], 16);
        float e = (b3 ? d[1] : d[0]) + __shfl_xor(b3 ? d[0] : d[1], 8);
        e += __shfl_xor(e, 4); e += __shfl_xor(e, 2); e += __shfl_xor(e, 1);
        const float rstd = 1.0f / sqrtf(ss * (1.f / D) + EPS);
        if (F.lane < 16) SSQ[(size_t)row * 16 + F.lane] = (F.lane == 0) ? ss : 0.f;
        const float z = e * rstd + bfv; const float lf = fminf(z, 0.f) - log1pf(__expf(-fabsf(z)));
        run += lf; mine[i] = run;
    }
    if ((F.lane & 7) == 0) tot[F.wave * 8 + myh] = run;
    __syncthreads();
    float* LC = (float*)(F_ws + WS_LC); float* TT = (float*)(F_ws + WS_TT);
    if ((F.lane & 7) == 0) { float off = 0.f; for (int w = 0; w < F.wave; ++w) off += tot[w * 8 + myh];
#pragma unroll
        for (int i = 0; i < 8; ++i) LC[(size_t)(row0 + i) * 8 + myh] = mine[i] + off; }
    if (F.tid < 8) { float s = 0.f; for (int w = 0; w < 8; ++w) s += tot[w * 8 + F.tid]; TT[tile * 8 + F.tid] = s; }
    __syncthreads();
}
__device__ __forceinline__ void p0_prologue(Frame& F) {
    for (int t = (int)blockIdx.x; t < M / 64; t += F.G) p0_xtile(F, t);
    LAS float* scr = (LAS float*)(F.lds + RING_OFF + F.wave * 16384);
    const int gw = F.vcu * NWAVES + F.wave, NGW = F.G * NWAVES;
    constexpr int I0 = 16 * 96, I1 = 16 * 32, I2 = 16 * 176, I3 = 44 * 32, I4 = 16 * 192, I5 = 32 * 32;
    constexpr int NITEMS = I0 + I1 + I2 + I3 + I4 + I5;
    unsigned char* ws = F_ws;
    for (int it = gw; it < NITEMS; it += NGW) {
        int r = it;
        if (r < I0) { p0_matrix(r, F_fox_w_in, 1024, 3072, 3080, false, (bf16*)(ws + WS_WQKV0), F_norm_mix, scr, F.lane); continue; } r -= I0;
        if (r < I1) { p0_matrix(r, F_fox_w_out, 1024, 1024, 1024, false, (bf16*)(ws + WS_WO0), nullptr, scr, F.lane); continue; } r -= I1;
        if (r < I2) { p0_matrix(r, F_ffn_w_in, 1024, 2 * DFF, 2 * DFF, true, (bf16*)(ws + WS_WFI0), F_norm_ffn, scr, F.lane); continue; } r -= I2;
        if (r < I3) { p0_matrix(r, F_ffn_w_out, DFF, 1024, 1024, false, (bf16*)(ws + WS_WFO0), nullptr, scr, F.lane); continue; } r -= I3;
        if (r < I4) { p0_matrix(r, F_ret_w_in, 1024, 6144, 6144, false, (bf16*)(ws + WS_WRI), F_norm_mix + D, scr, F.lane); continue; } r -= I4;
        p0_matrix(r, F_ret_w_out, 2048, 1024, 1024, false, (bf16*)(ws + WS_WRO), nullptr, scr, F.lane);
    }
    float* rope = (float*)(ws + WS_ROPE);
    {
        const int idx0 = F.vcu * (NWAVES * 64) + F.tid;
        const float inv = (float)exp2(-(double)(idx0 & 127) * (13.287712379549449 / 128.0));
        for (int idx = idx0; idx < SEQ * 128; idx += F.G * NWAVES * 64) {
            const float ang = (float)(idx >> 7) * inv;
            const double t = (double)ang * 0.15915494309189535; const float fr = (float)(t - rint(t));
            f32x2 cs; cs.x = __builtin_amdgcn_cosf(fr); cs.y = __builtin_amdgcn_sinf(fr);
            *(f32x2*)(rope + (size_t)idx * 2) = cs;
        }
    }
}

__device__ __forceinline__ void p0_late_weights(Frame& F, int first) {
    const int nwg = F.G - first; if ((int)blockIdx.x < first || nwg <= 0) return;
    LAS float* scr = (LAS float*)(F.lds + RING_OFF + F.wave * 16384);
    const int gw = ((int)blockIdx.x - first) * NWAVES + F.wave, NGW = nwg * NWAVES;
    constexpr int I6 = 16 * 176, I7 = 44 * 32;
    unsigned char* ws = F_ws;
    for (int it = gw; it < I6 + I7; it += NGW) {
        if (it < I6) p0_matrix(it, F_ffn_w_in + (size_t)D * 2 * DFF, 1024, 2 * DFF, 2 * DFF, true, (bf16*)(ws + WS_WFI1), F_norm_ffn + D, scr, F.lane);
        else p0_matrix(it - I6, F_ffn_w_out + (size_t)DFF * D, DFF, 1024, 1024, false, (bf16*)(ws + WS_WFO1), nullptr, scr, F.lane);
    }
}

__device__ __forceinline__ void fill_rstd_tab(Frame& F, const pg8::StaticOrder& S) {
    LAS float* tab = (LAS float*)(F.lds + TAB_OFF); const float* SSQ = (const float*)(F_ws + WS_SSQ);
    pg8::Unit u;
    for (int i = 0; i < 8 && S.next(i, u); ++i) if (F.tid < 256) {
        const f32x4* p = (const f32x4*)(SSQ + (size_t)(u.pm * 256 + F.tid) * 16); const f32x4 a = p[0], b = p[1], c = p[2], d = p[3];
        const float s = ((a.x + a.y) + (a.z + a.w)) + ((b.x + b.y) + (b.z + b.w)) + ((c.x + c.y) + (c.z + c.w)) + ((d.x + d.y) + (d.z + d.w));
        tab[i * 256 + F.tid] = 1.0f / sqrtf(s * (1.f / D) + EPS); }
    __syncthreads();
}
__device__ __forceinline__ void fill_gate_tab(Frame& F, const pg8::StaticOrder& S) {
    LAS f32x2* stab = (LAS f32x2*)(F.lds + STAB_OFF); const float* PST = (const float*)(F_ws + WS_PST);
    pg8::Unit u;
    for (int i = 0; i < 2 && S.next(i, u); ++i) if (F.tid < 256) {
        const f32x4* p = (const f32x4*)(PST + ((size_t)(u.pm * 256 + F.tid) * 4 + (u.pn >> 1)) * 32); float s = 0.f, q = 0.f;
#pragma unroll
        for (int j = 0; j < 8; ++j) { const f32x4 v = p[j]; s += v.x + v.z; q += v.y + v.w; }
        const float mu = s * (1.f / RDV), var = fmaxf(q * (1.f / RDV) - mu * mu, 0.f);
        f32x2 st; st.x = mu; st.y = 1.0f / sqrtf(var + EPS); stab[i * 256 + F.tid] = st; }
    __syncthreads();
}


__device__ __forceinline__ void cbg_phase(Frame& F) {
    const float* LC = (const float*)(F_ws + WS_LC); const float* TT = (const float*)(F_ws + WS_TT); float* CBG = (float*)(F_ws + WS_CBG);
    LAS float* pre = (LAS float*)(F.lds);
    for (int item = (int)blockIdx.x; item < 16 * 16; item += F.G) {
        const int bh = item >> 4, seg = item & 15, b = bh >> 3, h = bh & 7, s = seg * 512 + F.tid;
        __syncthreads();
        if (F.tid < 128) pre[F.tid] = TT[(b * 128 + F.tid) * 8 + h];
        __syncthreads();
        if (F.tid == 0) { float p = 0.f; for (int t = 0; t < 128; ++t) { const float v = pre[t]; pre[t] = p; p += v; } }
        __syncthreads();
        CBG[(size_t)bh * SEQ + s] = -(pre[s >> 6] + LC[(size_t)(b * SEQ + s) * 8 + h]) * LOG2E;
    }
    __syncthreads();
}
constexpr size_t WS_PML = WS_END;
static_assert(WS_PML + 2 * MiB <= 256 * MiB, "pml");
constexpr int CW_SPL = 3072;
__device__ __forceinline__ fa::BlockRef fa_ref(Frame& F, int bh, int qb, int kb0, int khi, int mode, int half, float Bq, int rep) {
    const int b = bh >> 3, h = bh & 7; fa::BlockRef r; r.base = (GAS char*)F_ws;
    const unsigned ro = (unsigned)(((b * SEQ + qb * 256) * 1024 + h * 128) * 2), ho = (unsigned)((b * SEQ * 1024 + h * 128) * 2);
    r.qo = (unsigned)WS_Q0 + ro; r.oo = (unsigned)WS_O0 + ro; r.ko = (unsigned)WS_K0 + ho; r.vo = (unsigned)WS_V0 + ho;
    r.cbo = (unsigned)WS_CBG + (unsigned)(bh * SEQ * 4); r.P0 = qb * 256; r.kb0 = kb0; r.Bq = Bq; r.khi = khi; r.mode = mode; r.slot = (bh * 32 + qb) * 2 + half;
    r.part = (GAS char*)F_out; r.pml = (GAS float*)(F_ws + WS_PML); r.cnt = (GAS unsigned*)(F_ws + WS_CTL) + CW_SPL + rep * 512 + bh * 32 + qb; return r;
}
constexpr float SKIP_LOG2 = 148.f;
constexpr int SPLIT_MIN = 40;
constexpr int ATT_LDS_DESC = 133632 + 64;
__device__ __forceinline__ void fa_describe(Frame& F, int n, int xq, LAS float* kmax2, LAS int* desc) {
    const int half = n & 1, bi = n >> 1;
    const int bh = (bi & 1) ? 8 + ((xq + 4) & 7) : xq, qb = 31 - (bi >> 1), b = bh >> 3, h = bh & 7;
    const float* nq = (const float*)(F_ws + WS_NRM) + ((size_t)(b * 32 + qb) * 8 + h) * 8;
    float q2 = 0.f;
#pragma unroll
    for (int wc = 0; wc < 4; ++wc) q2 += fmaxf(nq[2 * wc], nq[2 * wc + 1]);
    const float B = sqrtf(q2 * kmax2[bh]) * 1.01f, th = 2.f * B + SKIP_LOG2;
    const float* cb = (const float*)(F_ws + WS_CBG) + (size_t)bh * SEQ;
    const float cbi = cb[qb * 256];
    const float c0 = cb[64 * F.lane + 63], c1 = cb[64 * (F.lane + 64) + 63];
    const unsigned long long m0 = __ballot(cbi - c0 <= th), m1 = __ballot(cbi - c1 <= th);
    int t = m0 ? (int)__builtin_ctzll(m0) : (m1 ? 64 + (int)__builtin_ctzll(m1) : 4 * qb);
    if (t > 4 * qb) t = 4 * qb;
    const int nt = 4 * qb + 4 - t, tmid = t + (nt >> 1);
    int lo = 64 * t, top = qb * 256 + 256, mode = 0;
    if (nt >= SPLIT_MIN) { mode = 1; if (half) top = 64 * tmid; else lo = 64 * tmid; } else if (half) mode = 2;
    if (F.lane == 0) { desc[0] = bh; desc[1] = qb; desc[2] = lo; desc[5] = (int)__float_as_uint(B); desc[6] = top; desc[7] = mode; desc[8] = half; }
}
__device__ __forceinline__ void attn_fast_phase(Frame& F, char* shm, int rep = 0) {
    LAS float* kmax2 = (LAS float*)(F.lds + ATT_LDS_DESC); LAS int* desc = (LAS int*)(F.lds + ATT_LDS_DESC + 64);
    const int total = 128, xq = (int)blockIdx.x & 7;
    __syncthreads();
    if (F.tid < 64) { const int bh = F.tid >> 2, wc = F.tid & 3, b = bh >> 3, h = bh & 7; const float* nk = (const float*)(F_ws + WS_NRM) + (size_t)64 * 64;
        float m = 0.f; for (int pm = 0; pm < 32; ++pm) { const float* p = nk + (((size_t)(b * 32 + pm) * 8 + h) * 4 + wc) * 2; m = fmaxf(m, fmaxf(p[0], p[1])); }
        m += __shfl_xor(m, 1); m += __shfl_xor(m, 2); if (wc == 0) kmax2[bh] = m; }
    __syncthreads();
    gu32* ctr0 = (gu32*)(F_ws + WS_CTL) + CW_ATT + rep * 8;
    int n = (int)blockIdx.x >> 3, qsel = xq;
    while (n < total) {
        if (F.wave == 0) fa_describe(F, n, qsel, kmax2, desc);
        __syncthreads();
        const int mode = __builtin_amdgcn_readfirstlane(desc[7]);
        if (mode != 2) {
            const fa::BlockRef cur = fa_ref(F, __builtin_amdgcn_readfirstlane(desc[0]), __builtin_amdgcn_readfirstlane(desc[1]), __builtin_amdgcn_readfirstlane(desc[2]), __builtin_amdgcn_readfirstlane(desc[6]), mode,
                                            __builtin_amdgcn_readfirstlane(desc[8]), __uint_as_float((unsigned)__builtin_amdgcn_readfirstlane(desc[5])), rep);
            fa::fa_block(cur, shm, F.tid);
        }
        if (F.wave == 0) { int nn = total, qs = xq;
            for (int k = 0; k < 8; ++k) { const int q = (xq + k) & 7; int v = 0;
                if (F.lane == 0) v = (((int)F.G + 7 - q) >> 3) + (int)__hip_atomic_fetch_add(ctr0 + 64 * q, 1u, __ATOMIC_RELAXED, __HIP_MEMORY_SCOPE_AGENT);
                v = __builtin_amdgcn_readfirstlane(v); if (v < total) { nn = v; qs = q; break; } }
            if (F.lane == 0) { desc[3] = nn; desc[4] = qs; } }
        __syncthreads();
        n = __builtin_amdgcn_readfirstlane(desc[3]); qsel = __builtin_amdgcn_readfirstlane(desc[4]);
    }
}

__device__ __forceinline__ void attn_ref_phase(Frame& F) {
    const bf16* Q = (const bf16*)(F_ws + WS_Q0); const bf16* K = (const bf16*)(F_ws + WS_K0); const bf16* V = (const bf16*)(F_ws + WS_V0); bf16* O = (bf16*)(F_ws + WS_O0);
    const float* LC = (const float*)(F_ws + WS_LC); const float* TT = (const float*)(F_ws + WS_TT);
    LAS float* Ks = (LAS float*)(F.lds); LAS float* Vs = (LAS float*)(F.lds + 32768); LAS float* cbs = (LAS float*)(F.lds + 65536); LAS float* Pp = (LAS float*)(F.lds + 65536 + 256);
    const int r = F.tid >> 3, part = F.tid & 7;
    const int NU = BATCH * FH * (SEQ / 64);
    for (int unit = (int)blockIdx.x; unit < NU; unit += F.G) {
        const int bh = unit & 15, qb = unit >> 4, b = bh >> 3, h = bh & 7, q0 = qb * 64;
        __syncthreads();
        if (F.tid == 0) { float s = 0.f; for (int t = 0; t < 32; ++t) { Pp[t] = s; s += TT[(b * 32 + t) * 8 + h]; } }
        float q[16], o[16]; float m = -1e30f, l = 0.f;
        { const bf16* qp = Q + (size_t)(b * SEQ + q0 + r) * D + h * FDH + part * 16; const v4u a = *(const v4u*)qp, c = *(const v4u*)(qp + 8);
          q[0] = pg8::bf_lo(a.x); q[1] = pg8::bf_hi(a.x); q[2] = pg8::bf_lo(a.y); q[3] = pg8::bf_hi(a.y); q[4] = pg8::bf_lo(a.z); q[5] = pg8::bf_hi(a.z); q[6] = pg8::bf_lo(a.w); q[7] = pg8::bf_hi(a.w);
          q[8] = pg8::bf_lo(c.x); q[9] = pg8::bf_hi(c.x); q[10] = pg8::bf_lo(c.y); q[11] = pg8::bf_hi(c.y); q[12] = pg8::bf_lo(c.z); q[13] = pg8::bf_hi(c.z); q[14] = pg8::bf_lo(c.w); q[15] = pg8::bf_hi(c.w); }
#pragma unroll
        for (int d = 0; d < 16; ++d) o[d] = 0.f;
        for (int kt = 0; kt <= qb; ++kt) {
            __syncthreads();
            { const size_t go = (size_t)(b * SEQ + kt * 64 + r) * D + h * FDH + part * 16;
              const v4u a = *(const v4u*)(K + go), c = *(const v4u*)(K + go + 8), e = *(const v4u*)(V + go), f = *(const v4u*)(V + go + 8);
              LAS float* kd = Ks + r * 128 + part * 16; LAS float* vd = Vs + r * 128 + part * 16;
              kd[0] = pg8::bf_lo(a.x); kd[1] = pg8::bf_hi(a.x); kd[2] = pg8::bf_lo(a.y); kd[3] = pg8::bf_hi(a.y); kd[4] = pg8::bf_lo(a.z); kd[5] = pg8::bf_hi(a.z); kd[6] = pg8::bf_lo(a.w); kd[7] = pg8::bf_hi(a.w);
              kd[8] = pg8::bf_lo(c.x); kd[9] = pg8::bf_hi(c.x); kd[10] = pg8::bf_lo(c.y); kd[11] = pg8::bf_hi(c.y); kd[12] = pg8::bf_lo(c.z); kd[13] = pg8::bf_hi(c.z); kd[14] = pg8::bf_lo(c.w); kd[15] = pg8::bf_hi(c.w);
              vd[0] = pg8::bf_lo(e.x); vd[1] = pg8::bf_hi(e.x); vd[2] = pg8::bf_lo(e.y); vd[3] = pg8::bf_hi(e.y); vd[4] = pg8::bf_lo(e.z); vd[5] = pg8::bf_hi(e.z); vd[6] = pg8::bf_lo(e.w); vd[7] = pg8::bf_hi(e.w);
              vd[8] = pg8::bf_lo(f.x); vd[9] = pg8::bf_hi(f.x); vd[10] = pg8::bf_lo(f.y); vd[11] = pg8::bf_hi(f.y); vd[12] = pg8::bf_lo(f.z); vd[13] = pg8::bf_hi(f.z); vd[14] = pg8::bf_lo(f.w); vd[15] = pg8::bf_hi(f.w); }
            if (F.tid < 64) { const int key = kt * 64 + F.tid; cbs[F.tid] = ((const float*)(F_ws + WS_CBG))[(size_t)bh * SEQ + key]; }
            __syncthreads();
            const int jmax = (kt == qb) ? r : 63;
            for (int j = 0; j <= jmax; ++j) {
                const LAS float* kr = Ks + j * 128 + part * 16; float dot = 0.f;
#pragma unroll
                for (int d = 0; d < 16; ++d) dot += q[d] * kr[d];
                dot += __shfl_xor(dot, 1); dot += __shfl_xor(dot, 2); dot += __shfl_xor(dot, 4);
                const float s = dot + cbs[j], mn = fmaxf(m, s), al = __builtin_amdgcn_exp2f(m - mn), p = __builtin_amdgcn_exp2f(s - mn);
                l = l * al + p; m = mn;
                const LAS float* vr = Vs + j * 128 + part * 16;
#pragma unroll
                for (int d = 0; d < 16; ++d) o[d] = o[d] * al + p * vr[d];
            }
        }
        const float il = 1.0f / l;
        v4u w0, w1; w0.x = pk2(o[0] * il, o[1] * il); w0.y = pk2(o[2] * il, o[3] * il); w0.z = pk2(o[4] * il, o[5] * il); w0.w = pk2(o[6] * il, o[7] * il);
        w1.x = pk2(o[8] * il, o[9] * il); w1.y = pk2(o[10] * il, o[11] * il); w1.z = pk2(o[12] * il, o[13] * il); w1.w = pk2(o[14] * il, o[15] * il);
        bf16* op = O + (size_t)(b * SEQ + q0 + r) * D + h * FDH + part * 16; *(v4u*)op = w0; *(v4u*)(op + 8) = w1;
    }
    __syncthreads();
}

__device__ __forceinline__ void ret_ref_phase(Frame& F) {
    const bf16* Q1 = (const bf16*)(F_ws + WS_Q1); const bf16* K1 = (const bf16*)(F_ws + WS_K1); bf16* V1 = (bf16*)(F_ws + WS_V1); float* PST = (float*)(F_ws + WS_PST);
    LAS bf16* Qs = (LAS bf16*)(F.lds); LAS bf16* Ks = (LAS bf16*)(F.lds + 32768); LAS float* Sm = (LAS float*)(F.lds + 65536); LAS float* St = (LAS float*)(F.lds + 81920);
    LAS float* Vs = (LAS float*)(F.lds + 114688); LAS float* pw = (LAS float*)(F.lds + 122880);
    for (int unit = (int)blockIdx.x; unit < BATCH * RH * 16; unit += F.G) {
        const int b = unit >> 6, h = (unit >> 4) & 3, vs = unit & 15, v0 = vs * 32;
        const float lg = logf(1.0f - exp2f(-5.0f - (float)h));
        __syncthreads();
        for (int i = F.tid; i < 256 * 32; i += NWAVES * 64) St[i] = 0.f;
        if (F.tid <= 64) pw[F.tid] = expf(lg * (float)F.tid);
        for (int n = 0; n < NCH; ++n) {
            const size_t t0 = (size_t)b * SEQ + (size_t)n * CH;
            __syncthreads();
#pragma unroll
            for (int i = 0; i < 4; ++i) { const int p = F.tid + 512 * i, row = p >> 5, c = p & 31;
                *(LAS v4u*)(Qs + row * 256 + c * 8) = *(const v4u*)(Q1 + (t0 + row) * 1024 + h * 256 + c * 8);
                *(LAS v4u*)(Ks + row * 256 + c * 8) = *(const v4u*)(K1 + (t0 + row) * 1024 + h * 256 + c * 8); }
            { const int idx = F.tid * 4, row = idx >> 5, c = idx & 31; const unsigned long long vv = *(const unsigned long long*)(V1 + (t0 + row) * 2048 + h * 512 + v0 + c);
              const unsigned lo = (unsigned)vv, hi = (unsigned)(vv >> 32); LAS float* d = Vs + row * 32 + c; d[0] = pg8::bf_lo(lo); d[1] = pg8::bf_hi(lo); d[2] = pg8::bf_lo(hi); d[3] = pg8::bf_hi(hi); }
            __syncthreads();
            {
                const int i = F.tid >> 3, j0 = (F.tid & 7) * 8; float a[8];
#pragma unroll
                for (int jj = 0; jj < 8; ++jj) a[jj] = 0.f;
                for (int d = 0; d < 256; d += 2) { const unsigned qw = *(const LAS unsigned*)(Qs + i * 256 + d); const float qa = pg8::bf_lo(qw), qb = pg8::bf_hi(qw);
#pragma unroll
                    for (int jj = 0; jj < 8; ++jj) { const unsigned kw = *(const LAS unsigned*)(Ks + (j0 + jj) * 256 + d); a[jj] += qa * pg8::bf_lo(kw) + qb * pg8::bf_hi(kw); } }
#pragma unroll
                for (int jj = 0; jj < 8; ++jj) { const int dj = i - (j0 + jj); Sm[i * 64 + j0 + jj] = a[jj] * pw[dj < 0 ? -dj : dj]; }
            }
            __syncthreads();
            {
                const int i = F.tid >> 3, vv0 = (F.tid & 7) * 4; float y[4] = {0.f, 0.f, 0.f, 0.f};
                for (int d = 0; d < 256; d += 2) { const unsigned qw = *(const LAS unsigned*)(Qs + i * 256 + d); const float qa = pg8::bf_lo(qw), qb = pg8::bf_hi(qw);
                    const f32x4 s0 = *(const LAS f32x4*)(St + d * 32 + vv0), s1 = *(const LAS f32x4*)(St + (d + 1) * 32 + vv0);
                    y[0] += qa * s0.x + qb * s1.x; y[1] += qa * s0.y + qb * s1.y; y[2] += qa * s0.z + qb * s1.z; y[3] += qa * s0.w + qb * s1.w; }
                const float qd = pw[i + 1];
#pragma unroll
                for (int e = 0; e < 4; ++e) y[e] *= qd;
                for (int j = 0; j < 64; ++j) { const float s = Sm[i * 64 + j]; const f32x4 vv = *(const LAS f32x4*)(Vs + j * 32 + vv0); y[0] += s * vv.x; y[1] += s * vv.y; y[2] += s * vv.z; y[3] += s * vv.w; }
                float ps = (y[0] + y[1]) + (y[2] + y[3]), pq = (y[0] * y[0] + y[1] * y[1]) + (y[2] * y[2] + y[3] * y[3]);
                ps += __shfl_xor(ps, 1); pq += __shfl_xor(pq, 1); ps += __shfl_xor(ps, 2); pq += __shfl_xor(pq, 2); ps += __shfl_xor(ps, 4); pq += __shfl_xor(pq, 4);
                if ((F.tid & 7) == 0) { f32x2 st; st.x = ps; st.y = pq; *(f32x2*)(PST + (((t0 + i) * 4 + h) * 16 + vs) * 2) = st; }
                *(unsigned long long*)(V1 + (t0 + i) * 2048 + h * 512 + v0 + vv0) = (unsigned long long)pk2(y[0], y[1]) | ((unsigned long long)pk2(y[2], y[3]) << 32);
            }
            __syncthreads();
            {
                const int d = F.tid >> 1, vv0 = (F.tid & 1) * 16; float a[16]; const float cd = pw[64];
#pragma unroll
                for (int e = 0; e < 16; ++e) a[e] = St[d * 32 + vv0 + e] * cd;
                for (int j = 0; j < 64; ++j) { const float kd = pg8::bf_lo((unsigned)Ks[j * 256 + d]) * pw[63 - j];
#pragma unroll
                    for (int e = 0; e < 16; e += 4) { const f32x4 vv = *(const LAS f32x4*)(Vs + j * 32 + vv0 + e); a[e] += kd * vv.x; a[e + 1] += kd * vv.y; a[e + 2] += kd * vv.z; a[e + 3] += kd * vv.w; } }
#pragma unroll
                for (int e = 0; e < 16; ++e) St[d * 32 + vv0 + e] = a[e];
            }
        }
    }
    __syncthreads();
}


__device__ __forceinline__ rtn::Ptrs rt_ptrs(Frame& F) {
    rtn::Ptrs P; GAS char* w = (GAS char*)F_ws;
    P.Q = w + WS_Q1; P.K = w + WS_K1; P.V = w + WS_V1; P.L = (GAS char*)F_out; P.PST = (GAS float*)(w + WS_PST); return P;
}
#ifndef RT_PAIR
#define RT_PAIR 1
#endif
__device__ __forceinline__ void ret_pass1_phase(Frame& F) {
    const rtn::Ptrs P = rt_ptrs(F);
    { const int nit = 8 * (rtn::NG - 1) * 2; p0_late_weights(F, F.G > nit + 16 ? nit : 0); }
    for (int it = (int)blockIdx.x; it < 8 * (rtn::NG - 1) * 2; it += F.G) { const int half = RT_PAIR ? (it >> 3) & 1 : it & 1, r = RT_PAIR ? (it & 7) | ((it >> 4) << 3) : it >> 1, g = r % (rtn::NG - 1), bh = r / (rtn::NG - 1); rtn::run_item<false>(P, bh, half, g, 0u, F.wave); }
}
__device__ __forceinline__ void ret_scan_phase(Frame& F) {
    GAS char* L = (GAS char*)F_out;
    for (int i = (int)blockIdx.x * (NWAVES * 64) + F.tid; i < 16 * 8192; i += F.G * (NWAVES * 64)) {
        const int c = i & 8191, bhh = i >> 13, half = bhh & 1, bh = bhh >> 1, h = bh & 3;
        const float lg = __logf(1.0f - __builtin_amdgcn_exp2f(-5.0f - (float)h)), cdg = __expf(lg * (float)(rtn::RG * 64));
        GAS char* p = L + ((size_t)(bh * (rtn::NG - 1)) * 2 + half) * 131072 + (size_t)c * 16;
        pg8::u32x4 w[rtn::NG - 1];
#pragma unroll
        for (int gp = 0; gp < rtn::NG - 1; ++gp) w[gp] = *(const GAS pg8::u32x4*)(p + (size_t)gp * 262144);
        float x[8] = {0.f, 0.f, 0.f, 0.f, 0.f, 0.f, 0.f, 0.f};
#pragma unroll
        for (int gp = 0; gp < rtn::NG - 1; ++gp) {
            x[0] = x[0] * cdg + pg8::bf_lo(w[gp].x); x[1] = x[1] * cdg + pg8::bf_hi(w[gp].x); x[2] = x[2] * cdg + pg8::bf_lo(w[gp].y); x[3] = x[3] * cdg + pg8::bf_hi(w[gp].y);
            x[4] = x[4] * cdg + pg8::bf_lo(w[gp].z); x[5] = x[5] * cdg + pg8::bf_hi(w[gp].z); x[6] = x[6] * cdg + pg8::bf_lo(w[gp].w); x[7] = x[7] * cdg + pg8::bf_hi(w[gp].w);
            if (gp > 0) { pg8::u32x4 o; o.x = pg8::cvt_pk_bf16(x[0], x[1]); o.y = pg8::cvt_pk_bf16(x[2], x[3]); o.z = pg8::cvt_pk_bf16(x[4], x[5]); o.w = pg8::cvt_pk_bf16(x[6], x[7]); *(GAS pg8::u32x4*)(p + (size_t)gp * 262144) = o; }
        }
    }
}
__device__ __forceinline__ void ret_pass2_phase(Frame& F) {
    const rtn::Ptrs P = rt_ptrs(F);
    for (int it = (int)blockIdx.x; it < 8 * rtn::NG * 2; it += F.G) { const int half = RT_PAIR ? (it >> 3) & 1 : it & 1, r = RT_PAIR ? (it & 7) | ((it >> 4) << 3) : it >> 1, g = r % rtn::NG, bh = r / rtn::NG; rtn::run_item<true>(P, bh, half, g, 0u, F.wave); }
}

__device__ __forceinline__ void final_norm_phase(Frame& F) {
    const float* SSQ = (const float*)(F_ws + WS_SSQ); const bf16* XB = (const bf16*)(F_ws + WS_XB);
    const int gw = F.vcu * NWAVES + F.wave, NGW = F.G * NWAVES;
    f32x4 gv[4];
#pragma unroll
    for (int j = 0; j < 4; ++j) gv[j] = ((const f32x4*)F_final_norm)[F.lane + 64 * j];
    for (int row = gw; row < M; row += NGW) {
        float s = (F.lane < 16) ? SSQ[(size_t)row * 16 + F.lane] : 0.f; s = wave_sum(s);
        const float rstd = 1.0f / sqrtf(s * (1.f / D) + EPS);
        const GAS unsigned long long* xr = (const GAS unsigned long long*)(XB + (size_t)row * D) + F.lane;
        GAS f32x4* orow = (GAS f32x4*)(F_out + (size_t)row * D) + F.lane;
#pragma unroll
        for (int j = 0; j < 4; ++j) { const unsigned long long w = xr[64 * j]; const unsigned lo = (unsigned)w, hi = (unsigned)(w >> 32); f32x4 v;
            v.x = pg8::bf_lo(lo); v.y = pg8::bf_hi(lo); v.z = pg8::bf_lo(hi); v.w = pg8::bf_hi(hi); orow[64 * j] = v * rstd * gv[j]; }
    }
}
#ifndef MK_N_LAUNCHES
#define MK_N_LAUNCHES 1
#endif
constexpr int N_LAUNCHES = MK_N_LAUNCHES;
#ifndef REP_PHASE
#define REP_PHASE -1
#endif
#define REPS(k) ((k) == REP_PHASE ? 2 : 1)
#ifndef FAST_ATTN
#define FAST_ATTN 0
#endif
#ifndef FAST_RET
#define FAST_RET 0
#endif
__device__ __forceinline__ bool relaunder(Frame& F) { int t = F.wave * 64 + hw_lane_id(); asm volatile("" : "+v"(t));     F.tid = t; F.lane = t & 63; F.wave = __builtin_amdgcn_readfirstlane(t >> 6); const __attribute__((address_space(4))) Args* a = F.ap; asm volatile("" : "+s"(a)); F.ap = a; return true; }
__global__ void __launch_bounds__(NWAVES * 64, 2) fox_ret_fwd(Args args) {
    extern __shared__ __attribute__((aligned(16))) unsigned char lds[];
    Frame F;
    F.lds = (LAS unsigned char*)lds;
    F.MISC = (volatile LAS unsigned*)(F.lds + MISC_OFF);
    F.tid = threadIdx.x; F.lane = F.tid & 63; F.wave = __builtin_amdgcn_readfirstlane(F.tid >> 6);
    F.G = gridDim.x; { const int bx = blockIdx.x; F.vcu = (F.G % 8 == 0) ? (bx % 8) * (F.G / 8) + bx / 8 : bx; }
    F.ap = (const __attribute__((address_space(4))) Args*)__builtin_amdgcn_kernarg_segment_ptr();
    for (int u = F.tid; u < (LDS_BYTES - LDSCTL_OFF) / 4; u += NWAVES * 64) ((LAS unsigned*)(F.lds + LDSCTL_OFF))[u] = 0u;
    __syncthreads();
    XcdBarrier bar; bar.bar = (unsigned*)(F_ws + WS_CTL) + CW_BAR; bar.x = 0; bar.st = nullptr;
    if (N_LAUNCHES == 1) bar = xcd_barrier_post((unsigned*)(F_ws + WS_CTL) + CW_BAR, F.MISC + 8);
#define GRID_BAR() do { if (N_LAUNCHES == 1) { xcd_barrier(bar); if (REP_PHASE == -2) xcd_barrier(bar); } } while (0)
    const int lo = F.ap->ph_lo, hi = F.ap->ph_hi;
#define IN(k) (lo <= (k) && (k) < hi && relaunder(F))
#define BOTH(k) (IN(k) && IN((k) + 1))
#define ws F_ws
#define XB ((pg8::bf16_t*)(F_ws + WS_XB))
#define SSQ ((float*)(F_ws + WS_SSQ))
    const LAS float* const tab = (const LAS float*)(F.lds + TAB_OFF);

#ifndef TPROBE
#define TPROBE -1
#endif
#define TP(k) if (TPROBE == (k) && F.tid == 0) F.MISC[21] = (unsigned)__builtin_amdgcn_s_memrealtime();
    if (TPROBE >= 0 && F.tid == 0) F.MISC[20] = (unsigned)__builtin_amdgcn_s_memrealtime();
#define RUN_PHASE(k, BODY) TP(k) if (IN(k)) { BODY; if (REP_PHASE == (k)) { GRID_BAR(); relaunder(F); BODY; } if (BOTH(k)) GRID_BAR(); }
#define RUN_PHASE2(k, BODY, BODY2) TP(k) if (IN(k)) { BODY; if (REP_PHASE == (k) || REP_PHASE == 100 + (k) || REP_PHASE == 200 + (k)) { GRID_BAR(); relaunder(F); BODY2; } if (BOTH(k)) GRID_BAR(); }
#define GEMM_PHASE(EPI, Aptr, Bptr, N_, K_, PRE, ...) do { \
        pg8::Gemm g{(const pg8::bf16_t*)(Aptr), (const pg8::bf16_t*)(Bptr), M, (N_), (K_)}; pg8::StaticOrder S; S.init(M, (N_), F.G, (int)blockIdx.x); \
        PRE; pg8::EPI E{__VA_ARGS__}; \
        pg8::gemm_phase<pg8::EPI, pg8::StaticOrder, true, true>(F.lds + RING_OFF, g, S, E, F.wave); } while (0)
#define GEMM_PHASE_HOT(EPI, Aptr, Bptr, N_, K_, PRE, ...) do { \
        pg8::Gemm g{(const pg8::bf16_t*)(Aptr), (const pg8::bf16_t*)(Bptr), M, (N_), (K_)}; pg8::StaticOrderHot S; S.init(M, (N_), F.G, (int)blockIdx.x); \
        PRE; pg8::EPI E{__VA_ARGS__}; \
        pg8::gemm_phase<pg8::EPI, pg8::StaticOrderHot, true, true>(F.lds + RING_OFF, g, S, E, F.wave); } while (0)
    RUN_PHASE(0, p0_prologue(F))
    RUN_PHASE(1, GEMM_PHASE(EpiQKV0, XB, ws + WS_WQKV0, 3072, 1024, cbg_phase(F); fill_rstd_tab(F, S), (pg8::bf16_t*)(ws + WS_Q0), tab, QSCALE, (float*)(ws + WS_NRM)))
#if FAST_ATTN
    RUN_PHASE2(2, attn_fast_phase(F, (char*)lds), attn_fast_phase(F, (char*)lds, 1))
#else
    RUN_PHASE(2, attn_ref_phase(F))
#endif
    RUN_PHASE2(3, GEMM_PHASE(EpiRes, ws + WS_O0, ws + WS_WO0, 1024, 1024, (void)0, XB, SSQ), GEMM_PHASE(EpiRes, ws + WS_O0, ws + WS_WO0, 1024, 1024, (void)0, (pg8::bf16_t*)F_out, (float*)F_out + 8388608))
#if REP_PHASE == 104
    RUN_PHASE2(4, GEMM_PHASE(EpiSwiGLU, XB, ws + WS_WFI0, 2 * DFF, 1024, fill_rstd_tab(F, S), (pg8::bf16_t*)(ws + WS_HID), tab), GEMM_PHASE(EpiNull, XB, ws + WS_WFI0, 2 * DFF, 1024, (void)0, 0))
#else
    RUN_PHASE(4, GEMM_PHASE(EpiSwiGLU, XB, ws + WS_WFI0, 2 * DFF, 1024, fill_rstd_tab(F, S), (pg8::bf16_t*)(ws + WS_HID), tab))
#endif
#if REP_PHASE == 205
    RUN_PHASE2(5, GEMM_PHASE(EpiRes, ws + WS_HID, ws + WS_WFO0, 1024, DFF, (void)0, XB, SSQ), GEMM_PHASE_HOT(EpiNull, ws + WS_HID, ws + WS_WFO0, 1024, DFF, (void)0, 0))
#elif REP_PHASE == 105
    RUN_PHASE2(5, GEMM_PHASE(EpiRes, ws + WS_HID, ws + WS_WFO0, 1024, DFF, (void)0, XB, SSQ), GEMM_PHASE(EpiNull, ws + WS_HID, ws + WS_WFO0, 1024, DFF, (void)0, 0))
#else
    RUN_PHASE2(5, GEMM_PHASE(EpiRes, ws + WS_HID, ws + WS_WFO0, 1024, DFF, (void)0, XB, SSQ), GEMM_PHASE(EpiRes, ws + WS_HID, ws + WS_WFO0, 1024, DFF, (void)0, (pg8::bf16_t*)F_out, (float*)F_out + 8388608))
#endif
    RUN_PHASE(6, GEMM_PHASE(EpiRet, XB, ws + WS_WRI, 4096, 1024, fill_rstd_tab(F, S), (pg8::bf16_t*)(ws + WS_Q1), (pg8::bf16_t*)(ws + WS_K1), (pg8::bf16_t*)(ws + WS_V1), (const float*)(ws + WS_ROPE), tab))
#if FAST_RET
    RUN_PHASE(7, ret_pass1_phase(F))
    RUN_PHASE(8, ret_scan_phase(F))
    RUN_PHASE(9, ret_pass2_phase(F))
#else
    RUN_PHASE(7, (void)0)
    RUN_PHASE(8, (void)0)
    RUN_PHASE(9, ret_ref_phase(F))
#endif
#if REP_PHASE == 110
    RUN_PHASE2(10, GEMM_PHASE(EpiGate, XB, (const pg8::bf16_t*)(ws + WS_WRI) + (size_t)4096 * 1024, 2048, 1024, fill_rstd_tab(F, S); fill_gate_tab(F, S), (pg8::bf16_t*)(ws + WS_V1), tab, (const LAS pg8::f32x2*)(F.lds + STAB_OFF)), GEMM_PHASE(EpiNull, XB, (const pg8::bf16_t*)(ws + WS_WRI) + (size_t)4096 * 1024, 2048, 1024, (void)0, 0))
#else
    RUN_PHASE(10, GEMM_PHASE(EpiGate, XB, (const pg8::bf16_t*)(ws + WS_WRI) + (size_t)4096 * 1024, 2048, 1024, fill_rstd_tab(F, S); fill_gate_tab(F, S), (pg8::bf16_t*)(ws + WS_V1), tab, (const LAS pg8::f32x2*)(F.lds + STAB_OFF)))
#endif
    RUN_PHASE2(11, GEMM_PHASE(EpiRes, ws + WS_V1, ws + WS_WRO, 1024, 2048, (void)0, XB, SSQ), GEMM_PHASE(EpiRes, ws + WS_V1, ws + WS_WRO, 1024, 2048, (void)0, (pg8::bf16_t*)F_out, (float*)F_out + 8388608))
    RUN_PHASE(12, GEMM_PHASE(EpiSwiGLU, XB, ws + WS_WFI1, 2 * DFF, 1024, fill_rstd_tab(F, S), (pg8::bf16_t*)(ws + WS_HID), tab))
    RUN_PHASE2(13, GEMM_PHASE(EpiRes, ws + WS_HID, ws + WS_WFO1, 1024, DFF, (void)0, XB, SSQ), GEMM_PHASE(EpiRes, ws + WS_HID, ws + WS_WFO1, 1024, DFF, (void)0, (pg8::bf16_t*)F_out, (float*)F_out + 8388608))
    TP(14) if (IN(14)) final_norm_phase(F);
    TP(15)
    if (TPROBE >= 0 && blockIdx.x == 0 && F.tid == 0) { const unsigned d = (TPROBE == 100) ? F.MISC[22] : F.MISC[21] - F.MISC[20], t0 = (unsigned)__builtin_amdgcn_s_memrealtime();
        while ((unsigned)__builtin_amdgcn_s_memrealtime() - t0 < d) __builtin_amdgcn_s_sleep(8); }
#undef RUN_PHASE
#undef RUN_PHASE2
#undef GEMM_PHASE
#undef IN
#undef ws
#undef XB
#undef SSQ
#undef BOTH
#undef GRID_BAR
}

extern "C" void kernel_launch(void* const* d_in, const int* in_sizes, int n_in, void* d_out, int out_size, void* d_ws, size_t ws_size, hipStream_t stream) {
    static int grid = 0;
    if (grid == 0) {
        if (n_in != 11 || in_sizes[0] != M * D || out_size != M * D || ws_size < WS_END) { fprintf(stderr, "kernel_launch: shape/workspace mismatch (n_in %d, in0 %d, out %d, ws %zu, need %zu)\n", n_in, n_in > 0 ? in_sizes[0] : -1, out_size, ws_size, (size_t)WS_END); grid = -1; return; }
        int dev = 0, cus = 0, per_cu = 0;
        if (hipGetDevice(&dev) != hipSuccess || hipDeviceGetAttribute(&cus, hipDeviceAttributeMultiprocessorCount, dev) != hipSuccess) { fprintf(stderr, "kernel_launch: device query failed\n"); grid = -1; return; }
        if (hipFuncSetAttribute((const void*)fox_ret_fwd, hipFuncAttributeMaxDynamicSharedMemorySize, LDS_BYTES) != hipSuccess) { fprintf(stderr, "kernel_launch: hipFuncSetAttribute failed\n"); grid = -1; return; }
        if (hipOccupancyMaxActiveBlocksPerMultiprocessor(&per_cu, (const void*)fox_ret_fwd, NWAVES * 64, LDS_BYTES) != hipSuccess || per_cu < 1) { fprintf(stderr, "kernel_launch: occupancy query reports %d workgroups per CU\n", per_cu); per_cu = 1; }
        (void)hipGetLastError();
        grid = cus;
        if (grid > 256) grid = 256;
    }
    if (grid < 0) return;
    if (hipMemsetAsync((char*)d_ws + WS_CTL, 0, CTL_ZERO_BYTES, stream) != hipSuccess) { fprintf(stderr, "kernel_launch: hipMemsetAsync failed\n"); return; }
    Args a{};
    for (int i = 0; i < 11; ++i) a.in[i] = (const float*)d_in[i];
    a.out = (float*)d_out; a.wsp = (unsigned char*)d_ws;
    for (int li = 0; li < N_LAUNCHES; ++li) {
        a.ph_lo = (N_LAUNCHES == 1) ? 0 : li; a.ph_hi = (N_LAUNCHES == 1) ? NPHASE : li + 1; a.li = li;
        hipLaunchKernelGGL(fox_ret_fwd, dim3(grid), dim3(NWAVES * 64), LDS_BYTES, stream, a);
        const hipError_t le = hipPeekAtLastError();
        if (le != hipSuccess) { fprintf(stderr, "kernel_launch: launch %d failed: %s\n", li, hipGetErrorName(le)); break; }
    }
}
```

```cpp
#define MK_N_LAUNCHES 1
#define FAST_ATTN 1
#define FAST_RET 1
#include <hip/hip_runtime.h>
#include <cstdio>
#include <cstdint>
#include <cmath>
__device__ __forceinline__ int hw_lane_id() { int l; asm volatile("v_mbcnt_lo_u32_b32 %0, -1, 0\n\tv_mbcnt_hi_u32_b32 %0, -1, %0" : "=v"(l)); return l; }
namespace pg8 {
#define PG8_LAS __attribute__((address_space(3)))
typedef unsigned short bf16_t;
typedef short bf16x8 __attribute__((ext_vector_type(8)));
typedef float f32x4 __attribute__((ext_vector_type(4)));
typedef unsigned u32x4 __attribute__((ext_vector_type(4)));
constexpr int BM = 256, BK = 64, HALF = 128, HTB = HALF * BK * 2  , STAGE_BYTES = 8 * HTB, NXCD = 8, WGM = 8;

__host__ __device__ __forceinline__ int lds_byte(int r, int c) { const int st = (r >> 4) * 2 + (c >> 5), rr = r & 15, cc = c & 31, ob = rr * 64 + cc * 2; return st * 1024 + (ob ^ (((ob >> 9) & 1) << 5)); }
__host__ __device__ __forceinline__ void stage_rc(int b, int& R, int& C) { const int st = b / 1024, sb = b % 1024, swz = sb ^ (((sb >> 9) & 1) << 5); R = (st >> 1) * 16 + swz / 64; C = (st & 1) * 32 + (swz % 64) / 2; }
__host__ __device__ __forceinline__ int perm32(int rho) { const int n = rho >> 4, i = rho & 15; return 8 * (i >> 2) + 4 * n + (i & 3); }

struct Unit { int pm, pn; };
struct Gemm { const bf16_t* A; const bf16_t* Bt; int M, N, K; };

struct StaticOrder {
    int nM, nN, nwg, G, c;
    __host__ __device__ void init(int M, int N, int G_, int c_) { nM = M / BM; nN = N / BM; nwg = nM * nN; G = G_; c = c_; }
    __host__ __device__ bool next(int i, Unit& u) const {
        const long L = (long)i * G + c; if (L >= nwg) return false;
        int wgid = (int)L; { const int q = nwg / NXCD, r = nwg % NXCD, xcd = wgid % NXCD, off = wgid / NXCD; wgid = (xcd < r ? xcd * (q + 1) : r * (q + 1) + (xcd - r) * q) + off; }
        const int nig = WGM * nN, gid = wgid / nig, fm = gid * WGM, gsz = (nM - fm) < WGM ? (nM - fm) : WGM;
        u.pm = fm + ((wgid % nig) % gsz); u.pn = (wgid % nig) / gsz; return true;
    }
    __device__ __forceinline__ void a_ready(const Unit&) const {}
    __device__ __forceinline__ void done(const Unit&) const {}
};
struct StaticOrderHot : StaticOrder {
    __host__ __device__ bool next(int i, Unit& u) const { const bool ok = StaticOrder::next(i, u); u.pm = 0; return ok; }
};

__device__ __forceinline__ unsigned cvt_pk_bf16(float lo, float hi) { unsigned r; asm volatile("v_cvt_pk_bf16_f32 %0, %1, %2" : "=v"(r) : "v"(lo), "v"(hi)); return r; }
typedef float f32x2 __attribute__((ext_vector_type(2)));
__device__ __forceinline__ float silu_f(float x) { return x * __builtin_amdgcn_rcpf(1.0f + __builtin_amdgcn_exp2f(-1.4426950408889634f * x)); }
__device__ __forceinline__ u32x4 pack8f(const f32x4 v0, const f32x4 v1) { u32x4 w; w.x = cvt_pk_bf16(v0[0], v0[1]); w.y = cvt_pk_bf16(v0[2], v0[3]); w.z = cvt_pk_bf16(v1[0], v1[1]); w.w = cvt_pk_bf16(v1[2], v1[3]); return w; }
#ifndef EPI_WT
#define EPI_WT 1
#endif
__device__ __forceinline__ __amdgpu_buffer_rsrc_t epi_rsrc(const void* base, unsigned bytes) { return __builtin_amdgcn_make_buffer_rsrc((void*)base, (short)0, (int)bytes, 0x00020000); }
__device__ __forceinline__ void st16(__amdgpu_buffer_rsrc_t r, unsigned byte_off, u32x4 v) { __builtin_amdgcn_raw_buffer_store_b128(v, r, byte_off, 0, EPI_WT ? 16 : 0); }
__device__ __forceinline__ float bf_lo(unsigned w) { return __builtin_bit_cast(float, w << 16); }
__device__ __forceinline__ float bf_hi(unsigned w) { return __builtin_bit_cast(float, w & 0xffff0000u); }

struct EpiQKV0 {
    static constexpr int PROBE_ID = 1; static constexpr bool PERM = true, AFTER_DRAIN = false, ACC_INIT = false;
    bf16_t* Q; const PG8_LAS float* tab; float qscale; float* nrm;
    __device__ __forceinline__ void operator()(const f32x4 (&acc)[2][2][4][2], const Unit& u, int ui, int wr, int wc, int fr, int fq) const {
        const int colt = u.pn * BM, t = colt >> 10; const __amdgpu_buffer_rsrc_t rs_ = epi_rsrc(Q + (size_t)t * ((size_t)16384 * 1024), 16384u * 2048u);
        const int cb = (colt & 1023) + wc * 32 + 8 * fq; const float sc = t == 0 ? qscale : 1.f;
        float mx0 = 0.f, mx1 = 0.f;
#pragma unroll
        for (int ai = 0; ai < 2; ++ai)
#pragma unroll
            for (int m = 0; m < 4; ++m) { const int rl = ai * HALF + wr * 64 + m * 16 + fr; const float rs = tab[ui * 256 + rl] * sc;
                const unsigned rowo = (unsigned)((u.pm * BM + rl) * 1024 + cb) * 2u;
#pragma unroll
                for (int bj = 0; bj < 2; ++bj) { const u32x4 w = pack8f(acc[ai][bj][m][0] * rs, acc[ai][bj][m][1] * rs); st16(rs_, rowo + bj * HALF * 2, w);
                    if (t < 2) { float q = (bf_lo(w.x) * bf_lo(w.x) + bf_hi(w.x) * bf_hi(w.x)) + (bf_lo(w.y) * bf_lo(w.y) + bf_hi(w.y) * bf_hi(w.y));
                        q += (bf_lo(w.z) * bf_lo(w.z) + bf_hi(w.z) * bf_hi(w.z)) + (bf_lo(w.w) * bf_lo(w.w) + bf_hi(w.w) * bf_hi(w.w));
                        q += __shfl_xor(q, 16); q += __shfl_xor(q, 32);
                        if (bj == 0) mx0 = fmaxf(mx0, q); else mx1 = fmaxf(mx1, q); } } }
        if (t < 2) {
#pragma unroll
            for (int o = 1; o < 16; o <<= 1) { mx0 = fmaxf(mx0, __shfl_xor(mx0, o)); mx1 = fmaxf(mx1, __shfl_xor(mx1, o)); }
            if (fr == 0 && fq == 0) { const int head = ((colt & 1023) >> 7); float* d = nrm + ((((size_t)t * 64 + u.pm) * 8 + head) * 4 + wc) * 2 + wr; d[0] = mx0; d[8] = mx1; }
        }
    }
};
struct EpiRes {
    static constexpr int PROBE_ID = 2; static constexpr bool PERM = true, AFTER_DRAIN = false, ACC_INIT = true;
    bf16_t* xb; float* ssq;
    __device__ __forceinline__ void init_issue(u32x4 (&raw)[2][2][4], const Unit& u, int wr, int wc, int fr, int fq) const {
        const int col0 = u.pn * BM + wc * 32 + 8 * fq;
#pragma unroll
        for (int ai = 0; ai < 2; ++ai)
#pragma unroll
            for (int m = 0; m < 4; ++m) { const int row = u.pm * BM + ai * HALF + wr * 64 + m * 16 + fr; const bf16_t* rowp = xb + (size_t)row * 1024 + col0;
#pragma unroll
                for (int bj = 0; bj < 2; ++bj) raw[ai][bj][m] = *(const u32x4*)(rowp + bj * HALF); }
    }
    __device__ __forceinline__ void init_finish(f32x4 (&acc)[2][2][4][2], const u32x4 (&raw)[2][2][4]) const {
#pragma unroll
        for (int ai = 0; ai < 2; ++ai)
#pragma unroll
            for (int bj = 0; bj < 2; ++bj)
#pragma unroll
                for (int m = 0; m < 4; ++m) { const u32x4 b = raw[ai][bj][m];
                    acc[ai][bj][m][0] = (f32x4){bf_lo(b.x), bf_hi(b.x), bf_lo(b.y), bf_hi(b.y)}; acc[ai][bj][m][1] = (f32x4){bf_lo(b.z), bf_hi(b.z), bf_lo(b.w), bf_hi(b.w)}; }
    }
    __device__ __forceinline__ void operator()(const f32x4 (&acc)[2][2][4][2], const Unit& u, int ui, int wr, int wc, int fr, int fq) const {
        const int col0 = u.pn * BM + wc * 32 + 8 * fq; const __amdgpu_buffer_rsrc_t rs_ = epi_rsrc(xb, 16384u * 2048u);
        float ss[2][4];
#pragma unroll
        for (int ai = 0; ai < 2; ++ai)
#pragma unroll
            for (int m = 0; m < 4; ++m) { const int row = u.pm * BM + ai * HALF + wr * 64 + m * 16 + fr; const unsigned rowo = (unsigned)(row * 1024 + col0) * 2u; float s = 0.f;
#pragma unroll
                for (int bj = 0; bj < 2; ++bj) { const f32x4 o0 = acc[ai][bj][m][0], o1 = acc[ai][bj][m][1];
                    s += ((o0[0] * o0[0] + o0[1] * o0[1]) + (o0[2] * o0[2] + o0[3] * o0[3])) + ((o1[0] * o1[0] + o1[1] * o1[1]) + (o1[2] * o1[2] + o1[3] * o1[3]));
                    st16(rs_, rowo + bj * HALF * 2, pack8f(o0, o1)); }
                ss[ai][m] = s; }
        const bool b5 = (fq & 2) != 0, b4 = (fq & 1) != 0; float k1[4], k2[2];
#pragma unroll
        for (int m = 0; m < 4; ++m) k1[m] = (b5 ? ss[1][m] : ss[0][m]) + __shfl_xor(b5 ? ss[0][m] : ss[1][m], 32);
#pragma unroll
        for (int mm = 0; mm < 2; ++mm) k2[mm] = (b4 ? k1[2 + mm] : k1[mm]) + __shfl_xor(b4 ? k1[mm] : k1[2 + mm], 16);
#pragma unroll
        for (int mm = 0; mm < 2; ++mm) { const int row = u.pm * BM + (b5 ? HALF : 0) + wr * 64 + (2 * (b4 ? 1 : 0) + mm) * 16 + fr; ssq[(size_t)row * 16 + u.pn * 4 + wc] = k2[mm]; }
    }
};
struct EpiResFinal {
    static constexpr int PROBE_ID = 7; static constexpr bool PERM = true, AFTER_DRAIN = false, ACC_INIT = true;
    bf16_t* xb; float* ssq; float* out; const float* gain; unsigned* cnt;
    __device__ __forceinline__ void init_issue(u32x4 (&raw)[2][2][4], const Unit& u, int wr, int wc, int fr, int fq) const {
        const int col0 = u.pn * BM + wc * 32 + 8 * fq;
#pragma unroll
        for (int ai = 0; ai < 2; ++ai)
#pragma unroll
            for (int m = 0; m < 4; ++m) { const int row = u.pm * BM + ai * HALF + wr * 64 + m * 16 + fr; const bf16_t* rowp = xb + (size_t)row * 1024 + col0;
#pragma unroll
                for (int bj = 0; bj < 2; ++bj) raw[ai][bj][m] = *(const u32x4*)(rowp + bj * HALF); }
    }
    __device__ __forceinline__ void init_finish(f32x4 (&acc)[2][2][4][2], const u32x4 (&raw)[2][2][4]) const {
#pragma unroll
        for (int ai = 0; ai < 2; ++ai)
#pragma unroll
            for (int bj = 0; bj < 2; ++bj)
#pragma unroll
                for (int m = 0; m < 4; ++m) { const u32x4 b = raw[ai][bj][m];
                    acc[ai][bj][m][0] = (f32x4){bf_lo(b.x), bf_hi(b.x), bf_lo(b.y), bf_hi(b.y)}; acc[ai][bj][m][1] = (f32x4){bf_lo(b.z), bf_hi(b.z), bf_lo(b.w), bf_hi(b.w)}; }
    }
    __device__ __forceinline__ void operator()(const f32x4 (&acc)[2][2][4][2], const Unit& u, int ui, int wr, int wc, int fr, int fq) const {
        const int col0 = u.pn * BM + wc * 32 + 8 * fq;
#pragma unroll
        for (int ai = 0; ai < 2; ++ai)
#pragma unroll
            for (int m = 0; m < 4; ++m) { const int row = u.pm * BM + ai * HALF + wr * 64 + m * 16 + fr; float s = 0.f;
#pragma unroll
                for (int bj = 0; bj < 2; ++bj) { const f32x4 o0 = acc[ai][bj][m][0], o1 = acc[ai][bj][m][1];
                    s += ((o0[0] * o0[0] + o0[1] * o0[1]) + (o0[2] * o0[2] + o0[3] * o0[3])) + ((o1[0] * o1[0] + o1[1] * o1[1]) + (o1[2] * o1[2] + o1[3] * o1[3])); }
                s += __shfl_xor(s, 16); s += __shfl_xor(s, 32);
                if (fq == 0) ssq[(size_t)row * 16 + u.pn * 4 + wc] = s; }
        asm volatile("s_waitcnt vmcnt(0)" ::: "memory");
        __syncthreads();
        if (wr == 0 && wc == 0 && fr == 0 && fq == 0) {
            __builtin_amdgcn_fence(__ATOMIC_RELEASE, "agent"); asm volatile("s_waitcnt vmcnt(0)" ::: "memory");
            __hip_atomic_fetch_add(cnt + u.pm, 1u, __ATOMIC_RELAXED, __HIP_MEMORY_SCOPE_AGENT);
            unsigned sp = 0; while (__hip_atomic_load(cnt + u.pm, __ATOMIC_RELAXED, __HIP_MEMORY_SCOPE_AGENT) < 4u && ++sp < (1u << 22)) __builtin_amdgcn_s_sleep(2);
            __builtin_amdgcn_fence(__ATOMIC_ACQUIRE, "agent"); asm volatile("s_waitcnt vmcnt(0)" ::: "memory"); }
        __syncthreads();
        f32x4 gv[2][2];
#pragma unroll
        for (int bj = 0; bj < 2; ++bj) { gv[bj][0] = *(const f32x4*)(gain + col0 + bj * HALF); gv[bj][1] = *(const f32x4*)(gain + col0 + bj * HALF + 4); }
#pragma unroll
        for (int ai = 0; ai < 2; ++ai)
#pragma unroll
            for (int m = 0; m < 4; ++m) { const int row = u.pm * BM + ai * HALF + wr * 64 + m * 16 + fr;
                const f32x4* p = (const f32x4*)(ssq + (size_t)row * 16); const f32x4 a = p[0], b = p[1], c = p[2], d = p[3];
                const float sq = ((a.x + a.y) + (a.z + a.w)) + ((b.x + b.y) + (b.z + b.w)) + ((c.x + c.y) + (c.z + c.w)) + ((d.x + d.y) + (d.z + d.w));
                const float rstd = 1.0f / sqrtf(sq * (1.f / 1024.f) + 1e-6f);
                float* orow = out + (size_t)row * 1024 + col0;
#pragma unroll
                for (int bj = 0; bj < 2; ++bj) { *(f32x4*)(orow + bj * HALF) = acc[ai][bj][m][0] * rstd * gv[bj][0]; *(f32x4*)(orow + bj * HALF + 4) = acc[ai][bj][m][1] * rstd * gv[bj][1]; } }
    }
};
struct EpiSwiGLU {
    static constexpr int PROBE_ID = 3; static constexpr bool PERM = true, AFTER_DRAIN = false, ACC_INIT = false;
    bf16_t* Hd; const PG8_LAS float* tab;
    __device__ __forceinline__ void operator()(const f32x4 (&acc)[2][2][4][2], const Unit& u, int ui, int wr, int wc, int fr, int fq) const {
        const int hc0 = u.pn * HALF + wc * 32 + 8 * fq; const __amdgpu_buffer_rsrc_t rs_ = epi_rsrc(Hd, 16384u * 5632u);
#pragma unroll
        for (int ai = 0; ai < 2; ++ai)
#pragma unroll
            for (int m = 0; m < 4; ++m) { const int rl = ai * HALF + wr * 64 + m * 16 + fr; const float rs = tab[ui * 256 + rl];
                f32x4 h0, h1;
                const float c1 = -1.4426950408889634f * rs, c2 = rs * rs;
#pragma unroll
                for (int e = 0; e < 4; ++e) { const float g0 = acc[ai][0][m][0][e], g1 = acc[ai][0][m][1][e];
                    h0[e] = (g0 * acc[ai][1][m][0][e]) * __builtin_amdgcn_rcpf(1.0f + __builtin_amdgcn_exp2f(g0 * c1)) * c2;
                    h1[e] = (g1 * acc[ai][1][m][1][e]) * __builtin_amdgcn_rcpf(1.0f + __builtin_amdgcn_exp2f(g1 * c1)) * c2; }
                st16(rs_, (unsigned)((u.pm * BM + rl) * 2816 + hc0) * 2u, pack8f(h0, h1)); }
    }
};
struct EpiRet {
    static constexpr int PROBE_ID = 4; static constexpr bool PERM = true, AFTER_DRAIN = false, ACC_INIT = false;
    bf16_t* Q; bf16_t* Kp; bf16_t* V; const float* rope; const PG8_LAS float* tab;
    __device__ __forceinline__ void operator()(const f32x4 (&acc)[2][2][4][2], const Unit& u, int ui, int wr, int wc, int fr, int fq) const {
        if (u.pn < 8) {
            const bool isk = u.pn >= 4; const int head = u.pn & 3; const __amdgpu_buffer_rsrc_t rs_ = epi_rsrc(isk ? Kp : Q, 16384u * 2048u); const float sc = isk ? 0.0625f : 1.f; const int i0 = wc * 32 + 8 * fq;
            const f32x4 iv0 = *(const f32x4*)(rope + i0), iv1 = *(const f32x4*)(rope + i0 + 4);
#pragma unroll
            for (int ai = 0; ai < 2; ++ai)
#pragma unroll
                for (int m = 0; m < 4; ++m) { const int rl = ai * HALF + wr * 64 + m * 16 + fr, row = u.pm * BM + rl; const float rs = tab[ui * 256 + rl] * sc;
                    const float posf = (float)(row & 8191);
                    f32x4 o1[2], o2[2];
#pragma unroll
                    for (int n = 0; n < 2; ++n) { const f32x4 t1 = acc[ai][0][m][n] * rs, t2 = acc[ai][1][m][n] * rs; const f32x4 iv = n ? iv1 : iv0;
#pragma unroll
                        for (int e = 0; e < 4; ++e) { const float ang = posf * iv[e];
                            const float kr_ = __builtin_rintf(ang * 1.591549367e-01f); const float fr_ = __builtin_fmaf(ang, 6.420638327e-09f, __builtin_fmaf(ang, 1.591549367e-01f, -kr_));
                            const float c = __builtin_amdgcn_cosf(fr_), sn = __builtin_amdgcn_sinf(fr_);
                            o1[n][e] = t1[e] * c - t2[e] * sn; o2[n][e] = t1[e] * sn + t2[e] * c; } }
                    const unsigned rowo = (unsigned)(row * 1024 + head * 256 + i0) * 2u;
                    st16(rs_, rowo, pack8f(o1[0], o1[1])); st16(rs_, rowo + HALF * 2, pack8f(o2[0], o2[1]));
                    if (m & 1) asm volatile("" ::: "memory"); }
        } else {
            const int cb = (u.pn - 8) * BM + wc * 32 + 8 * fq; const __amdgpu_buffer_rsrc_t rs_ = epi_rsrc(V, 16384u * 4096u);
#pragma unroll
            for (int ai = 0; ai < 2; ++ai)
#pragma unroll
                for (int m = 0; m < 4; ++m) { const int rl = ai * HALF + wr * 64 + m * 16 + fr; const float rs = tab[ui * 256 + rl];
                    const unsigned rowo = (unsigned)((u.pm * BM + rl) * 2048 + cb) * 2u;
#pragma unroll
                    for (int bj = 0; bj < 2; ++bj) st16(rs_, rowo + bj * HALF * 2, pack8f(acc[ai][bj][m][0] * rs, acc[ai][bj][m][1] * rs)); }
        }
    }
};
struct EpiGate {
    static constexpr int PROBE_ID = 5; static constexpr bool PERM = true, AFTER_DRAIN = false, ACC_INIT = false;
    bf16_t* Y; const PG8_LAS float* tab; const PG8_LAS f32x2* stab;
    __device__ __forceinline__ void operator()(const f32x4 (&acc)[2][2][4][2], const Unit& u, int ui, int wr, int wc, int fr, int fq) const {
        const int cb = u.pn * BM + wc * 32 + 8 * fq; const __amdgpu_buffer_rsrc_t rs_ = epi_rsrc(Y, 16384u * 4096u);
        u32x4 yq[8][2];
#define EG_OFF(gi, bj) ((unsigned)((u.pm * BM + ((gi) >> 2) * HALF + wr * 64 + ((gi) & 3) * 16 + fr) * 2048 + cb + (bj) * HALF) * 2u)
#define EG_LOAD(gi) do { yq[gi][0] = __builtin_amdgcn_raw_buffer_load_b128(rs_, EG_OFF(gi, 0), 0, 0); yq[gi][1] = __builtin_amdgcn_raw_buffer_load_b128(rs_, EG_OFF(gi, 1), 0, 0); } while (0)
        EG_LOAD(0); EG_LOAD(1); EG_LOAD(2);
#pragma unroll
        for (int gi = 0; gi < 8; ++gi) { const int ai = gi >> 2, m = gi & 3;
            if (gi + 3 < 8) EG_LOAD(gi + 3 < 8 ? gi + 3 : 7);
            const int rl = ai * HALF + wr * 64 + m * 16 + fr; const float rs = tab[ui * 256 + rl]; const f32x2 st = stab[ui * 256 + rl];
#pragma unroll
            for (int bj = 0; bj < 2; ++bj) { const u32x4 yv = yq[gi][bj]; f32x4 y0, y1;
                y0[0] = bf_lo(yv.x); y0[1] = bf_hi(yv.x); y0[2] = bf_lo(yv.y); y0[3] = bf_hi(yv.y); y1[0] = bf_lo(yv.z); y1[1] = bf_hi(yv.z); y1[2] = bf_lo(yv.w); y1[3] = bf_hi(yv.w);
                f32x4 g0 = acc[ai][bj][m][0], g1 = acc[ai][bj][m][1]; const float c1 = -1.4426950408889634f * rs, c2 = rs * st.y;
#pragma unroll
                for (int e = 0; e < 4; ++e) { g0[e] = (g0[e] * (y0[e] - st.x)) * __builtin_amdgcn_rcpf(1.0f + __builtin_amdgcn_exp2f(g0[e] * c1)) * c2;
                    g1[e] = (g1[e] * (y1[e] - st.x)) * __builtin_amdgcn_rcpf(1.0f + __builtin_amdgcn_exp2f(g1[e] * c1)) * c2; }
                st16(rs_, EG_OFF(gi, bj), pack8f(g0, g1)); } }
#undef EG_LOAD
#undef EG_OFF
    }
};
struct EpiNull {
    static constexpr int PROBE_ID = 6; static constexpr bool PERM = true, AFTER_DRAIN = false, ACC_INIT = false;
    int dummy;
    __device__ __forceinline__ void operator()(const f32x4 (&acc)[2][2][4][2], const Unit& u, int ui, int wr, int wc, int fr, int fq) const {
#pragma unroll
        for (int ai = 0; ai < 2; ++ai)
#pragma unroll
            for (int bj = 0; bj < 2; ++bj)
#pragma unroll
                for (int m = 0; m < 4; ++m) { asm volatile("" :: "v"(acc[ai][bj][m][0]), "v"(acc[ai][bj][m][1])); }
    }
};
template <class Epi, class Sched, bool ALIGN_EPI = false, bool SP2 = false>
__device__ __forceinline__ void gemm_phase(PG8_LAS unsigned char* lds, const Gemm g, const Sched& S, const Epi& E, int wave_in) {
    int tid_ = wave_in * 64 + hw_lane_id(); asm volatile("" : "+v"(tid_));
    const int tid = tid_, wid = __builtin_amdgcn_readfirstlane(tid >> 6), lane = tid & 63, wr = wid >> 2, wc = wid & 3, fr = lane & 15, fq = lane >> 4;
    const int K = g.K, nt = K / BK;
    unsigned voffA[2], voffB[2];
#pragma unroll
    for (int i = 0; i < 2; ++i) { int R, C; stage_rc(tid * 16 + i * 8192, R, C); const int Rb = Epi::PERM ? ((R & ~31) + perm32(R & 31)) : R;
        voffA[i] = (unsigned)(R * K + C) * 2u; voffB[i] = (unsigned)(Rb * K + C) * 2u; }
    const size_t kstep = (size_t)(BK * 2);
    const size_t hstep = (size_t)HALF * K * 2;
    const size_t tstep = 2 * hstep;
    const unsigned ldsw = (unsigned)wid * 1024u;
    const int aoff = lds_byte(wr * 64 + fr, fq * 8), boff = lds_byte(wc * 32 + fr, fq * 8);
#define PG8_SA(b, h) (((b) * 2 + (h)) * HTB)
#define PG8_SB(b, h) ((4 + (b) * 2 + (h)) * HTB)
#define PG8_STAGE(bufoff, gbase, voff) do { _Pragma("unroll") for (int _i = 0; _i < 2; ++_i) \
        __builtin_amdgcn_global_load_lds((const unsigned*)((const char*)(gbase) + (voff)[_i]), (PG8_LAS unsigned*)(lds + (bufoff) + ldsw + _i * 8192), 16, 0, 0); } while (0)
#define PG8_LDA(dst, b, h) do { _Pragma("unroll") for (int m = 0; m < 4; ++m) _Pragma("unroll") for (int k = 0; k < 2; ++k) dst[m][k] = *(const PG8_LAS bf16x8*)(lds + PG8_SA(b, h) + aoff + m * 2048 + k * 1024); } while (0)
#define PG8_LDB(dst, b, h) do { _Pragma("unroll") for (int n = 0; n < 2; ++n) _Pragma("unroll") for (int k = 0; k < 2; ++k) dst[n][k] = *(const PG8_LAS bf16x8*)(lds + PG8_SB(b, h) + boff + n * 2048 + k * 1024); } while (0)
#define PG8_MMA(ai, bj, At, Bt) do { __builtin_amdgcn_s_setprio(1); _Pragma("unroll") for (int m = 0; m < 4; ++m) _Pragma("unroll") for (int n = 0; n < 2; ++n) _Pragma("unroll") for (int k = 0; k < 2; ++k) \
        acc[ai][bj][m][n] = __builtin_amdgcn_mfma_f32_16x16x32_bf16(Bt[n][k], At[m][k], acc[ai][bj][m][n], 0, 0, 0); __builtin_amdgcn_s_setprio(0); } while (0)
#define PG8_WAIT_V(n) asm volatile("s_waitcnt vmcnt(" #n ")" ::: "memory")
#define PG8_WAIT_L(n) asm volatile("s_waitcnt lgkmcnt(" #n ")" ::: "memory")
#define PG8_BAR __builtin_amdgcn_s_barrier()
#define PG8_SCHED __builtin_amdgcn_sched_barrier(0)
#ifdef GE_TPROBE
    unsigned tqg_ = 0; if (tid == 0) tqg_ = (unsigned)__builtin_amdgcn_s_memrealtime();
#define GE_MARK(k) if (Epi::PROBE_ID == GE_TPROBE_ID && tid == 0) { if (GE_TPROBE == (k)) { *(PG8_LAS unsigned*)(lds + 131480) += (unsigned)__builtin_amdgcn_s_memrealtime() - tqg_; tqg_ = (unsigned)__builtin_amdgcn_s_memrealtime(); } else tqg_ = (unsigned)__builtin_amdgcn_s_memrealtime(); }
#else
#define GE_MARK(k)
#endif
    Unit cur, nxt; int ui = 0;
    if (!S.next(0, cur)) return;
    f32x4 acc[2][2][4][2];
    u32x4 raw[2][2][4];
    if constexpr (Epi::ACC_INIT) E.init_issue(raw, cur, wr, wc, fr, fq);
    bf16x8 At[4][2], B0[2][2], B1[2][2];
    const char* cA = (const char*)g.A + (size_t)cur.pm * tstep; const char* cB = (const char*)g.Bt + (size_t)cur.pn * tstep;
    S.a_ready(cur);
    if constexpr (SP2) {
        PG8_STAGE(PG8_SB(0, 0), cB, voffB); PG8_STAGE(PG8_SB(0, 1), cB + hstep, voffB); PG8_STAGE(PG8_SA(0, 0), cA, voffA); PG8_STAGE(PG8_SA(0, 1), cA + hstep, voffA);
        if (wr == 1) PG8_BAR;
        PG8_WAIT_V(2); PG8_BAR;
        PG8_STAGE(PG8_SB(1, 0), cB + kstep, voffB); PG8_STAGE(PG8_SA(1, 0), cA + kstep, voffA); PG8_STAGE(PG8_SB(1, 1), cB + hstep + kstep, voffB);
        PG8_WAIT_V(6); PG8_BAR;
    } else {
        PG8_STAGE(PG8_SB(0, 0), cB, voffB); PG8_STAGE(PG8_SA(0, 0), cA, voffA); PG8_STAGE(PG8_SB(0, 1), cB + hstep, voffB); PG8_STAGE(PG8_SA(0, 1), cA + hstep, voffA);
        if (wr == 1) PG8_BAR;
        PG8_WAIT_V(4); PG8_BAR;
        PG8_STAGE(PG8_SB(1, 0), cB + kstep, voffB); PG8_STAGE(PG8_SA(1, 0), cA + kstep, voffA); PG8_STAGE(PG8_SB(1, 1), cB + hstep + kstep, voffB);
        PG8_WAIT_V(6); PG8_BAR;
    }
    GE_MARK(10)
    if constexpr (Epi::ACC_INIT) E.init_finish(acc, raw);
    else {
#pragma unroll
        for (int a = 0; a < 2; ++a)
#pragma unroll
            for (int b = 0; b < 2; ++b)
#pragma unroll
                for (int m = 0; m < 4; ++m)
#pragma unroll
                    for (int n = 0; n < 2; ++n) acc[a][b][m][n] = (f32x4){0.f, 0.f, 0.f, 0.f};
    }
    for (;;) {
        const bool has_next = S.next(ui + 1, nxt);
        const char* nA = has_next ? (const char*)g.A + (size_t)nxt.pm * tstep : cA; const char* nB = has_next ? (const char*)g.Bt + (size_t)nxt.pn * tstep : cB;
        for (int t = 0; t < nt; t += 2) {
            const bool last = (t == nt - 2);
            const char* a1 = cA + (size_t)(t + 1) * kstep;
            const char* a2 = last ? nA : cA + (size_t)(t + 2) * kstep; const char* b2 = last ? nB : cB + (size_t)(t + 2) * kstep;
            const char* a3 = a2 + kstep; const char* b3 = b2 + kstep;
            if (last && has_next) S.a_ready(nxt);
            if constexpr (SP2) {
            PG8_LDB(B0, 0, 0); PG8_LDB(B1, 0, 1); PG8_SCHED; PG8_LDA(At, 0, 0); PG8_STAGE(PG8_SA(1, 1), a1 + hstep, voffA);
            PG8_WAIT_V(8); PG8_WAIT_L(0); PG8_BAR; PG8_MMA(0, 0, At, B0); PG8_MMA(0, 1, At, B1); PG8_BAR; PG8_SCHED;
            PG8_LDA(At, 0, 1); PG8_STAGE(PG8_SB(0, 0), b2, voffB); PG8_STAGE(PG8_SB(0, 1), b2 + hstep, voffB); PG8_STAGE(PG8_SA(0, 0), a2, voffA);
            PG8_WAIT_V(8); PG8_WAIT_L(0); PG8_BAR; PG8_MMA(1, 0, At, B0); PG8_MMA(1, 1, At, B1); PG8_BAR; PG8_SCHED;
            PG8_LDB(B0, 1, 0); PG8_LDB(B1, 1, 1); PG8_SCHED; PG8_LDA(At, 1, 0); PG8_STAGE(PG8_SA(0, 1), a2 + hstep, voffA);
            PG8_WAIT_V(8); PG8_WAIT_L(0); PG8_BAR; PG8_MMA(0, 0, At, B0); PG8_MMA(0, 1, At, B1); PG8_BAR; PG8_SCHED;
            PG8_LDA(At, 1, 1); PG8_STAGE(PG8_SB(1, 0), b3, voffB); PG8_STAGE(PG8_SB(1, 1), b3 + hstep, voffB); PG8_STAGE(PG8_SA(1, 0), a3, voffA);
            PG8_WAIT_V(8); PG8_WAIT_L(0); PG8_BAR; PG8_MMA(1, 0, At, B0); PG8_MMA(1, 1, At, B1); PG8_BAR; PG8_SCHED;
            } else {
            PG8_LDB(B0, 0, 0); PG8_SCHED; PG8_LDA(At, 0, 0); PG8_STAGE(PG8_SA(1, 1), a1 + hstep, voffA);
            PG8_WAIT_L(8); PG8_BAR; PG8_WAIT_L(0); PG8_MMA(0, 0, At, B0); PG8_BAR; PG8_SCHED;
            PG8_LDB(B1, 0, 1); PG8_STAGE(PG8_SB(0, 0), b2, voffB);
            PG8_BAR; PG8_WAIT_L(0); PG8_MMA(0, 1, At, B1); PG8_BAR;
            PG8_LDA(At, 0, 1); PG8_STAGE(PG8_SA(0, 0), a2, voffA);
            PG8_BAR; PG8_WAIT_L(0); PG8_MMA(1, 0, At, B0); PG8_BAR; PG8_SCHED;
            PG8_STAGE(PG8_SB(0, 1), b2 + hstep, voffB);
            PG8_WAIT_V(6); PG8_BAR; PG8_MMA(1, 1, At, B1); PG8_BAR;
            PG8_LDB(B0, 1, 0); PG8_SCHED; PG8_LDA(At, 1, 0); PG8_STAGE(PG8_SA(0, 1), a2 + hstep, voffA);
            PG8_WAIT_L(8); PG8_BAR; PG8_WAIT_L(0); PG8_MMA(0, 0, At, B0); PG8_BAR; PG8_SCHED;
            PG8_LDB(B1, 1, 1); PG8_STAGE(PG8_SB(1, 0), b3, voffB);
            PG8_BAR; PG8_WAIT_L(0); PG8_MMA(0, 1, At, B1); PG8_BAR;
            PG8_LDA(At, 1, 1); PG8_STAGE(PG8_SA(1, 0), a3, voffA);
            PG8_BAR; PG8_WAIT_L(0); PG8_MMA(1, 0, At, B0); PG8_BAR; PG8_SCHED;
            PG8_STAGE(PG8_SB(1, 1), b3 + hstep, voffB);
            PG8_WAIT_V(6); PG8_BAR; PG8_MMA(1, 1, At, B1); PG8_BAR;
            }
        }
        GE_MARK(11)
        if constexpr (ALIGN_EPI) { if (wr == 0) PG8_BAR; }
#ifdef GE_TPROBE
        unsigned tqe_ = 0; if (Epi::PROBE_ID == GE_TPROBE_ID && ui == GE_TPROBE && tid == 0) tqe_ = (unsigned)__builtin_amdgcn_s_memrealtime();
#endif
        if constexpr (!Epi::AFTER_DRAIN) { E(acc, cur, ui, wr, wc, fr, fq); S.done(cur); }
#ifdef GE_TPROBE
        if (Epi::PROBE_ID == GE_TPROBE_ID && ui == GE_TPROBE && tid == 0) { asm volatile("s_waitcnt vmcnt(0)" ::: "memory"); *(PG8_LAS unsigned*)(lds + 131480) += (unsigned)__builtin_amdgcn_s_memrealtime() - tqe_; }
#endif
        if (!has_next) break;
        cur = nxt; cA = nA; cB = nB; ++ui;
        if constexpr (Epi::ACC_INIT) { E.init_issue(raw, cur, wr, wc, fr, fq); E.init_finish(acc, raw); }
        else {
#pragma unroll
            for (int a = 0; a < 2; ++a)
#pragma unroll
                for (int b = 0; b < 2; ++b)
#pragma unroll
                    for (int m = 0; m < 4; ++m)
#pragma unroll
                        for (int n = 0; n < 2; ++n) acc[a][b][m][n] = (f32x4){0.f, 0.f, 0.f, 0.f};
        }
        if constexpr (ALIGN_EPI) { if (wr == 1) PG8_BAR; }
    }
    PG8_WAIT_V(0);
    if constexpr (!ALIGN_EPI) { if (wr == 0) PG8_BAR; }
    PG8_BAR;
    GE_MARK(12)
    if constexpr (Epi::AFTER_DRAIN) { E.fused(acc, cur, wr, wc, fr, fq, lds, wid, lane); S.done(cur); }
#undef PG8_SA
#undef PG8_SB
#undef PG8_STAGE
#undef PG8_LDA
#undef PG8_LDB
#undef PG8_MMA
#undef PG8_WAIT_V
#undef PG8_WAIT_L
#undef PG8_BAR
#undef PG8_SCHED
}
}
constexpr int NWAVES = 8;
constexpr int BATCH = 2, SEQ = 8192, D = 1024, M = BATCH * SEQ;
constexpr int FH = 8, FDH = 128;
constexpr int RH = 4, RDK = 256, RDV = 512, CH = 64, NCH = SEQ / CH;
constexpr int DFF = 2816;
constexpr float EPS = 1e-6f;
constexpr float LOG2E = 1.4426950408889634f;
constexpr float QSCALE = 0.08838834764831845f * LOG2E;
#ifndef FUSE_FINAL
#define FUSE_FINAL 0
#endif
constexpr int NPHASE = FUSE_FINAL ? 14 : 15;
constexpr int CW_FIN = 2560;

constexpr size_t MiB = 1u << 20;
constexpr size_t WS_CTL = 0, CTL_ZERO_BYTES = 32768;
constexpr size_t WS_SSQ = 1 * MiB;
constexpr size_t WS_LC = 2 * MiB;
constexpr size_t WS_TT = 2 * MiB + 512 * 1024;
constexpr size_t WS_NRM = 2 * MiB + 512 * 1024 + 16384;
constexpr size_t WS_ROPE = 3 * MiB;
constexpr size_t WS_WQKV0 = 11 * MiB;
constexpr size_t WS_WO0 = 17 * MiB;
constexpr size_t WS_WFI0 = 19 * MiB;
constexpr size_t WS_WFO0 = 30 * MiB;
constexpr size_t WS_WRI = 36 * MiB;
constexpr size_t WS_WRO = 48 * MiB;
constexpr size_t WS_WFI1 = 52 * MiB;
constexpr size_t WS_WFO1 = 63 * MiB;
constexpr size_t WS_XB = 69 * MiB;
constexpr size_t WS_ACT = 101 * MiB;
constexpr size_t WS_Q0 = WS_ACT, WS_K0 = WS_ACT + 32 * MiB, WS_V0 = WS_ACT + 64 * MiB;
constexpr size_t WS_O0 = WS_ACT + 96 * MiB;
constexpr size_t WS_HID = WS_ACT;
constexpr size_t WS_Q1 = WS_ACT, WS_K1 = WS_ACT + 32 * MiB, WS_V1 = WS_ACT + 64 * MiB;
constexpr size_t WS_PST = WS_ACT + 128 * MiB;
constexpr size_t WS_CBG = WS_PST;
constexpr size_t WS_LBUF = WS_WQKV0;
constexpr size_t WS_END = WS_PST + 8 * MiB;
static_assert(WS_WFO1 + (size_t)1024 * 2816 * 2 <= WS_XB && WS_HID + (size_t)M * DFF * 2 <= WS_PST && WS_END <= 256 * MiB, "d_ws map");
constexpr int CW_TMO = 0, CW_CODE = 1;
constexpr int CW_BAR = 4096;
constexpr int CW_ATT = 2048;

constexpr int RING_OFF = 0, RING_BYTES = 131072;
constexpr int LDSCTL_OFF = RING_BYTES, MISC_OFF = LDSCTL_OFF + 320;
constexpr int TAB_OFF = RING_BYTES + 512;
constexpr int STAB_OFF = TAB_OFF + 8192;
constexpr int LDS_BYTES = 147456;
static_assert(STAB_OFF + 4096 <= LDS_BYTES, "LDS map");
#define GAS __attribute__((address_space(1)))
#define LAS __attribute__((address_space(3)))
typedef unsigned short bf16;
typedef unsigned v4u __attribute__((ext_vector_type(4)));
typedef float f32x4 __attribute__((ext_vector_type(4)));
typedef short bf16x8 __attribute__((ext_vector_type(8)));
typedef GAS unsigned gu32;
typedef GAS unsigned long long gu64;
#define RLX_AGENT __ATOMIC_RELAXED, __HIP_MEMORY_SCOPE_AGENT
#define LDS_WAIT() asm volatile("s_waitcnt lgkmcnt(0)" ::: "memory")
#define VM_WAIT() asm volatile("s_waitcnt vmcnt(0)" ::: "memory")
__device__ __forceinline__ unsigned long long rt() { return __builtin_amdgcn_s_memrealtime(); }
__device__ __forceinline__ unsigned f2bf(float f) { unsigned u = __builtin_bit_cast(unsigned, f); return (u + 0x7fffu + ((u >> 16) & 1u)) >> 16; }
__device__ __forceinline__ unsigned pk2(float lo, float hi) { return f2bf(lo) | (f2bf(hi) << 16); }
typedef float f32x2 __attribute__((ext_vector_type(2)));
#define XB_TMO      128
#define XB_XCNT(j)  (256  + 64 * (j))
#define XB_XSUB(j)  (1280 + 64 * (j))
#define XB_XGEN(j)  (2304 + 64 * (j))
#define XB_TOP      3328
#define XB_TOPGEN   3392
#define XCD_BAR_WORDS 3456
#define XB_SPIN_CAP (1u << 18)

__device__ __forceinline__ unsigned xb_ld(unsigned* p)              { return __hip_atomic_load(p, __ATOMIC_RELAXED, __HIP_MEMORY_SCOPE_AGENT); }
__device__ __forceinline__ unsigned xb_add(unsigned* p, unsigned v) { return __hip_atomic_fetch_add(p, v, __ATOMIC_RELAXED, __HIP_MEMORY_SCOPE_AGENT); }
__device__ __forceinline__ unsigned xb_xcc_id() { return (unsigned)__builtin_amdgcn_s_getreg((3 << 11) | 20) & 0xFu; }
#define XB_SPIN(cond, bar) do { unsigned _sp = 0; while (cond) { __builtin_amdgcn_s_sleep(1); \
    if ((++_sp & 255u) == 0u) { if (xb_ld(&(bar)[XB_TMO])) break; if (_sp > XB_SPIN_CAP) { atomicAdd(&(bar)[XB_TMO], 1u); break; } } } } while (0)

struct XcdBarrier {
    unsigned* bar; unsigned x;
    volatile LAS unsigned* st;
};

__device__ __forceinline__ XcdBarrier xcd_barrier_post(unsigned* bar, volatile LAS unsigned* st) {
    XcdBarrier b; b.bar = bar; b.x = xb_xcc_id(); b.st = st;
    if (threadIdx.x == 0) (void)xb_add(&bar[XB_XCNT(b.x)], 1u);
    return b;
}
__device__ __forceinline__ void xcd_barrier_complete(unsigned* bar, unsigned x, unsigned& nloc, unsigned& nx) {
    const unsigned G = gridDim.x * gridDim.y * gridDim.z;
    unsigned sum, cnt, mine, sp = 0u;
    for (;;) {
        sum = 0u; cnt = 0u; mine = 0u;
#pragma unroll
        for (unsigned j = 0; j < 16; ++j) { const unsigned c = xb_ld(&bar[XB_XCNT(j)]); sum += c; cnt += (c > 0u) ? 1u : 0u; mine = (j == x) ? c : mine; }
        if (sum == G) break;
        __builtin_amdgcn_s_sleep(1);
        if ((++sp & 255u) == 0u) { if (xb_ld(&bar[XB_TMO])) break; if (sp > XB_SPIN_CAP) { atomicAdd(&bar[XB_TMO], 1u); break; } }
    }
    nloc = mine > 0u ? mine : 1u; nx = cnt > 0u ? cnt : 1u;
}

__device__ __forceinline__ void xcd_barrier(const XcdBarrier& b) {
    asm volatile("s_waitcnt vmcnt(0)" ::: "memory");
    __syncthreads();
    if (threadIdx.x == 0) {
        unsigned* bar = b.bar;
        __builtin_amdgcn_s_waitcnt(0);
        unsigned nloc = b.st[0], nx = b.st[1];
        if (nloc == 0u) { xcd_barrier_complete(bar, b.x, nloc, nx); b.st[0] = nloc; b.st[1] = nx; }
        const unsigned old = xb_add(&bar[XB_XSUB(b.x)], 1u);
        const unsigned gen = old / nloc;
        if (old + 1u == (gen + 1u) * nloc) {
            __builtin_amdgcn_fence(__ATOMIC_RELEASE, "agent");
            asm volatile("s_waitcnt vmcnt(0)" ::: "memory");
            const unsigned og = xb_add(&bar[XB_TOP], 1u);
            const unsigned tg = og / nx;
            if (og + 1u == (tg + 1u) * nx) xb_add(&bar[XB_TOPGEN], 1u);
            else XB_SPIN(xb_ld(&bar[XB_TOPGEN]) == tg, bar);
            __builtin_amdgcn_fence(__ATOMIC_ACQUIRE, "agent");
            xb_add(&bar[XB_XGEN(b.x)], 1u);
            asm volatile("s_waitcnt vmcnt(0)" ::: "memory");
        } else {
            XB_SPIN(xb_ld(&bar[XB_XGEN(b.x)]) == gen, bar);
            __builtin_amdgcn_fence(__ATOMIC_ACQUIRE, "agent");
            asm volatile("s_waitcnt vmcnt(0)" ::: "memory");
        }
    }
    __syncthreads();
}
namespace fa {
constexpr int D = 128, LDQ = 1024;
constexpr float THR = 8.f;
constexpr bool WSKIP = false;
constexpr int NW = 8, QBLK = 32, KVBLK = 64, QB = NW * QBLK;
constexpr int SHM_V = KVBLK * D * 2, SHM_K = KVBLK * D * 2;
constexpr int LDS_BYTES = 131072;
using bf16 = unsigned short;
typedef short bf16x8 __attribute__((ext_vector_type(8)));
typedef short s16x4 __attribute__((ext_vector_type(4)));
typedef float f32x16 __attribute__((ext_vector_type(16)));
typedef float f32x4 __attribute__((ext_vector_type(4)));
typedef unsigned u32x4 __attribute__((ext_vector_type(4)));
#define KSWZ(row, colB) ((row) * 256 + ((colB) ^ (((row) & 7) << 4)))
#define SBAR() __builtin_amdgcn_sched_barrier(0)
__device__ __forceinline__ int v_st(int k, int c) { const int kk = (k & ~0xC) | ((k & 4) << 1) | ((k & 8) >> 1); return ((kk >> 3) * 4 + (c >> 5)) * 512 + ((kk & 7) * 32 + (c & 31)) * 2; }
__device__ __forceinline__ int v_rd_base(int lane) { return ((lane & 3) << 3) | (((lane >> 2) & 3) << 6) | (((lane >> 4) & 1) << 5) | (((lane >> 5) & 1) << 8); }
constexpr int v_rd_off(int d0, int ks, int half) { return d0 * 512 + ks * 4096 + half * 2048; }
__device__ __forceinline__ int crow(int r, int hi) { return (r & 3) + 8 * (r >> 2) + 4 * hi; }
__device__ __forceinline__ unsigned cvtpk(float lo, float hi) {
    unsigned r; asm volatile("v_cvt_pk_bf16_f32 %0, %1, %2" : "=v"(r) : "v"(lo), "v"(hi)); return r;
}
__device__ __forceinline__ bf16x8 pack8(f32x4 a, f32x4 b) {
    u32x4 w = {cvtpk(a[0], a[1]), cvtpk(a[2], a[3]), cvtpk(b[0], b[1]), cvtpk(b[2], b[3])};
    return *reinterpret_cast<bf16x8*>(&w);
}
__device__ __forceinline__ bf16x8 load8(const bf16* p) { return *reinterpret_cast<const bf16x8*>(p); }
__device__ __forceinline__ void mask_tile(f32x16& p0, f32x16& p1, int dq, unsigned W) {
    const float NEG = -__builtin_inff();
#pragma unroll
    for (int r = 0; r < 16; ++r) {
        const int c = (r & 3) + 8 * (r >> 2);
        if ((unsigned)(dq - c) >= W) p0[r] = NEG;
        if ((unsigned)(dq - c - 32) >= W) p1[r] = NEG;
    }
}
__device__ __forceinline__ void partialSM(f32x16& p0, f32x16& p1, float& m_reg, float& mn, float& alpha) {
    float pmax = p0[0]; for (int r = 1; r < 16; ++r) pmax = fmaxf(pmax, p0[r]); for (int r = 0; r < 16; ++r) pmax = fmaxf(pmax, p1[r]);
    { auto rr = __builtin_amdgcn_permlane32_swap(__float_as_uint(pmax), __float_as_uint(pmax), false, false);
      pmax = fmaxf(__uint_as_float(rr[0]), __uint_as_float(rr[1])); }
    if (__builtin_expect(__all((pmax - m_reg) <= THR), 1)) { mn = m_reg; alpha = 1.f; }
    else { mn = fmaxf(m_reg, pmax); alpha = __builtin_amdgcn_exp2f(m_reg - mn); m_reg = mn; }
    for (int r = 0; r < 16; ++r) p0[r] = p0[r] - mn; for (int r = 0; r < 16; ++r) p1[r] = p1[r] - mn;
    for (int r = 0; r < 16; ++r) p0[r] = __builtin_amdgcn_exp2f(p0[r]);
}
__device__ __forceinline__ void finishSM(f32x16& p0, f32x16& p1, float alpha, float& l_reg, bf16x8& pa0, bf16x8& pa1, bf16x8& pa2, bf16x8& pa3) {
    for (int r = 0; r < 16; ++r) p1[r] = __builtin_amdgcn_exp2f(p1[r]);
    float ps = 0; for (int r = 0; r < 16; ++r) ps += p0[r]; for (int r = 0; r < 16; ++r) ps += p1[r];
    { auto rr = __builtin_amdgcn_permlane32_swap(__float_as_uint(ps), __float_as_uint(ps), false, false);
      ps = __uint_as_float(rr[0]) + __uint_as_float(rr[1]); }
    l_reg = l_reg * alpha + ps;
#define PK4(P, B_, OUT) do { unsigned a0 = cvtpk(P[B_+0], P[B_+1]), a1 = cvtpk(P[B_+2], P[B_+3]);                          \
        unsigned b0 = cvtpk(P[B_+4], P[B_+5]), b1 = cvtpk(P[B_+6], P[B_+7]);                                             \
        auto r0 = __builtin_amdgcn_permlane32_swap(a0, b0, false, false); auto r1 = __builtin_amdgcn_permlane32_swap(a1, b1, false, false); \
        u32x4 w = {r0[0], r1[0], r0[1], r1[1]}; OUT = *reinterpret_cast<bf16x8*>(&w); } while (0)
    PK4(p0, 0, pa0); PK4(p0, 8, pa1); PK4(p1, 0, pa2); PK4(p1, 8, pa3);
#undef PK4
}
__device__ __forceinline__ void qkt(f32x16& p0, f32x16& p1, const char* K_slot, int r32, int hi, const bf16x8* qr, const float* cbt) {
#pragma unroll
    for (int g = 0; g < 4; ++g) { const f32x4 a = *(const f32x4*)(cbt + 8 * g + 4 * hi), b = *(const f32x4*)(cbt + 32 + 8 * g + 4 * hi);
        p0[4 * g] = a[0]; p0[4 * g + 1] = a[1]; p0[4 * g + 2] = a[2]; p0[4 * g + 3] = a[3]; p1[4 * g] = b[0]; p1[4 * g + 1] = b[1]; p1[4 * g + 2] = b[2]; p1[4 * g + 3] = b[3]; }
    const char* kb[4];
#pragma unroll
    for (int dd = 0; dd < 4; ++dd) kb[dd] = K_slot + KSWZ(r32, (dd * 16 + hi * 8) * 2);
#pragma unroll
    for (int d0 = 0; d0 < 8; ++d0) { const char* a = kb[d0 & 3] + (d0 >> 2) * 128;
        bf16x8 b0 = *reinterpret_cast<const bf16x8*>(a);
        bf16x8 b1 = *reinterpret_cast<const bf16x8*>(a + 32 * 256);
        p0 = __builtin_amdgcn_mfma_f32_32x32x16_bf16(b0, qr[d0], p0, 0, 0, 0);
        p1 = __builtin_amdgcn_mfma_f32_32x32x16_bf16(b1, qr[d0], p1, 0, 0, 0); }
}
__device__ __forceinline__ void pv_tile(f32x16* o, int vbs, bf16x8 pa0, bf16x8 pa1, bf16x8 pa2, bf16x8 pa3) {
#define TRRD(dst, off) asm volatile("ds_read_b64_tr_b16 %0, %1 offset:%2" : "=&v"(dst) : "v"(vbs), "i"(off) : "memory")
#define PV_D0(d0) do { s16x4 l0, l1, l2, l3, h0, h1, h2, h3; constexpr int b_ = v_rd_off(d0, 0, 0);     \
        TRRD(l0, b_); TRRD(h0, b_ + 2048); TRRD(l1, b_ + 4096); TRRD(h1, b_ + 6144); TRRD(l2, b_ + 8192); TRRD(h2, b_ + 10240); TRRD(l3, b_ + 12288); TRRD(h3, b_ + 14336); \
        asm volatile("s_waitcnt lgkmcnt(0)" ::: "memory"); SBAR();                 \
        o[d0] = __builtin_amdgcn_mfma_f32_32x32x16_bf16(pa0, (bf16x8){l0[0], l0[1], l0[2], l0[3], h0[0], h0[1], h0[2], h0[3]}, o[d0], 0, 0, 0);   \
        o[d0] = __builtin_amdgcn_mfma_f32_32x32x16_bf16(pa1, (bf16x8){l1[0], l1[1], l1[2], l1[3], h1[0], h1[1], h1[2], h1[3]}, o[d0], 0, 0, 0);   \
        o[d0] = __builtin_amdgcn_mfma_f32_32x32x16_bf16(pa2, (bf16x8){l2[0], l2[1], l2[2], l2[3], h2[0], h2[1], h2[2], h2[3]}, o[d0], 0, 0, 0);   \
        o[d0] = __builtin_amdgcn_mfma_f32_32x32x16_bf16(pa3, (bf16x8){l3[0], l3[1], l3[2], l3[3], h3[0], h3[1], h3[2], h3[3]}, o[d0], 0, 0, 0); } while (0)
    PV_D0(0); PV_D0(1); PV_D0(2); PV_D0(3);
#undef PV_D0
#undef TRRD
}

#define FGAS __attribute__((address_space(1)))
struct BlockRef { FGAS char* base; unsigned qo, ko, vo, oo, cbo; int P0, kb0, khi, mode, slot0, pidx, nparts; float Bq; FGAS char* partA; FGAS char* partB; FGAS float* pml; FGAS unsigned* cnt; };
constexpr int PART_SLOTS_A = 1024;
__device__ __forceinline__ FGAS char* part_ptr(const BlockRef& c, int slot) { return slot < PART_SLOTS_A ? c.partA + (size_t)slot * 65536 : c.partB + (size_t)(slot - PART_SLOTS_A) * 65536; }
constexpr int LDS_VR = 0, LDS_KR = 3 * SHM_V, LDS_CBR = 3 * SHM_V + 3 * SHM_K, LDS_WSR = 131584;
__device__ __forceinline__ void glds16(const FGAS char* gsrc, unsigned lds_dst) {
    unsigned keep; asm volatile("s_mov_b32 %0, m0\n\ts_mov_b32 m0, %2\n\ts_nop 0\n\tglobal_load_lds_dwordx4 %1, off\n\ts_mov_b32 m0, %0" : "=&s"(keep) : "v"(gsrc), "s"(lds_dst) : "memory");
}
typedef unsigned u32x2 __attribute__((ext_vector_type(2)));
__device__ __forceinline__ float qx1(float v) { return __builtin_bit_cast(float, __builtin_amdgcn_mov_dpp(__builtin_bit_cast(int, v), 0xB1, 0xF, 0xF, true)); }
__device__ __forceinline__ float qx2(float v) { return __builtin_bit_cast(float, __builtin_amdgcn_mov_dpp(__builtin_bit_cast(int, v), 0x4E, 0xF, 0xF, true)); }
#define WAIT_BAR(N) asm volatile("s_waitcnt vmcnt(" #N ") lgkmcnt(0)\n\ts_barrier" ::: "memory")
__device__ __forceinline__ void fa_block(const BlockRef& cur, char* lds, int tid_in) {
    int tid = tid_in; asm volatile("" : "+v"(tid));
    const int wid = __builtin_amdgcn_readfirstlane(tid >> 6), lane = tid & 63, r32 = lane & 31, hi = lane >> 5;
#ifndef FA_TPROBE
#define FA_TPROBE 0
#endif
#define FA_T0() if (FA_TPROBE && tid == 0) tpf_ = (unsigned)__builtin_amdgcn_s_memrealtime();
#define FA_T1(k) if (FA_TPROBE == (k) && tid == 0) *(unsigned*)(lds + 131480) += (unsigned)__builtin_amdgcn_s_memrealtime() - tpf_; FA_T0()
    unsigned tpf_ = 0; FA_T0()
    const int kb0 = cur.kb0, NT0 = (cur.khi - kb0) / KVBLK;
    const int NT = NT0;
    const int qlo = cur.P0 + wid * QBLK, qm = qlo + r32 - 4 * hi;
    float* CBA = (float*)(lds + LDS_CBR);
    float* ws = (float*)(lds + LDS_WSR) + wid * 64; float* li_l = ws, * al_l = ws + 32; float* mm_l = (float*)(lds + LDS_WSR + 2048);
    const unsigned lds0 = (unsigned)(uintptr_t)lds;
    for (int i = tid; i < (cur.khi - kb0) / 4; i += NW * 64) ((f32x4*)CBA)[i] = *(const FGAS f32x4*)(cur.base + cur.cbo + (unsigned)(kb0 * 4) + (unsigned)i * 16u);
    bf16x8 qr[8];
    { const unsigned qoff = (unsigned)(((wid * QBLK + r32) * LDQ + hi * 8) * 2);
#pragma unroll
      for (int d0 = 0; d0 < 8; ++d0) qr[d0] = *(const FGAS bf16x8*)(cur.base + cur.qo + qoff + d0 * 32); }
    asm volatile("s_waitcnt vmcnt(0)" ::: "memory");
    unsigned kso[2], vso[2];
#pragma unroll
    for (int i = 0; i < 2; ++i) { const int p = 2 * wid + i, row = 4 * p + (lane >> 4), c = (lane & 15) ^ (row & 7); kso[i] = (unsigned)(row * (LDQ * 2) + c * 16);
        const int sub = 2 * p + (lane >> 5), kk = 8 * (sub >> 2) + ((lane & 31) >> 2), k = (kk & ~0xC) | ((kk & 4) << 1) | ((kk & 8) >> 1), cc = 32 * (sub & 3) + 8 * (lane & 3); vso[i] = (unsigned)(k * (LDQ * 2) + cc * 2); }
    const FGAS char* Kt = cur.base + cur.ko + (size_t)kb0 * (LDQ * 2); const FGAS char* Vt = cur.base + cur.vo + (size_t)kb0 * (LDQ * 2);
#define DMA_K(t, slot) do { const FGAS char* g_ = Kt + (size_t)(NT0 - 1 - (t)) * (KVBLK * LDQ * 2); const unsigned d_ = (unsigned)__builtin_amdgcn_readfirstlane(lds0 + LDS_KR + (slot) + 2048 * wid); glds16(g_ + kso[0], d_); glds16(g_ + kso[1], d_ + 1024); } while (0)
#define DMA_V(t, slot) do { const FGAS char* g_ = Vt + (size_t)(NT0 - 1 - (t)) * (KVBLK * LDQ * 2); const unsigned d_ = (unsigned)__builtin_amdgcn_readfirstlane(lds0 + LDS_VR + (slot) + 2048 * wid); glds16(g_ + vso[0], d_); glds16(g_ + vso[1], d_ + 1024); } while (0)
    DMA_K(0, 0); DMA_V(0, 0); DMA_K(1, SHM_K);
    float m_reg = -1e30f, l_reg = 0; f32x16 o[4] = {};
    const int vb0 = (int)lds0 + LDS_VR + v_rd_base(lane);
#define RESC(a) do { if (__any((a) < 1.f)) { if (hi == 0) al_l[r32] = (a); asm volatile("s_waitcnt lgkmcnt(0)" ::: "memory");              \
                     for (int d_ = 0; d_ < 4; ++d_) for (int r = 0; r < 16; ++r) o[d_][r] *= al_l[crow(r, hi)]; } } while (0)
#define KBASE(t) (kb0 + (NT0 - 1 - (t)) * KVBLK)
#define MASKT(P0_, P1_, t) do { const int kb_ = KBASE(t); if (kb_ + KVBLK - 1 > qlo) mask_tile(P0_, P1_, qm - kb_, 0x40000000u); } while (0)
    f32x16 pA0, pA1, pB0, pB1; float mnA, mnB, alA, alB; bf16x8 pa0, pa1, pa2, pa3;
    int s_prev = 0, s_cur = 0, s_next = SHM_K;
#define ROT() do { s_prev = s_cur; s_cur = s_next; s_next = (s_next == 2 * SHM_K) ? 0 : s_next + SHM_K; } while (0)
    WAIT_BAR(4);
    FA_T1(1)
    DMA_K(2, 2 * SHM_K); DMA_V(1, SHM_V);
    SBAR(); qkt(pA0, pA1, lds + LDS_KR, r32, hi, qr, CBA + (NT0 - 1) * KVBLK);
    MASKT(pA0, pA1, 0); partialSM(pA0, pA1, m_reg, mnA, alA);
    WAIT_BAR(4);
    ROT();
#define STEP(PX0, PX1, mnX, alX, PY0, PY1, alY, t) do {                                                                       \
        { const int s_nn = (s_next == 2 * SHM_K) ? 0 : s_next + SHM_K;                  \
          if ((t) + 2 < NT) DMA_K((t) + 2, s_nn); if ((t) + 1 < NT) DMA_V((t) + 1, s_next); }                                  \
        SBAR(); qkt(PX0, PX1, lds + LDS_KR + s_cur, r32, hi, qr, CBA + (NT0 - 1 - (t)) * KVBLK);                                           \
        finishSM(PY0, PY1, alY, l_reg, pa0, pa1, pa2, pa3); SBAR();                                                           \
        pv_tile(o, vb0 + s_prev, pa0, pa1, pa2, pa3); MASKT(PX0, PX1, (t)); partialSM(PX0, PX1, m_reg, mnX, alX);             \
        RESC(alX);                                                                                                            \
        if ((t) + 2 < NT) WAIT_BAR(4); else if ((t) + 1 < NT) WAIT_BAR(2); else WAIT_BAR(0);                                   \
        ROT(); } while (0)
    int t = 1;
    for (; t + 1 < NT; t += 2) {
        STEP(pB0, pB1, mnB, alB, pA0, pA1, alA, t);
        STEP(pA0, pA1, mnA, alA, pB0, pB1, alB, t + 1);
    }
    if (t < NT) {
        STEP(pB0, pB1, mnB, alB, pA0, pA1, alA, t);
        finishSM(pB0, pB1, alB, l_reg, pa0, pa1, pa2, pa3); SBAR();
    } else {
        finishSM(pA0, pA1, alA, l_reg, pa0, pa1, pa2, pa3); SBAR();
    }
    pv_tile(o, vb0 + s_prev, pa0, pa1, pa2, pa3);
    FA_T1(2)
    if (FA_TPROBE == 4 && tid == 0) *(unsigned*)(lds + 131480) += (unsigned)NT0 * 100u;
    if (hi == 0) li_l[r32] = l_reg; asm volatile("s_waitcnt lgkmcnt(0)" ::: "memory");
#pragma unroll
    for (int r = 0; r < 16; ++r) { const float rl = __builtin_amdgcn_rcpf(li_l[crow(r, hi)]);
#pragma unroll
        for (int d0 = 0; d0 < 4; ++d0) o[d0][r] *= rl; }
    bool store_o = true;
    if (cur.mode == 1) {
        const int slot = cur.slot0 + cur.pidx;
        const __amdgpu_buffer_rsrc_t prs = __builtin_amdgcn_make_buffer_rsrc((void*)part_ptr(cur, slot), (short)0, 65536, 0x00020000);
        const __amdgpu_buffer_rsrc_t mrs = __builtin_amdgcn_make_buffer_rsrc((void*)(cur.pml + (size_t)slot * 512), (short)0, 2048, 0x00020000);
        const unsigned pvo = (unsigned)(wid * 8192 + lane * 16);
#ifdef FA_STRESS
        for (int z_ = 0; z_ < ((wid * 37 + (int)blockIdx.x * 11) & 63); ++z_) __builtin_amdgcn_s_sleep(20);
#endif
#pragma unroll
        for (int q = 0; q < 8; ++q) { u32x4 w;
            w.x = cvtpk(o[q >> 1][8 * (q & 1)], o[q >> 1][8 * (q & 1) + 1]); w.y = cvtpk(o[q >> 1][8 * (q & 1) + 2], o[q >> 1][8 * (q & 1) + 3]);
            w.z = cvtpk(o[q >> 1][8 * (q & 1) + 4], o[q >> 1][8 * (q & 1) + 5]); w.w = cvtpk(o[q >> 1][8 * (q & 1) + 6], o[q >> 1][8 * (q & 1) + 7]);
            __builtin_amdgcn_raw_buffer_store_b128(w, prs, pvo + q * 1024, 0, 16); }
        typedef float f32x2 __attribute__((ext_vector_type(2)));
        if (hi == 0) { u32x2 ml; ml.x = __builtin_bit_cast(unsigned, m_reg); ml.y = __builtin_bit_cast(unsigned, l_reg); __builtin_amdgcn_raw_buffer_store_b64(ml, mrs, (unsigned)((wid * QBLK + r32) * 8), 0, 16); }
        asm volatile("s_waitcnt vmcnt(0) lgkmcnt(0)\n\ts_barrier" ::: "memory");
        int* hf = (int*)(lds + LDS_WSR + 2048);
        if (tid == 0) { const unsigned old = __hip_atomic_fetch_add(cur.cnt, 1u, __ATOMIC_RELAXED, __HIP_MEMORY_SCOPE_AGENT); hf[0] = (int)old; }
        asm volatile("s_waitcnt vmcnt(0) lgkmcnt(0)\n\ts_barrier" ::: "memory");
        store_o = __builtin_amdgcn_readfirstlane(hf[0]) == cur.nparts - 1;
        if (store_o) {
            float Mr = 0.f, Lr = 0.f;
#ifdef MERGE_DELAY
            for (int z_ = 0; z_ < MERGE_DELAY; ++z_) __builtin_amdgcn_s_sleep(16);
#endif
            for (int q = 0; q < cur.nparts; ++q) {
                const int oslot = cur.slot0 + q;
                const __amdgpu_buffer_rsrc_t ors = __builtin_amdgcn_make_buffer_rsrc((void*)part_ptr(cur, oslot), (short)0, 65536, 0x00020000);
                const __amdgpu_buffer_rsrc_t oms = __builtin_amdgcn_make_buffer_rsrc((void*)(cur.pml + (size_t)oslot * 512), (short)0, 2048, 0x00020000);
                if (hi == 0) { const u32x2 mo_ = __builtin_amdgcn_raw_buffer_load_b64(oms, (unsigned)((wid * QBLK + r32) * 8), 0, 16); f32x2 mo; mo.x = __builtin_bit_cast(float, mo_.x); mo.y = __builtin_bit_cast(float, mo_.y);
                    if (q == 0) { li_l[r32] = 0.f; al_l[r32] = 1.f; Mr = mo.x; Lr = mo.y; }
                    else { const float M = fmaxf(Mr, mo.x), a = Lr * __builtin_amdgcn_exp2f(Mr - M), b = mo.y * __builtin_amdgcn_exp2f(mo.x - M), inv = 1.0f / (a + b);
                        li_l[r32] = a * inv; al_l[r32] = b * inv; Mr = M; Lr = a + b; } }
                u32x4 ov[8];
#pragma unroll
                for (int k = 0; k < 8; ++k) ov[k] = __builtin_amdgcn_raw_buffer_load_b128(ors, pvo + k * 1024, 0, 16);
                asm volatile("s_waitcnt lgkmcnt(0)" ::: "memory");
#pragma unroll
                for (int r = 0; r < 16; ++r) { const float ws_ = li_l[crow(r, hi)], wo_ = al_l[crow(r, hi)];
#pragma unroll
                    for (int d0 = 0; d0 < 4; ++d0) { const u32x4 w = ov[2 * d0 + (r >> 3)]; const unsigned wd = (r & 7) < 2 ? w.x : ((r & 7) < 4 ? w.y : ((r & 7) < 6 ? w.z : w.w));
                        const float other = (r & 1) ? __builtin_bit_cast(float, wd & 0xffff0000u) : __builtin_bit_cast(float, wd << 16);
                        o[d0][r] = ws_ * o[d0][r] + wo_ * other; } }
                asm volatile("s_waitcnt lgkmcnt(0)" ::: "memory");
            }
        }
    }
    if (store_o) {
        const bool l0 = (r32 & 1) != 0, l1 = (r32 & 2) != 0;
        FGAS char* ob = cur.base + cur.oo + (unsigned)(((wid * QBLK + (r32 & 3) + 4 * hi) * LDQ + 4 * (r32 >> 2)) * 2);
#pragma unroll
        for (int d0 = 0; d0 < 4; ++d0)
#pragma unroll
            for (int k = 0; k < 4; ++k) { float a0 = o[d0][4 * k], a1 = o[d0][4 * k + 1], a2 = o[d0][4 * k + 2], a3 = o[d0][4 * k + 3];
                { const float r = qx1(l0 ? a0 : a1); a0 = l0 ? r : a0; a1 = l0 ? a1 : r; }
                { const float r = qx1(l0 ? a2 : a3); a2 = l0 ? r : a2; a3 = l0 ? a3 : r; }
                { const float r = qx2(l1 ? a0 : a2); a0 = l1 ? r : a0; a2 = l1 ? a2 : r; }
                { const float r = qx2(l1 ? a1 : a3); a1 = l1 ? r : a1; a3 = l1 ? a3 : r; }
                u32x2 w; w.x = cvtpk(a0, a1); w.y = cvtpk(a2, a3);
                *(FGAS u32x2*)(ob + (unsigned)(8 * k * LDQ * 2 + d0 * 64)) = w; }
    }
    asm volatile("s_waitcnt lgkmcnt(0)\n\ts_barrier" ::: "memory");
    FA_T1(3)
#undef RESC
#undef KBASE
#undef MASKT
#undef STEP
#undef ROT
#undef DMA_K
#undef DMA_V
}
#undef WAIT_BAR
#undef FGAS
#undef SBAR
#undef KSWZ
}
namespace rtn {
#define RLAS __attribute__((address_space(3)))
#define RGAS __attribute__((address_space(1)))
typedef short bf16x8 __attribute__((ext_vector_type(8)));
typedef short v4i16_t __attribute__((ext_vector_type(4)));
typedef float f32x16 __attribute__((ext_vector_type(16)));
typedef float f32x4 __attribute__((ext_vector_type(4)));
typedef unsigned u32x4 __attribute__((ext_vector_type(4)));
typedef unsigned u32x2 __attribute__((ext_vector_type(2)));
constexpr int NG = 16, RG = 8;
constexpr int LQ = 0, LK = 32768, LV = 65536, LK2 = 98304, LS = 132096, LPW = 140288;
constexpr int LDS_BYTES = LPW + 1024;
__device__ __forceinline__ int crow(int r, int hi) { return (r & 3) + 8 * (r >> 2) + 4 * hi; }
__device__ __forceinline__ unsigned cvtpk(float lo, float hi) { unsigned r; asm volatile("v_cvt_pk_bf16_f32 %0, %1, %2" : "=v"(r) : "v"(lo), "v"(hi)); return r; }
__device__ __forceinline__ float bflo(unsigned w) { return __builtin_bit_cast(float, w << 16); }
__device__ __forceinline__ float bfhi(unsigned w) { return __builtin_bit_cast(float, w & 0xffff0000u); }
__device__ __forceinline__ int off512(int row, int ch) { return 512 * row + 16 * (ch ^ (((row & 3) << 2) | ((row >> 2) & 3))); }
__device__ __forceinline__ int offS(int row, int ch8) { return 128 * row + 16 * (ch8 ^ ((row >> 1) & 7)); }
__device__ __forceinline__ bf16x8 lds128(unsigned a) { return *(const RLAS bf16x8*)(uintptr_t)a; }
__device__ __forceinline__ v4i16_t ldstr(unsigned a) { return __builtin_amdgcn_ds_read_tr16_b64_v4i16((RLAS v4i16_t*)(uintptr_t)a); }
__device__ __forceinline__ void glds16(const RGAS char* gsrc, unsigned lds_dst) {
    unsigned keep; asm volatile("s_mov_b32 %0, m0\n\ts_mov_b32 m0, %2\n\ts_nop 0\n\tglobal_load_lds_dwordx4 %1, off\n\ts_mov_b32 m0, %0" : "=&s"(keep) : "v"(gsrc), "s"(lds_dst) : "memory");
}
__device__ __forceinline__ void stage_tile(const RGAS char* g, unsigned ld_bytes, unsigned lbase, int wave, int lane) {
#pragma unroll
    for (int i = 0; i < 4; ++i) { const int pid = wave * 4 + i, row = 2 * pid + (lane >> 5), ch = (lane & 31) ^ (((row & 3) << 2) | ((row >> 2) & 3));
        glds16(g + (unsigned)row * ld_bytes + (unsigned)ch * 16u, (unsigned)__builtin_amdgcn_readfirstlane(lbase + 1024u * (unsigned)pid)); }
}
#ifndef RT_TOUCH
#define RT_TOUCH 0
#endif
#ifndef RT_TPROBE
#define RT_TPROBE 0
#endif
constexpr int LDUMMY = 145408;
__device__ __forceinline__ float qx1(float v) { return __builtin_bit_cast(float, __builtin_amdgcn_mov_dpp(__builtin_bit_cast(int, v), 0xB1, 0xF, 0xF, true)); }
__device__ __forceinline__ float qx2(float v) { return __builtin_bit_cast(float, __builtin_amdgcn_mov_dpp(__builtin_bit_cast(int, v), 0x4E, 0xF, 0xF, true)); }
__device__ __forceinline__ void glds4(const RGAS char* gsrc, unsigned lds_dst) {
    unsigned keep; asm volatile("s_mov_b32 %0, m0\n\ts_mov_b32 m0, %2\n\ts_nop 0\n\tglobal_load_lds_dword %1, off\n\ts_mov_b32 m0, %0" : "=&s"(keep) : "v"(gsrc), "s"(lds_dst) : "memory");
}
__device__ __forceinline__ void touch_tile(const RGAS char* g, unsigned ld_bytes, unsigned lds0, int wave, int lane) {
    const unsigned line = (unsigned)((wave & 3) * 64 + lane);
    glds4(g + (line >> 2) * ld_bytes + (line & 3) * 128u, (unsigned)__builtin_amdgcn_readfirstlane(lds0 + LDUMMY + 256u * (unsigned)wave));
}
constexpr int LST = 141312;
__device__ __forceinline__ void pst_flush(RGAS float* PST, unsigned lds0, size_t tokm, int h, int half, int lane) {
    typedef float f32x2 __attribute__((ext_vector_type(2)));
    const RLAS f32x4* p = (const RLAS f32x4*)(uintptr_t)(lds0 + LST + (unsigned)(lane * 64));
    const f32x4 a = p[0], b = p[1], c = p[2], d = p[3];
    f32x2 st; st.x = ((a[0] + a[2]) + (b[0] + b[2])) + ((c[0] + c[2]) + (d[0] + d[2])); st.y = ((a[1] + a[3]) + (b[1] + b[3])) + ((c[1] + c[3]) + (d[1] + d[3]));
    *(RGAS f32x2*)(PST + (((tokm + (size_t)lane) * 4 + h) * 2 + half) * 2) = st;
}
struct Ptrs { const RGAS char* Q; const RGAS char* K; RGAS char* V; RGAS char* L; RGAS float* PST; };
__device__ __forceinline__ void load_vfrags(bf16x8 (&vf)[4], unsigned vb0, unsigned vb1) {
#pragma unroll
    for (int s = 0; s < 4; ++s) { const v4i16_t lo = ldstr(vb0 + 8192 * s), hi = ldstr(vb1 + 8192 * s + 2048); vf[s] = (bf16x8){lo[0], lo[1], lo[2], lo[3], hi[0], hi[1], hi[2], hi[3]}; }
}
__device__ __forceinline__ void update_state(f32x16 (&X)[8], const bf16x8 (&vf)[4], unsigned kt0, unsigned kt1, unsigned lds0, int hh, float scl) {
    const RLAS float* pwr = (const RLAS float*)(uintptr_t)(lds0 + LPW + 144 * 4);
    v4i16_t fa[3][2][2];
#define RT_LOADB(buf, b) do { _Pragma("unroll") for (int j = 0; j < 2; ++j) { const int dt_ = 2 * ((b) & 3) + j, s_ = (b) >> 2; \
        fa[buf][j][0] = ldstr((kt0 ^ (unsigned)(64 * dt_)) + 8192 * s_); fa[buf][j][1] = ldstr((kt1 ^ (unsigned)(64 * dt_)) + 8192 * s_ + 2048); } } while (0)
    RT_LOADB(0, 0); RT_LOADB(1, 1);
    bf16x8 vs;
#pragma unroll
    for (int b = 0; b < 16; ++b) {
        if (b + 2 < 16) RT_LOADB((b + 2) % 3, b + 2);
        if ((b & 3) == 0) { const int s = b >> 2; const f32x4 f0 = *(const RLAS f32x4*)(pwr + 16 * s + 8 * hh), f1 = *(const RLAS f32x4*)(pwr + 16 * s + 8 * hh + 4);
            const u32x4 w = __builtin_bit_cast(u32x4, vf[s]); u32x4 o;
            o.x = cvtpk(bflo(w.x) * f0[0] * scl, bfhi(w.x) * f0[1] * scl); o.y = cvtpk(bflo(w.y) * f0[2] * scl, bfhi(w.y) * f0[3] * scl);
            o.z = cvtpk(bflo(w.z) * f1[0] * scl, bfhi(w.z) * f1[1] * scl); o.w = cvtpk(bflo(w.w) * f1[2] * scl, bfhi(w.w) * f1[3] * scl);
            vs = __builtin_bit_cast(bf16x8, o); }
        __builtin_amdgcn_sched_barrier(0);
#pragma unroll
        for (int j = 0; j < 2; ++j) { const v4i16_t lo = fa[b % 3][j][0], hi = fa[b % 3][j][1]; const int dt = 2 * (b & 3) + j;
            X[dt] = __builtin_amdgcn_mfma_f32_32x32x16_bf16((bf16x8){lo[0], lo[1], lo[2], lo[3], hi[0], hi[1], hi[2], hi[3]}, vs, X[dt], 0, 0, 0); }
        __builtin_amdgcn_sched_barrier(0);
    }
#undef RT_LOADB
}
__device__ __forceinline__ void dump_state(const f32x16 (&X)[8], RGAS char* L, int wave, int lane, float scl) {
#pragma unroll
    for (int dt = 0; dt < 8; ++dt)
#pragma unroll
        for (int s = 0; s < 2; ++s) { u32x4 o; o.x = cvtpk(X[dt][8 * s] * scl, X[dt][8 * s + 1] * scl); o.y = cvtpk(X[dt][8 * s + 2] * scl, X[dt][8 * s + 3] * scl);
            o.z = cvtpk(X[dt][8 * s + 4] * scl, X[dt][8 * s + 5] * scl); o.w = cvtpk(X[dt][8 * s + 6] * scl, X[dt][8 * s + 7] * scl);
            *(RGAS u32x4*)(L + (unsigned)(wave * 16384 + (2 * dt + s) * 1024 + lane * 16)) = o; }
}
__device__ __forceinline__ void accum_state(f32x16 (&X)[8], const RGAS char* L, int wave, int lane, float dec) {
#pragma unroll
    for (int dt = 0; dt < 8; ++dt)
#pragma unroll
        for (int s = 0; s < 2; ++s) { const u32x4 w = *(const RGAS u32x4*)(L + (unsigned)(wave * 16384 + (2 * dt + s) * 1024 + lane * 16));
            X[dt][8 * s] = X[dt][8 * s] * dec + bflo(w.x); X[dt][8 * s + 1] = X[dt][8 * s + 1] * dec + bfhi(w.x); X[dt][8 * s + 2] = X[dt][8 * s + 2] * dec + bflo(w.y); X[dt][8 * s + 3] = X[dt][8 * s + 3] * dec + bfhi(w.y);
            X[dt][8 * s + 4] = X[dt][8 * s + 4] * dec + bflo(w.z); X[dt][8 * s + 5] = X[dt][8 * s + 5] * dec + bfhi(w.z); X[dt][8 * s + 6] = X[dt][8 * s + 6] * dec + bflo(w.w); X[dt][8 * s + 7] = X[dt][8 * s + 7] * dec + bfhi(w.w); }
}
__device__ __forceinline__ void load_state(f32x16 (&X)[8], const RGAS char* L, int wave, int lane) {
#pragma unroll
    for (int dt = 0; dt < 8; ++dt)
#pragma unroll
        for (int s = 0; s < 2; ++s) { const u32x4 w = *(const RGAS u32x4*)(L + (unsigned)(wave * 16384 + (2 * dt + s) * 1024 + lane * 16));
            X[dt][8 * s] = bflo(w.x); X[dt][8 * s + 1] = bfhi(w.x); X[dt][8 * s + 2] = bflo(w.y); X[dt][8 * s + 3] = bfhi(w.y);
            X[dt][8 * s + 4] = bflo(w.z); X[dt][8 * s + 5] = bfhi(w.z); X[dt][8 * s + 6] = bflo(w.w); X[dt][8 * s + 7] = bfhi(w.w); }
}
template <bool FULL>
__device__ __forceinline__ void run_item(const Ptrs& P, int bh, int half, int g, unsigned lds0, int wave_in) {
    int lane0_ = hw_lane_id(); asm volatile("" : "+v"(lane0_));
    const int lane0 = lane0_, wave = wave_in, tid = wave * 64 + lane0;
    const int b = bh >> 2, h = bh & 3;
    const float lg = __logf(1.0f - __builtin_amdgcn_exp2f(-5.0f - (float)h));
    const float cd = __expf(lg * 64.f), cdinv = __expf(-lg * 64.f);
    RLAS float* pw = (RLAS float*)(uintptr_t)(lds0 + LPW);
    __syncthreads();
    if (tid <= 64) pw[tid] = __expf(lg * (float)tid);
    if (tid < 64) { pw[80 + tid] = __expf(lg * (float)(tid + 1)); pw[144 + tid] = __expf(lg * (float)(63 - tid)); }
    const int g16 = lane0 >> 4, blk = g16 & 1, q4 = (lane0 & 15) >> 2, p4 = lane0 & 3, sp = ((p4 & 1) << 1) | (p4 >> 1), hh0 = lane0 >> 5;
    const unsigned trrow = (unsigned)(512 * (8 * hh0 + q4));
    const int fl = (q4 << 2) | (hh0 << 1);
    unsigned vb0_ = lds0 + LV + trrow + 16u * (unsigned)((4 * wave + 2 * blk + (p4 >> 1)) ^ fl) + 8u * (unsigned)(p4 & 1);
    unsigned kt0_ = lds0 + LK + trrow + 16u * (unsigned)((2 * blk + (sp >> 1)) ^ fl) + 8u * (unsigned)(sp & 1);
    unsigned lane_ = (unsigned)lane0;
    const size_t tok0 = (size_t)b * 8192 + (size_t)g * (RG * 64);
    const RGAS char* Qg = P.Q + (tok0 * 1024 + (size_t)h * 256) * 2; const RGAS char* Kg = P.K + (tok0 * 1024 + (size_t)h * 256) * 2;
    RGAS char* Vg = P.V + (tok0 * 2048 + (size_t)h * 512 + (size_t)half * 256) * 2;
    __syncthreads();
    if constexpr (FULL) { stage_tile(Qg, 2048, lds0 + LQ, wave, lane0); stage_tile(Vg, 4096, lds0 + LV, wave, lane0); } else { stage_tile(Vg, 4096, lds0 + LV, wave, lane0); }
    stage_tile(Kg, 2048, lds0 + LK, wave, lane0);
    f32x16 X[8];
#pragma unroll
    for (int dt = 0; dt < 8; ++dt) X[dt] = f32x16{};
    if constexpr (FULL) {
        if (g > 0) load_state(X, P.L + (size_t)((bh * (NG - 1) + g - 1) * 2 + half) * 131072, wave, lane0);
    }
#if RT_TPROBE == 3 || RT_TPROBE == 5
    unsigned tq3_ = 0; if (FULL && tid == 0) tq3_ = (unsigned)__builtin_amdgcn_s_memrealtime();
#endif
    float cdm = 1.f, cdim = cdinv;
    for (int m = 0; m < RG; ++m) {
        const unsigned kb = (m & 1) ? (unsigned)(LK2 - LK) : 0u, vbuf = (!FULL && (m & 1)) ? (unsigned)(LQ - LV) : 0u;
#if RT_TPROBE == 1 || RT_TPROBE == 4
        unsigned tq0_ = 0; if (FULL && tid == 0) tq0_ = (unsigned)__builtin_amdgcn_s_memrealtime();
#endif
        asm volatile("s_waitcnt vmcnt(0)" ::: "memory");
#if RT_TPROBE == 1
        if (FULL && tid == 0) *(RLAS unsigned*)(uintptr_t)(lds0 + 131480) += (unsigned)__builtin_amdgcn_s_memrealtime() - tq0_;
#endif
        __syncthreads();
#if RT_TPROBE == 4
        if (FULL && tid == 0) *(RLAS unsigned*)(uintptr_t)(lds0 + 131480) += (unsigned)__builtin_amdgcn_s_memrealtime() - tq0_;
#endif
#if RT_TPROBE == 5
        if (FULL && tid == 0 && m == 0) *(RLAS unsigned*)(uintptr_t)(lds0 + 131480) += (unsigned)__builtin_amdgcn_s_memrealtime() - tq3_;
#endif
        asm volatile("" : "+v"(vb0_), "+v"(kt0_), "+v"(lane_));
        const unsigned vb0 = vb0_ + vbuf, vb1 = vb0 ^ 16u, kt0 = kt0_ + kb, kt1 = kt0 ^ 16u; const int lane = (int)lane_, hh = lane >> 5, c32 = lane & 31, i16 = lane & 15;
#if RT_TPROBE == 7
        unsigned tq7_ = 0; if (FULL && tid == 0) tq7_ = (unsigned)__builtin_amdgcn_s_memrealtime();
#endif
        if (m + 1 < RG) { stage_tile(Kg + (size_t)(m + 1) * (64 * 2048), 2048, lds0 + LK + ((m & 1) ? 0u : (unsigned)(LK2 - LK)), wave, lane);
            if constexpr (!FULL) stage_tile(Vg + (size_t)(m + 1) * (64 * 4096), 4096, lds0 + ((m & 1) ? (unsigned)LV : (unsigned)LQ), wave, lane); }
        if (FULL && m > 0 && wave == 7) pst_flush(P.PST, lds0, tok0 + (size_t)(m - 1) * 64, h, half, lane);
        if (RT_TOUCH && m + 2 < RG) {
            if (wave < 4) { if constexpr (FULL) touch_tile(Qg + (size_t)(m + 2) * (64 * 2048), 2048, lds0, wave, lane); touch_tile(Vg + (size_t)(m + 2) * (64 * 4096), 4096, lds0, wave, lane); }
            else touch_tile(Kg + (size_t)(m + 2) * (64 * 2048), 2048, lds0, wave, lane); }
#if RT_TPROBE == 7
        if (FULL && tid == 0) *(RLAS unsigned*)(uintptr_t)(lds0 + 131480) += (unsigned)__builtin_amdgcn_s_memrealtime() - tq7_;
#endif
        bf16x8 vf[4];
        if constexpr (FULL) {
#if RT_TPROBE == 8
            unsigned tq8_ = 0; if (tid == 0) tq8_ = (unsigned)__builtin_amdgcn_s_memrealtime();
#endif
            {
                const int itile = wave >> 1, jt0 = 2 * (wave & 1), qq = lane >> 4;
                const int fS = ((i16 & 3) << 2) | ((i16 >> 2) & 3);
                const unsigned qa = lds0 + LQ + (unsigned)(512 * (16 * itile + i16)) + 16u * (unsigned)(qq ^ fS), ka = lds0 + LK + kb + (unsigned)(512 * (16 * jt0 + i16)) + 16u * (unsigned)(qq ^ fS);
                f32x4 s0 = {0.f, 0.f, 0.f, 0.f}, s1 = {0.f, 0.f, 0.f, 0.f};
#pragma unroll
                for (int s = 0; s < 8; ++s) { const bf16x8 qf = lds128(qa ^ (unsigned)(64 * s)), k0 = lds128(ka ^ (unsigned)(64 * s)), k1 = lds128((ka ^ (unsigned)(64 * s)) + 8192);
                    s0 = __builtin_amdgcn_mfma_f32_16x16x32_bf16(k0, qf, s0, 0, 0, 0); s1 = __builtin_amdgcn_mfma_f32_16x16x32_bf16(k1, qf, s1, 0, 0, 0);
                    if ((s & 3) == 3) asm volatile("" ::: "memory"); }
                const int irow = 16 * itile + i16;
#pragma unroll
                for (int tt = 0; tt < 2; ++tt) { const f32x4 sv = tt ? s1 : s0; const int jb = 16 * (jt0 + tt) + 4 * qq; float e[4];
#pragma unroll
                    for (int r = 0; r < 4; ++r) { const int dj = irow - (jb + r); e[r] = sv[r] * pw[dj < 0 ? -dj : dj]; }
                    u32x2 o; o.x = cvtpk(e[0], e[1]); o.y = cvtpk(e[2], e[3]);
                    *(RLAS u32x2*)(uintptr_t)(lds0 + LS + offS(irow, 2 * (jt0 + tt) + (qq >> 1)) + 8 * (qq & 1)) = o; }
            }
            load_vfrags(vf, vb0, vb1);
            f32x16 Y[2]; Y[0] = f32x16{}; Y[1] = f32x16{};
            const int fQ = ((c32 & 3) << 2) | ((c32 >> 2) & 3);
            const unsigned qr0 = lds0 + LQ + (unsigned)(512 * c32) + 16u * (unsigned)(hh ^ fQ);
#pragma unroll
            for (int dt = 0; dt < 8; ++dt)
#pragma unroll
                for (int s = 0; s < 2; ++s) { u32x4 pb; pb.x = cvtpk(X[dt][8 * s], X[dt][8 * s + 1]); pb.y = cvtpk(X[dt][8 * s + 2], X[dt][8 * s + 3]); pb.z = cvtpk(X[dt][8 * s + 4], X[dt][8 * s + 5]); pb.w = cvtpk(X[dt][8 * s + 6], X[dt][8 * s + 7]);
                    const bf16x8 bq = __builtin_bit_cast(bf16x8, pb); const unsigned a = qr0 ^ (unsigned)(16 * (4 * dt + 2 * s));
                    Y[0] = __builtin_amdgcn_mfma_f32_32x32x16_bf16(lds128(a), bq, Y[0], 0, 0, 0); Y[1] = __builtin_amdgcn_mfma_f32_32x32x16_bf16(lds128(a + 16384), bq, Y[1], 0, 0, 0);
                    if (s == 1 && (dt & 1)) asm volatile("" ::: "memory"); }
#pragma unroll
            for (int it = 0; it < 2; ++it)
#pragma unroll
                for (int rg = 0; rg < 4; ++rg) { const f32x4 f = *(const RLAS f32x4*)(pw + 80 + 32 * it + 8 * rg + 4 * hh);
                    Y[it][4 * rg] *= f[0] * cdm; Y[it][4 * rg + 1] *= f[1] * cdm; Y[it][4 * rg + 2] *= f[2] * cdm; Y[it][4 * rg + 3] *= f[3] * cdm; }
#if RT_TPROBE == 8
            if (tid == 0) *(RLAS unsigned*)(uintptr_t)(lds0 + 131480) += (unsigned)__builtin_amdgcn_s_memrealtime() - tq8_;
#endif
#if RT_TPROBE == 2
            unsigned tq1_ = 0; if (tid == 0) tq1_ = (unsigned)__builtin_amdgcn_s_memrealtime();
#endif
            asm volatile("s_waitcnt lgkmcnt(0)" ::: "memory"); __builtin_amdgcn_s_barrier(); asm volatile("" ::: "memory");
#if RT_TPROBE == 2
            if (tid == 0) *(RLAS unsigned*)(uintptr_t)(lds0 + 131480) += (unsigned)__builtin_amdgcn_s_memrealtime() - tq1_;
#endif
            if (m + 1 < RG) { stage_tile(Qg + (size_t)(m + 1) * (64 * 2048), 2048, lds0 + LQ, wave, lane); stage_tile(Vg + (size_t)(m + 1) * (64 * 4096), 4096, lds0 + LV, wave, lane); }
            const unsigned sr0 = lds0 + LS + (unsigned)(128 * c32) + 16u * (unsigned)(hh ^ ((c32 >> 1) & 7));
            const unsigned sr1 = lds0 + LS + (unsigned)(128 * (32 + c32)) + 16u * (unsigned)(hh ^ (((32 + c32) >> 1) & 7));
#pragma unroll
            for (int s = 0; s < 4; ++s) { Y[0] = __builtin_amdgcn_mfma_f32_32x32x16_bf16(lds128(sr0 ^ (unsigned)(32 * s)), vf[s], Y[0], 0, 0, 0);
                Y[1] = __builtin_amdgcn_mfma_f32_32x32x16_bf16(lds128(sr1 ^ (unsigned)(32 * s)), vf[s], Y[1], 0, 0, 0); }
#if RT_TPROBE == 6
            unsigned tq6_ = 0; if (tid == 0) tq6_ = (unsigned)__builtin_amdgcn_s_memrealtime();
#endif
            const size_t tokm = tok0 + (size_t)m * 64;
            RGAS char* yb = P.V + ((tokm * 2048 + (size_t)h * 512 + (size_t)half * 256 + (size_t)wave * 32) * 2);
            const bool l0 = (c32 & 1) != 0, l1 = (c32 & 2) != 0;
            float p1[8], p2[8];
#pragma unroll
            for (int it = 0; it < 2; ++it)
#pragma unroll
                for (int k = 0; k < 4; ++k) { float a0 = Y[it][4 * k], a1 = Y[it][4 * k + 1], a2 = Y[it][4 * k + 2], a3 = Y[it][4 * k + 3];
                    { const float r = qx1(l0 ? a0 : a1); a0 = l0 ? r : a0; a1 = l0 ? a1 : r; }
                    { const float r = qx1(l0 ? a2 : a3); a2 = l0 ? r : a2; a3 = l0 ? a3 : r; }
                    { const float r = qx2(l1 ? a0 : a2); a0 = l1 ? r : a0; a2 = l1 ? a2 : r; }
                    { const float r = qx2(l1 ? a1 : a3); a1 = l1 ? r : a1; a3 = l1 ? a3 : r; }
                    u32x2 o; o.x = cvtpk(a0, a1); o.y = cvtpk(a2, a3);
                    *(RGAS u32x2*)(yb + (unsigned)(32 * it + 8 * k + (c32 & 3) + 4 * hh) * 4096u + (unsigned)(c32 >> 2) * 8u) = o;
                    p1[4 * it + k] = (a0 + a1) + (a2 + a3); p2[4 * it + k] = (a0 * a0 + a1 * a1) + (a2 * a2 + a3 * a3); }
            {
                const bool b4 = (c32 & 16) != 0, b3 = (c32 & 8) != 0, b2 = (c32 & 4) != 0;
                float q1[4], q2[4], r1[2], r2[2];
#pragma unroll
                for (int j = 0; j < 4; ++j) { q1[j] = (b4 ? p1[4 + j] : p1[j]) + __shfl_xor(b4 ? p1[j] : p1[4 + j], 16); q2[j] = (b4 ? p2[4 + j] : p2[j]) + __shfl_xor(b4 ? p2[j] : p2[4 + j], 16); }
#pragma unroll
                for (int j = 0; j < 2; ++j) { r1[j] = (b3 ? q1[2 + j] : q1[j]) + __shfl_xor(b3 ? q1[j] : q1[2 + j], 8); r2[j] = (b3 ? q2[2 + j] : q2[j]) + __shfl_xor(b3 ? q2[j] : q2[2 + j], 8); }
                typedef float f32x2 __attribute__((ext_vector_type(2))); f32x2 st;
                st.x = (b2 ? r1[1] : r1[0]) + __shfl_xor(b2 ? r1[0] : r1[1], 4); st.y = (b2 ? r2[1] : r2[0]) + __shfl_xor(b2 ? r2[0] : r2[1], 4);
                const int row = 32 * (b4 ? 1 : 0) + 8 * (2 * (b3 ? 1 : 0) + (b2 ? 1 : 0)) + (c32 & 3) + 4 * hh;
                *(RLAS f32x2*)(uintptr_t)(lds0 + LST + (unsigned)(row * 64 + wave * 8)) = st;
            }
#if RT_TPROBE == 6
            if (tid == 0) *(RLAS unsigned*)(uintptr_t)(lds0 + 131480) += (unsigned)__builtin_amdgcn_s_memrealtime() - tq6_;
#endif
        } else {
            load_vfrags(vf, vb0, vb1);
        }
#if RT_TPROBE == 9
        unsigned tq9_ = 0; if (FULL && tid == 0) tq9_ = (unsigned)__builtin_amdgcn_s_memrealtime();
#endif
        if (!(FULL && m == RG - 1)) update_state(X, vf, kt0, kt1, lds0, hh, cdim);
#if RT_TPROBE == 9
        if (FULL && tid == 0) *(RLAS unsigned*)(uintptr_t)(lds0 + 131480) += (unsigned)__builtin_amdgcn_s_memrealtime() - tq9_;
#endif
        cdm *= cd; cdim *= cdinv;
    }
    __syncthreads();
    if (FULL && wave == 7) pst_flush(P.PST, lds0, tok0 + (size_t)(RG - 1) * 64, h, half, lane0);
#if RT_TPROBE == 3
    if (FULL && tid == 0) *(RLAS unsigned*)(uintptr_t)(lds0 + 131480) += (unsigned)__builtin_amdgcn_s_memrealtime() - tq3_;
#endif
    if constexpr (!FULL) dump_state(X, P.L + (size_t)((bh * (NG - 1) + g) * 2 + half) * 131072, wave, lane0, cdm);
}
#undef RLAS
#undef RGAS
}
struct Args { const float* in[11]; float* out; unsigned char* wsp; int ph_lo, ph_hi, li, pad; };
struct Frame {
    LAS unsigned char* lds;
    volatile LAS unsigned* MISC;
    int tid, lane, wave;
    int vcu, G;
    const __attribute__((address_space(4))) Args* ap;
};
#define FP(i) (F.ap->in[i])
#define F_x FP(0)
#define F_norm_mix FP(1)
#define F_norm_ffn FP(2)
#define F_fox_w_in FP(3)
#define F_fox_b_f FP(4)
#define F_fox_w_out FP(5)
#define F_ret_w_in FP(6)
#define F_ret_w_out FP(7)
#define F_ffn_w_in FP(8)
#define F_ffn_w_out FP(9)
#define F_final_norm FP(10)
#define F_out (F.ap->out)
#define F_ws (F.ap->wsp)
__device__ __forceinline__ float wave_sum(float v) {
#pragma unroll
    for (int o = 1; o < 64; o <<= 1) v += __shfl_xor(v, o);
    return v;
}

#ifndef ATT_TAIL_CONV
#define ATT_TAIL_CONV 3
#endif
__device__ __forceinline__ void p0_item(const float* W, int K, int Nsrc, int scol0, bf16* WT, int drow0, int k0, const float* g, LAS float* scr, int lane) {
    const int nq = lane & 7, kr = lane >> 3;
    f32x4 v[8];
#pragma unroll
    for (int i = 0; i < 8; ++i) v[i] = *(const GAS f32x4*)(W + (size_t)(k0 + kr + 8 * i) * Nsrc + scol0 + 4 * nq);
#pragma unroll
    for (int i = 0; i < 8; ++i) { const int kk = kr + 8 * i; const float gv = g ? g[k0 + kk] : 1.f; LAS float* d = scr + kk * 33 + 4 * nq;
        d[0] = v[i].x * gv; d[1] = v[i].y * gv; d[2] = v[i].z * gv; d[3] = v[i].w * gv; }
    LDS_WAIT(); asm volatile("" ::: "memory");
    const int c = lane & 7;
#pragma unroll
    for (int j = 0; j < 4; ++j) { const int n = (lane >> 3) + 8 * j; const LAS float* s = scr + (8 * c) * 33 + n;
        v4u o; o.x = pk2(s[0 * 33], s[1 * 33]); o.y = pk2(s[2 * 33], s[3 * 33]); o.z = pk2(s[4 * 33], s[5 * 33]); o.w = pk2(s[6 * 33], s[7 * 33]);
        *(GAS v4u*)(WT + (size_t)(drow0 + n) * K + k0 + 8 * c) = o; }
    LDS_WAIT(); asm volatile("" ::: "memory");
}
__device__ __forceinline__ void p0_matrix(int r, const float* W, int K, int N, int Nsrc, bool swiglu, bf16* WT, const float* g, LAS float* scr, int lane) {
    const int nblk = N / 32, kb = r / nblk, nb = r % nblk, drow0 = 32 * nb;
    int scol0 = drow0;
    if (swiglu) { const int t = drow0 >> 8, rr = drow0 & 255; scol0 = (rr < 128) ? t * 128 + rr : DFF + t * 128 + (rr - 128); }
    p0_item(W, K, Nsrc, scol0, WT, drow0, 64 * kb, g, scr, lane);
}
template <bool LOAD>
__device__ __forceinline__ void p0_item2(f32x4 (&v)[8], float (&gv)[8], const float* W, int K, int Nsrc, int scol0, bf16* WT, int drow0, int k0, const float* g, LAS float* scr, int lane) {
    const int nq = lane & 7, kr = lane >> 3;
    if constexpr (LOAD) {
#pragma unroll
        for (int i = 0; i < 8; ++i) { v[i] = *(const GAS f32x4*)(W + (size_t)(k0 + kr + 8 * i) * Nsrc + scol0 + 4 * nq); gv[i] = g ? g[k0 + kr + 8 * i] : 1.f; }
    } else {
#pragma unroll
        for (int i = 0; i < 8; ++i) { const int kk = kr + 8 * i; LAS float* d = scr + kk * 33 + 4 * nq;
            d[0] = v[i].x * gv[i]; d[1] = v[i].y * gv[i]; d[2] = v[i].z * gv[i]; d[3] = v[i].w * gv[i]; }
        LDS_WAIT(); asm volatile("" ::: "memory");
        const int c = lane & 7;
#pragma unroll
        for (int j = 0; j < 4; ++j) { const int n = (lane >> 3) + 8 * j; const LAS float* s = scr + (8 * c) * 33 + n;
            v4u o; o.x = pk2(s[0 * 33], s[1 * 33]); o.y = pk2(s[2 * 33], s[3 * 33]); o.z = pk2(s[4 * 33], s[5 * 33]); o.w = pk2(s[6 * 33], s[7 * 33]);
            *(GAS v4u*)(WT + (size_t)(drow0 + n) * K + k0 + 8 * c) = o; }
        LDS_WAIT(); asm volatile("" ::: "memory");
    }
}
template <bool LOAD>
__device__ __forceinline__ void p0_matrix2(f32x4 (&v)[8], float (&gv)[8], int r, const float* W, int K, int N, int Nsrc, bool swiglu, bf16* WT, const float* g, LAS float* scr, int lane) {
    const int nblk = N / 32, kb = r / nblk, nb = r % nblk, drow0 = 32 * nb;
    int scol0 = drow0;
    if (swiglu) { const int t = drow0 >> 8, rr = drow0 & 255; scol0 = (rr < 128) ? t * 128 + rr : DFF + t * 128 + (rr - 128); }
    p0_item2<LOAD>(v, gv, W, K, Nsrc, scol0, WT, drow0, 64 * kb, g, scr, lane);
}
__device__ __forceinline__ void p0_xtile(Frame& F, int tile) {
    LAS float* wfs = (LAS float*)(F.lds);
    LAS float* tot = (LAS float*)(F.lds + 32768);
    const int row0 = tile * 64 + F.wave * 8;
    f32x4 v[4], vn[4];
    { const GAS f32x4* xr = (const GAS f32x4*)(F_x + (size_t)row0 * D) + F.lane;
#pragma unroll
      for (int j = 0; j < 4; ++j) vn[j] = xr[64 * j]; }
#pragma unroll
    for (int kk = 0; kk < 2; ++kk) { const int k = F.tid + 512 * kk; const float gk = F_norm_mix[k];
        const f32x4 w0 = *(const GAS f32x4*)(F_fox_w_in + (size_t)k * 3080 + 3072), w1 = *(const GAS f32x4*)(F_fox_w_in + (size_t)k * 3080 + 3076);
        wfs[k] = w0.x * gk; wfs[1024 + k] = w0.y * gk; wfs[2048 + k] = w0.z * gk; wfs[3072 + k] = w0.w * gk; wfs[4096 + k] = w1.x * gk; wfs[5120 + k] = w1.y * gk; wfs[6144 + k] = w1.z * gk; wfs[7168 + k] = w1.w * gk; }
    __syncthreads();
    const int myh = (F.lane >> 3) & 7;
    const float bfv = F_fox_b_f[myh];
    bf16* XB = (bf16*)(F_ws + WS_XB); float* SSQ = (float*)(F_ws + WS_SSQ);
    const bool b5 = (F.lane & 32) != 0, b4 = (F.lane & 16) != 0, b3 = (F.lane & 8) != 0;
    float run = 0.f, mine[8];
    f32x4 wreg[8][4];
#pragma unroll
    for (int h = 0; h < 8; ++h)
#pragma unroll
        for (int j = 0; j < 4; ++j) wreg[h][j] = *(const LAS f32x4*)(wfs + h * 1024 + 4 * (F.lane + 64 * j));
#pragma unroll
    for (int i = 0; i < 8; ++i) {
        const int row = row0 + i;
#pragma unroll
        for (int j = 0; j < 4; ++j) v[j] = vn[j];
        if (i < 7) { const GAS f32x4* xr = (const GAS f32x4*)(F_x + (size_t)(row + 1) * D) + F.lane;
#pragma unroll
            for (int j = 0; j < 4; ++j) vn[j] = xr[64 * j]; }
        float ss = 0.f;
#pragma unroll
        for (int j = 0; j < 4; ++j) ss += (v[j].x * v[j].x + v[j].y * v[j].y) + (v[j].z * v[j].z + v[j].w * v[j].w);
        GAS unsigned long long* o8 = (GAS unsigned long long*)(XB + (size_t)row * D) + F.lane;
#pragma unroll
        for (int j = 0; j < 4; ++j) o8[64 * j] = (unsigned long long)pk2(v[j].x, v[j].y) | ((unsigned long long)pk2(v[j].z, v[j].w) << 32);
        float a[8];
#pragma unroll
        for (int h = 0; h < 8; ++h) { float acc = 0.f;
#pragma unroll
            for (int j = 0; j < 4; ++j) { const f32x4 w = wreg[h][j]; acc += (v[j].x * w.x + v[j].y * w.y) + (v[j].z * w.z + v[j].w * w.w); }
            a[h] = acc; }
        ss = wave_sum(ss);
        float c[4], d[2];
#pragma unroll
        for (int k = 0; k < 4; ++k) c[k] = (b5 ? a[4 + k] : a[k]) + __shfl_xor(b5 ? a[k] : a[4 + k], 32);
#pragma unroll
        for (int k = 0; k < 2; ++k) d[k] = (b4 ? c[2 + k] : c[k]) + __shfl_xor(b4 ? c[k] : c[2 + k], 16);
        float e = (b3 ? d[1] : d[0]) + __shfl_xor(b3 ? d[0] : d[1], 8);
        e += __shfl_xor(e, 4); e += __shfl_xor(e, 2); e += __shfl_xor(e, 1);
        const float rstd = 1.0f / sqrtf(ss * (1.f / D) + EPS);
        if (F.lane < 16) SSQ[(size_t)row * 16 + F.lane] = (F.lane == 0) ? ss : 0.f;
        const float z = e * rstd + bfv; const float lf = fminf(z, 0.f) - log1pf(__expf(-fabsf(z)));
        run += lf; mine[i] = run;
    }
    if ((F.lane & 7) == 0) tot[F.wave * 8 + myh] = run;
    __syncthreads();
    float* LC = (float*)(F_ws + WS_LC); float* TT = (float*)(F_ws + WS_TT);
    if ((F.lane & 7) == 0) { float off = 0.f; for (int w = 0; w < F.wave; ++w) off += tot[w * 8 + myh];
#pragma unroll
        for (int i = 0; i < 8; ++i) LC[(size_t)(row0 + i) * 8 + myh] = mine[i] + off; }
    if (F.tid < 8) { float s = 0.f; for (int w = 0; w < 8; ++w) s += tot[w * 8 + F.tid]; TT[tile * 8 + F.tid] = s; }
    __syncthreads();
}
__device__ __forceinline__ void p0_prologue(Frame& F) {
#ifndef P0_TPROBE
#define P0_TPROBE 0
#endif
#define P0_T0() unsigned tp0_ = 0; if (P0_TPROBE && F.tid == 0) tp0_ = (unsigned)__builtin_amdgcn_s_memrealtime();
#define P0_T1(k) if (P0_TPROBE == (k) && F.tid == 0) F.MISC[22] += (unsigned)__builtin_amdgcn_s_memrealtime() - tp0_; if (P0_TPROBE && F.tid == 0) tp0_ = (unsigned)__builtin_amdgcn_s_memrealtime();
    P0_T0()
    for (int t = (int)blockIdx.x; t < M / 64; t += F.G) p0_xtile(F, t);
    P0_T1(1)
    LAS float* scr = (LAS float*)(F.lds + RING_OFF + F.wave * 16384);
    const int gw = F.vcu * NWAVES + F.wave, NGW = F.G * NWAVES;
    constexpr int I0 = 16 * 96, I1 = 16 * 32, I2 = 16 * 176, I3 = 44 * 32, I4 = 16 * 192, I5 = 32 * 32;
    constexpr int NITEMS = ATT_TAIL_CONV >= 3 ? I0 : I0 + I1 + I2 + I3 + (ATT_TAIL_CONV == 2 ? 0 : I4 + I5);
    unsigned char* ws = F_ws;
    for (int it = gw; it < NITEMS; it += NGW) {
        int r = it;
        if (r < I0) { p0_matrix(r, F_fox_w_in, 1024, 3072, 3080, false, (bf16*)(ws + WS_WQKV0), F_norm_mix, scr, F.lane); continue; } r -= I0;
        if (r < I1) { p0_matrix(r, F_fox_w_out, 1024, 1024, 1024, false, (bf16*)(ws + WS_WO0), nullptr, scr, F.lane); continue; } r -= I1;
        if (r < I2) { p0_matrix(r, F_ffn_w_in, 1024, 2 * DFF, 2 * DFF, true, (bf16*)(ws + WS_WFI0), F_norm_ffn, scr, F.lane); continue; } r -= I2;
        if (r < I3) { p0_matrix(r, F_ffn_w_out, DFF, 1024, 1024, false, (bf16*)(ws + WS_WFO0), nullptr, scr, F.lane); continue; } r -= I3;
        if (r < I4) { p0_matrix(r, F_ret_w_in, 1024, 6144, 6144, false, (bf16*)(ws + WS_WRI), F_norm_mix + D, scr, F.lane); continue; } r -= I4;
        p0_matrix(r, F_ret_w_out, 2048, 1024, 1024, false, (bf16*)(ws + WS_WRO), nullptr, scr, F.lane);
    }
    P0_T1(2)
    if (blockIdx.x == 0 && F.tid < 128) ((float*)(ws + WS_ROPE))[F.tid] = (float)exp2(-(double)F.tid * (13.287712379549449 / 128.0));
    P0_T1(3)
}

__device__ __forceinline__ void p0_late_weights(Frame& F, int first) {
    const int nwg = F.G - first; if ((int)blockIdx.x < first || nwg <= 0) return;
    LAS float* scr = (LAS float*)(F.lds + RING_OFF + F.wave * 16384);
    const int gw = ((int)blockIdx.x - first) * NWAVES + F.wave, NGW = nwg * NWAVES;
    constexpr int I6 = 16 * 176, I7 = 44 * 32;
    unsigned char* ws = F_ws;
    for (int it = gw; it < I6 + I7; it += NGW) {
        if (it < I6) p0_matrix(it, F_ffn_w_in + (size_t)D * 2 * DFF, 1024, 2 * DFF, 2 * DFF, true, (bf16*)(ws + WS_WFI1), F_norm_ffn + D, scr, F.lane);
        else p0_matrix(it - I6, F_ffn_w_out + (size_t)DFF * D, DFF, 1024, 1024, false, (bf16*)(ws + WS_WFO1), nullptr, scr, F.lane);
    }
}

__device__ __forceinline__ void fill_rstd_tab(Frame& F, const pg8::StaticOrder& S) {
    LAS float* tab = (LAS float*)(F.lds + TAB_OFF); const float* SSQ = (const float*)(F_ws + WS_SSQ);
    f32x4 a[4][4]; bool ok[4];
#pragma unroll
    for (int j = 0; j < 4; ++j) { const int idx = F.tid + 512 * j, i = idx >> 8, r = idx & 255; pg8::Unit u; ok[j] = S.next(i, u);
        if (ok[j]) { const f32x4* p = (const f32x4*)(SSQ + (size_t)(u.pm * 256 + r) * 16); a[j][0] = p[0]; a[j][1] = p[1]; a[j][2] = p[2]; a[j][3] = p[3]; } }
#pragma unroll
    for (int j = 0; j < 4; ++j) if (ok[j]) { const f32x4 x0 = a[j][0], x1 = a[j][1], x2 = a[j][2], x3 = a[j][3];
        const float s = ((x0.x + x0.y) + (x0.z + x0.w)) + ((x1.x + x1.y) + (x1.z + x1.w)) + ((x2.x + x2.y) + (x2.z + x2.w)) + ((x3.x + x3.y) + (x3.z + x3.w));
        tab[F.tid + 512 * j] = 1.0f / sqrtf(s * (1.f / D) + EPS); }
    __syncthreads();
}
__device__ __forceinline__ void fill_gate_tab(Frame& F, const pg8::StaticOrder& S) {
    LAS f32x2* stab = (LAS f32x2*)(F.lds + STAB_OFF); const float* PST = (const float*)(F_ws + WS_PST);
    pg8::Unit u;
    { const int i = F.tid >> 8, r = F.tid & 255;
      if (S.next(i, u)) {
        const f32x4 v = *(const f32x4*)(PST + ((size_t)(u.pm * 256 + r) * 4 + (u.pn >> 1)) * 4); const float s = v.x + v.z, q = v.y + v.w;
        const float mu = s * (1.f / RDV), var = fmaxf(q * (1.f / RDV) - mu * mu, 0.f);
        f32x2 st; st.x = mu; st.y = 1.0f / sqrtf(var + EPS); stab[F.tid] = st; } }
    __syncthreads();
}


__device__ __forceinline__ void cbg_phase(Frame& F) {
    const float* LC = (const float*)(F_ws + WS_LC); const float* TT = (const float*)(F_ws + WS_TT); float* CBG = (float*)(F_ws + WS_CBG);
    LAS float* pre = (LAS float*)(F.lds);
    for (int item = (int)blockIdx.x; item < 16 * 16; item += F.G) {
        const int bh = item >> 4, seg = item & 15, b = bh >> 3, h = bh & 7, s = seg * 512 + F.tid;
        const float lc = LC[(size_t)(b * SEQ + s) * 8 + h];
        __syncthreads();
        if (F.wave == 0) {
            const float v0 = TT[(b * 128 + 2 * F.lane) * 8 + h], v1 = TT[(b * 128 + 2 * F.lane + 1) * 8 + h];
            float sc = v0 + v1;
#pragma unroll
            for (int o = 1; o < 64; o <<= 1) { const float t = __shfl_up(sc, o); if (F.lane >= o) sc += t; }
            const float ex = sc - (v0 + v1);
            pre[2 * F.lane] = ex; pre[2 * F.lane + 1] = ex + v0; }
        __syncthreads();
        CBG[(size_t)bh * SEQ + s] = -(pre[s >> 6] + lc) * LOG2E;
    }
    __syncthreads();
}
#ifndef SPLIT_TILES_
#define SPLIT_TILES_ 64
#endif
constexpr int SPLIT_MIN = 40, SPLIT_TILES = SPLIT_TILES_;
#ifndef LATE_TILES_
#define LATE_TILES_ 16
#endif
#ifndef SPLIT_QB_
#define SPLIT_QB_ 16
#endif
constexpr int SPLIT_QB = SPLIT_QB_, LATE_TILES = LATE_TILES_;
__host__ __device__ constexpr int att_parts_of(int qb, int nt) {
#ifndef LATE_SKIP_NT
#define LATE_SKIP_NT -1
#endif
#ifndef LATE_FULL_ONLY
#define LATE_FULL_ONLY 0
#endif
    return qb >= SPLIT_QB ? (nt >= SPLIT_MIN ? ((nt + SPLIT_TILES - 1) / SPLIT_TILES < 2 ? 2 : (nt + SPLIT_TILES - 1) / SPLIT_TILES) : 1) : ((nt > LATE_TILES && nt != LATE_SKIP_NT && (!LATE_FULL_ONLY || nt == 4 * (qb + 1))) ? (nt + LATE_TILES - 1) / LATE_TILES : 1); }
__host__ __device__ constexpr int att_slots_upto(int qb) { int s = 0; for (int q = 0; q < qb; ++q) { const int p = att_parts_of(q, 4 * (q + 1)); s += p > 1 ? p : 0; } return s; }
__host__ __device__ constexpr int att_tickets_from(int qb) { int s = 0; for (int q = 31; q > qb; --q) s += 2 * att_parts_of(q, 4 * (q + 1)); return s; }
constexpr int ATT_SLOTS_PER_HEAD = att_slots_upto(32), ATT_TICKETS = att_tickets_from(-1);
constexpr size_t WS_PARTB = 240 * MiB;
constexpr size_t WS_PML = WS_END;
static_assert(16 * ATT_SLOTS_PER_HEAD <= 1024 + 256 && WS_PARTB + (size_t)256 * 65536 <= 256 * MiB && WS_PML + (size_t)16 * ATT_SLOTS_PER_HEAD * 2048 <= WS_PARTB, "attention part slots");
constexpr int CW_SPL = 3072;
__device__ __forceinline__ fa::BlockRef fa_ref(Frame& F, int bh, int qb, int kb0, int khi, int mode, int pidx, int nparts, int slot0, float Bq, int rep) {
    const int b = bh >> 3, h = bh & 7; fa::BlockRef r; r.base = (GAS char*)F_ws;
    const unsigned ro = (unsigned)(((b * SEQ + qb * 256) * 1024 + h * 128) * 2), ho = (unsigned)((b * SEQ * 1024 + h * 128) * 2);
    r.qo = (unsigned)WS_Q0 + ro; r.oo = (unsigned)WS_O0 + ro; r.ko = (unsigned)WS_K0 + ho; r.vo = (unsigned)WS_V0 + ho;
    r.cbo = (unsigned)WS_CBG + (unsigned)(bh * SEQ * 4); r.P0 = qb * 256; r.kb0 = kb0; r.Bq = Bq; r.khi = khi; r.mode = mode; r.slot0 = slot0; r.pidx = pidx; r.nparts = nparts;
    r.partA = (GAS char*)F_out; r.partB = (GAS char*)(F_ws + WS_PARTB); r.pml = (GAS float*)(F_ws + WS_PML); r.cnt = (GAS unsigned*)(F_ws + WS_CTL) + CW_SPL + rep * 512 + bh * 32 + qb; return r;
}
constexpr float SKIP_LOG2 = 148.f;
constexpr int ATT_LDS_DESC = 133632 + 64;
__device__ __forceinline__ int att_slots_upto_rt(int qb) { int s = 0; for (int q = 0; q < qb; ++q) { const int p = att_parts_of(q, 4 * (q + 1)); s += p > 1 ? p : 0; } return s; }
__device__ __forceinline__ void fa_describe(Frame& F, int n, int xq, LAS float* kmax2, LAS int* desc) {
    int qb = 31, n0 = 0;
    for (; qb > 0; --qb) { const int w = 2 * att_parts_of(qb, 4 * (qb + 1)); if (n < n0 + w) break; n0 += w; }
    const int pq = att_parts_of(qb, 4 * (qb + 1)), rr = n - n0, hsel = rr >= pq ? 1 : 0, part = rr - hsel * pq;
    const int bh = hsel ? 8 + ((xq + 4) & 7) : xq, b = bh >> 3, h = bh & 7;
    const float* nq = (const float*)(F_ws + WS_NRM) + ((size_t)(b * 32 + qb) * 8 + h) * 8;
    float q2 = 0.f;
#pragma unroll
    for (int wc = 0; wc < 4; ++wc) q2 += fmaxf(nq[2 * wc], nq[2 * wc + 1]);
    const float B = sqrtf(q2 * kmax2[bh]) * 1.01f, th = 2.f * B + SKIP_LOG2;
    const float* cb = (const float*)(F_ws + WS_CBG) + (size_t)bh * SEQ;
    const float cbi = cb[qb * 256];
    const float c0 = cb[64 * F.lane + 63], c1 = cb[64 * (F.lane + 64) + 63];
    const unsigned long long m0 = __ballot(cbi - c0 <= th), m1 = __ballot(cbi - c1 <= th);
    int t = m0 ? (int)__builtin_ctzll(m0) : (m1 ? 64 + (int)__builtin_ctzll(m1) : 4 * qb);
    if (t > 4 * qb) t = 4 * qb;
    const int nt = 4 * qb + 4 - t, np = att_parts_of(qb, nt);
    int lo = 64 * t, top = qb * 256 + 256, mode = 0;
    if (part >= np) mode = 2;
    else if (np > 1) { mode = 1; const int e1 = nt - (part * nt) / np, e0 = nt - ((part + 1) * nt) / np; top = 64 * (t + e1); lo = 64 * (t + e0); }
    if (F.lane == 0) { desc[0] = bh; desc[1] = qb; desc[2] = lo; desc[5] = (int)__float_as_uint(B); desc[6] = top; desc[7] = mode; desc[8] = part; desc[9] = np; desc[10] = bh * ATT_SLOTS_PER_HEAD + att_slots_upto_rt(qb); }
}
__device__ __forceinline__ void attn_fast_phase(Frame& F, char* shm, int rep = 0) {
    LAS float* kmax2 = (LAS float*)(F.lds + ATT_LDS_DESC); LAS int* desc = (LAS int*)(F.lds + ATT_LDS_DESC + 64);
    const int total = ATT_TICKETS, xq = (int)blockIdx.x & 7;
    unsigned tpk_ = 0;
#ifdef AT_KPROBE
    if (F.tid == 0) tpk_ = (unsigned)__builtin_amdgcn_s_memrealtime();
#endif
    __syncthreads();
    if (F.tid < 64) { const int bh = F.tid >> 2, wc = F.tid & 3, b = bh >> 3, h = bh & 7; const float* nk = (const float*)(F_ws + WS_NRM) + (size_t)64 * 64;
        float m = 0.f; for (int pm = 0; pm < 32; ++pm) { const float* p = nk + (((size_t)(b * 32 + pm) * 8 + h) * 4 + wc) * 2; m = fmaxf(m, fmaxf(p[0], p[1])); }
        m += __shfl_xor(m, 1); m += __shfl_xor(m, 2); if (wc == 0) kmax2[bh] = m; }
    __syncthreads();
#ifdef AT_KPROBE
    if (F.tid == 0) F.MISC[22] += ((unsigned)__builtin_amdgcn_s_memrealtime() - tpk_) * 10u;
#endif
    gu32* ctr0 = (gu32*)(F_ws + WS_CTL) + CW_ATT + rep * 8;
    int n = (int)blockIdx.x >> 3, qsel = xq;
#ifndef AT_TPROBE
#define AT_TPROBE 0
#endif
#define AT_T0() if (AT_TPROBE && F.tid == 0) tpa_ = (unsigned)__builtin_amdgcn_s_memrealtime();
#define AT_T1(k) if (AT_TPROBE == (k) && F.tid == 0) F.MISC[22] += (unsigned)__builtin_amdgcn_s_memrealtime() - tpa_; AT_T0()
    unsigned tpa_ = 0; AT_T0()
    while (n < total) {
        if (F.wave == 0) fa_describe(F, n, qsel, kmax2, desc);
        __syncthreads();
        const int mode = __builtin_amdgcn_readfirstlane(desc[7]);
        AT_T1(1)
        if (AT_TPROBE == 4 && F.tid == 0 && mode != 2) F.MISC[22] += 100;
        if (AT_TPROBE == 5 && F.tid == 0 && mode == 2) F.MISC[22] += 100;
        if (mode != 2) {
            const fa::BlockRef cur = fa_ref(F, __builtin_amdgcn_readfirstlane(desc[0]), __builtin_amdgcn_readfirstlane(desc[1]), __builtin_amdgcn_readfirstlane(desc[2]), __builtin_amdgcn_readfirstlane(desc[6]), mode,
                                            __builtin_amdgcn_readfirstlane(desc[8]), __builtin_amdgcn_readfirstlane(desc[9]), __builtin_amdgcn_readfirstlane(desc[10]), __uint_as_float((unsigned)__builtin_amdgcn_readfirstlane(desc[5])), rep);
            fa::fa_block(cur, shm, F.tid);
        }
        AT_T1(2)
        if (F.wave == 0) { int nn = total, qs = xq;
            { int v = 0; if (F.lane == 0) v = (((int)F.G + 7 - xq) >> 3) + (int)__hip_atomic_fetch_add(ctr0 + 64 * xq, 1u, __ATOMIC_RELAXED, __HIP_MEMORY_SCOPE_AGENT);
              v = __builtin_amdgcn_readfirstlane(v); if (v < total) nn = v; }
            for (int tr = 0; tr < 6 && nn >= total; ++tr) {
                int c = 0x7fffffff;
                if (F.lane < 8 && F.lane != xq) c = (((int)F.G + 7 - F.lane) >> 3) + (int)__hip_atomic_load(ctr0 + 64 * F.lane, __ATOMIC_RELAXED, __HIP_MEMORY_SCOPE_AGENT);
                int best = c;
#pragma unroll
                for (int o = 1; o < 8; o <<= 1) { const int t = __shfl_xor(best, o); best = t < best ? t : best; }
                best = __builtin_amdgcn_readfirstlane(best);
                if (best >= total) break;
                const int q = (int)__builtin_ctzll(__ballot(c == best));
                int v = 0; if (F.lane == 0) v = (((int)F.G + 7 - q) >> 3) + (int)__hip_atomic_fetch_add(ctr0 + 64 * q, 1u, __ATOMIC_RELAXED, __HIP_MEMORY_SCOPE_AGENT);
                v = __builtin_amdgcn_readfirstlane(v); if (v < total) { nn = v; qs = q; }
            }
            if (F.lane == 0) { desc[3] = nn; desc[4] = qs; } }
        __syncthreads();
        n = __builtin_amdgcn_readfirstlane(desc[3]); qsel = __builtin_amdgcn_readfirstlane(desc[4]);
        AT_T1(3)
    }
#if ATT_TAIL_CONV
    {
#if ATT_TAIL_CONV >= 3
        constexpr int J1 = 16 * 32, J2 = 16 * 176, J3 = 44 * 32, J4 = 16 * 192, J5 = 32 * 32, J6 = ATT_TAIL_CONV == 4 ? 16 * 176 : 0, J7 = ATT_TAIL_CONV == 4 ? 44 * 32 : 0, NTK = (J1 + J2 + J3 + J4 + J5 + J6 + J7 + NWAVES - 1) / NWAVES;
#elif ATT_TAIL_CONV == 2
        constexpr int I6 = 16 * 192, I7 = 32 * 32, NTK = (I6 + I7 + NWAVES - 1) / NWAVES;
#else
        constexpr int I6 = 16 * 176, I7 = 44 * 32, NTK = (I6 + I7 + NWAVES - 1) / NWAVES;
#endif
        gu32* cctr = (gu32*)(F_ws + WS_CTL) + CW_ATT + 32;
        LAS float* scr = (LAS float*)(F.lds + RING_OFF + F.wave * 16384);
#if ATT_TAIL_CONV >= 3
#define TAILCV(LOAD, it_, V, G) do { int r = (it_); unsigned char* ws = F_ws; \
            if (r < J1) p0_matrix2<LOAD>(V, G, r, F_fox_w_out, 1024, 1024, 1024, false, (bf16*)(ws + WS_WO0), nullptr, scr, F.lane); \
            else if ((r -= J1) < J2) p0_matrix2<LOAD>(V, G, r, F_ffn_w_in, 1024, 2 * DFF, 2 * DFF, true, (bf16*)(ws + WS_WFI0), F_norm_ffn, scr, F.lane); \
            else if ((r -= J2) < J3) p0_matrix2<LOAD>(V, G, r, F_ffn_w_out, DFF, 1024, 1024, false, (bf16*)(ws + WS_WFO0), nullptr, scr, F.lane); \
            else if ((r -= J3) < J4) p0_matrix2<LOAD>(V, G, r, F_ret_w_in, 1024, 6144, 6144, false, (bf16*)(ws + WS_WRI), F_norm_mix + D, scr, F.lane); \
            else if ((r -= J4) < J5) p0_matrix2<LOAD>(V, G, r, F_ret_w_out, 2048, 1024, 1024, false, (bf16*)(ws + WS_WRO), nullptr, scr, F.lane); \
            else if ((r -= J5) < J6) p0_matrix2<LOAD>(V, G, r, F_ffn_w_in + (size_t)D * 2 * DFF, 1024, 2 * DFF, 2 * DFF, true, (bf16*)(ws + WS_WFI1), F_norm_ffn + D, scr, F.lane); \
            else if ((r -= J6) < J7) p0_matrix2<LOAD>(V, G, r, F_ffn_w_out + (size_t)DFF * D, DFF, 1024, 1024, false, (bf16*)(ws + WS_WFO1), nullptr, scr, F.lane); } while (0)
        constexpr int NIT = J1 + J2 + J3 + J4 + J5 + J6 + J7;
        f32x4 wv[8], wn[8]; float gv[8], gn[8];
        __syncthreads();
        if (F.tid == 0) desc[3] = (int)__hip_atomic_fetch_add(cctr, 1u, __ATOMIC_RELAXED, __HIP_MEMORY_SCOPE_AGENT);
        __syncthreads();
        int tk = __builtin_amdgcn_readfirstlane(desc[3]);
        if (tk < NTK && tk * NWAVES + F.wave < NIT) TAILCV(true, tk * NWAVES + F.wave, wv, gv);
        while (tk < NTK) {
            __syncthreads();
            if (F.tid == 0) desc[3] = (int)__hip_atomic_fetch_add(cctr, 1u, __ATOMIC_RELAXED, __HIP_MEMORY_SCOPE_AGENT);
            __syncthreads();
            const int tn = __builtin_amdgcn_readfirstlane(desc[3]);
            if (tn < NTK && tn * NWAVES + F.wave < NIT) TAILCV(true, tn * NWAVES + F.wave, wn, gn);
            if (tk * NWAVES + F.wave < NIT) TAILCV(false, tk * NWAVES + F.wave, wv, gv);
#pragma unroll
            for (int i = 0; i < 8; ++i) { wv[i] = wn[i]; gv[i] = gn[i]; }
            tk = tn;
        }
#undef TAILCV
#else
        for (;;) {
            __syncthreads();
            if (F.tid == 0) desc[3] = (int)__hip_atomic_fetch_add(cctr, 1u, __ATOMIC_RELAXED, __HIP_MEMORY_SCOPE_AGENT);
            __syncthreads();
            const int tk = __builtin_amdgcn_readfirstlane(desc[3]); if (tk >= NTK) break;
            const int it = tk * NWAVES + F.wave;
#if ATT_TAIL_CONV == 2
            if (it < I6) p0_matrix(it, F_ret_w_in, 1024, 6144, 6144, false, (bf16*)(F_ws + WS_WRI), F_norm_mix + D, scr, F.lane);
            else if (it < I6 + I7) p0_matrix(it - I6, F_ret_w_out, 2048, 1024, 1024, false, (bf16*)(F_ws + WS_WRO), nullptr, scr, F.lane);
#else
            if (it < I6) p0_matrix(it, F_ffn_w_in + (size_t)D * 2 * DFF, 1024, 2 * DFF, 2 * DFF, true, (bf16*)(F_ws + WS_WFI1), F_norm_ffn + D, scr, F.lane);
            else if (it < I6 + I7) p0_matrix(it - I6, F_ffn_w_out + (size_t)DFF * D, DFF, 1024, 1024, false, (bf16*)(F_ws + WS_WFO1), nullptr, scr, F.lane);
#endif
        }
#endif
    }
#endif
}

__device__ __forceinline__ void attn_ref_phase(Frame& F) {
    const bf16* Q = (const bf16*)(F_ws + WS_Q0); const bf16* K = (const bf16*)(F_ws + WS_K0); const bf16* V = (const bf16*)(F_ws + WS_V0); bf16* O = (bf16*)(F_ws + WS_O0);
    const float* LC = (const float*)(F_ws + WS_LC); const float* TT = (const float*)(F_ws + WS_TT);
    LAS float* Ks = (LAS float*)(F.lds); LAS float* Vs = (LAS float*)(F.lds + 32768); LAS float* cbs = (LAS float*)(F.lds + 65536); LAS float* Pp = (LAS float*)(F.lds + 65536 + 256);
    const int r = F.tid >> 3, part = F.tid & 7;
    const int NU = BATCH * FH * (SEQ / 64);
    for (int unit = (int)blockIdx.x; unit < NU; unit += F.G) {
        const int bh = unit & 15, qb = unit >> 4, b = bh >> 3, h = bh & 7, q0 = qb * 64;
        __syncthreads();
        if (F.tid == 0) { float s = 0.f; for (int t = 0; t < 32; ++t) { Pp[t] = s; s += TT[(b * 32 + t) * 8 + h]; } }
        float q[16], o[16]; float m = -1e30f, l = 0.f;
        { const bf16* qp = Q + (size_t)(b * SEQ + q0 + r) * D + h * FDH + part * 16; const v4u a = *(const v4u*)qp, c = *(const v4u*)(qp + 8);
          q[0] = pg8::bf_lo(a.x); q[1] = pg8::bf_hi(a.x); q[2] = pg8::bf_lo(a.y); q[3] = pg8::bf_hi(a.y); q[4] = pg8::bf_lo(a.z); q[5] = pg8::bf_hi(a.z); q[6] = pg8::bf_lo(a.w); q[7] = pg8::bf_hi(a.w);
          q[8] = pg8::bf_lo(c.x); q[9] = pg8::bf_hi(c.x); q[10] = pg8::bf_lo(c.y); q[11] = pg8::bf_hi(c.y); q[12] = pg8::bf_lo(c.z); q[13] = pg8::bf_hi(c.z); q[14] = pg8::bf_lo(c.w); q[15] = pg8::bf_hi(c.w); }
#pragma unroll
        for (int d = 0; d < 16; ++d) o[d] = 0.f;
        for (int kt = 0; kt <= qb; ++kt) {
            __syncthreads();
            { const size_t go = (size_t)(b * SEQ + kt * 64 + r) * D + h * FDH + part * 16;
              const v4u a = *(const v4u*)(K + go), c = *(const v4u*)(K + go + 8), e = *(const v4u*)(V + go), f = *(const v4u*)(V + go + 8);
              LAS float* kd = Ks + r * 128 + part * 16; LAS float* vd = Vs + r * 128 + part * 16;
              kd[0] = pg8::bf_lo(a.x); kd[1] = pg8::bf_hi(a.x); kd[2] = pg8::bf_lo(a.y); kd[3] = pg8::bf_hi(a.y); kd[4] = pg8::bf_lo(a.z); kd[5] = pg8::bf_hi(a.z); kd[6] = pg8::bf_lo(a.w); kd[7] = pg8::bf_hi(a.w);
              kd[8] = pg8::bf_lo(c.x); kd[9] = pg8::bf_hi(c.x); kd[10] = pg8::bf_lo(c.y); kd[11] = pg8::bf_hi(c.y); kd[12] = pg8::bf_lo(c.z); kd[13] = pg8::bf_hi(c.z); kd[14] = pg8::bf_lo(c.w); kd[15] = pg8::bf_hi(c.w);
              vd[0] = pg8::bf_lo(e.x); vd[1] = pg8::bf_hi(e.x); vd[2] = pg8::bf_lo(e.y); vd[3] = pg8::bf_hi(e.y); vd[4] = pg8::bf_lo(e.z); vd[5] = pg8::bf_hi(e.z); vd[6] = pg8::bf_lo(e.w); vd[7] = pg8::bf_hi(e.w);
              vd[8] = pg8::bf_lo(f.x); vd[9] = pg8::bf_hi(f.x); vd[10] = pg8::bf_lo(f.y); vd[11] = pg8::bf_hi(f.y); vd[12] = pg8::bf_lo(f.z); vd[13] = pg8::bf_hi(f.z); vd[14] = pg8::bf_lo(f.w); vd[15] = pg8::bf_hi(f.w); }
            if (F.tid < 64) { const int key = kt * 64 + F.tid; cbs[F.tid] = ((const float*)(F_ws + WS_CBG))[(size_t)bh * SEQ + key]; }
            __syncthreads();
            const int jmax = (kt == qb) ? r : 63;
            for (int j = 0; j <= jmax; ++j) {
                const LAS float* kr = Ks + j * 128 + part * 16; float dot = 0.f;
#pragma unroll
                for (int d = 0; d < 16; ++d) dot += q[d] * kr[d];
                dot += __shfl_xor(dot, 1); dot += __shfl_xor(dot, 2); dot += __shfl_xor(dot, 4);
                const float s = dot + cbs[j], mn = fmaxf(m, s), al = __builtin_amdgcn_exp2f(m - mn), p = __builtin_amdgcn_exp2f(s - mn);
                l = l * al + p; m = mn;
                const LAS float* vr = Vs + j * 128 + part * 16;
#pragma unroll
                for (int d = 0; d < 16; ++d) o[d] = o[d] * al + p * vr[d];
            }
        }
        const float il = 1.0f / l;
        v4u w0, w1; w0.x = pk2(o[0] * il, o[1] * il); w0.y = pk2(o[2] * il, o[3] * il); w0.z = pk2(o[4] * il, o[5] * il); w0.w = pk2(o[6] * il, o[7] * il);
        w1.x = pk2(o[8] * il, o[9] * il); w1.y = pk2(o[10] * il, o[11] * il); w1.z = pk2(o[12] * il, o[13] * il); w1.w = pk2(o[14] * il, o[15] * il);
        bf16* op = O + (size_t)(b * SEQ + q0 + r) * D + h * FDH + part * 16; *(v4u*)op = w0; *(v4u*)(op + 8) = w1;
    }
    __syncthreads();
}

__device__ __forceinline__ void ret_ref_phase(Frame& F) {
    const bf16* Q1 = (const bf16*)(F_ws + WS_Q1); const bf16* K1 = (const bf16*)(F_ws + WS_K1); bf16* V1 = (bf16*)(F_ws + WS_V1); float* PST = (float*)(F_ws + WS_PST);
    LAS bf16* Qs = (LAS bf16*)(F.lds); LAS bf16* Ks = (LAS bf16*)(F.lds + 32768); LAS float* Sm = (LAS float*)(F.lds + 65536); LAS float* St = (LAS float*)(F.lds + 81920);
    LAS float* Vs = (LAS float*)(F.lds + 114688); LAS float* pw = (LAS float*)(F.lds + 122880);
    for (int unit = (int)blockIdx.x; unit < BATCH * RH * 16; unit += F.G) {
        const int b = unit >> 6, h = (unit >> 4) & 3, vs = unit & 15, v0 = vs * 32;
        const float lg = logf(1.0f - exp2f(-5.0f - (float)h));
        __syncthreads();
        for (int i = F.tid; i < 256 * 32; i += NWAVES * 64) St[i] = 0.f;
        if (F.tid <= 64) pw[F.tid] = expf(lg * (float)F.tid);
        for (int n = 0; n < NCH; ++n) {
            const size_t t0 = (size_t)b * SEQ + (size_t)n * CH;
            __syncthreads();
#pragma unroll
            for (int i = 0; i < 4; ++i) { const int p = F.tid + 512 * i, row = p >> 5, c = p & 31;
                *(LAS v4u*)(Qs + row * 256 + c * 8) = *(const v4u*)(Q1 + (t0 + row) * 1024 + h * 256 + c * 8);
                *(LAS v4u*)(Ks + row * 256 + c * 8) = *(const v4u*)(K1 + (t0 + row) * 1024 + h * 256 + c * 8); }
            { const int idx = F.tid * 4, row = idx >> 5, c = idx & 31; const unsigned long long vv = *(const unsigned long long*)(V1 + (t0 + row) * 2048 + h * 512 + v0 + c);
              const unsigned lo = (unsigned)vv, hi = (unsigned)(vv >> 32); LAS float* d = Vs + row * 32 + c; d[0] = pg8::bf_lo(lo); d[1] = pg8::bf_hi(lo); d[2] = pg8::bf_lo(hi); d[3] = pg8::bf_hi(hi); }
            __syncthreads();
            {
                const int i = F.tid >> 3, j0 = (F.tid & 7) * 8; float a[8];
#pragma unroll
                for (int jj = 0; jj < 8; ++jj) a[jj] = 0.f;
                for (int d = 0; d < 256; d += 2) { const unsigned qw = *(const LAS unsigned*)(Qs + i * 256 + d); const float qa = pg8::bf_lo(qw), qb = pg8::bf_hi(qw);
#pragma unroll
                    for (int jj = 0; jj < 8; ++jj) { const unsigned kw = *(const LAS unsigned*)(Ks + (j0 + jj) * 256 + d); a[jj] += qa * pg8::bf_lo(kw) + qb * pg8::bf_hi(kw); } }
#pragma unroll
                for (int jj = 0; jj < 8; ++jj) { const int dj = i - (j0 + jj); Sm[i * 64 + j0 + jj] = a[jj] * pw[dj < 0 ? -dj : dj]; }
            }
            __syncthreads();
            {
                const int i = F.tid >> 3, vv0 = (F.tid & 7) * 4; float y[4] = {0.f, 0.f, 0.f, 0.f};
                for (int d = 0; d < 256; d += 2) { const unsigned qw = *(const LAS unsigned*)(Qs + i * 256 + d); const float qa = pg8::bf_lo(qw), qb = pg8::bf_hi(qw);
                    const f32x4 s0 = *(const LAS f32x4*)(St + d * 32 + vv0), s1 = *(const LAS f32x4*)(St + (d + 1) * 32 + vv0);
                    y[0] += qa * s0.x + qb * s1.x; y[1] += qa * s0.y + qb * s1.y; y[2] += qa * s0.z + qb * s1.z; y[3] += qa * s0.w + qb * s1.w; }
                const float qd = pw[i + 1];
#pragma unroll
                for (int e = 0; e < 4; ++e) y[e] *= qd;
                for (int j = 0; j < 64; ++j) { const float s = Sm[i * 64 + j]; const f32x4 vv = *(const LAS f32x4*)(Vs + j * 32 + vv0); y[0] += s * vv.x; y[1] += s * vv.y; y[2] += s * vv.z; y[3] += s * vv.w; }
                float ps = (y[0] + y[1]) + (y[2] + y[3]), pq = (y[0] * y[0] + y[1] * y[1]) + (y[2] * y[2] + y[3] * y[3]);
                ps += __shfl_xor(ps, 1); pq += __shfl_xor(pq, 1); ps += __shfl_xor(ps, 2); pq += __shfl_xor(pq, 2); ps += __shfl_xor(ps, 4); pq += __shfl_xor(pq, 4);
                if ((F.tid & 7) == 0) { f32x2 st; st.x = ps; st.y = pq; *(f32x2*)(PST + (((t0 + i) * 4 + h) * 16 + vs) * 2) = st; }
                *(unsigned long long*)(V1 + (t0 + i) * 2048 + h * 512 + v0 + vv0) = (unsigned long long)pk2(y[0], y[1]) | ((unsigned long long)pk2(y[2], y[3]) << 32);
            }
            __syncthreads();
            {
                const int d = F.tid >> 1, vv0 = (F.tid & 1) * 16; float a[16]; const float cd = pw[64];
#pragma unroll
                for (int e = 0; e < 16; ++e) a[e] = St[d * 32 + vv0 + e] * cd;
                for (int j = 0; j < 64; ++j) { const float kd = pg8::bf_lo((unsigned)Ks[j * 256 + d]) * pw[63 - j];
#pragma unroll
                    for (int e = 0; e < 16; e += 4) { const f32x4 vv = *(const LAS f32x4*)(Vs + j * 32 + vv0 + e); a[e] += kd * vv.x; a[e + 1] += kd * vv.y; a[e + 2] += kd * vv.z; a[e + 3] += kd * vv.w; } }
#pragma unroll
                for (int e = 0; e < 16; ++e) St[d * 32 + vv0 + e] = a[e];
            }
        }
    }
    __syncthreads();
}


__device__ __forceinline__ rtn::Ptrs rt_ptrs(Frame& F) {
    rtn::Ptrs P; GAS char* w = (GAS char*)F_ws;
    P.Q = w + WS_Q1; P.K = w + WS_K1; P.V = w + WS_V1; P.L = (GAS char*)F_out; P.PST = (GAS float*)(w + WS_PST); return P;
}
#ifndef RT_PAIR
#define RT_PAIR 1
#endif
__device__ __forceinline__ void ret_pass1_phase(Frame& F) {
    const rtn::Ptrs P = rt_ptrs(F);
#if ATT_TAIL_CONV != 1 && ATT_TAIL_CONV != 4
    { const int nit = 8 * (rtn::NG - 1) * 2; p0_late_weights(F, F.G > nit + 16 ? nit : 0); }
#endif
#if RT_PAIR == 2
    for (int it = (int)blockIdx.x; it < 256; it += F.G) { const int x = it & 7, j = it >> 3, half = j & 1, h = (j >> 1) & 3, g = 4 * (x & 3) + (j >> 3), bh = (x >> 2) * 4 + h;
        if (g < rtn::NG - 1) rtn::run_item<false>(P, bh, half, g, 0u, F.wave); }
#else
    for (int it = (int)blockIdx.x; it < 8 * (rtn::NG - 1) * 2; it += F.G) { const int half = RT_PAIR ? (it >> 3) & 1 : it & 1, r = RT_PAIR ? (it & 7) | ((it >> 4) << 3) : it >> 1, g = r % (rtn::NG - 1), bh = r / (rtn::NG - 1); rtn::run_item<false>(P, bh, half, g, 0u, F.wave); }
#endif
}
__device__ __forceinline__ void ret_scan_phase(Frame& F) {
    GAS char* L = (GAS char*)F_out;
    for (int i = (int)blockIdx.x * (NWAVES * 64) + F.tid; i < 16 * 8192; i += F.G * (NWAVES * 64)) {
        const int c = i & 8191, bhh = i >> 13, half = bhh & 1, bh = bhh >> 1, h = bh & 3;
        const float lg = __logf(1.0f - __builtin_amdgcn_exp2f(-5.0f - (float)h)), cdg = __expf(lg * (float)(rtn::RG * 64));
        GAS char* p = L + ((size_t)(bh * (rtn::NG - 1)) * 2 + half) * 131072 + (size_t)c * 16;
        pg8::u32x4 w[rtn::NG - 1];
#pragma unroll
        for (int gp = 0; gp < rtn::NG - 1; ++gp) w[gp] = *(const GAS pg8::u32x4*)(p + (size_t)gp * 262144);
        float x[8] = {0.f, 0.f, 0.f, 0.f, 0.f, 0.f, 0.f, 0.f};
#pragma unroll
        for (int gp = 0; gp < rtn::NG - 1; ++gp) {
            x[0] = x[0] * cdg + pg8::bf_lo(w[gp].x); x[1] = x[1] * cdg + pg8::bf_hi(w[gp].x); x[2] = x[2] * cdg + pg8::bf_lo(w[gp].y); x[3] = x[3] * cdg + pg8::bf_hi(w[gp].y);
            x[4] = x[4] * cdg + pg8::bf_lo(w[gp].z); x[5] = x[5] * cdg + pg8::bf_hi(w[gp].z); x[6] = x[6] * cdg + pg8::bf_lo(w[gp].w); x[7] = x[7] * cdg + pg8::bf_hi(w[gp].w);
            if (gp > 0) { pg8::u32x4 o; o.x = pg8::cvt_pk_bf16(x[0], x[1]); o.y = pg8::cvt_pk_bf16(x[2], x[3]); o.z = pg8::cvt_pk_bf16(x[4], x[5]); o.w = pg8::cvt_pk_bf16(x[6], x[7]); *(GAS pg8::u32x4*)(p + (size_t)gp * 262144) = o; }
        }
    }
}
__device__ __forceinline__ void ret_pass2_phase(Frame& F) {
    const rtn::Ptrs P = rt_ptrs(F);
#if RT_PAIR == 2
    for (int it = (int)blockIdx.x; it < 256; it += F.G) { const int x = it & 7, j = it >> 3, half = j & 1, h = (j >> 1) & 3, g = 4 * (x & 3) + (j >> 3), bh = (x >> 2) * 4 + h; rtn::run_item<true>(P, bh, half, g, 0u, F.wave); }
#else
    for (int it = (int)blockIdx.x; it < 8 * rtn::NG * 2; it += F.G) { const int half = RT_PAIR ? (it >> 3) & 1 : it & 1, r = RT_PAIR ? (it & 7) | ((it >> 4) << 3) : it >> 1, g = r % rtn::NG, bh = r / rtn::NG; rtn::run_item<true>(P, bh, half, g, 0u, F.wave); }
#endif
}

__device__ __forceinline__ void final_norm_phase(Frame& F) {
    const float* SSQ = (const float*)(F_ws + WS_SSQ); const bf16* XB = (const bf16*)(F_ws + WS_XB);
    const int gw = F.vcu * NWAVES + F.wave, NGW = F.G * NWAVES;
    f32x4 gv[4];
#pragma unroll
    for (int j = 0; j < 4; ++j) gv[j] = ((const f32x4*)F_final_norm)[F.lane + 64 * j];
    for (int row0 = gw; row0 < M; row0 += 8 * NGW) {
        float sq[8]; unsigned long long w[8][4];
#pragma unroll
        for (int k = 0; k < 8; ++k) { const int row = row0 + k * NGW;
            if (row < M) { sq[k] = (F.lane < 16) ? SSQ[(size_t)row * 16 + F.lane] : 0.f; const GAS unsigned long long* xr = (const GAS unsigned long long*)(XB + (size_t)row * D) + F.lane;
#pragma unroll
                for (int j = 0; j < 4; ++j) w[k][j] = xr[64 * j]; } }
#pragma unroll
        for (int k = 0; k < 8; ++k) { const int row = row0 + k * NGW;
            if (row < M) { const float s = wave_sum(sq[k]); const float rstd = 1.0f / sqrtf(s * (1.f / D) + EPS);
                GAS f32x4* orow = (GAS f32x4*)(F_out + (size_t)row * D) + F.lane;
#pragma unroll
                for (int j = 0; j < 4; ++j) { const unsigned lo = (unsigned)w[k][j], hi = (unsigned)(w[k][j] >> 32); f32x4 v;
                    v.x = pg8::bf_lo(lo); v.y = pg8::bf_hi(lo); v.z = pg8::bf_lo(hi); v.w = pg8::bf_hi(hi); orow[64 * j] = v * rstd * gv[j]; } } }
    }
}
#ifndef MK_N_LAUNCHES
#define MK_N_LAUNCHES 1
#endif
constexpr int N_LAUNCHES = MK_N_LAUNCHES;
#ifndef REP_PHASE
#define REP_PHASE -1
#endif
#define REPS(k) ((k) == REP_PHASE ? 2 : 1)
#ifndef FAST_ATTN
#define FAST_ATTN 0
#endif
#ifndef FAST_RET
#define FAST_RET 0
#endif
__device__ __forceinline__ bool relaunder(Frame& F) { int t = F.wave * 64 + hw_lane_id(); asm volatile("" : "+v"(t));     F.tid = t; F.lane = t & 63; F.wave = __builtin_amdgcn_readfirstlane(t >> 6); const __attribute__((address_space(4))) Args* a = F.ap; asm volatile("" : "+s"(a)); F.ap = a; return true; }
__global__ void __launch_bounds__(NWAVES * 64, 2) fox_ret_fwd(Args args) {
    extern __shared__ __attribute__((aligned(16))) unsigned char lds[];
    Frame F;
    F.lds = (LAS unsigned char*)lds;
    F.MISC = (volatile LAS unsigned*)(F.lds + MISC_OFF);
    F.tid = threadIdx.x; F.lane = F.tid & 63; F.wave = __builtin_amdgcn_readfirstlane(F.tid >> 6);
    F.G = gridDim.x; { const int bx = blockIdx.x; F.vcu = (F.G % 8 == 0) ? (bx % 8) * (F.G / 8) + bx / 8 : bx; }
    F.ap = (const __attribute__((address_space(4))) Args*)__builtin_amdgcn_kernarg_segment_ptr();
    for (int u = F.tid; u < (LDS_BYTES - LDSCTL_OFF) / 4; u += NWAVES * 64) ((LAS unsigned*)(F.lds + LDSCTL_OFF))[u] = 0u;
    __syncthreads();
    XcdBarrier bar; bar.bar = (unsigned*)(F_ws + WS_CTL) + CW_BAR; bar.x = 0; bar.st = nullptr;
    if (N_LAUNCHES == 1) bar = xcd_barrier_post((unsigned*)(F_ws + WS_CTL) + CW_BAR, F.MISC + 8);
#define GRID_BAR() do { if (N_LAUNCHES == 1) { xcd_barrier(bar); if (REP_PHASE == -2) xcd_barrier(bar); } } while (0)
    const int lo = F.ap->ph_lo, hi = F.ap->ph_hi;
#define IN(k) (lo <= (k) && (k) < hi && relaunder(F))
#define BOTH(k) (IN(k) && IN((k) + 1))
#define ws F_ws
#define XB ((pg8::bf16_t*)(F_ws + WS_XB))
#define SSQ ((float*)(F_ws + WS_SSQ))
    const LAS float* const tab = (const LAS float*)(F.lds + TAB_OFF);

#ifndef FUSE_FINAL
#define FUSE_FINAL 0
#endif
#ifndef TPROBE
#define TPROBE -1
#endif
#define TP(k) if (TPROBE == (k) && F.tid == 0) F.MISC[21] = (unsigned)__builtin_amdgcn_s_memrealtime(); if (TPROBE == 200 + (k) && F.tid == 0) F.MISC[20] = (unsigned)__builtin_amdgcn_s_memrealtime();
#define TPE(k) if (TPROBE == 200 + (k) && F.tid == 0) F.MISC[21] = (unsigned)__builtin_amdgcn_s_memrealtime();
    if (TPROBE >= 0 && F.tid == 0) F.MISC[20] = (unsigned)__builtin_amdgcn_s_memrealtime();
#define RUN_PHASE(k, BODY) TP(k) if (IN(k)) { BODY; TPE(k) if (REP_PHASE == (k)) { GRID_BAR(); relaunder(F); BODY; } if (BOTH(k)) GRID_BAR(); }
#define RUN_PHASE2(k, BODY, BODY2) TP(k) if (IN(k)) { BODY; TPE(k) if (REP_PHASE == (k) || REP_PHASE == 100 + (k) || REP_PHASE == 200 + (k)) { GRID_BAR(); relaunder(F); BODY2; } if (BOTH(k)) GRID_BAR(); }
#define GEMM_PHASE(EPI, Aptr, Bptr, N_, K_, PRE, ...) do { \
        pg8::Gemm g{(const pg8::bf16_t*)(Aptr), (const pg8::bf16_t*)(Bptr), M, (N_), (K_)}; pg8::StaticOrder S; S.init(M, (N_), F.G, (int)blockIdx.x); \
        PRE; pg8::EPI E{__VA_ARGS__}; \
        pg8::gemm_phase<pg8::EPI, pg8::StaticOrder, true, true>(F.lds + RING_OFF, g, S, E, F.wave); } while (0)
#define GEMM_PHASE_HOT(EPI, Aptr, Bptr, N_, K_, PRE, ...) do { \
        pg8::Gemm g{(const pg8::bf16_t*)(Aptr), (const pg8::bf16_t*)(Bptr), M, (N_), (K_)}; pg8::StaticOrderHot S; S.init(M, (N_), F.G, (int)blockIdx.x); \
        PRE; pg8::EPI E{__VA_ARGS__}; \
        pg8::gemm_phase<pg8::EPI, pg8::StaticOrderHot, true, true>(F.lds + RING_OFF, g, S, E, F.wave); } while (0)
    RUN_PHASE(0, p0_prologue(F))
    RUN_PHASE(1, GEMM_PHASE(EpiQKV0, XB, ws + WS_WQKV0, 3072, 1024, cbg_phase(F); fill_rstd_tab(F, S), (pg8::bf16_t*)(ws + WS_Q0), tab, QSCALE, (float*)(ws + WS_NRM)))
#if FAST_ATTN
    RUN_PHASE2(2, attn_fast_phase(F, (char*)lds), attn_fast_phase(F, (char*)lds, 1))
#else
    RUN_PHASE(2, attn_ref_phase(F))
#endif
    RUN_PHASE2(3, GEMM_PHASE(EpiRes, ws + WS_O0, ws + WS_WO0, 1024, 1024, (void)0, XB, SSQ), GEMM_PHASE(EpiRes, ws + WS_O0, ws + WS_WO0, 1024, 1024, (void)0, (pg8::bf16_t*)F_out, (float*)F_out + 8388608))
#if REP_PHASE == 104
    RUN_PHASE2(4, GEMM_PHASE(EpiSwiGLU, XB, ws + WS_WFI0, 2 * DFF, 1024, fill_rstd_tab(F, S), (pg8::bf16_t*)(ws + WS_HID), tab), GEMM_PHASE(EpiNull, XB, ws + WS_WFI0, 2 * DFF, 1024, (void)0, 0))
#else
    RUN_PHASE(4, GEMM_PHASE(EpiSwiGLU, XB, ws + WS_WFI0, 2 * DFF, 1024, fill_rstd_tab(F, S), (pg8::bf16_t*)(ws + WS_HID), tab))
#endif
#if REP_PHASE == 205
    RUN_PHASE2(5, GEMM_PHASE(EpiRes, ws + WS_HID, ws + WS_WFO0, 1024, DFF, (void)0, XB, SSQ), GEMM_PHASE_HOT(EpiNull, ws + WS_HID, ws + WS_WFO0, 1024, DFF, (void)0, 0))
#elif REP_PHASE == 105
    RUN_PHASE2(5, GEMM_PHASE(EpiRes, ws + WS_HID, ws + WS_WFO0, 1024, DFF, (void)0, XB, SSQ), GEMM_PHASE(EpiNull, ws + WS_HID, ws + WS_WFO0, 1024, DFF, (void)0, 0))
#else
    RUN_PHASE2(5, GEMM_PHASE(EpiRes, ws + WS_HID, ws + WS_WFO0, 1024, DFF, (void)0, XB, SSQ), GEMM_PHASE(EpiRes, ws + WS_HID, ws + WS_WFO0, 1024, DFF, (void)0, (pg8::bf16_t*)F_out, (float*)F_out + 8388608))
#endif
    RUN_PHASE(6, GEMM_PHASE(EpiRet, XB, ws + WS_WRI, 4096, 1024, fill_rstd_tab(F, S), (pg8::bf16_t*)(ws + WS_Q1), (pg8::bf16_t*)(ws + WS_K1), (pg8::bf16_t*)(ws + WS_V1), (const float*)(ws + WS_ROPE), tab))
#if FAST_RET
    RUN_PHASE(7, ret_pass1_phase(F))
    RUN_PHASE(8, ret_scan_phase(F))
    RUN_PHASE(9, ret_pass2_phase(F))
#else
    RUN_PHASE(7, (void)0)
    RUN_PHASE(8, (void)0)
    RUN_PHASE(9, ret_ref_phase(F))
#endif
#if REP_PHASE == 110
    RUN_PHASE2(10, GEMM_PHASE(EpiGate, XB, (const pg8::bf16_t*)(ws + WS_WRI) + (size_t)4096 * 1024, 2048, 1024, fill_rstd_tab(F, S); fill_gate_tab(F, S), (pg8::bf16_t*)(ws + WS_V1), tab, (const LAS pg8::f32x2*)(F.lds + STAB_OFF)), GEMM_PHASE(EpiNull, XB, (const pg8::bf16_t*)(ws + WS_WRI) + (size_t)4096 * 1024, 2048, 1024, (void)0, 0))
#else
    RUN_PHASE(10, GEMM_PHASE(EpiGate, XB, (const pg8::bf16_t*)(ws + WS_WRI) + (size_t)4096 * 1024, 2048, 1024, fill_rstd_tab(F, S); fill_gate_tab(F, S), (pg8::bf16_t*)(ws + WS_V1), tab, (const LAS pg8::f32x2*)(F.lds + STAB_OFF)))
#endif
    RUN_PHASE2(11, GEMM_PHASE(EpiRes, ws + WS_V1, ws + WS_WRO, 1024, 2048, (void)0, XB, SSQ), GEMM_PHASE(EpiRes, ws + WS_V1, ws + WS_WRO, 1024, 2048, (void)0, (pg8::bf16_t*)F_out, (float*)F_out + 8388608))
    RUN_PHASE(12, GEMM_PHASE(EpiSwiGLU, XB, ws + WS_WFI1, 2 * DFF, 1024, fill_rstd_tab(F, S), (pg8::bf16_t*)(ws + WS_HID), tab))
#if FUSE_FINAL
    RUN_PHASE(13, GEMM_PHASE(EpiResFinal, ws + WS_HID, ws + WS_WFO1, 1024, DFF, (void)0, XB, SSQ, F_out, F_final_norm, (unsigned*)(F_ws + WS_CTL) + CW_FIN))
    TP(14)
#else
    RUN_PHASE2(13, GEMM_PHASE(EpiRes, ws + WS_HID, ws + WS_WFO1, 1024, DFF, (void)0, XB, SSQ), GEMM_PHASE(EpiRes, ws + WS_HID, ws + WS_WFO1, 1024, DFF, (void)0, (pg8::bf16_t*)F_out, (float*)F_out + 8388608))
    TP(14) if (IN(14)) final_norm_phase(F);
#endif
    TP(15)
#ifndef PROBE_WG
#define PROBE_WG 0
#endif
    if (TPROBE >= 0 && blockIdx.x == PROBE_WG && F.tid == 0) { const unsigned d = (TPROBE == 100) ? F.MISC[22] : F.MISC[21] - F.MISC[20], t0 = (unsigned)__builtin_amdgcn_s_memrealtime();
        while ((unsigned)__builtin_amdgcn_s_memrealtime() - t0 < d) __builtin_amdgcn_s_sleep(8); }
#undef RUN_PHASE
#undef RUN_PHASE2
#undef GEMM_PHASE
#undef IN
#undef ws
#undef XB
#undef SSQ
#undef BOTH
#undef GRID_BAR
}

extern "C" void kernel_launch(void* const* d_in, const int* in_sizes, int n_in, void* d_out, int out_size, void* d_ws, size_t ws_size, hipStream_t stream) {
    static int grid = 0;
    if (grid == 0) {
        if (n_in != 11 || in_sizes[0] != M * D || out_size != M * D || ws_size < ((size_t)256 << 20)) { fprintf(stderr, "kernel_launch: shape/workspace mismatch (n_in %d, in0 %d, out %d, ws %zu, need %zu)\n", n_in, n_in > 0 ? in_sizes[0] : -1, out_size, ws_size, (size_t)256 << 20); grid = -1; return; }
        int dev = 0, cus = 0, per_cu = 0;
        if (hipGetDevice(&dev) != hipSuccess || hipDeviceGetAttribute(&cus, hipDeviceAttributeMultiprocessorCount, dev) != hipSuccess) { fprintf(stderr, "kernel_launch: device query failed\n"); grid = -1; return; }
        if (hipFuncSetAttribute((const void*)fox_ret_fwd, hipFuncAttributeMaxDynamicSharedMemorySize, LDS_BYTES) != hipSuccess) { fprintf(stderr, "kernel_launch: hipFuncSetAttribute failed\n"); grid = -1; return; }
        if (hipOccupancyMaxActiveBlocksPerMultiprocessor(&per_cu, (const void*)fox_ret_fwd, NWAVES * 64, LDS_BYTES) != hipSuccess || per_cu < 1) { fprintf(stderr, "kernel_launch: occupancy query reports %d workgroups per CU\n", per_cu); per_cu = 1; }
        (void)hipGetLastError();
        grid = cus;
        if (grid > 256) grid = 256;
    }
    if (grid < 0) return;
    if (hipMemsetAsync((char*)d_ws + WS_CTL, 0, CTL_ZERO_BYTES, stream) != hipSuccess) { fprintf(stderr, "kernel_launch: hipMemsetAsync failed\n"); return; }
    Args a{};
    for (int i = 0; i < 11; ++i) a.in[i] = (const float*)d_in[i];
    a.out = (float*)d_out; a.wsp = (unsigned char*)d_ws;
    for (int li = 0; li < N_LAUNCHES; ++li) {
        a.ph_lo = (N_LAUNCHES == 1) ? 0 : li; a.ph_hi = (N_LAUNCHES == 1) ? NPHASE : li + 1; a.li = li;
        hipLaunchKernelGGL(fox_ret_fwd, dim3(grid), dim3(NWAVES * 64), LDS_BYTES, stream, a);
        const hipError_t le = hipPeekAtLastError();
        if (le != hipSuccess) { fprintf(stderr, "kernel_launch: launch %d failed: %s\n", li, hipGetErrorName(le)); break; }
    }
}
```
